# Optimizing an MI355X kernel written in HIP

```python
import jax, jax.numpy as jnp
from jax import lax
import numpy as np

D_MODEL = 1024
BATCH = 16
SEQ = 2048
DEPTH = 1

CHUNK = 64
LEFT_CHUNKS = 8
BAND = (LEFT_CHUNKS + 1) * CHUNK
REL_CLIP = 128
REL_TABLE = CHUNK + REL_CLIP

RWKV_HEAD_DIM = 64
RWKV_WIDTH = D_MODEL
RWKV_HEADS = RWKV_WIDTH // RWKV_HEAD_DIM
DECAY_LORA = 64
ICLR_LORA = 64
GATE_LORA = 160
RWKV_IN = 3 * RWKV_WIDTH + DECAY_LORA + ICLR_LORA + GATE_LORA

ATT_HEAD_DIM = 64
ATT_WIDTH = D_MODEL
ATT_HEADS = ATT_WIDTH // ATT_HEAD_DIM

IN_WIDTH = RWKV_IN + 3 * ATT_WIDTH + 2 * D_MODEL

MEM_TOKENS = 256
MEM_HEADS = 4
MEM_WIDTH = D_MODEL // 2
MEM_HEAD_DIM = MEM_WIDTH // MEM_HEADS

FFN_HIDDEN = ((8 * D_MODEL) // 3 + 255) // 256 * 256

NORM_EPS = 1e-6
GROUP_NORM_EPS = 64e-5
MASK_VALUE = -1e30

kernel_name = "hybrid_rwkv7_chunkattn_gated_block"


def rms_norm(x, gain):
    xf = x.astype(jnp.float32)
    y = xf * lax.rsqrt(jnp.mean(xf * xf, axis=-1, keepdims=True) + NORM_EPS)
    return (y * gain.astype(jnp.float32)).astype(x.dtype)


def token_shift(p):
    return jnp.pad(p, ((0, 0), (1, 0), (0, 0)))[:, :-1]


def wkv7_scan(r, decay, k, v, kk, a):
    B, S, H, N = r.shape

    def step(state, inp):
        r_t, w_t, k_t, v_t, kk_t, a_t = inp
        sa = jnp.einsum('bhvk,bhk->bhv', state, kk_t)
        state = (state * w_t[:, :, None, :]
                 - sa[..., None] * (kk_t * a_t)[:, :, None, :]
                 + v_t[..., None] * k_t[:, :, None, :])
        return state, jnp.einsum('bhvk,bhk->bhv', state, r_t)

    xs = tuple(jnp.swapaxes(t, 0, 1) for t in (r, decay, k, v, kk, a))
    s0 = jnp.zeros((B, H, N, N), jnp.float32)
    _, ys = lax.scan(step, s0, xs)
    return jnp.swapaxes(ys, 0, 1)


def rwkv7_time_mix(p, shift_mix, decay_base, decay_up, iclr_base, iclr_up, gate_up,
                   key_norm_scale, key_iclr_scale, bonus_scale, lnx_w, lnx_b):
    B, S, _ = p.shape
    f32 = jnp.float32
    z = p + (token_shift(p) - p) * shift_mix
    W = RWKV_WIDTH
    r, k, v, zw, za, zg = jnp.split(
        z, [W, 2 * W, 3 * W, 3 * W + DECAY_LORA, 3 * W + DECAY_LORA + ICLR_LORA], axis=-1)
    w_log = -jax.nn.softplus(-(decay_base + jnp.tanh(zw) @ decay_up)) - 0.5
    decay = jnp.exp(-jnp.exp(w_log.astype(f32)))
    a = jax.nn.sigmoid(iclr_base + za @ iclr_up)
    g = jax.nn.sigmoid(zg) @ gate_up

    def heads(t):
        return t.astype(f32).reshape(B, S, RWKV_HEADS, RWKV_HEAD_DIM)

    kk = heads(k * key_norm_scale)
    kk = kk * lax.rsqrt(jnp.maximum(jnp.sum(kk * kk, axis=-1, keepdims=True), 1e-24))
    k = k * (1.0 + (a - 1.0) * key_iclr_scale)
    rh, kh, vh, ah = heads(r), heads(k), heads(v), heads(a)
    y = wkv7_scan(rh, heads(decay), kh, vh, kk, ah)
    mu = jnp.mean(y, axis=-1, keepdims=True)
    var = jnp.mean(jnp.square(y - mu), axis=-1, keepdims=True)
    y = ((y - mu) * lax.rsqrt(var + GROUP_NORM_EPS)).reshape(B, S, W)
    y = y * lnx_w.astype(f32) + lnx_b.astype(f32)
    bonus = jnp.sum(rh * kh * bonus_scale.astype(f32), axis=-1, keepdims=True) * vh
    out = (y + bonus.reshape(B, S, W)) * g.astype(f32)
    return out.astype(p.dtype)


def chunk_attention(q, k, v, rel_bias):
    B, S, _ = q.shape
    n_chunks = S // CHUNK
    pad = LEFT_CHUNKS * CHUNK
    q = q.reshape(B, S, ATT_HEADS, ATT_HEAD_DIM)
    k_pad = jnp.pad(k.reshape(B, S, ATT_HEADS, ATT_HEAD_DIM), ((0, 0), (pad, 0), (0, 0), (0, 0)))
    v_pad = jnp.pad(v.reshape(B, S, ATT_HEADS, ATT_HEAD_DIM), ((0, 0), (pad, 0), (0, 0), (0, 0)))
    dist = jnp.arange(CHUNK)[:, None] - jnp.arange(BAND)[None, :] + pad
    idx = jnp.minimum(dist, REL_CLIP) + (CHUNK - 1)
    bias = rel_bias.astype(jnp.float32)[:, idx]
    scale = ATT_HEAD_DIM ** -0.5

    def one_chunk(c):
        start = c * CHUNK
        qc = lax.dynamic_slice_in_dim(q, start, CHUNK, axis=1)
        kc = lax.dynamic_slice_in_dim(k_pad, start, BAND, axis=1)
        vc = lax.dynamic_slice_in_dim(v_pad, start, BAND, axis=1)
        s = jnp.einsum('bqhd,bkhd->bhqk', qc, kc).astype(jnp.float32) * scale + bias
        valid = (start - pad + jnp.arange(BAND)) >= 0
        s = jnp.where(valid[None, None, None, :], s, MASK_VALUE)
        pr = jax.nn.softmax(s, axis=-1).astype(vc.dtype)
        return jnp.einsum('bhqk,bkhd->bqhd', pr, vc)

    out = lax.map(one_chunk, jnp.arange(n_chunks))
    return jnp.transpose(out, (1, 0, 2, 3, 4)).reshape(B, S, ATT_WIDTH)


def memory_cross_attention(h, mem_n, w_q, w_kv, w_o):
    B, S, _ = h.shape
    M = mem_n.shape[1]
    q = (h @ w_q).reshape(B, S, MEM_HEADS, MEM_HEAD_DIM)
    k, v = jnp.split(mem_n @ w_kv, 2, axis=-1)
    k = k.reshape(B, M, MEM_HEADS, MEM_HEAD_DIM)
    v = v.reshape(B, M, MEM_HEADS, MEM_HEAD_DIM)
    s = jnp.einsum('bshd,bmhd->bhsm', q, k).astype(jnp.float32) * (MEM_HEAD_DIM ** -0.5)
    pr = jax.nn.softmax(s, axis=-1).astype(v.dtype)
    o = jnp.einsum('bhsm,bmhd->bshd', pr, v).reshape(B, S, MEM_WIDTH)
    return o @ w_o


def swiglu_ffn(h, w_in, w_out):
    gate, up = jnp.split(h @ w_in, 2, axis=-1)
    return (jax.nn.silu(gate) * up) @ w_out


def setup_inputs(seed: int = 0) -> dict:
    key = jax.random.key(seed)
    ks = iter(jax.random.split(key, 48))

    def nrm(shape, scale):
        return jax.random.normal(next(ks), shape, jnp.float32) * scale

    def gain(width=D_MODEL):
        return 1.0 + nrm((DEPTH, width), 0.02)

    L = DEPTH
    return {
        "x": nrm((BATCH, SEQ, D_MODEL), 1.0),
        "mem": nrm((BATCH, MEM_TOKENS, D_MODEL), 1.0),
        "g_pre_mix": gain(),
        "g_post_mix": gain(),
        "w_in": nrm((L, D_MODEL, IN_WIDTH), D_MODEL ** -0.5),
        "shift_mix": jax.random.uniform(next(ks), (L, RWKV_IN), jnp.float32),
        "decay_base": jax.random.uniform(next(ks), (L, RWKV_WIDTH), jnp.float32, -6.0, -1.0),
        "decay_up": nrm((L, DECAY_LORA, RWKV_WIDTH), DECAY_LORA ** -0.5),
        "iclr_base": nrm((L, RWKV_WIDTH), 0.5),
        "iclr_up": nrm((L, ICLR_LORA, RWKV_WIDTH), ICLR_LORA ** -0.5),
        "gate_up": nrm((L, GATE_LORA, RWKV_WIDTH), GATE_LORA ** -0.5),
        "key_norm_scale": 0.85 + nrm((L, RWKV_WIDTH), 0.02),
        "key_iclr_scale": 1.0 + nrm((L, RWKV_WIDTH), 0.02),
        "bonus_scale": nrm((L, RWKV_HEADS, RWKV_HEAD_DIM), 0.1),
        "lnx_w": gain(RWKV_WIDTH),
        "lnx_b": nrm((L, RWKV_WIDTH), 0.02),
        "rel_bias": nrm((L, ATT_HEADS, REL_TABLE), 0.1),
        "w_branch_a": nrm((L, RWKV_WIDTH, D_MODEL), RWKV_WIDTH ** -0.5),
        "w_branch_b": nrm((L, ATT_WIDTH, D_MODEL), ATT_WIDTH ** -0.5),
        "w_out": nrm((L, D_MODEL, D_MODEL), D_MODEL ** -0.5),
        "g_pre_cross": gain(),
        "g_post_cross": gain(),
        "g_mem": gain(),
        "w_q_mem": nrm((L, D_MODEL, MEM_WIDTH), D_MODEL ** -0.5),
        "w_kv_mem": nrm((L, D_MODEL, 2 * MEM_WIDTH), D_MODEL ** -0.5),
        "w_o_mem": nrm((L, MEM_WIDTH, D_MODEL), MEM_WIDTH ** -0.5),
        "g_pre_ffn": gain(),
        "g_post_ffn": gain(),
        "w_ffn_in": nrm((L, D_MODEL, 2 * FFN_HIDDEN), D_MODEL ** -0.5),
        "w_ffn_out": nrm((L, FFN_HIDDEN, D_MODEL), FFN_HIDDEN ** -0.5),
    }


def reference(x, mem, g_pre_mix, g_post_mix, w_in, shift_mix, decay_base, decay_up,
              iclr_base, iclr_up, gate_up, key_norm_scale, key_iclr_scale, bonus_scale,
              lnx_w, lnx_b, rel_bias, w_branch_a, w_branch_b, w_out,
              g_pre_cross, g_post_cross, g_mem, w_q_mem, w_kv_mem, w_o_mem,
              g_pre_ffn, g_post_ffn, w_ffn_in, w_ffn_out):
    split_at = [RWKV_IN,
                RWKV_IN + ATT_WIDTH,
                RWKV_IN + 2 * ATT_WIDTH,
                RWKV_IN + 3 * ATT_WIDTH,
                RWKV_IN + 3 * ATT_WIDTH + D_MODEL]
    for l in range(DEPTH):
        h = rms_norm(x, g_pre_mix[l])
        proj = h @ w_in[l]
        p_rwkv, q, k, v, z_ga, z_gb = jnp.split(proj, split_at, axis=-1)
        y_a = rwkv7_time_mix(p_rwkv, shift_mix[l], decay_base[l], decay_up[l],
                             iclr_base[l], iclr_up[l], gate_up[l], key_norm_scale[l],
                             key_iclr_scale[l], bonus_scale[l], lnx_w[l], lnx_b[l])
        y_b = chunk_attention(q, k, v, rel_bias[l])
        mixed = (jax.nn.sigmoid(z_ga) * (y_a @ w_branch_a[l])
                 + jax.nn.sigmoid(z_gb) * (y_b @ w_branch_b[l]))
        x = x + rms_norm(mixed @ w_out[l], g_post_mix[l])
        h = rms_norm(x, g_pre_cross[l])
        m = rms_norm(mem, g_mem[l])
        x = x + rms_norm(memory_cross_attention(h, m, w_q_mem[l], w_kv_mem[l], w_o_mem[l]),
                         g_post_cross[l])
        h = rms_norm(x, g_pre_ffn[l])
        x = x + rms_norm(swiglu_ffn(h, w_ffn_in[l], w_ffn_out[l]), g_post_ffn[l])
    return x
```

```cpp
#include <hip/hip_runtime.h>
#include <hip/hip_bf16.h>
#include <cstdio>
#include <cstdint>

#define LAS __attribute__((address_space(3)))
#define GAS __attribute__((address_space(1)))
typedef unsigned short bf16_t;
typedef short bf16x8 __attribute__((ext_vector_type(8)));
typedef short s16x4 __attribute__((ext_vector_type(4)));
typedef float f32x4 __attribute__((ext_vector_type(4)));
typedef float f32x2 __attribute__((ext_vector_type(2)));
typedef float f32x16 __attribute__((ext_vector_type(16)));
typedef unsigned u32x4 __attribute__((ext_vector_type(4)));
typedef unsigned u32x2 __attribute__((ext_vector_type(2)));

constexpr int NB = 16, SEQ = 2048, DM = 1024, M = NB * SEQ;
constexpr int NP = 6656;
constexpr int NPQ = 2048, C_R = 0, C_Q = 1024;
constexpr int NPR = 4608, C_K = 0, C_V = 1024, C_L = 2048, C_KA = 2560, C_VA = 3584;
constexpr int C_GA = 0, C_GB = 1024;
constexpr int FFH = 2816, MEMT = 256, MROWS = NB * MEMT;
constexpr float NORM_EPS = 1e-6f, GN_EPS = 64e-5f;
constexpr float LOG2E = 1.4426950408889634f;
constexpr float QS_ATT = 0.125f * LOG2E;
constexpr float QS_MEM = 0.08838834764831845f * LOG2E;

constexpr size_t MiB = 1u << 20;
constexpr size_t WS_CTL = 0, CTL_ZERO_BYTES = 32 * 1024;
constexpr size_t WS_W1T = 1 * MiB;
constexpr size_t WS_WGT = 14 * MiB;
constexpr size_t WS_WABT = 18 * MiB;
constexpr size_t WS_WOUTT = 22 * MiB;
constexpr size_t WS_WQT = 24 * MiB;
constexpr size_t WS_WKVT = 25 * MiB;
constexpr size_t WS_WOT = 27 * MiB;
constexpr size_t WS_WF1T = 28 * MiB;
constexpr size_t WS_WF2T = 39 * MiB;
constexpr size_t WS_DUPT = 45 * MiB;
constexpr size_t WS_IUPT = WS_DUPT + 128 * 1024;
constexpr size_t WS_GUPT = WS_IUPT + 128 * 1024;
constexpr size_t WS_PQ = 48 * MiB;
constexpr size_t WS_PR = 176 * MiB;
constexpr size_t WS_MN = 464 * MiB;
constexpr size_t WS_KVM = 472 * MiB;
constexpr size_t WS_LORA = 480 * MiB;
constexpr size_t WS_O1 = 48 * MiB;
constexpr size_t WS_XN2 = 112 * MiB;
constexpr size_t WS_Q2 = 176 * MiB;
constexpr size_t WS_O2 = 208 * MiB;
constexpr size_t WS_ACT = 240 * MiB;
constexpr size_t WS_END = 512 * MiB;
constexpr int CW_BAR = 4096;

constexpr int RING_BYTES = 131072;
constexpr int LDSCTL_OFF = RING_BYTES, MISC_OFF = LDSCTL_OFF + 320;
constexpr int LDS_BYTES = 151552;
constexpr int NWAVES = 8;

#define RLX_AGENT __ATOMIC_RELAXED, __HIP_MEMORY_SCOPE_AGENT
#define LDS_WAIT() asm volatile("s_waitcnt lgkmcnt(0)" ::: "memory")
#define VM_WAIT() asm volatile("s_waitcnt vmcnt(0)" ::: "memory")

__device__ __forceinline__ unsigned f2bf(float f) { unsigned u = __builtin_bit_cast(unsigned, f); return (u + 0x7fffu + ((u >> 16) & 1u)) >> 16; }
__device__ __forceinline__ unsigned pk2(float lo, float hi) { return f2bf(lo) | (f2bf(hi) << 16); }
__device__ __forceinline__ float bf2f(unsigned short b) { return __builtin_bit_cast(float, (unsigned)b << 16); }
__device__ __forceinline__ float bflo(unsigned w) { return __builtin_bit_cast(float, w << 16); }
__device__ __forceinline__ float bfhi(unsigned w) { return __builtin_bit_cast(float, w & 0xffff0000u); }
typedef __bf16 bf16x2_t __attribute__((ext_vector_type(2)));
__device__ __forceinline__ unsigned cvtpk(float lo, float hi) { f32x2 v = {lo, hi}; bf16x2_t b = __builtin_convertvector(v, bf16x2_t); return __builtin_bit_cast(unsigned, b); }
__device__ __forceinline__ float wave_sum(float v) {
#pragma unroll
    for (int o = 1; o < 64; o <<= 1) v += __shfl_xor(v, o);
    return v;
}
__device__ __forceinline__ float fast_exp2(float x) { return __builtin_amdgcn_exp2f(x); }
__device__ __forceinline__ float sigmoidf_(float x) { return __builtin_amdgcn_rcpf(1.0f + __builtin_amdgcn_exp2f(-x * LOG2E)); }

#define XB_TMO      128
#define XB_XCNT(j)  (256  + 64 * (j))
#define XB_XSUB(j)  (1280 + 64 * (j))
#define XB_XGEN(j)  (2304 + 64 * (j))
#define XB_TOP      3328
#define XB_TOPGEN   3392
#define XCD_BAR_WORDS 3456
#define XB_SPIN_CAP (1u << 18)
__device__ __forceinline__ unsigned xb_ld(unsigned* p)              { return __hip_atomic_load(p, __ATOMIC_RELAXED, __HIP_MEMORY_SCOPE_AGENT); }
__device__ __forceinline__ unsigned xb_add(unsigned* p, unsigned v) { return __hip_atomic_fetch_add(p, v, __ATOMIC_RELAXED, __HIP_MEMORY_SCOPE_AGENT); }
__device__ __forceinline__ unsigned xb_xcc_id() { return (unsigned)__builtin_amdgcn_s_getreg((3 << 11) | 20) & 0xFu; }
#define XB_SPIN(cond, bar) do { unsigned _sp = 0; while (cond) { __builtin_amdgcn_s_sleep(1); \
    if ((++_sp & 255u) == 0u) { if (xb_ld(&(bar)[XB_TMO])) break; if (_sp > XB_SPIN_CAP) { atomicAdd(&(bar)[XB_TMO], 1u); break; } } } } while (0)
struct XcdBarrier { unsigned* bar; unsigned x; volatile LAS unsigned* st; };
__device__ __forceinline__ XcdBarrier xcd_barrier_post(unsigned* bar, volatile LAS unsigned* st) {
    XcdBarrier b; b.bar = bar; b.x = xb_xcc_id(); b.st = st;
    if (threadIdx.x == 0) (void)xb_add(&bar[XB_XCNT(b.x)], 1u);
    return b;
}
__device__ __forceinline__ void xcd_barrier_complete(unsigned* bar, unsigned x, unsigned& nloc, unsigned& nx) {
    const unsigned G = gridDim.x * gridDim.y * gridDim.z;
    unsigned sum, cnt, mine, sp = 0u;
    for (;;) {
        sum = 0u; cnt = 0u; mine = 0u;
#pragma unroll
        for (unsigned j = 0; j < 16; ++j) { const unsigned c = xb_ld(&bar[XB_XCNT(j)]); sum += c; cnt += (c > 0u) ? 1u : 0u; mine = (j == x) ? c : mine; }
        if (sum == G) break;
        __builtin_amdgcn_s_sleep(1);
        if ((++sp & 255u) == 0u) { if (xb_ld(&bar[XB_TMO])) break; if (sp > XB_SPIN_CAP) { atomicAdd(&bar[XB_TMO], 1u); break; } }
    }
    nloc = mine > 0u ? mine : 1u; nx = cnt > 0u ? cnt : 1u;
}
__device__ __forceinline__ void xcd_barrier(const XcdBarrier& b) {
    asm volatile("s_waitcnt vmcnt(0)" ::: "memory");
    __syncthreads();
    if (threadIdx.x == 0) {
        unsigned* bar = b.bar;
        __builtin_amdgcn_s_waitcnt(0);
        unsigned nloc = b.st[0], nx = b.st[1];
        if (nloc == 0u) { xcd_barrier_complete(bar, b.x, nloc, nx); b.st[0] = nloc; b.st[1] = nx; }
        const unsigned old = xb_add(&bar[XB_XSUB(b.x)], 1u);
        const unsigned gen = old / nloc;
        if (old + 1u == (gen + 1u) * nloc) {
            __builtin_amdgcn_fence(__ATOMIC_RELEASE, "agent");
            asm volatile("s_waitcnt vmcnt(0)" ::: "memory");
            const unsigned og = xb_add(&bar[XB_TOP], 1u);
            const unsigned tg = og / nx;
            if (og + 1u == (tg + 1u) * nx) xb_add(&bar[XB_TOPGEN], 1u);
            else XB_SPIN(xb_ld(&bar[XB_TOPGEN]) == tg, bar);
            __builtin_amdgcn_fence(__ATOMIC_ACQUIRE, "agent");
            xb_add(&bar[XB_XGEN(b.x)], 1u);
            asm volatile("s_waitcnt vmcnt(0)" ::: "memory");
        } else {
            XB_SPIN(xb_ld(&bar[XB_XGEN(b.x)]) == gen, bar);
            __builtin_amdgcn_fence(__ATOMIC_ACQUIRE, "agent");
            asm volatile("s_waitcnt vmcnt(0)" ::: "memory");
        }
    }
    __syncthreads();
}

namespace pg8 {
constexpr int BM = 256, BK = 64, HALF = 128, HTB = HALF * BK * 2, STAGE_BYTES = 8 * HTB, NXCD = 8, WGM = 4;
__host__ __device__ __forceinline__ int lds_byte(int r, int c) { const int st = (r >> 4) * 2 + (c >> 5), rr = r & 15, cc = c & 31, ob = rr * 64 + cc * 2; return st * 1024 + (ob ^ (((ob >> 9) & 1) << 5)); }
__host__ __device__ __forceinline__ void stage_rc(int b, int& R, int& C) { const int st = b / 1024, sb = b % 1024, swz = sb ^ (((sb >> 9) & 1) << 5); R = (st >> 1) * 16 + swz / 64; C = (st & 1) * 32 + (swz % 64) / 2; }
__host__ __device__ __forceinline__ int perm32(int rho) { const int n = rho >> 4, i = rho & 15; return 8 * (i >> 2) + 4 * n + (i & 3); }

struct Unit { int pm, pn, ac; };
struct Gemm { const bf16_t* A; const bf16_t* Bt; int lda, K; };

__device__ __forceinline__ void tile_of(int wgid0, int nM, int nN, int& pm, int& pn) {
    const int nwg = nM * nN; int wgid = wgid0;
    { const int q = nwg / NXCD, r = nwg % NXCD, xcd = wgid % NXCD, off = wgid / NXCD; wgid = (xcd < r ? xcd * (q + 1) : r * (q + 1) + (xcd - r) * q) + off; }
    const int nig = WGM * nN, gid = wgid / nig, fm = gid * WGM, gsz = (nM - fm) < WGM ? (nM - fm) : WGM;
    pm = fm + ((wgid % nig) % gsz); pn = (wgid % nig) / gsz;
}
#define EPI_FOR_ROWS for (int ai = 0; ai < 2; ++ai) _Pragma("unroll") for (int m = 0; m < 4; ++m)
enum { EPI_STORE = 0, EPI_SIGMOID = 1, EPI_MIX = 2, EPI_SWIGLU = 3 };
struct Epi {
    int type; bf16_t* O; int ldc; int coff; int s_lo, s_hi; float scale; const bf16_t* P; int nt; bf16_t* O2; int ldc2; int split; int pld;
    __device__ __forceinline__ void operator()(const f32x4 (&acc)[2][2][4][2], const Unit& u, int wr, int wc, int fr, int fq) const {
        const int row0 = u.pm * BM + wr * 64 + fr;
        if (type == EPI_STORE || type == EPI_SIGMOID) {
            const float sc = (u.pn >= s_lo && u.pn < s_hi) ? scale : 1.f;
            const bool hi2 = (split > 0) && (u.pn >= split); bf16_t* const Ob = hi2 ? O2 : O; const int ldo = hi2 ? ldc2 : ldc;
            const int col0 = coff + (hi2 ? u.pn - split : u.pn) * BM + wc * 32 + 8 * fq; const bool sg = (type == EPI_SIGMOID);
#pragma unroll
            EPI_FOR_ROWS { bf16_t* rowp = Ob + (size_t)(row0 + ai * HALF + m * 16) * ldo + col0;
#pragma unroll
                for (int bj = 0; bj < 2; ++bj) { f32x4 v0 = acc[ai][bj][m][0] * sc, v1 = acc[ai][bj][m][1] * sc;
                    if (sg) {
#pragma unroll
                        for (int e = 0; e < 4; ++e) { v0[e] = sigmoidf_(v0[e]); v1[e] = sigmoidf_(v1[e]); } }
                    u32x4 w; w.x = cvtpk(v0[0], v0[1]); w.y = cvtpk(v0[2], v0[3]); w.z = cvtpk(v1[0], v1[1]); w.w = cvtpk(v1[2], v1[3]);
                    if (nt) __builtin_nontemporal_store(w, (u32x4*)(rowp + bj * HALF)); else *(u32x4*)(rowp + bj * HALF) = w; } }
        } else if (type == EPI_MIX) {
            const int pn = u.pn & 3;
            const int col0 = pn * BM + wc * 32 + 8 * fq;
            const int gcol = C_GB + col0;
#pragma unroll
            for (int ai = 0; ai < 2; ++ai) {
                u32x4 gv[4][2];
#pragma unroll
                for (int m = 0; m < 4; ++m)
#pragma unroll
                    for (int bj = 0; bj < 2; ++bj) gv[m][bj] = *(const u32x4*)(P + (size_t)(row0 + ai * HALF + m * 16) * pld + gcol + bj * HALF);
#pragma unroll
                for (int m = 0; m < 4; ++m)
#pragma unroll
                    for (int bj = 0; bj < 2; ++bj) { const size_t row = (size_t)(row0 + ai * HALF + m * 16);
                        const u32x4 g = gv[m][bj];
                        f32x4 v0 = acc[ai][bj][m][0], v1 = acc[ai][bj][m][1];
                        v0[0] *= bflo(g.x); v0[1] *= bfhi(g.x); v0[2] *= bflo(g.y); v0[3] *= bfhi(g.y);
                        v1[0] *= bflo(g.z); v1[1] *= bfhi(g.z); v1[2] *= bflo(g.w); v1[3] *= bfhi(g.w);
                        u32x4 w; w.x = cvtpk(v0[0], v0[1]); w.y = cvtpk(v0[2], v0[3]); w.z = cvtpk(v1[0], v1[1]); w.w = cvtpk(v1[2], v1[3]);
                        *(u32x4*)(O + row * ldc + col0 + bj * HALF) = w; }
            }
        } else {
            const int col0 = u.pn * HALF + wc * 32 + 8 * fq;
#pragma unroll
            EPI_FOR_ROWS { bf16_t* rowp = O + (size_t)(row0 + ai * HALF + m * 16) * ldc + col0;
                f32x4 v0 = acc[ai][0][m][0], v1 = acc[ai][0][m][1]; const f32x4 u0 = acc[ai][1][m][0], u1 = acc[ai][1][m][1];
#pragma unroll
                for (int e = 0; e < 4; ++e) { v0[e] = v0[e] * sigmoidf_(v0[e]) * u0[e]; v1[e] = v1[e] * sigmoidf_(v1[e]) * u1[e]; }
                u32x4 w; w.x = cvtpk(v0[0], v0[1]); w.y = cvtpk(v0[2], v0[3]); w.z = cvtpk(v1[0], v1[1]); w.w = cvtpk(v1[2], v1[3]);
                *(u32x4*)rowp = w; }
        }
    }
    __device__ __forceinline__ bool keep(const Unit& u) const { return type == EPI_MIX && (u.pn >> 2) == 0; }
    __device__ __forceinline__ void scale_keep(f32x4 (&acc)[2][2][4][2], const Unit& u, int wr, int wc, int fr, int fq) const {
        const int row0 = u.pm * BM + wr * 64 + fr, col0 = (u.pn & 3) * BM + wc * 32 + 8 * fq;
#pragma unroll
        for (int ai = 0; ai < 2; ++ai) {
            u32x4 ga[4][2], gb[4][2];
#pragma unroll
            for (int m = 0; m < 4; ++m)
#pragma unroll
                for (int bj = 0; bj < 2; ++bj) { const bf16_t* gp = P + (size_t)(row0 + ai * HALF + m * 16) * pld + col0 + bj * HALF; ga[m][bj] = *(const u32x4*)(gp + C_GA); gb[m][bj] = *(const u32x4*)(gp + C_GB); }
#pragma unroll
            for (int m = 0; m < 4; ++m)
#pragma unroll
                for (int bj = 0; bj < 2; ++bj) { const u32x4 a = ga[m][bj], b = gb[m][bj];
                    f32x4& v0 = acc[ai][bj][m][0]; f32x4& v1 = acc[ai][bj][m][1];
                    v0[0] *= bflo(a.x) * __builtin_amdgcn_rcpf(bflo(b.x)); v0[1] *= bfhi(a.x) * __builtin_amdgcn_rcpf(bfhi(b.x)); v0[2] *= bflo(a.y) * __builtin_amdgcn_rcpf(bflo(b.y)); v0[3] *= bfhi(a.y) * __builtin_amdgcn_rcpf(bfhi(b.y));
                    v1[0] *= bflo(a.z) * __builtin_amdgcn_rcpf(bflo(b.z)); v1[1] *= bfhi(a.z) * __builtin_amdgcn_rcpf(bfhi(b.z)); v1[2] *= bflo(a.w) * __builtin_amdgcn_rcpf(bflo(b.w)); v1[3] *= bfhi(a.w) * __builtin_amdgcn_rcpf(bfhi(b.w)); }
        }
    }
};
struct Order {
    int nM, nN, nwg, G, c, pair;
    __device__ __forceinline__ void init(int M_, int N_, int G_, int c_, int pair_) { nM = M_ / BM; nN = N_ / BM; nwg = nM * nN; G = G_; c = c_; pair = pair_; }
    __device__ __forceinline__ bool next(int i, Unit& u) const {
        const int ii = pair ? (i >> 1) : i;
        const long L = (long)ii * G + c; if (L >= nwg) return false;
        int pn; tile_of((int)L, nM, nN, u.pm, pn);
        const int half = pair ? (i & 1) : 0; u.pn = half * nN + pn; u.ac = (pair == 1) ? half * 1024 : 0; return true;
    }
};

__device__ __forceinline__ void gemm_phase(LAS unsigned char* lds, const Gemm& g, const Order& S, const Epi& E) {
    int tid = threadIdx.x; asm volatile("" : "+v"(tid));
    const int wid = __builtin_amdgcn_readfirstlane(tid >> 6), lane = tid & 63, wr = wid >> 2, wc = wid & 3, fr = lane & 15, fq = lane >> 4;
    const int K = g.K, lda = g.lda, nt = K / BK;
    unsigned voffA[2], voffB[2];
#pragma unroll
    for (int i = 0; i < 2; ++i) { int R, C; stage_rc(tid * 16 + i * 8192, R, C); const int Rb = (R & ~31) + perm32(R & 31);
        voffA[i] = (unsigned)(R * lda + C) * 2u; voffB[i] = (unsigned)(Rb * K + C) * 2u; }
    const size_t kstep = (size_t)(BK * 2);
    const size_t hstepA = (size_t)HALF * lda * 2, hstepB = (size_t)HALF * K * 2;
    const size_t tstepA = 2 * hstepA, tstepB = 2 * hstepB;
    const unsigned ldsw = (unsigned)wid * 1024u;
    const int aoff = lds_byte(wr * 64 + fr, fq * 8), boff = lds_byte(wc * 32 + fr, fq * 8);
#define PG8_SA(b, h) (((b) * 2 + (h)) * HTB)
#define PG8_SB(b, h) ((4 + (b) * 2 + (h)) * HTB)
#define PG8_STAGE(bufoff, gbase, voff) do { _Pragma("unroll") for (int _i = 0; _i < 2; ++_i) \
        __builtin_amdgcn_global_load_lds((const unsigned*)((const char*)(gbase) + (voff)[_i]), (LAS unsigned*)(lds + (bufoff) + ldsw + _i * 8192), 16, 0, 0); } while (0)
#define PG8_LDA(dst, b, h) do { _Pragma("unroll") for (int m = 0; m < 4; ++m) _Pragma("unroll") for (int k = 0; k < 2; ++k) dst[m][k] = *(const LAS bf16x8*)(lds + PG8_SA(b, h) + aoff + m * 2048 + k * 1024); } while (0)
#define PG8_LDB(dst, b, h) do { _Pragma("unroll") for (int n = 0; n < 2; ++n) _Pragma("unroll") for (int k = 0; k < 2; ++k) dst[n][k] = *(const LAS bf16x8*)(lds + PG8_SB(b, h) + boff + n * 2048 + k * 1024); } while (0)
#define PG8_MMA(ai, bj, At, Bt) do { __builtin_amdgcn_s_setprio(1); _Pragma("unroll") for (int m = 0; m < 4; ++m) _Pragma("unroll") for (int n = 0; n < 2; ++n) _Pragma("unroll") for (int k = 0; k < 2; ++k) \
        acc[ai][bj][m][n] = __builtin_amdgcn_mfma_f32_16x16x32_bf16(Bt[n][k], At[m][k], acc[ai][bj][m][n], 0, 0, 0); __builtin_amdgcn_s_setprio(0); } while (0)
#define PG8_WAIT_V(n) asm volatile("s_waitcnt vmcnt(" #n ")" ::: "memory")
#define PG8_WAIT_L(n) asm volatile("s_waitcnt lgkmcnt(" #n ")" ::: "memory")
#define PG8_BAR __builtin_amdgcn_s_barrier()
#define PG8_SCHED __builtin_amdgcn_sched_barrier(0)
    Unit cur, nxt; int ui = 0;
    if (!S.next(0, cur)) return;
    f32x4 acc[2][2][4][2];
#pragma unroll
    for (int a = 0; a < 2; ++a)
#pragma unroll
        for (int b = 0; b < 2; ++b)
#pragma unroll
            for (int m = 0; m < 4; ++m)
#pragma unroll
                for (int n = 0; n < 2; ++n) acc[a][b][m][n] = (f32x4){0.f, 0.f, 0.f, 0.f};
    bf16x8 At[4][2], B0[2][2], B1[2][2];
    const char* cA = (const char*)g.A + (size_t)cur.pm * tstepA + (size_t)cur.ac * 2; const char* cB = (const char*)g.Bt + (size_t)cur.pn * tstepB;
    PG8_STAGE(PG8_SB(0, 0), cB, voffB); PG8_STAGE(PG8_SB(0, 1), cB + hstepB, voffB); PG8_STAGE(PG8_SA(0, 0), cA, voffA); PG8_STAGE(PG8_SA(0, 1), cA + hstepA, voffA);
    if (wr == 1) PG8_BAR;
    PG8_WAIT_V(2); PG8_BAR;
    PG8_STAGE(PG8_SB(1, 0), cB + kstep, voffB); PG8_STAGE(PG8_SA(1, 0), cA + kstep, voffA); PG8_STAGE(PG8_SB(1, 1), cB + hstepB + kstep, voffB);
    PG8_WAIT_V(6); PG8_BAR;
    for (;;) {
        const bool has_next = S.next(ui + 1, nxt);
        const char* nA = has_next ? (const char*)g.A + (size_t)nxt.pm * tstepA + (size_t)nxt.ac * 2 : cA; const char* nB = has_next ? (const char*)g.Bt + (size_t)nxt.pn * tstepB : cB;
        for (int t = 0; t < nt; t += 2) {
            const bool last = (t == nt - 2);
            const char* a1 = cA + (size_t)(t + 1) * kstep;
            const char* a2 = last ? nA : cA + (size_t)(t + 2) * kstep; const char* b2 = last ? nB : cB + (size_t)(t + 2) * kstep;
            const char* a3 = a2 + kstep; const char* b3 = b2 + kstep;
            PG8_LDB(B0, 0, 0); PG8_LDB(B1, 0, 1); PG8_SCHED; PG8_LDA(At, 0, 0); PG8_STAGE(PG8_SA(1, 1), a1 + hstepA, voffA);
            PG8_WAIT_V(8); PG8_WAIT_L(0); PG8_BAR; PG8_MMA(0, 0, At, B0); PG8_MMA(0, 1, At, B1); PG8_BAR; PG8_SCHED;
            PG8_LDA(At, 0, 1); PG8_STAGE(PG8_SB(0, 0), b2, voffB); PG8_STAGE(PG8_SB(0, 1), b2 + hstepB, voffB); PG8_STAGE(PG8_SA(0, 0), a2, voffA);
            PG8_WAIT_V(8); PG8_WAIT_L(0); PG8_BAR; PG8_MMA(1, 0, At, B0); PG8_MMA(1, 1, At, B1); PG8_BAR; PG8_SCHED;
            PG8_LDB(B0, 1, 0); PG8_LDB(B1, 1, 1); PG8_SCHED; PG8_LDA(At, 1, 0); PG8_STAGE(PG8_SA(0, 1), a2 + hstepA, voffA);
            PG8_WAIT_V(8); PG8_WAIT_L(0); PG8_BAR; PG8_MMA(0, 0, At, B0); PG8_MMA(0, 1, At, B1); PG8_BAR; PG8_SCHED;
            PG8_LDA(At, 1, 1); PG8_STAGE(PG8_SB(1, 0), b3, voffB); PG8_STAGE(PG8_SB(1, 1), b3 + hstepB, voffB); PG8_STAGE(PG8_SA(1, 0), a3, voffA);
            PG8_WAIT_V(8); PG8_WAIT_L(0); PG8_BAR; PG8_MMA(1, 0, At, B0); PG8_MMA(1, 1, At, B1); PG8_BAR; PG8_SCHED;
        }
        if (wr == 0) PG8_BAR;
        const bool keep_acc = E.keep(cur);
        if (keep_acc) E.scale_keep(acc, cur, wr, wc, fr, fq); else E(acc, cur, wr, wc, fr, fq);
        if (!has_next) break;
        if (!keep_acc)
#pragma unroll
        for (int a = 0; a < 2; ++a)
#pragma unroll
            for (int b = 0; b < 2; ++b)
#pragma unroll
                for (int m = 0; m < 4; ++m)
#pragma unroll
                    for (int n = 0; n < 2; ++n) acc[a][b][m][n] = (f32x4){0.f, 0.f, 0.f, 0.f};
        cur = nxt; cA = nA; cB = nB; ++ui;
        if (wr == 1) PG8_BAR;
    }
    PG8_WAIT_V(0);
    PG8_BAR;
#undef PG8_SA
#undef PG8_SB
#undef PG8_STAGE
#undef PG8_LDA
#undef PG8_LDB
#undef PG8_MMA
#undef PG8_WAIT_V
#undef PG8_WAIT_L
#undef PG8_BAR
#undef PG8_SCHED
}
}

enum { I_X = 0, I_MEM, I_GPREMIX, I_GPOSTMIX, I_WIN, I_SHIFT, I_DBASE, I_DUP, I_IBASE, I_IUP, I_GUP, I_KNS, I_KIS, I_BONUS, I_LNW, I_LNB, I_RELB,
       I_WA, I_WB, I_WOUT, I_GPRECROSS, I_GPOSTCROSS, I_GMEM, I_WQM, I_WKVM, I_WOM, I_GPREFFN, I_GPOSTFFN, I_WF1, I_WF2, N_IN };
struct Args { const float* in[N_IN]; float* out; unsigned char* ws; };

__device__ __forceinline__ void p0_transpose_item(const float* W, int ldsrc, int K, int col0, bf16_t* WT, int dld, int drow0, int k0, LAS float* scr, int lane) {
    float tv[32];
#pragma unroll
    for (int i = 0; i < 32; ++i) { const int kk = 2 * i + (lane >> 5); const int k = k0 + kk;
        tv[i] = (k < K) ? __builtin_nontemporal_load(W + (size_t)k * ldsrc + col0 + (lane & 31)) : 0.f; }
#pragma unroll
    for (int i = 0; i < 32; ++i) { const int kk = 2 * i + (lane >> 5); scr[kk * 33 + (lane & 31)] = tv[i]; }
    LDS_WAIT(); asm volatile("" ::: "memory");
    const int c = lane & 7;
    if (k0 + 8 * c < K) {
#pragma unroll
        for (int j = 0; j < 4; ++j) { const int n = (lane >> 3) + 8 * j; const LAS float* s = scr + (8 * c) * 33 + n;
            u32x4 o; o.x = pk2(s[0 * 33], s[1 * 33]); o.y = pk2(s[2 * 33], s[3 * 33]); o.z = pk2(s[4 * 33], s[5 * 33]); o.w = pk2(s[6 * 33], s[7 * 33]);
            *(u32x4*)(WT + (size_t)(drow0 + n) * dld + k0 + 8 * c) = o; }
    }
    LDS_WAIT(); asm volatile("" ::: "memory");
}
constexpr int NJOBS = 19;
__device__ __forceinline__ void job_desc(const Args& a, int j, const float*& src, int& ld, int& K, int& col0, int& ncols, size_t& dst, int& drow0, int& mode) {
    mode = 0;
    switch (j) {
    case 0:  src = a.in[I_WIN]; ld = 8480; K = 1024; col0 = 0;    ncols = 1024; dst = WS_W1T; drow0 = 0; break;
    case 1:  src = a.in[I_WIN]; ld = 8480; K = 1024; col0 = 3360; ncols = 1024; dst = WS_W1T; drow0 = 1024; break;
    case 2:  src = a.in[I_WIN]; ld = 8480; K = 1024; col0 = 1024; ncols = 1024; dst = WS_W1T; drow0 = 2048; break;
    case 3:  src = a.in[I_WIN]; ld = 8480; K = 1024; col0 = 2048; ncols = 1024; dst = WS_W1T; drow0 = 3072; break;
    case 4:  src = a.in[I_WIN]; ld = 8480; K = 1024; col0 = 3072; ncols = 288;  dst = WS_W1T; drow0 = 4096; break;
    case 5:  src = a.in[I_WIN]; ld = 8480; K = 1024; col0 = 4384; ncols = 1024; dst = WS_W1T; drow0 = 4608; break;
    case 6:  src = a.in[I_WIN]; ld = 8480; K = 1024; col0 = 5408; ncols = 1024; dst = WS_W1T; drow0 = 5632; break;
    case 7:  src = a.in[I_WIN]; ld = 8480; K = 1024; col0 = 6432; ncols = 2048; dst = WS_WGT; drow0 = 0; break;
    case 8:  src = a.in[I_WA];  ld = 1024; K = 1024; col0 = 0; ncols = 1024; dst = WS_WABT; drow0 = 0; break;
    case 9:  src = a.in[I_WB];  ld = 1024; K = 1024; col0 = 0; ncols = 1024; dst = WS_WABT; drow0 = 1024; break;
    case 10: src = a.in[I_WOUT]; ld = 1024; K = 1024; col0 = 0; ncols = 1024; dst = WS_WOUTT; drow0 = 0; break;
    case 11: src = a.in[I_WQM]; ld = 512;  K = 1024; col0 = 0; ncols = 512;  dst = WS_WQT; drow0 = 0; break;
    case 12: src = a.in[I_WKVM]; ld = 1024; K = 1024; col0 = 0; ncols = 1024; dst = WS_WKVT; drow0 = 0; break;
    case 13: src = a.in[I_WOM]; ld = 1024; K = 512;  col0 = 0; ncols = 1024; dst = WS_WOT; drow0 = 0; break;
    case 14: src = a.in[I_WF1]; ld = 5632; K = 1024; col0 = 0; ncols = 5632; dst = WS_WF1T; drow0 = 0; mode = 1; break;
    case 15: src = a.in[I_WF2]; ld = 1024; K = 2816; col0 = 0; ncols = 1024; dst = WS_WF2T; drow0 = 0; break;
    case 16: src = a.in[I_DUP]; ld = 1024; K = 64;   col0 = 0; ncols = 1024; dst = WS_DUPT; drow0 = 0; break;
    case 17: src = a.in[I_IUP]; ld = 1024; K = 64;   col0 = 0; ncols = 1024; dst = WS_IUPT; drow0 = 0; break;
    default: src = a.in[I_GUP]; ld = 1024; K = 160;  col0 = 0; ncols = 1024; dst = WS_GUPT; drow0 = 0; break;
    }
}
__device__ __forceinline__ void rms_row_to_bf16(const float* xrow, const float* gain, bf16_t* orow, int lane) {
    const f32x4* xr = (const f32x4*)xrow + lane; const f32x4* gr = (const f32x4*)gain + lane;
    f32x4 v[4]; float s = 0.f;
#pragma unroll
    for (int j = 0; j < 4; ++j) { v[j] = xr[64 * j]; s += (v[j].x * v[j].x + v[j].y * v[j].y) + (v[j].z * v[j].z + v[j].w * v[j].w); }
    const float rs = 1.0f / sqrtf(wave_sum(s) * (1.f / DM) + NORM_EPS);
    u32x2* o8 = (u32x2*)orow + lane;
#pragma unroll
    for (int j = 0; j < 4; ++j) { const f32x4 g = gr[64 * j]; u32x2 w; w.x = cvtpk(v[j].x * rs * g.x, v[j].y * rs * g.y); w.y = cvtpk(v[j].z * rs * g.z, v[j].w * rs * g.w); o8[64 * j] = w; }
}
__device__ __forceinline__ void rms_row2_to_bf16(const float* xa, const float* xb, const float* gain, bf16_t* oa, bf16_t* ob, int lane) {
    const f32x4* xr0 = (const f32x4*)xa + lane; const f32x4* xr1 = (const f32x4*)xb + lane; const f32x4* gr = (const f32x4*)gain + lane;
    f32x4 v0[4], v1[4]; float s0 = 0.f, s1 = 0.f;
#pragma unroll
    for (int j = 0; j < 4; ++j) { v0[j] = __builtin_nontemporal_load(xr0 + 64 * j); v1[j] = __builtin_nontemporal_load(xr1 + 64 * j); }
#pragma unroll
    for (int j = 0; j < 4; ++j) { s0 += (v0[j].x * v0[j].x + v0[j].y * v0[j].y) + (v0[j].z * v0[j].z + v0[j].w * v0[j].w); s1 += (v1[j].x * v1[j].x + v1[j].y * v1[j].y) + (v1[j].z * v1[j].z + v1[j].w * v1[j].w); }
    const float rs0 = __builtin_amdgcn_rsqf(wave_sum(s0) * (1.f / DM) + NORM_EPS), rs1 = __builtin_amdgcn_rsqf(wave_sum(s1) * (1.f / DM) + NORM_EPS);
    u32x2* o0 = (u32x2*)oa + lane; u32x2* o1 = (u32x2*)ob + lane;
#pragma unroll
    for (int j = 0; j < 4; ++j) { const f32x4 g = gr[64 * j]; u32x2 w;
        w.x = cvtpk(v0[j].x * rs0 * g.x, v0[j].y * rs0 * g.y); w.y = cvtpk(v0[j].z * rs0 * g.z, v0[j].w * rs0 * g.w); o0[64 * j] = w;
        w.x = cvtpk(v1[j].x * rs1 * g.x, v1[j].y * rs1 * g.y); w.y = cvtpk(v1[j].z * rs1 * g.z, v1[j].w * rs1 * g.w); o1[64 * j] = w; }
}
__device__ __forceinline__ void p0_prologue(const Args& a, LAS unsigned char* lds, int vcu, int G, int wave, int lane) {
    LAS float* scr = (LAS float*)(lds + wave * 16384);
    const int gw = vcu * NWAVES + wave, NGW = G * NWAVES;
    int total = 0;
    for (int j = 0; j < NJOBS; ++j) { int ld, K, col0, ncols, drow0, mode; size_t dst; const float* src; job_desc(a, j, src, ld, K, col0, ncols, dst, drow0, mode); total += ((K + 63) / 64) * (ncols / 32); }
    for (int it = gw; it < total; it += NGW) {
        int r = it;
        for (int j = 0; j < NJOBS; ++j) {
            int ld, K, col0, ncols, drow0, mode; size_t dst; const float* src; job_desc(a, j, src, ld, K, col0, ncols, dst, drow0, mode);
            const int nblk = ncols / 32, cnt = ((K + 63) / 64) * nblk;
            if (r < cnt) {
                const int kb = r / nblk, nb = r % nblk; int n0 = 32 * nb; int drow = drow0 + n0;
                if (mode == 1) { const int up = n0 >= FFH ? 1 : 0; const int nn = n0 - up * FFH; drow = 256 * (nn / 128) + 128 * up + (nn % 128); }
                p0_transpose_item(src, ld, K, col0 + n0, (bf16_t*)(a.ws + dst), K, drow, 64 * kb, scr, lane);
                break;
            }
            r -= cnt;
        }
    }
    { u32x4* z = (u32x4*)(a.ws + WS_W1T + (size_t)4384 * 1024 * 2); const int n16 = 224 * 1024 * 2 / 16;
      for (int i = gw * 64 + lane; i < n16; i += NGW * 64) z[i] = (u32x4){0u, 0u, 0u, 0u}; }
    bf16_t* XN = (bf16_t*)a.out; bf16_t* MN = (bf16_t*)(a.ws + WS_MN);
    for (int m = gw; m < M; m += 2 * NGW) rms_row2_to_bf16(a.in[I_X] + (size_t)m * DM, a.in[I_X] + (size_t)(m + NGW) * DM, a.in[I_GPREMIX], XN + (size_t)m * DM, XN + (size_t)(m + NGW) * DM, lane);
    for (int m = gw; m < MROWS; m += NGW) rms_row_to_bf16(a.in[I_MEM] + (size_t)m * DM, a.in[I_GMEM], MN + (size_t)m * DM, lane);
}

template <bool XIB, bool XOB>
__device__ __forceinline__ void norm_pass(const bf16_t* O, const void* xres_, void* xout_, const float* g1, const float* g2, bf16_t* hn, int vcu, int G, int wave, int lane) {
    const int gw = vcu * NWAVES + wave, NGW = G * NWAVES;
    for (int m0 = gw; m0 < M; m0 += 2 * NGW) {
        f32x4 ov[2][4], xv[2][4]; float s[2] = {0.f, 0.f};
#pragma unroll
        for (int q = 0; q < 2; ++q) { const size_t m = (size_t)m0 + (size_t)q * NGW;
            const u32x2* orow = (const u32x2*)(O + m * DM) + lane;
#pragma unroll
            for (int j = 0; j < 4; ++j) { const u32x2 w = __builtin_nontemporal_load(orow + 64 * j); ov[q][j] = (f32x4){bflo(w.x), bfhi(w.x), bflo(w.y), bfhi(w.y)};
                if (XIB) { const u32x2 xw = __builtin_nontemporal_load((const u32x2*)((const bf16_t*)xres_ + m * DM) + lane + 64 * j); xv[q][j] = (f32x4){bflo(xw.x), bfhi(xw.x), bflo(xw.y), bfhi(xw.y)}; }
                else xv[q][j] = __builtin_nontemporal_load((const f32x4*)((const float*)xres_ + m * DM) + lane + 64 * j); } }
#pragma unroll
        for (int q = 0; q < 2; ++q)
#pragma unroll
            for (int j = 0; j < 4; ++j) s[q] += (ov[q][j].x * ov[q][j].x + ov[q][j].y * ov[q][j].y) + (ov[q][j].z * ov[q][j].z + ov[q][j].w * ov[q][j].w);
        const float rs[2] = {__builtin_amdgcn_rsqf(wave_sum(s[0]) * (1.f / DM) + NORM_EPS), __builtin_amdgcn_rsqf(wave_sum(s[1]) * (1.f / DM) + NORM_EPS)};
        float s2[2] = {0.f, 0.f};
#pragma unroll
        for (int q = 0; q < 2; ++q) { const size_t m = (size_t)m0 + (size_t)q * NGW;
#pragma unroll
            for (int j = 0; j < 4; ++j) { const f32x4 g = ((const f32x4*)g1 + lane)[64 * j]; xv[q][j] = xv[q][j] + ov[q][j] * rs[q] * g;
                if (XOB) { u32x2 w; w.x = cvtpk(xv[q][j].x, xv[q][j].y); w.y = cvtpk(xv[q][j].z, xv[q][j].w); __builtin_nontemporal_store(w, (u32x2*)((bf16_t*)xout_ + m * DM) + lane + 64 * j); }
                else __builtin_nontemporal_store(xv[q][j], (f32x4*)((float*)xout_ + m * DM) + lane + 64 * j);
                s2[q] += (xv[q][j].x * xv[q][j].x + xv[q][j].y * xv[q][j].y) + (xv[q][j].z * xv[q][j].z + xv[q][j].w * xv[q][j].w); } }
        if (hn) {
            const float r2[2] = {__builtin_amdgcn_rsqf(wave_sum(s2[0]) * (1.f / DM) + NORM_EPS), __builtin_amdgcn_rsqf(wave_sum(s2[1]) * (1.f / DM) + NORM_EPS)};
#pragma unroll
            for (int q = 0; q < 2; ++q) { const size_t m = (size_t)m0 + (size_t)q * NGW; u32x2* ho = (u32x2*)(hn + m * DM) + lane;
#pragma unroll
                for (int j = 0; j < 4; ++j) { const f32x4 g = ((const f32x4*)g2 + lane)[64 * j]; u32x2 w; w.x = cvtpk(xv[q][j].x * r2[q] * g.x, xv[q][j].y * r2[q] * g.y); w.y = cvtpk(xv[q][j].z * r2[q] * g.z, xv[q][j].w * r2[q] * g.w); ho[64 * j] = w; } }
        }
    }
}

__device__ __forceinline__ int crow(int r, int hi) { return (r & 3) + 8 * (r >> 2) + 4 * hi; }
typedef short v4i16_t __attribute__((ext_vector_type(4)));
__device__ __forceinline__ s16x4 vtr(const LAS unsigned char* p) { return __builtin_bit_cast(s16x4, __builtin_amdgcn_ds_read_tr16_b64_v4i16((LAS v4i16_t*)p)); }

template <int D, class BiasF>
__device__ __forceinline__ void attn_qk(const LAS unsigned char* Kb, const bf16x8 (&qr)[D / 16], float m_run, f32x16& p0, f32x16& p1, float& mx, int r32, int hi, const BiasF& biasf) {
    const LAS unsigned char* kb = Kb + hi * 1024 + r32 * 16;
    if (biasf.uniform()) {
        f32x16 ci; const float c = biasf.uval() - m_run;
#pragma unroll
        for (int r = 0; r < 16; ++r) ci[r] = c;
        p0 = __builtin_amdgcn_mfma_f32_32x32x16_bf16(*(const LAS bf16x8*)(kb), qr[0], ci, 0, 0, 0);
        p1 = __builtin_amdgcn_mfma_f32_32x32x16_bf16(*(const LAS bf16x8*)(kb + 512), qr[0], ci, 0, 0, 0);
    } else {
#pragma unroll
        for (int r = 0; r < 16; ++r) { p0[r] = biasf(crow(r, hi)) - m_run; p1[r] = biasf(crow(r, hi) + 32) - m_run; }
        p0 = __builtin_amdgcn_mfma_f32_32x32x16_bf16(*(const LAS bf16x8*)(kb), qr[0], p0, 0, 0, 0);
        p1 = __builtin_amdgcn_mfma_f32_32x32x16_bf16(*(const LAS bf16x8*)(kb + 512), qr[0], p1, 0, 0, 0);
    }
#pragma unroll
    for (int d0 = 1; d0 < D / 16; ++d0) {
        const bf16x8 b0 = *(const LAS bf16x8*)(kb + d0 * 2048);
        const bf16x8 b1 = *(const LAS bf16x8*)(kb + d0 * 2048 + 512);
        p0 = __builtin_amdgcn_mfma_f32_32x32x16_bf16(b0, qr[d0], p0, 0, 0, 0);
        p1 = __builtin_amdgcn_mfma_f32_32x32x16_bf16(b1, qr[d0], p1, 0, 0, 0);
    }
    float ma = fmaxf(fmaxf(p0[0], p0[1]), p1[0]), mb = fmaxf(fmaxf(p0[2], p0[3]), p1[1]);
    ma = fmaxf(fmaxf(ma, p1[2]), p1[3]);
#pragma unroll
    for (int r = 4; r < 16; r += 4) { ma = fmaxf(fmaxf(ma, p0[r]), p0[r + 1]); mb = fmaxf(fmaxf(mb, p0[r + 2]), p0[r + 3]); ma = fmaxf(fmaxf(ma, p1[r]), p1[r + 1]); mb = fmaxf(fmaxf(mb, p1[r + 2]), p1[r + 3]); }
    mx = fmaxf(ma, mb);
}
template <int D>
__device__ __forceinline__ void attn_pv(const LAS unsigned char* Vb, float& m_run, float& l_run, f32x16 (&o)[D / 32], f32x16& p0, f32x16& p1, float mx, LAS float* wsf, int r32, int hi, bool first) {
    mx = fmaxf(mx, __shfl_xor(mx, 32));
    float dl = 0.f;
    if (first) { m_run = mx; dl = mx; }
    else if (__any(mx > 8.0f)) {
        dl = fmaxf(mx, 0.f);
        const float alpha = fast_exp2(-dl);
        m_run += dl; l_run *= alpha;
        if (hi == 0) wsf[r32] = alpha;
        LDS_WAIT(); asm volatile("" ::: "memory");
#pragma unroll
        for (int r = 0; r < 16; ++r) { const float a = wsf[crow(r, hi)];
#pragma unroll
            for (int d = 0; d < D / 32; ++d) o[d][r] *= a; }
    }
    float ps = 0.f, ps2 = 0.f;
#pragma unroll
    for (int r = 0; r < 16; ++r) { p0[r] = fast_exp2(p0[r] - dl); p1[r] = fast_exp2(p1[r] - dl); ps += p0[r]; ps2 += p1[r]; }
    l_run += ps + ps2;
    u32x4 pw[4];
    pw[0] = (u32x4){cvtpk(p0[0], p0[1]), cvtpk(p0[2], p0[3]), cvtpk(p0[4], p0[5]), cvtpk(p0[6], p0[7])};
    pw[1] = (u32x4){cvtpk(p0[8], p0[9]), cvtpk(p0[10], p0[11]), cvtpk(p0[12], p0[13]), cvtpk(p0[14], p0[15])};
    pw[2] = (u32x4){cvtpk(p1[0], p1[1]), cvtpk(p1[2], p1[3]), cvtpk(p1[4], p1[5]), cvtpk(p1[6], p1[7])};
    pw[3] = (u32x4){cvtpk(p1[8], p1[9]), cvtpk(p1[10], p1[11]), cvtpk(p1[12], p1[13]), cvtpk(p1[14], p1[15])};
    const LAS unsigned char* vp = Vb + ((r32 >> 4) & 1) * 32 + (r32 & 3) * 8 + (4 * hi + ((r32 & 15) >> 2)) * 64;
#pragma unroll
    for (int d0 = 0; d0 < D / 32; ++d0) {
#pragma unroll
        for (int ks = 0; ks < 4; ++ks) {
            const s16x4 lo = vtr(vp + d0 * 4096 + ks * 1024), hh = vtr(vp + d0 * 4096 + ks * 1024 + 512);
            const bf16x8 vf = (bf16x8){lo[0], lo[1], lo[2], lo[3], hh[0], hh[1], hh[2], hh[3]};
            o[d0] = __builtin_amdgcn_mfma_f32_32x32x16_bf16(__builtin_bit_cast(bf16x8, pw[ks]), vf, o[d0], 0, 0, 0);
        }
    }
}
template <int D, class BiasF>
__device__ __forceinline__ void attn_tile(const LAS unsigned char* Kb, const LAS unsigned char* Vb, const bf16x8 (&qr)[D / 16], float& m_run, float& l_run, f32x16 (&o)[D / 32],
                                          LAS float* wsf, int r32, int hi, const BiasF& biasf, bool first) {
    f32x16 p0, p1; float mx;
    attn_qk<D>(Kb, qr, m_run, p0, p1, mx, r32, hi, biasf);
    attn_pv<D>(Vb, m_run, l_run, o, p0, p1, mx, wsf, r32, hi, first);
}
template <int ND>
__device__ __forceinline__ void attn_finish(float l_run, f32x16 (&o)[ND], LAS float* wsf, int r32, int hi) {
    const float l = l_run + __shfl_xor(l_run, 32);
    LDS_WAIT(); asm volatile("" ::: "memory");
    if (hi == 0) wsf[32 + r32] = 1.0f / l;
    LDS_WAIT(); asm volatile("" ::: "memory");
#pragma unroll
    for (int r = 0; r < 16; ++r) { const float a = wsf[32 + crow(r, hi)];
#pragma unroll
        for (int d = 0; d < ND; ++d) o[d][r] *= a; }
}

constexpr int ATT_GRP = 32768, ATT_K = 0, ATT_V = 16384, ATT_TB = 65536, ATT_WS = ATT_TB + 1024, ATT_OST = ATT_WS + 2048, ATT_LDS = ATT_OST + 8 * 4096;
static_assert(ATT_LDS <= RING_BYTES, "attention LDS");
struct ChunkBias {
    const LAS float* tb; int base; bool far; float farv;
    __device__ __forceinline__ bool uniform() const { return far; }
    __device__ __forceinline__ float uval() const { return farv; }
    __device__ __forceinline__ float operator()(int kin) const { int d = base - kin; d = d > 128 ? 128 : d; return tb[d + 63]; }
};
__device__ __forceinline__ void chunk_attention_head(const bf16_t* PQp, const bf16_t* PRp, bf16_t* Oout, int opitch, const float* relb, int b, int h, LAS unsigned char* lds, int tid) {
    const int lane = tid & 63, r32 = lane & 31, hi = lane >> 5; const int wid = __builtin_amdgcn_readfirstlane(tid >> 6);
    const int grp = wid >> 2, wg = wid & 3;
    LAS float* tb = (LAS float*)(lds + ATT_TB);
    LAS float* wsf = (LAS float*)(lds + ATT_WS) + wid * 64;
    LAS unsigned char* gl = lds + grp * ATT_GRP;
    if (tid < 192) tb[tid] = relb[h * 192 + tid] * LOG2E;
    const size_t rowbase = (size_t)b * SEQ;
    const bf16_t* Kh = PRp + rowbase * NPR + C_KA + h * 64; const bf16_t* Vh = PRp + rowbase * NPR + C_VA + h * 64;
    const bf16_t* ksrc = Kh + (size_t)lane * NPR + wg * 8;
    const bf16_t* vsrc = Vh + (size_t)(16 * wg + (lane >> 2)) * NPR + (lane & 3) * 8;
    const int kdst = wg * 1024 + lane * 16, vdst = wg * 1024 + lane * 16;
    __syncthreads();
    const float farv = tb[191];
    if (grp == 1) { __builtin_amdgcn_s_setprio(1); __syncthreads(); }
    for (int it = 0; it < 8; ++it) {
        const int u = 2 * it + grp, c0 = 2 * u, cw = c0 + (wg >> 1), qin = 32 * (wg & 1) + r32;
        const bf16_t* Qw = PQp + (rowbase + u * 128 + wg * 32) * NPQ + C_Q + h * 64;
        bf16_t* Ow = Oout + (rowbase + u * 128 + wg * 32) * opitch + h * 64;
        bf16x8 qr[4];
#pragma unroll
        for (int d0 = 0; d0 < 4; ++d0) qr[d0] = *(const bf16x8*)&Qw[(size_t)r32 * NPQ + d0 * 16 + hi * 8];
        float m_run = 0.f, l_run = 0.f; f32x16 o[2]; bool first = true;
#pragma unroll
        for (int r = 0; r < 16; ++r) { o[0][r] = 0.f; o[1][r] = 0.f; }
        u32x4 kA[2], vA[2], kB[2], vB[2];
#define TVALID(t) ((t) <= 9 && (c0 - 8 + (t)) >= 0)
#define TLOAD(K_, V_, t) do { if (TVALID(t)) { const size_t ro_ = (size_t)(c0 - 8 + (t)) * 64 * NPR; _Pragma("unroll") for (int j = 0; j < 2; ++j) { K_[j] = *(const u32x4*)(ksrc + ro_ + j * 32); V_[j] = *(const u32x4*)(vsrc + ro_ + j * 32); } } } while (0)
#define TWRITE(K_, V_, t) do { if (TVALID(t)) { _Pragma("unroll") for (int j = 0; j < 2; ++j) { *(LAS u32x4*)(gl + ATT_K + ((t) & 1) * 8192 + j * 4096 + kdst) = K_[j]; *(LAS u32x4*)(gl + ATT_V + ((t) & 1) * 8192 + j * 4096 + vdst) = V_[j]; } } } while (0)
#define TSTEP(t) do { const int kc_ = c0 - 8 + (t); const int dc_ = cw - kc_; const bool vis_ = (kc_ >= 0 && dc_ >= 0 && dc_ <= 8); f32x16 p0, p1; float mx_ = 0.f; \
            if (vis_) { ChunkBias bf{tb, qin + 64 * dc_, dc_ >= 3, farv}; attn_qk<64>(gl + ATT_K + ((t) & 1) * 8192, qr, m_run, p0, p1, mx_, r32, hi, bf); } \
            __syncthreads(); \
            if (vis_) { attn_pv<64>(gl + ATT_V + ((t) & 1) * 8192, m_run, l_run, o, p0, p1, mx_, wsf, r32, hi, first); first = false; } } while (0)
        TLOAD(kB, vB, 0); TWRITE(kB, vB, 0);
        TLOAD(kA, vA, 1);
        __syncthreads();
#pragma unroll 1
        for (int kk = 0; kk < 10; kk += 2) {
            TLOAD(kB, vB, kk + 2);
            TSTEP(kk);
            TWRITE(kA, vA, kk + 1);
            __syncthreads();
            TLOAD(kA, vA, kk + 3);
            TSTEP(kk + 1);
            TWRITE(kB, vB, kk + 2);
            __syncthreads();
        }
#undef TVALID
#undef TLOAD
#undef TWRITE
#undef TSTEP
        attn_finish<2>(l_run, o, wsf, r32, hi);
        LAS unsigned short* stg = (LAS unsigned short*)(lds + ATT_OST) + wid * 2048;
#pragma unroll
        for (int r = 0; r < 16; r += 1) { const int orow = crow(r, hi);
#pragma unroll
            for (int d0 = 0; d0 < 2; ++d0) stg[orow * 64 + d0 * 32 + r32] = (unsigned short)f2bf(o[d0][r]); }
        LDS_WAIT(); asm volatile("" ::: "memory");
#pragma unroll
        for (int i = 0; i < 4; ++i) { const int row = i * 8 + (lane >> 3), ch = lane & 7; const u32x4 v = *(const LAS u32x4*)(stg + row * 64 + ch * 8); *(u32x4*)(Ow + (size_t)row * opitch + ch * 8) = v; }
        LDS_WAIT(); asm volatile("" ::: "memory");
        __syncthreads();
    }
    if (grp == 0) __syncthreads(); else __builtin_amdgcn_s_setprio(0);
}

constexpr int AT2_BUF = 32768, AT2_TB = 65536, AT2_WS = AT2_TB + 1024, AT2_OST = AT2_WS + 2048, AT2_LDS = AT2_OST + 8 * 4096;
static_assert(AT2_LDS <= RING_BYTES, "attention LDS");
template <class BiasF>
__device__ __forceinline__ void attn2_scores(const LAS unsigned char* Kb, bool vis, const bf16x8 (&qr)[4], float m_run, f32x16& pa, f32x16& pb, int r32, int hi, const BiasF& bf) {
    if (vis) {
        const LAS unsigned char* kb = Kb + hi * 1024 + r32 * 16;
        if (bf.uniform()) {
            f32x16 ci; const float c = bf.uval() - m_run;
#pragma unroll
            for (int r = 0; r < 16; ++r) ci[r] = c;
            pa = __builtin_amdgcn_mfma_f32_32x32x16_bf16(*(const LAS bf16x8*)(kb), qr[0], ci, 0, 0, 0);
            pb = __builtin_amdgcn_mfma_f32_32x32x16_bf16(*(const LAS bf16x8*)(kb + 512), qr[0], ci, 0, 0, 0);
        } else {
#pragma unroll
            for (int r = 0; r < 16; ++r) { pa[r] = bf(crow(r, hi)) - m_run; pb[r] = bf(crow(r, hi) + 32) - m_run; }
            pa = __builtin_amdgcn_mfma_f32_32x32x16_bf16(*(const LAS bf16x8*)(kb), qr[0], pa, 0, 0, 0);
            pb = __builtin_amdgcn_mfma_f32_32x32x16_bf16(*(const LAS bf16x8*)(kb + 512), qr[0], pb, 0, 0, 0);
        }
#pragma unroll
        for (int d0 = 1; d0 < 4; ++d0) {
            pa = __builtin_amdgcn_mfma_f32_32x32x16_bf16(*(const LAS bf16x8*)(kb + d0 * 2048), qr[d0], pa, 0, 0, 0);
            pb = __builtin_amdgcn_mfma_f32_32x32x16_bf16(*(const LAS bf16x8*)(kb + d0 * 2048 + 512), qr[d0], pb, 0, 0, 0);
        }
    } else {
#pragma unroll
        for (int r = 0; r < 16; ++r) { pa[r] = -1e30f; pb[r] = -1e30f; }
    }
}
__device__ __forceinline__ void attn2_pv(const LAS unsigned char* Vb, float dl, float& ps, f32x16 (&o)[2], f32x16& pa, f32x16& pb, int r32, int hi) {
#pragma unroll
    for (int r = 0; r < 16; ++r) { pa[r] = fast_exp2(pa[r] - dl); pb[r] = fast_exp2(pb[r] - dl); ps += pa[r] + pb[r]; }
    const LAS unsigned char* vp = Vb + ((r32 >> 4) & 1) * 32 + (r32 & 3) * 8 + (4 * hi + ((r32 & 15) >> 2)) * 64;
#pragma unroll
    for (int ks = 0; ks < 4; ++ks) {
        const f32x16& pp = (ks < 2) ? pa : pb; const int b8 = (ks & 1) * 8;
        const bf16x8 pf = __builtin_bit_cast(bf16x8, (u32x4){cvtpk(pp[b8 + 0], pp[b8 + 1]), cvtpk(pp[b8 + 2], pp[b8 + 3]), cvtpk(pp[b8 + 4], pp[b8 + 5]), cvtpk(pp[b8 + 6], pp[b8 + 7])});
#pragma unroll
        for (int d0 = 0; d0 < 2; ++d0) {
            const s16x4 lo = vtr(vp + d0 * 4096 + ks * 1024), hh = vtr(vp + d0 * 4096 + ks * 1024 + 512);
            const bf16x8 vf = (bf16x8){lo[0], lo[1], lo[2], lo[3], hh[0], hh[1], hh[2], hh[3]};
            o[d0] = __builtin_amdgcn_mfma_f32_32x32x16_bf16(pf, vf, o[d0], 0, 0, 0);
        }
    }
}
__device__ __forceinline__ void chunk_attention_head2(const bf16_t* PQp, const bf16_t* PRp, bf16_t* Oout, int opitch, const float* relb, int b, int h, LAS unsigned char* lds, int tid) {
    const int lane = tid & 63, r32 = lane & 31, hi = lane >> 5; const int wid = __builtin_amdgcn_readfirstlane(tid >> 6);
    LAS float* tb = (LAS float*)(lds + AT2_TB);
    LAS float* wsf = (LAS float*)(lds + AT2_WS) + wid * 64;
    if (tid < 192) tb[tid] = relb[h * 192 + tid] * LOG2E;
    const size_t rowbase = (size_t)b * SEQ;
    const bf16_t* Kh = PRp + rowbase * NPR + C_KA + h * 64; const bf16_t* Vh = PRp + rowbase * NPR + C_VA + h * 64;
    const bf16_t* ksrc = Kh + (size_t)lane * NPR + wid * 8;
    const bf16_t* vsrc = Vh + (size_t)(16 * (wid & 3) + (lane >> 2)) * NPR + (wid >> 2) * 32 + (lane & 3) * 8;
    const int pdst = wid * 1024 + lane * 16;
    __syncthreads();
    const float farv = tb[191];
    for (int qb = 0; qb < 8; ++qb) {
        const int c0 = qb * 4, cw = c0 + (wid >> 1), qin = 32 * (wid & 1) + r32;
        const bf16_t* Qw = PQp + (rowbase + qb * 256 + wid * 32) * NPQ + C_Q + h * 64;
        bf16_t* Ow = Oout + (rowbase + qb * 256 + wid * 32) * opitch + h * 64;
        bf16x8 qr[4];
#pragma unroll
        for (int d0 = 0; d0 < 4; ++d0) qr[d0] = *(const bf16x8*)&Qw[(size_t)r32 * NPQ + d0 * 16 + hi * 8];
        float m_run = 0.f, l_run = 0.f; f32x16 o[2]; bool first = true;
#pragma unroll
        for (int r = 0; r < 16; ++r) { o[0][r] = 0.f; o[1][r] = 0.f; }
        u32x4 kA[2], vA[2];
#define SVALID(s_) ((s_) <= 5 && (c0 - 8 + 2 * (s_)) >= 0)
#define SLOAD(s_) do { if (SVALID(s_)) { const size_t ro_ = (size_t)(c0 - 8 + 2 * (s_)) * 64 * NPR; _Pragma("unroll") for (int j = 0; j < 2; ++j) { kA[j] = *(const u32x4*)(ksrc + ro_ + (size_t)j * 64 * NPR); vA[j] = *(const u32x4*)(vsrc + ro_ + (size_t)j * 64 * NPR); } } } while (0)
#define SWRITE(s_) do { if (SVALID(s_)) { LAS unsigned char* bb_ = lds + ((s_) & 1) * AT2_BUF; _Pragma("unroll") for (int j = 0; j < 2; ++j) { *(LAS u32x4*)(bb_ + j * 16384 + pdst) = kA[j]; *(LAS u32x4*)(bb_ + j * 16384 + 8192 + pdst) = vA[j]; } } } while (0)
        SLOAD(0); SWRITE(0);
        __syncthreads();
#pragma unroll 1
        for (int ss = 0; ss < 6; ++ss) {
            SLOAD(ss + 1);
            const int kcA = c0 - 8 + 2 * ss; const int dA = cw - kcA, dB = dA - 1;
            const bool vA_ = (kcA >= 0 && dA >= 0 && dA <= 8), vB_ = (kcA >= 0 && dB >= 0 && dB <= 8);
            if (vA_ || vB_) {
                const LAS unsigned char* bb = lds + (ss & 1) * AT2_BUF;
                f32x16 p0, p1, p2, p3;
                attn2_scores(bb, vA_, qr, m_run, p0, p1, r32, hi, ChunkBias{tb, qin + 64 * dA, dA >= 3, farv});
                attn2_scores(bb + 16384, vB_, qr, m_run, p2, p3, r32, hi, ChunkBias{tb, qin + 64 * dB, dB >= 3, farv});
                float ma = fmaxf(fmaxf(p0[0], p1[0]), p2[0]), mb = fmaxf(fmaxf(p0[1], p1[1]), p3[0]);
                mb = fmaxf(mb, fmaxf(p2[1], p3[1]));
#pragma unroll
                for (int r = 2; r < 16; r += 2) { ma = fmaxf(fmaxf(ma, p0[r]), p1[r]); mb = fmaxf(fmaxf(mb, p0[r + 1]), p1[r + 1]); ma = fmaxf(fmaxf(ma, p2[r]), p3[r]); mb = fmaxf(fmaxf(mb, p2[r + 1]), p3[r + 1]); }
                float mx = fmaxf(ma, mb);
                mx = fmaxf(mx, __shfl_xor(mx, 32));
                float dl = 0.f;
                if (first) { m_run = mx; dl = mx; first = false; }
                else if (__any(mx > 8.0f)) {
                    dl = fmaxf(mx, 0.f);
                    const float alpha = fast_exp2(-dl);
                    m_run += dl; l_run *= alpha;
                    if (hi == 0) wsf[r32] = alpha;
                    LDS_WAIT(); asm volatile("" ::: "memory");
#pragma unroll
                    for (int r = 0; r < 16; ++r) { const float a = wsf[crow(r, hi)]; o[0][r] *= a; o[1][r] *= a; }
                }
                float ps = 0.f;
                if (vA_) attn2_pv(bb + 8192, dl, ps, o, p0, p1, r32, hi);
                if (vB_) attn2_pv(bb + 24576, dl, ps, o, p2, p3, r32, hi);
                l_run += ps;
            }
            SWRITE(ss + 1);
            __syncthreads();
        }
#undef SVALID
#undef SLOAD
#undef SWRITE
        attn_finish<2>(l_run, o, wsf, r32, hi);
        LAS unsigned short* stg = (LAS unsigned short*)(lds + AT2_OST) + wid * 2048;
#pragma unroll
        for (int r = 0; r < 16; r += 1) { const int orow = crow(r, hi);
#pragma unroll
            for (int d0 = 0; d0 < 2; ++d0) stg[orow * 64 + d0 * 32 + r32] = (unsigned short)f2bf(o[d0][r]); }
        LDS_WAIT(); asm volatile("" ::: "memory");
#pragma unroll
        for (int i = 0; i < 4; ++i) { const int row = i * 8 + (lane >> 3), ch = lane & 7; const u32x4 v = *(const LAS u32x4*)(stg + row * 64 + ch * 8); *(u32x4*)(Ow + (size_t)row * opitch + ch * 8) = v; }
        LDS_WAIT(); asm volatile("" ::: "memory");
        __syncthreads();
    }
}

constexpr int A3_SLOT = 8192, A3_K = 0, A3_V = 3 * A3_SLOT, A3_WS = 6 * A3_SLOT, A3_TB = A3_WS + 2048, A3_OST = A3_TB + 4352, A3_LDS = A3_OST + 8 * 4096;
static_assert(A3_LDS <= RING_BYTES, "attention LDS");
__device__ __forceinline__ void glds16(const void* g, unsigned lds_base) {
    unsigned sv; asm volatile("s_mov_b32 %0, m0\n\ts_mov_b32 m0, %2\n\ts_nop 0\n\tglobal_load_lds_dwordx4 %1, off\n\ts_mov_b32 m0, %0" : "=&s"(sv) : "v"(g), "s"(lds_base) : "memory"); }
#define MFMA32(a, b, c) __builtin_amdgcn_mfma_f32_32x32x16_bf16(a, b, c, 0, 0, 0)
#define A3_SBAR() __builtin_amdgcn_sched_barrier(0)
#define A3_PIN(x) asm volatile("" : "+v"(x))
#define A3_WAIT_BAR(N) asm volatile("s_waitcnt vmcnt(" #N ") lgkmcnt(0)\n\ts_barrier" ::: "memory")
#define A3_MX3(a, b, c) __builtin_fmaxf(__builtin_fmaxf((a), (b)), (c))
__device__ __forceinline__ void a3_swap32(float& a, float& b) { asm volatile("s_nop 1\n\tv_permlane32_swap_b32 %0, %1\n\ts_nop 1" : "+v"(a), "+v"(b)); }
__device__ __forceinline__ float a3_rowmax(const f32x16& p0, const f32x16& p1) {
    float a = A3_MX3(p0[0], p0[1], p1[0]), b = A3_MX3(p0[2], p0[3], p1[1]); a = A3_MX3(a, p1[2], p1[3]);
#pragma unroll
    for (int r = 4; r < 16; r += 4) { a = A3_MX3(a, p0[r], p0[r + 1]); b = A3_MX3(b, p0[r + 2], p0[r + 3]); a = A3_MX3(a, p1[r], p1[r + 1]); b = A3_MX3(b, p1[r + 2], p1[r + 3]); }
    float m = __builtin_fmaxf(a, b), m2 = m; a3_swap32(m, m2);
    return __builtin_fmaxf(m, m2); }
__device__ __forceinline__ void a3_kload2(bf16x8* kf, const LAS unsigned char* kp, int d0) { kf[2 * d0] = *(const LAS bf16x8*)(kp + d0 * 2048); kf[2 * d0 + 1] = *(const LAS bf16x8*)(kp + d0 * 2048 + 512); }
__device__ __forceinline__ void chunk_attention_head3(const bf16_t* PQp, const bf16_t* PRp, bf16_t* Oout, int opitch, const float* relb, int b, int h, LAS unsigned char* lds, int tid) {
    const int lane = tid & 63, r32 = lane & 31, hi = lane >> 5; const int wid = __builtin_amdgcn_readfirstlane(tid >> 6);
    LAS float* tbx = (LAS float*)(lds + A3_TB);
    LAS float* wsf = (LAS float*)(lds + A3_WS) + wid * 64;
    __syncthreads();
    for (int i = tid; i < 1040; i += 512) { const int s = i / 260, m = i - 260 * s, n = m - s; float v = 0.f;
        if (n >= 0 && n <= 254) { int D = 191 - n; D = D > 128 ? 128 : D; v = (relb[h * 192 + D + 63] - relb[h * 192 + 191]) * LOG2E; }
        tbx[i] = v; }
    const float farv = relb[h * 192 + 191] * LOG2E;
    const size_t rowbase = (size_t)b * SEQ;
    const bf16_t* Kh = PRp + rowbase * NPR + C_KA + h * 64; const bf16_t* Vh = PRp + rowbase * NPR + C_VA + h * 64;
    const unsigned lds0 = (unsigned)(size_t)lds;
    const unsigned kdst = lds0 + A3_K + wid * 1024, vdst = lds0 + A3_V + wid * 1024;
    const LAS unsigned char* vp0 = lds + A3_V + ((lane >> 4) & 1) * 32 + (lane & 3) * 8 + (4 * hi + ((lane & 15) >> 2)) * 64;
    const LAS unsigned char* kp0 = lds + A3_K + hi * 1024 + r32 * 16;
    const int sgn = (r32 + 1) & 3;
    const LAS float* tbase = tbx + 260 * sgn + (191 - (32 * (wid & 1) + r32) + 4 * hi + sgn);
    __syncthreads();
    const bf16_t* Kl = Kh + (size_t)lane * NPR + wid * 8;
    const bf16_t* Vl = Vh + (size_t)(16 * (wid & 3) + (lane >> 2)) * NPR + (wid >> 2) * 32 + (lane & 3) * 8;
    int sl_prev = 2 * A3_SLOT, sl_cur = 0, sl_next = A3_SLOT;
    bf16x8 qr[4];
#pragma unroll 1
    for (int qb = 0; qb < 8; ++qb) {
        const int c0 = qb * 4, kstart = c0 > 8 ? c0 - 8 : 0, NT = c0 + 4 - kstart, dc0 = c0 + (wid >> 1) - kstart;
        const int knext = qb < 7 ? (c0 > 4 ? c0 - 4 : 0) : kstart + NT - 1;
        const bf16_t* Qw = PQp + (rowbase + qb * 256 + wid * 32) * NPQ + C_Q + h * 64;
        bf16_t* Ow = Oout + (rowbase + qb * 256 + wid * 32) * opitch + h * 64;
#define A3_KC(t) int t_ = (t); const int kc_ = t_ < NT ? kstart + t_ : (qb < 7 ? knext + (t_ - NT) : knext);
#define DMA_K(t, slot) do { A3_KC(t) glds16(Kl + (size_t)kc_ * 64 * NPR, (unsigned)__builtin_amdgcn_readfirstlane(kdst + (slot))); } while (0)
#define DMA_V(t, slot) do { A3_KC(t) glds16(Vl + (size_t)kc_ * 64 * NPR, (unsigned)__builtin_amdgcn_readfirstlane(vdst + (slot))); } while (0)
#define NEARADD(X0, X1, dc) do { const LAS float* tp_ = tbase - 64 * (dc); _Pragma("unroll") for (int g = 0; g < 4; ++g) { const f32x4 a_ = *(const LAS f32x4*)(tp_ + 8 * g), b_ = *(const LAS f32x4*)(tp_ + 32 + 8 * g); \
            X0[4 * g] += a_[0]; X0[4 * g + 1] += a_[1]; X0[4 * g + 2] += a_[2]; X0[4 * g + 3] += a_[3]; X1[4 * g] += b_[0]; X1[4 * g + 1] += b_[1]; X1[4 * g + 2] += b_[2]; X1[4 * g + 3] += b_[3]; } } while (0)
        if (qb == 0) { DMA_K(0, sl_cur); DMA_V(0, sl_cur); DMA_K(1, sl_next);
#pragma unroll
            for (int d0 = 0; d0 < 4; ++d0) qr[d0] = *(const bf16x8*)&Qw[(size_t)r32 * NPQ + d0 * 16 + hi * 8]; }
        float mhat = 0.f, l_reg = 0.f; f32x16 o[2];
#pragma unroll
        for (int r = 0; r < 16; ++r) { o[0][r] = 0.f; o[1][r] = 0.f; }
        f32x16 ci16;
#pragma unroll
        for (int r = 0; r < 16; ++r) ci16[r] = farv;
        A3_PIN(ci16);
        bool resc = false, first = true;
        f32x16 pA0, pA1, pB0, pB1; bf16x8 kf[8]; s16x4 vlo[8], vhi[8]; u32x4 pw0, pw1, pw2, pw3;
#define ROT() do { sl_prev = sl_cur; sl_cur = sl_next; sl_next = (sl_next == 2 * A3_SLOT) ? 0 : sl_next + A3_SLOT; } while (0)
#define EX(v) __builtin_amdgcn_exp2f(v)
#define RESC() do { if (resc) { _Pragma("unroll") for (int d_ = 0; d_ < 2; ++d_) _Pragma("unroll") for (int r = 0; r < 16; ++r) o[d_][r] *= wsf[crow(r, hi)]; } } while (0)
#define DECIDE(C0, C1, t) resc = false; \
        { const int dc_ = dc0 - (t); \
          if (dc_ >= 0 && dc_ <= 8) { if (dc_ <= 2) NEARADD(C0, C1, dc_); \
              const float rm = a3_rowmax(C0, C1); float dl = 0.f; bool mv_ = false; \
              if (first) { dl = rm; first = false; mv_ = true; } \
              else if (__builtin_expect(__any(rm > 8.0f), 0)) { dl = __builtin_fmaxf(rm, 0.f); const float f = __builtin_amdgcn_exp2f(-dl); l_reg *= f; if (hi == 0) wsf[r32] = f; resc = true; mv_ = true; } \
              if (mv_) { mhat += dl; const float cv_ = farv - mhat; \
                  _Pragma("unroll") for (int r = 0; r < 16; ++r) { C0[r] -= dl; C1[r] -= dl; ci16[r] = cv_; } A3_PIN(ci16); } } \
          else { _Pragma("unroll") for (int r = 0; r < 16; ++r) { C0[r] = -30000.f; C1[r] = -30000.f; } } }
        if (qb == 0) { DMA_K(2, sl_prev); A3_WAIT_BAR(3); }
#pragma unroll
        for (int d0 = 0; d0 < 4; ++d0) a3_kload2(kf, kp0 + sl_cur, d0);
        pA0 = MFMA32(kf[0], qr[0], ci16); pA1 = MFMA32(kf[1], qr[0], ci16); pA0 = MFMA32(kf[2], qr[1], pA0); pA1 = MFMA32(kf[3], qr[1], pA1);
        pA0 = MFMA32(kf[4], qr[2], pA0); pA1 = MFMA32(kf[5], qr[2], pA1); pA0 = MFMA32(kf[6], qr[3], pA0); pA1 = MFMA32(kf[7], qr[3], pA1);
        { DECIDE(pA0, pA1, 0)
#pragma unroll
          for (int r = 0; r < 16; ++r) { pA0[r] = EX(pA0[r]); pA1[r] = EX(pA1[r]); } }
        A3_WAIT_BAR(0);
        DMA_K(3, sl_cur); DMA_V(1, sl_next); ROT();
#pragma unroll
        for (int d0 = 0; d0 < 4; ++d0) a3_kload2(kf, kp0 + sl_cur, d0);
        A3_WAIT_BAR(2);
#define PKW(P, i) cvtpk(P[i], P[i + 1])
#define PAF(k) __builtin_bit_cast(bf16x8, pw##k)
#define VFR(i) (bf16x8){vlo[i][0], vlo[i][1], vlo[i][2], vlo[i][3], vhi[i][0], vhi[i][1], vhi[i][2], vhi[i][3]}
#define VRD(i) do { vlo[i] = vtr(vp_ + (((i) >> 2) * 4096 + ((i) & 3) * 1024)); vhi[i] = vtr(vp_ + (((i) >> 2) * 4096 + ((i) & 3) * 1024 + 512)); } while (0)
#define KRD(G, d0) do { if (G) { a3_kload2(kf, kp0 + sl_next, d0); A3_SBAR(); } } while (0)
#define GAPA(MF, a0, a1, a2, a3, W0, W1, PW) do { MF; sacc += a0; sacc += a1; sacc += a2; sacc += a3; W0; W1; A3_PIN(PW); A3_PIN(sacc); A3_SBAR(); } while (0)
#define GAPB(MF, X, i) do { MF; X[i] = EX(X[i]); X[i + 1] = EX(X[i + 1]); X[i + 2] = EX(X[i + 2]); X[i + 3] = EX(X[i + 3]); A3_PIN(X); A3_SBAR(); } while (0)
#define STEP(C0, C1, P0, P1, t, GD, GL) do { A3_SBAR(); \
        const LAS unsigned char* vp_ = vp0 + sl_prev; \
        VRD(0); A3_SBAR(); float sacc = P0[0] + P0[1]; \
                           GAPA(C0 = MFMA32(kf[0], qr[0], ci16),   P0[2], P0[3], P0[4], P0[5],     pw0[0] = PKW(P0, 0),  pw0[1] = PKW(P0, 2),  pw0); \
        VRD(4); A3_SBAR(); GAPA(C1 = MFMA32(kf[1], qr[0], ci16),   P0[6], P0[7], P0[8], P0[9],     pw0[2] = PKW(P0, 4),  pw0[3] = PKW(P0, 6),  pw0); \
        VRD(1); A3_SBAR(); GAPA(C0 = MFMA32(kf[2], qr[1], C0),    P0[10], P0[11], P0[12], P0[13], pw1[0] = PKW(P0, 8),  pw1[1] = PKW(P0, 10), pw1); \
        VRD(5); A3_SBAR(); GAPA(C1 = MFMA32(kf[3], qr[1], C1),    P0[14], P0[15], P1[0], P1[1],   pw1[2] = PKW(P0, 12), pw1[3] = PKW(P0, 14), pw1); \
        VRD(2); A3_SBAR(); GAPA(C0 = MFMA32(kf[4], qr[2], C0),    P1[2], P1[3], P1[4], P1[5],     pw2[0] = PKW(P1, 0),  pw2[1] = PKW(P1, 2),  pw2); \
        VRD(6); A3_SBAR(); GAPA(C1 = MFMA32(kf[5], qr[2], C1),    P1[6], P1[7], P1[8], P1[9],     pw2[2] = PKW(P1, 4),  pw2[3] = PKW(P1, 6),  pw2); \
        VRD(3); A3_SBAR(); GAPA(C0 = MFMA32(kf[6], qr[3], C0),    P1[10], P1[11], P1[12], P1[13], pw3[0] = PKW(P1, 8),  pw3[1] = PKW(P1, 10), pw3); \
        VRD(7); A3_SBAR(); GAPA(C1 = MFMA32(kf[7], qr[3], C1),    P1[14], P1[15], 0.f, 0.f,       pw3[2] = PKW(P1, 12), pw3[3] = PKW(P1, 14), pw3); \
        l_reg += sacc; \
        if (GD) { DMA_K((t) + 3, sl_cur); DMA_V((t) + 1, sl_next); } \
        DECIDE(C0, C1, t) \
        A3_SBAR(); \
        GAPB(o[0] = MFMA32(PAF(0), VFR(0), o[0]), C0, 0);              GAPB(o[1] = MFMA32(PAF(0), VFR(4), o[1]), C0, 4); \
        KRD(GL, 0); GAPB(o[0] = MFMA32(PAF(1), VFR(1), o[0]), C0, 8);  KRD(GL, 1); GAPB(o[1] = MFMA32(PAF(1), VFR(5), o[1]), C0, 12); \
        KRD(GL, 2); GAPB(o[0] = MFMA32(PAF(2), VFR(2), o[0]), C1, 0);  KRD(GL, 3); GAPB(o[1] = MFMA32(PAF(2), VFR(6), o[1]), C1, 4); \
        GAPB(o[0] = MFMA32(PAF(3), VFR(3), o[0]), C1, 8);              GAPB(o[1] = MFMA32(PAF(3), VFR(7), o[1]), C1, 12); \
        } while (0)
        int t = 1;
#pragma unroll 1
        for (; t + 1 < NT; t += 2) {
            STEP(pB0, pB1, pA0, pA1, t, true, true);     A3_WAIT_BAR(2); RESC(); ROT();
            STEP(pA0, pA1, pB0, pB1, t + 1, true, true); A3_WAIT_BAR(2); RESC(); ROT();
        }
        STEP(pB0, pB1, pA0, pA1, NT - 1, true, false);
        A3_WAIT_BAR(2); RESC();
        if (qb < 7) { const bf16_t* Qn = Qw + (size_t)256 * NPQ;
#pragma unroll
            for (int d0 = 0; d0 < 4; ++d0) qr[d0] = *(const bf16x8*)&Qn[(size_t)r32 * NPQ + d0 * 16 + hi * 8]; }
        { float sacc = pB0[0] + pB0[1];
#pragma unroll
          for (int r = 2; r < 16; ++r) sacc += pB0[r];
#pragma unroll
          for (int r = 0; r < 16; ++r) sacc += pB1[r];
          l_reg += sacc;
          pw0 = (u32x4){PKW(pB0, 0), PKW(pB0, 2), PKW(pB0, 4), PKW(pB0, 6)}; pw1 = (u32x4){PKW(pB0, 8), PKW(pB0, 10), PKW(pB0, 12), PKW(pB0, 14)};
          pw2 = (u32x4){PKW(pB1, 0), PKW(pB1, 2), PKW(pB1, 4), PKW(pB1, 6)}; pw3 = (u32x4){PKW(pB1, 8), PKW(pB1, 10), PKW(pB1, 12), PKW(pB1, 14)};
          const LAS unsigned char* vp_ = vp0 + sl_cur;
#pragma unroll
          for (int i = 0; i < 8; ++i) VRD(i);
          o[0] = MFMA32(PAF(0), VFR(0), o[0]); o[1] = MFMA32(PAF(0), VFR(4), o[1]); o[0] = MFMA32(PAF(1), VFR(1), o[0]); o[1] = MFMA32(PAF(1), VFR(5), o[1]);
          o[0] = MFMA32(PAF(2), VFR(2), o[0]); o[1] = MFMA32(PAF(2), VFR(6), o[1]); o[0] = MFMA32(PAF(3), VFR(3), o[0]); o[1] = MFMA32(PAF(3), VFR(7), o[1]); }
        { float l2 = l_reg; a3_swap32(l_reg, l2); l_reg += l2; }
        if (hi == 0) wsf[32 + r32] = l_reg;
        LDS_WAIT(); asm volatile("" ::: "memory");
        LAS unsigned short* stg = (LAS unsigned short*)(lds + A3_OST) + wid * 2048;
#pragma unroll
        for (int r = 0; r < 16; ++r) { const int orow = crow(r, hi); const float rl = __builtin_amdgcn_rcpf(wsf[32 + orow]);
#pragma unroll
            for (int d0 = 0; d0 < 2; ++d0) stg[orow * 64 + d0 * 32 + r32] = (unsigned short)f2bf(o[d0][r] * rl); }
        LDS_WAIT(); asm volatile("" ::: "memory");
#pragma unroll
        for (int i = 0; i < 4; ++i) { const int row = i * 8 + (lane >> 3), ch = lane & 7; const u32x4 v = *(const LAS u32x4*)(stg + row * 64 + ch * 8); *(u32x4*)(Ow + (size_t)row * opitch + ch * 8) = v; }
        ROT();
        asm volatile("s_waitcnt lgkmcnt(0)\n\ts_barrier" ::: "memory");
#undef A3_KC
#undef DMA_K
#undef DMA_V
#undef NEARADD
#undef ROT
#undef EX
#undef RESC
#undef DECIDE
#undef PKW
#undef PAF
#undef VFR
#undef VRD
#undef KRD
#undef GAPA
#undef GAPB
#undef STEP
    }
    asm volatile("s_waitcnt vmcnt(0)" ::: "memory");
}

constexpr int CA_K = 0, CA_V = 65536, CA_WS = 132096, CA_OST = CA_WS + 8 * 256;
static_assert(CA_WS >= MISC_OFF + 128 && CA_OST + 8 * 2048 <= LDS_BYTES, "CA LDS");
struct NoBias { __device__ __forceinline__ bool uniform() const { return true; } __device__ __forceinline__ float uval() const { return 0.f; } __device__ __forceinline__ float operator()(int) const { return 0.f; } };
__device__ __forceinline__ void cross_attention(const bf16_t* Q2, const bf16_t* KVM, bf16_t* O2, LAS unsigned char* lds, int vcu, int G, int tid) {
    const int lane = tid & 63, r32 = lane & 31, hi = lane >> 5; const int wid = __builtin_amdgcn_readfirstlane(tid >> 6);
    LAS float* wsf = (LAS float*)(lds + CA_WS) + wid * 64;
    for (int u = vcu; u < 256; u += G) {
        const int pair = u >> 2, b = pair >> 2, hh = pair & 3;
        const bf16_t* Kg = KVM + (size_t)b * MEMT * DM + hh * 128; const bf16_t* Vg = Kg + 512;
        __syncthreads();
#pragma unroll
        for (int i = 0; i < 8; ++i) {
            const int piece = tid + 512 * i, key = piece & 255, ch = piece >> 8;
            const u32x4 v = *(const u32x4*)(Kg + (size_t)key * DM + ch * 8);
            *(LAS u32x4*)(lds + CA_K + (key >> 6) * 16384 + ch * 1024 + (key & 63) * 16) = v;
        }
#pragma unroll
        for (int i = 0; i < 8; ++i) {
            const int piece = tid + 512 * i, pc = piece & 15, key = piece >> 4;
            const u32x4 v = *(const u32x4*)(Vg + (size_t)key * DM + pc * 8);
            *(LAS u32x4*)(lds + CA_V + (key >> 6) * 16384 + (pc >> 2) * 4096 + (key & 63) * 64 + (pc & 3) * 16) = v;
        }
        __syncthreads();
        for (int qq = 0; qq < 2; ++qq) {
            const int qblk = 2 * (u & 3) + qq;
            const size_t row0 = (size_t)b * SEQ + qblk * 256 + wid * 32;
            const bf16_t* Qw = Q2 + row0 * 512 + hh * 128;
            bf16x8 qr[8];
#pragma unroll
            for (int d0 = 0; d0 < 8; ++d0) qr[d0] = *(const bf16x8*)&Qw[(size_t)r32 * 512 + d0 * 16 + hi * 8];
            float m_run = 0.f, l_run = 0.f; f32x16 o[4];
#pragma unroll
            for (int d = 0; d < 4; ++d)
#pragma unroll
                for (int r = 0; r < 16; ++r) o[d][r] = 0.f;
            attn_tile<128>(lds + CA_K, lds + CA_V, qr, m_run, l_run, o, wsf, r32, hi, NoBias{}, true);
#pragma unroll 1
            for (int t = 1; t < 4; ++t) attn_tile<128>(lds + CA_K + t * 16384, lds + CA_V + t * 16384, qr, m_run, l_run, o, wsf, r32, hi, NoBias{}, false);
            attn_finish<4>(l_run, o, wsf, r32, hi);
            bf16_t* Ow = O2 + row0 * 512 + hh * 128;
            LAS unsigned short* stg = (LAS unsigned short*)(lds + CA_OST) + wid * 1024;
#pragma unroll
            for (int d0 = 0; d0 < 4; ++d0) {
#pragma unroll
                for (int r = 0; r < 16; ++r) stg[crow(r, hi) * 32 + r32] = (unsigned short)f2bf(o[d0][r]);
                LDS_WAIT(); asm volatile("" ::: "memory");
#pragma unroll
                for (int i = 0; i < 2; ++i) { const int row = i * 16 + (lane >> 2), ch = lane & 3; const u32x4 v = *(const LAS u32x4*)(stg + row * 32 + ch * 8); *(u32x4*)(Ow + (size_t)row * 512 + d0 * 32 + ch * 8) = v; }
                LDS_WAIT(); asm volatile("" ::: "memory");
            }
        }
    }
    __syncthreads();
}

constexpr int TC = 32;
constexpr int SC_ZR = 0, SC_ZK = 8192, SC_ZV = 16384, SC_WD = 24576, SC_AA = 32768, SC_GG = 40960, SC_KK = 49152, SC_YY = 57344;
constexpr int SC_AW = 65536;
constexpr int SC_AZ = SC_AW + 32 * 144;
constexpr int SC_AG = SC_AZ + 32 * 144;
constexpr int SC_BD = SC_AG + 32 * 336;
constexpr int SC_CARRY = SC_BD + 128;
constexpr int SC_END = SC_CARRY + 2 * 64 * 16;
static_assert(SC_END <= RING_BYTES, "scan LDS");

template <int CTRL> __device__ __forceinline__ float dpp_f(float x) { return __builtin_bit_cast(float, __builtin_amdgcn_update_dpp(__builtin_bit_cast(int, x), __builtin_bit_cast(int, x), CTRL, 0xF, 0xF, false)); }
__device__ __forceinline__ float red8(float x) { x += dpp_f<0xB1>(x); x += dpp_f<0x4E>(x); x += dpp_f<0x141>(x); return x; }
__device__ __forceinline__ float red16(float x) { x = red8(x); x += dpp_f<0x140>(x); return x; }

template <int NK>
__device__ __forceinline__ f32x16 lora_mma(const LAS unsigned char* Abase, int astride, const bf16x8* bfr, int r32, int hi) {
    f32x16 acc;
#pragma unroll
    for (int r = 0; r < 16; ++r) acc[r] = 0.f;
#pragma unroll
    for (int s = 0; s < NK; ++s) {
        const bf16x8 af = *(const LAS bf16x8*)(Abase + r32 * astride + (16 * s + 8 * hi) * 2);
        acc = __builtin_amdgcn_mfma_f32_32x32x16_bf16(af, bfr[s], acc, 0, 0, 0);
    }
    return acc;
}

__device__ __forceinline__ void lora_prep(const Args& a, const bf16_t* P, int vcu, int G, int tid) {
    bf16_t* LORA = (bf16_t*)(a.ws + WS_LORA); const float* mixp = a.in[I_SHIFT] + 3072;
    for (int gp = vcu * 512 + tid; gp < M * 36; gp += G * 512) {
        const int m = gp / 36, pc = gp - m * 36;
        const bf16_t* src = P + (size_t)m * NPR + C_L + pc * 8;
        const u32x4 cur = *(const u32x4*)src;
        u32x4 prv = (u32x4){0u, 0u, 0u, 0u};
        if ((m & (SEQ - 1)) != 0) prv = *(const u32x4*)(src - NPR);
        const f32x4 m0 = *(const f32x4*)(mixp + pc * 8), m1 = *(const f32x4*)(mixp + pc * 8 + 4);
        float z[8];
        { const unsigned cw_[4] = {cur.x, cur.y, cur.z, cur.w}, pw_[4] = {prv.x, prv.y, prv.z, prv.w}; const float mm[8] = {m0.x, m0.y, m0.z, m0.w, m1.x, m1.y, m1.z, m1.w};
#pragma unroll
          for (int e = 0; e < 4; ++e) { const float c0_ = bflo(cw_[e]), c1_ = bfhi(cw_[e]), p0_ = bflo(pw_[e]), p1_ = bfhi(pw_[e]);
              z[2 * e] = c0_ + (p0_ - c0_) * mm[2 * e]; z[2 * e + 1] = c1_ + (p1_ - c1_) * mm[2 * e + 1]; } }
        if (pc < 8) {
#pragma unroll
            for (int e = 0; e < 8; ++e) { const float ex = fast_exp2(2.f * LOG2E * z[e]); z[e] = 1.f - 2.f * __builtin_amdgcn_rcpf(ex + 1.f); }
        } else if (pc >= 16) {
#pragma unroll
            for (int e = 0; e < 8; ++e) z[e] = sigmoidf_(z[e]);
        }
        *(u32x4*)(LORA + (size_t)m * 288 + pc * 8) = (u32x4){cvtpk(z[0], z[1]), cvtpk(z[2], z[3]), cvtpk(z[4], z[5]), cvtpk(z[6], z[7])};
    }
}

constexpr int CK_RAW = 0;
constexpr int CK_CARRY = 12288;
constexpr int CK_CL = 13312, CK_AA = CK_CL + 8192, CK_GG = CK_AA + 8192, CK_YY = CK_GG + 8192;
constexpr int CK_BD = CK_YY + 8192;
constexpr int CK_GC = CK_BD + 128;
constexpr int CK_AW = CK_GC + 256, CK_AZ = CK_AW + 32 * 144, CK_AG = CK_AZ + 32 * 144;
constexpr int CK_RKK = CK_AW, CK_RBH = CK_RKK + 4608, CK_RKH = CK_RBH + 4608, CK_RRH = CK_RKH + 4608;
constexpr int CK_VKK = CK_AG + 32 * 336;
constexpr int CK_VVM = CK_VKK + 4096;
constexpr int CK_VBT = CK_VVM + 4096;
constexpr int CK_VKT = CK_VBT + 4096;
constexpr int CK_IP = CK_VKT + 4096;
constexpr int CK_IT = CK_IP + 2048, CK_ILK = CK_IT + 2048, CK_IMB = CK_ILK + 2048, CK_IMK = CK_IMB + 2048;
constexpr int CK_IG = CK_IMK + 2048;
constexpr int CK_WD = CK_IG + 4096;
constexpr int CK_WG = CK_WD + 64 * 144;
constexpr int CK_END = CK_WG + 64 * 336;
constexpr int CK_WI = 132096;
static_assert(CK_WI + 64 * 144 <= LDS_BYTES, "lora weights LDS");
static_assert(CK_RRH + 4608 <= CK_VKK && CK_END <= RING_BYTES && (CK_AW % 16) == 0 && (CK_VKK % 16) == 0, "chunked scan LDS");

__device__ __forceinline__ bf16x8 a_perm(const LAS unsigned char* img, int stride, int row, int col0, int hi) {
    const LAS unsigned char* p = img + row * stride + (col0 + 4 * hi) * 2;
    const s16x4 lo = *(const LAS s16x4*)p, hh = *(const LAS s16x4*)(p + 16);
    return (bf16x8){lo[0], lo[1], lo[2], lo[3], hh[0], hh[1], hh[2], hh[3]};
}
__device__ __forceinline__ bf16x8 b_tr(const LAS unsigned char* blk, int ks, int r32, int hi) {
    const LAS unsigned char* vp = blk + ((r32 >> 4) & 1) * 32 + (r32 & 3) * 8 + (4 * hi + ((r32 & 15) >> 2)) * 64 + ks * 1024;
    const s16x4 lo = vtr(vp), hh = vtr(vp + 512);
    return (bf16x8){lo[0], lo[1], lo[2], lo[3], hh[0], hh[1], hh[2], hh[3]};
}
__device__ __forceinline__ bf16x8 acc_frag(const f32x16& x, int s) {
    const u32x4 w = (u32x4){cvtpk(x[8 * s + 0], x[8 * s + 1]), cvtpk(x[8 * s + 2], x[8 * s + 3]), cvtpk(x[8 * s + 4], x[8 * s + 5]), cvtpk(x[8 * s + 6], x[8 * s + 7])};
    return __builtin_bit_cast(bf16x8, w);
}
__device__ __forceinline__ void img_store_t(LAS unsigned char* img, int col, int hi, const f32x16& x, float sgn) {
#pragma unroll
    for (int q = 0; q < 4; ++q) *(LAS u32x2*)(img + col * 64 + (8 * q + 4 * hi) * 2) = (u32x2){cvtpk(x[4 * q] * sgn, x[4 * q + 1] * sgn), cvtpk(x[4 * q + 2] * sgn, x[4 * q + 3] * sgn)};
}
#define MFMA32(a, b, c) __builtin_amdgcn_mfma_f32_32x32x16_bf16(a, b, c, 0, 0, 0)

constexpr int PK_HB = 39296;
constexpr int HB_RKK = 0, HB_RBH = 4608, HB_RKH = 9216, HB_RRH = 13824, HB_VKK = 18432, HB_VVM = 22528, HB_VBT = 26624, HB_VKT = 30720, HB_GC = 34816, HB_BD = 35072, HB_GG = 35200;
constexpr int PK_RAW = 2 * PK_HB, PK_CARRY = PK_RAW + 12288, PK_CL = PK_CARRY + 1024, PK_AA = PK_CL + 8192, PK_AW = PK_AA + 8192, PK_AZ = PK_AW + 4608, PK_AG = PK_AZ + 4608;
static_assert(PK_AG + 32 * 336 <= RING_BYTES, "pipelined scan LDS (ring part)");
constexpr int PK_CONST = PK_AG + 32 * 336;
static_assert(PK_CONST + 2048 <= RING_BYTES, "pipelined scan LDS (constants)");
constexpr int PK_YY = 132096;
static_assert(PK_YY + 2 * 8192 <= LDS_BYTES, "pipelined scan LDS (upper part)");
constexpr int NCH = SEQ / TC;

__device__ __forceinline__ f32x16 gram_tile(const bf16x8 (&af)[4], const bf16x8 (&bf)[4]) {
    f32x16 acc;
#pragma unroll
    for (int r = 0; r < 16; ++r) acc[r] = 0.f;
#pragma unroll
    for (int s = 0; s < 4; ++s) acc = MFMA32(af[s], bf[s], acc);
    return acc;
}
template <int MODE> __device__ __forceinline__ void tri_mask(f32x16& x, int r32, int hi, float sgn) {
#pragma unroll
    for (int r = 0; r < 16; ++r) { const int row = crow(r, hi); const bool keep = (MODE == 0) ? (r32 < row) : ((MODE == 1) ? (r32 > row) : (r32 >= row)); x[r] = keep ? x[r] * sgn : 0.f; }
}

__device__ __forceinline__ void rwkv_head_pipe(const Args& a, const bf16_t* PQp, const bf16_t* PRp, bf16_t* Yout, int ypitch, int b, int h, LAS unsigned char* lds, int tid) {
    const int lane = tid & 63, r32 = lane & 31, hi = lane >> 5; const int wid = __builtin_amdgcn_readfirstlane(tid >> 6);
    const size_t rowbase = (size_t)b * SEQ;
    if (wid < 6) {
        LAS float* CL = (LAS float*)(lds + PK_CL); LAS float* AA = (LAS float*)(lds + PK_AA);
        const int lnb = wid & 1, lch = h * 64 + 32 * lnb + r32;
        const float lbase = (wid < 2) ? a.in[I_DBASE][lch] : ((wid < 4) ? a.in[I_IBASE][lch] : 0.f);
        const int oc = tid & 7, tk = (tid >> 3) & 31, ch0 = h * 64 + 8 * oc;
        if (tid < 128) { const int v8 = tid >> 4, q = tid & 15; const float* srcv;
            switch (v8) { case 0: srcv = a.in[I_KNS]; break; case 1: srcv = a.in[I_KIS]; break; case 2: srcv = a.in[I_BONUS]; break; case 3: srcv = a.in[I_LNW]; break; case 4: srcv = a.in[I_LNB]; break;
                          case 5: srcv = a.in[I_SHIFT]; break; case 6: srcv = a.in[I_SHIFT] + 1024; break; default: srcv = a.in[I_SHIFT] + 2048; break; }
            *(LAS f32x4*)(lds + PK_CONST + v8 * 256 + q * 16) = *(const f32x4*)(srcv + h * 64 + 4 * q); }
        (void)ch0;
#define CV(v8, q) (*(const LAS f32x4*)(lds + PK_CONST + (v8) * 256 + oc * 32 + (q) * 16))
        bf16x8 bfr[10];
        { const bf16_t* up = (wid < 2) ? (const bf16_t*)(a.ws + WS_DUPT) + (size_t)lch * 64 : ((wid < 4) ? (const bf16_t*)(a.ws + WS_IUPT) + (size_t)lch * 64 : (const bf16_t*)(a.ws + WS_GUPT) + (size_t)lch * 160);
          if (wid < 4) {
#pragma unroll
              for (int s = 0; s < 4; ++s) bfr[s] = *(const bf16x8*)(up + 16 * s + 8 * hi);
#pragma unroll
              for (int s = 4; s < 10; ++s) bfr[s] = bfr[0];
          } else {
#pragma unroll
              for (int s = 0; s < 10; ++s) bfr[s] = *(const bf16x8*)(up + 16 * s + 8 * hi);
          } }
        const unsigned char* psrc[5]; unsigned pstride[5]; u32x4 pre[5];
        const bf16_t* LORA = (const bf16_t*)(a.ws + WS_LORA);
#pragma unroll
        for (int i = 0; i < 5; ++i) {
            const int p = tid + 384 * i; const int tl = p / 60, pc = p - tl * 60;
            if (pc < 8) { psrc[i] = (const unsigned char*)(PQp + (rowbase + tl) * NPQ + C_R + h * 64 + pc * 8); pstride[i] = NPQ * 2; }
            else if (pc < 24) { psrc[i] = (const unsigned char*)(PRp + (rowbase + tl) * NPR + (pc < 16 ? C_K : C_V) + h * 64 + (pc & 7) * 8); pstride[i] = NPR * 2; }
            else { psrc[i] = (const unsigned char*)(LORA + (rowbase + tl) * 288 + (pc - 24) * 8); pstride[i] = 288 * 2; }
            pre[i] = __builtin_nontemporal_load((const u32x4*)psrc[i]);
        }
        u32x4 po_g[2], po_v[2]; float po_bd[2];
#pragma unroll
        for (int i2 = 0; i2 < 2; ++i2) { po_g[i2] = (u32x4){0u, 0u, 0u, 0u}; po_v[i2] = po_g[i2]; po_bd[i2] = 0.f; }
#pragma unroll 1
        for (int it = 0; it < NCH + 2; ++it) {
            if (it >= 2 && wid >= 4) {
                const LAS unsigned char* hb = lds + (it & 1) * PK_HB;
#pragma unroll
                for (int i2 = 0; i2 < 2; ++i2) { const int tk2 = ((tid - 256) >> 3) + 16 * i2;
                    po_g[i2] = *(const LAS u32x4*)(hb + HB_GG + tk2 * 128 + oc * 16); po_v[i2] = *(const LAS u32x4*)(hb + HB_VVM + (oc >> 2) * 2048 + tk2 * 64 + (oc & 3) * 16);
                    po_bd[i2] = *(const LAS float*)(hb + HB_BD + tk2 * 4); }
            }
#ifdef X_DUPCOPY
            for (int rep_ = 0; rep_ < 2; ++rep_)
#endif
            if (it < NCH) {
#pragma unroll
                for (int i = 0; i < 5; ++i) {
                    const int p = tid + 384 * i; const int tl = p / 60, pc = p - tl * 60;
                    LAS unsigned char* dst;
                    if (pc < 24) dst = lds + PK_RAW + (tl * 24 + pc) * 16;
                    else if (pc < 32) dst = lds + PK_AW + tl * 144 + (pc - 24) * 16;
                    else if (pc < 40) dst = lds + PK_AZ + tl * 144 + (pc - 32) * 16;
                    else dst = lds + PK_AG + tl * 336 + (pc - 40) * 16;
                    *(LAS u32x4*)dst = pre[i];
                }
                if (it + 1 < NCH) {
#pragma unroll
                    for (int i = 0; i < 5; ++i) pre[i] = __builtin_nontemporal_load((const u32x4*)(psrc[i] + (size_t)((it + 1) * TC) * pstride[i]));
                }
            }
            __syncthreads();
#ifdef X_DUPJ2
            for (int rep_ = 0; rep_ < 2; ++rep_)
#endif
            if (it < NCH) {
                LAS unsigned char* hb = lds + (it & 1) * PK_HB;
                f32x16 acc;
                if (wid < 4) acc = lora_mma<4>(lds + (wid < 2 ? PK_AW : PK_AZ), 144, bfr, r32, hi);
                else acc = lora_mma<10>(lds + PK_AG, 336, bfr, r32, hi);
                if (wid < 2) {
                    float ew[16];
#pragma unroll
                    for (int r = 0; r < 16; ++r) ew[r] = (-0.6065306597126334f * LOG2E) * sigmoidf_(lbase + acc[r]);
                    float pf[16], tot[4], oth[4];
#pragma unroll
                    for (int m = 0; m < 4; ++m) { pf[4 * m] = ew[4 * m]; pf[4 * m + 1] = pf[4 * m] + ew[4 * m + 1]; pf[4 * m + 2] = pf[4 * m + 1] + ew[4 * m + 2]; pf[4 * m + 3] = pf[4 * m + 2] + ew[4 * m + 3]; tot[m] = pf[4 * m + 3]; }
#pragma unroll
                    for (int m = 0; m < 4; ++m) oth[m] = __shfl_xor(tot[m], 32);
                    float off = 0.f;
#pragma unroll
                    for (int m = 0; m < 4; ++m) { const float o_m = off + (hi ? oth[m] : 0.f);
#pragma unroll
                        for (int q = 0; q < 4; ++q) { const int r = 4 * m + q; CL[crow(r, hi) * 64 + 32 * lnb + r32] = o_m + pf[r]; }
                        off += tot[m] + oth[m]; }
                } else if (wid < 4) {
#pragma unroll
                    for (int r = 0; r < 16; ++r) AA[crow(r, hi) * 64 + 32 * lnb + r32] = sigmoidf_(lbase + acc[r]);
                } else {
#pragma unroll
                    for (int r = 0; r < 16; ++r) *(LAS unsigned short*)(hb + HB_GG + crow(r, hi) * 128 + (32 * lnb + r32) * 2) = (unsigned short)f2bf(acc[r]);
                }
            }
            __syncthreads();
            if (it < NCH && wid < 4) {
                LAS unsigned char* hb = lds + (it & 1) * PK_HB;
                const LAS unsigned char* rc = lds + PK_RAW + (tk * 24 + oc) * 16;
                const u32x4 cr = *(const LAS u32x4*)rc, ck = *(const LAS u32x4*)(rc + 128), cv = *(const LAS u32x4*)(rc + 256);
                u32x4 pr, pk, pv;
                if (tk > 0) { pr = *(const LAS u32x4*)(rc - 384); pk = *(const LAS u32x4*)(rc - 256); pv = *(const LAS u32x4*)(rc - 128); }
                else if (it > 0) { const LAS unsigned char* cc = lds + PK_CARRY + ((it - 1) & 1) * 384 + oc * 16; pr = *(const LAS u32x4*)cc; pk = *(const LAS u32x4*)(cc + 128); pv = *(const LAS u32x4*)(cc + 256); }
                else { pr = (u32x4){0u, 0u, 0u, 0u}; pk = pr; pv = pr; }
                if (tk == TC - 1) { LAS unsigned char* cc = lds + PK_CARRY + (it & 1) * 384 + oc * 16; *(LAS u32x4*)cc = cr; *(LAS u32x4*)(cc + 128) = ck; *(LAS u32x4*)(cc + 256) = cv; }
                f32x4 rv[2], zk[2], vv[2];
#define LERP8(dst, c, p, mx) do { const f32x4 c0_ = (f32x4){bflo(c.x), bfhi(c.x), bflo(c.y), bfhi(c.y)}, c1_ = (f32x4){bflo(c.z), bfhi(c.z), bflo(c.w), bfhi(c.w)}; \
                    const f32x4 p0_ = (f32x4){bflo(p.x), bfhi(p.x), bflo(p.y), bfhi(p.y)}, p1_ = (f32x4){bflo(p.z), bfhi(p.z), bflo(p.w), bfhi(p.w)}; \
                    dst[0] = c0_ + (p0_ - c0_) * mx[0]; dst[1] = c1_ + (p1_ - c1_) * mx[1]; } while (0)
                { const f32x4 mr_[2] = {CV(5, 0), CV(5, 1)}, mk_[2] = {CV(6, 0), CV(6, 1)}, mv_[2] = {CV(7, 0), CV(7, 1)}; LERP8(rv, cr, pr, mr_); LERP8(zk, ck, pk, mk_); LERP8(vv, cv, pv, mv_); }
#undef LERP8
                f32x4 kkv[2], kp[2], bb[2]; float ss = 0.f, bd = 0.f;
                f32x4 e1[2], e0[2], em[2], ec[2];
#pragma unroll
                for (int q = 0; q < 2; ++q) {
                    const f32x4 av = *(LAS f32x4*)(AA + tk * 64 + 8 * oc + 4 * q);
                    const f32x4 cl = *(LAS f32x4*)(CL + tk * 64 + 8 * oc + 4 * q), clc = *(LAS f32x4*)(CL + 31 * 64 + 8 * oc + 4 * q);
                    f32x4 clp = (f32x4){0.f, 0.f, 0.f, 0.f}; if (tk > 0) clp = *(LAS f32x4*)(CL + (tk - 1) * 64 + 8 * oc + 4 * q);
                    kkv[q] = zk[q] * CV(0, q);
                    ss += (kkv[q].x * kkv[q].x + kkv[q].y * kkv[q].y) + (kkv[q].z * kkv[q].z + kkv[q].w * kkv[q].w);
                    kp[q] = zk[q] * (1.0f + (av - 1.0f) * CV(1, q));
                    bb[q] = av;
                    const f32x4 t3 = rv[q] * kp[q] * CV(2, q); bd += (t3.x + t3.y) + (t3.z + t3.w);
#pragma unroll
                    for (int e = 0; e < 4; ++e) { e1[q][e] = fast_exp2(cl[e]); e0[q][e] = fast_exp2(clp[e]); em[q][e] = fast_exp2(-cl[e]); ec[q][e] = fast_exp2(clc[e] - cl[e]); }
                }
                ss = red8(ss); bd = red8(bd);
                const float inv = __builtin_amdgcn_rsqf(fmaxf(ss, 1e-24f));
                if (oc == 0) *(LAS float*)(hb + HB_BD + tk * 4) = bd;
                if (tk == 31) { *(LAS f32x4*)(hb + HB_GC + 32 * oc) = e1[0]; *(LAS f32x4*)(hb + HB_GC + 32 * oc + 16) = e1[1]; }
                u32x4 wkk, wbh, wkh, wrh, wbt, wkt, wvv;
                {
                    const f32x4 k0 = kkv[0] * inv, k1 = kkv[1] * inv, b0 = k0 * bb[0], b1 = k1 * bb[1];
                    const f32x4 kkh0 = k0 * e0[0], kkh1 = k1 * e0[1], bh0 = b0 * em[0], bh1 = b1 * em[1], kh0 = kp[0] * em[0], kh1 = kp[1] * em[1];
                    const f32x4 rh0 = rv[0] * e1[0], rh1 = rv[1] * e1[1], bt0 = b0 * ec[0], bt1 = b1 * ec[1], kt0 = kp[0] * ec[0], kt1 = kp[1] * ec[1];
                    wkk = (u32x4){cvtpk(kkh0.x, kkh0.y), cvtpk(kkh0.z, kkh0.w), cvtpk(kkh1.x, kkh1.y), cvtpk(kkh1.z, kkh1.w)};
                    wbh = (u32x4){cvtpk(bh0.x, bh0.y), cvtpk(bh0.z, bh0.w), cvtpk(bh1.x, bh1.y), cvtpk(bh1.z, bh1.w)};
                    wkh = (u32x4){cvtpk(kh0.x, kh0.y), cvtpk(kh0.z, kh0.w), cvtpk(kh1.x, kh1.y), cvtpk(kh1.z, kh1.w)};
                    wrh = (u32x4){cvtpk(rh0.x, rh0.y), cvtpk(rh0.z, rh0.w), cvtpk(rh1.x, rh1.y), cvtpk(rh1.z, rh1.w)};
                    wbt = (u32x4){cvtpk(-bt0.x, -bt0.y), cvtpk(-bt0.z, -bt0.w), cvtpk(-bt1.x, -bt1.y), cvtpk(-bt1.z, -bt1.w)};
                    wkt = (u32x4){cvtpk(kt0.x, kt0.y), cvtpk(kt0.z, kt0.w), cvtpk(kt1.x, kt1.y), cvtpk(kt1.z, kt1.w)};
                    wvv = (u32x4){cvtpk(vv[0].x, vv[0].y), cvtpk(vv[0].z, vv[0].w), cvtpk(vv[1].x, vv[1].y), cvtpk(vv[1].z, vv[1].w)};
                }
                const int ro = tk * 144 + 16 * oc, vo = (oc >> 2) * 2048 + tk * 64 + (oc & 3) * 16;
                *(LAS u32x4*)(hb + HB_RKK + ro) = wkk; *(LAS u32x4*)(hb + HB_RBH + ro) = wbh; *(LAS u32x4*)(hb + HB_RKH + ro) = wkh; *(LAS u32x4*)(hb + HB_RRH + ro) = wrh;
                *(LAS u32x4*)(hb + HB_VKK + vo) = wkk; *(LAS u32x4*)(hb + HB_VVM + vo) = wvv; *(LAS u32x4*)(hb + HB_VBT + vo) = wbt; *(LAS u32x4*)(hb + HB_VKT + vo) = wkt;
            }
            if (it >= 2 && wid >= 4) {
                const LAS float* YY = (const LAS float*)(lds + PK_YY + (it & 1) * 8192); const int t0p = (it - 2) * TC;
#pragma unroll
                for (int i2 = 0; i2 < 2; ++i2) { const int tk2 = ((tid - 256) >> 3) + 16 * i2;
                    const f32x4 y0 = *(const LAS f32x4*)(YY + tk2 * 64 + 8 * oc), y1 = *(const LAS f32x4*)(YY + tk2 * 64 + 8 * oc + 4);
                    const u32x4 gw = po_g[i2], vw = po_v[i2];
                    const f32x4 g0 = (f32x4){bflo(gw.x), bfhi(gw.x), bflo(gw.y), bfhi(gw.y)}, g1 = (f32x4){bflo(gw.z), bfhi(gw.z), bflo(gw.w), bfhi(gw.w)};
                    const f32x4 v0 = (f32x4){bflo(vw.x), bfhi(vw.x), bflo(vw.y), bfhi(vw.y)}, v1 = (f32x4){bflo(vw.z), bfhi(vw.z), bflo(vw.w), bfhi(vw.w)};
                    float s1 = ((y0.x + y0.y) + (y0.z + y0.w)) + ((y1.x + y1.y) + (y1.z + y1.w)); s1 = red8(s1);
                    const float mu = s1 * (1.f / 64.f);
                    const f32x4 d0 = y0 - mu, d1 = y1 - mu;
                    float s2 = ((d0.x * d0.x + d0.y * d0.y) + (d0.z * d0.z + d0.w * d0.w)) + ((d1.x * d1.x + d1.y * d1.y) + (d1.z * d1.z + d1.w * d1.w)); s2 = red8(s2);
                    const float rstd = __builtin_amdgcn_rsqf(s2 * (1.f / 64.f) + GN_EPS);
                    const float bd = po_bd[i2];
                    const f32x4 o0 = ((d0 * rstd) * CV(3, 0) + CV(4, 0) + v0 * bd) * g0, o1 = ((d1 * rstd) * CV(3, 1) + CV(4, 1) + v1 * bd) * g1;
                    *(u32x4*)(Yout + (rowbase + t0p + tk2) * ypitch + h * 64 + 8 * oc) = (u32x4){cvtpk(o0.x, o0.y), cvtpk(o0.z, o0.w), cvtpk(o1.x, o1.y), cvtpk(o1.z, o1.w)}; }
            }
            __syncthreads();
        }
    } else {
        const int vb = wid - 6;
        __builtin_amdgcn_s_setprio(2);
        f32x16 St0, St1;
#pragma unroll
        for (int r = 0; r < 16; ++r) { St0[r] = 0.f; St1[r] = 0.f; }
#pragma unroll 1
        for (int it = 0; it < NCH + 2; ++it) {
            const bool act = (it >= 1) && (it <= NCH);
            const LAS unsigned char* hb = lds + ((it - 1) & 1) * PK_HB;
            f32x16 Pw, Qw, R, Rt, LkT, MbT, MkT;
#ifdef X_DUPGRAM
            for (int rep_ = 0; rep_ < 2; ++rep_)
#endif
            if (act) {
                bf16x8 fkk[4], fbh[4], fkh[4], frh[4];
#pragma unroll
                for (int s = 0; s < 4; ++s) { const int o = r32 * 144 + (16 * s + 8 * hi) * 2;
                    fkk[s] = *(const LAS bf16x8*)(hb + HB_RKK + o); fbh[s] = *(const LAS bf16x8*)(hb + HB_RBH + o); fkh[s] = *(const LAS bf16x8*)(hb + HB_RKH + o); frh[s] = *(const LAS bf16x8*)(hb + HB_RRH + o); }
                Pw = gram_tile(fkk, fbh);  tri_mask<0>(Pw, r32, hi, 1.f);
                Qw = gram_tile(fbh, fkk);  tri_mask<1>(Qw, r32, hi, 1.f);
                LkT = gram_tile(fkh, fkk); tri_mask<1>(LkT, r32, hi, 1.f);
                MbT = gram_tile(fbh, frh); tri_mask<2>(MbT, r32, hi, -1.f);
                MkT = gram_tile(fkh, frh); tri_mask<2>(MkT, r32, hi, 1.f);
            }
            __syncthreads();
            if (act) {
#pragma unroll
                for (int r = 0; r < 16; ++r) { const float id = (crow(r, hi) == r32) ? 1.f : 0.f; R[r] = id - Pw[r]; Rt[r] = id - Qw[r]; }
#ifdef X_DUPNEU
#pragma unroll 1
                for (int k = 0; k < 8; ++k) {
#else
#pragma unroll 1
                for (int k = 0; k < 4; ++k) {
#endif
                    const bf16x8 p0 = acc_frag(Pw, 0), p1 = acc_frag(Pw, 1), q0 = acc_frag(Qw, 0), q1 = acc_frag(Qw, 1);
                    f32x16 Pn, Qn;
#pragma unroll
                    for (int r = 0; r < 16; ++r) { Pn[r] = 0.f; Qn[r] = 0.f; }
                    Pn = MFMA32(q0, p0, Pn); Pn = MFMA32(q1, p1, Pn);
                    Qn = MFMA32(p0, q0, Qn); Qn = MFMA32(p1, q1, Qn);
                    const bf16x8 r0 = acc_frag(R, 0), r1 = acc_frag(R, 1);
                    const bf16x8 n0 = acc_frag(Qn, 0), n1 = acc_frag(Qn, 1);
                    f32x16 Rn = R, Rtn = Rt;
                    Rn = MFMA32(n0, r0, Rn);  Rn = MFMA32(n1, r1, Rn);
                    Rtn = MFMA32(r0, n0, Rtn); Rtn = MFMA32(r1, n1, Rtn);
                    R = Rn; Rt = Rtn; Pw = Pn; Qw = Qn;
                }
            }
            __syncthreads();
            if (act) {
                const bf16x8 t0f = acc_frag(Rt, 0), t1f = acc_frag(Rt, 1);
                const bf16x8 v0f = b_tr(hb + HB_VVM + vb * 2048, 0, r32, hi), v1f = b_tr(hb + HB_VVM + vb * 2048, 1, r32, hi);
                f32x16 X;
#pragma unroll
                for (int r = 0; r < 16; ++r) X[r] = 0.f;
                X = MFMA32(acc_frag(LkT, 0), v0f, X); X = MFMA32(acc_frag(LkT, 1), v1f, X);
                f32x16 E;
#pragma unroll
                for (int r = 0; r < 16; ++r) E[r] = 0.f;
                E = MFMA32(t0f, acc_frag(X, 0), E); E = MFMA32(t1f, acc_frag(X, 1), E);
                f32x16 G0, G1;
#pragma unroll
                for (int r = 0; r < 16; ++r) { G0[r] = 0.f; G1[r] = 0.f; }
                G0 = MFMA32(b_tr(hb + HB_VKK, 0, r32, hi), t0f, G0);        G0 = MFMA32(b_tr(hb + HB_VKK, 1, r32, hi), t1f, G0);
                G1 = MFMA32(b_tr(hb + HB_VKK + 2048, 0, r32, hi), t0f, G1); G1 = MFMA32(b_tr(hb + HB_VKK + 2048, 1, r32, hi), t1f, G1);
                const bf16x8 s00 = acc_frag(St0, 0), s01 = acc_frag(St0, 1), s10 = acc_frag(St1, 0), s11 = acc_frag(St1, 1);
                E = MFMA32(acc_frag(G0, 0), s00, E); E = MFMA32(acc_frag(G0, 1), s01, E);
                E = MFMA32(acc_frag(G1, 0), s10, E); E = MFMA32(acc_frag(G1, 1), s11, E);
                const bf16x8 e0f = acc_frag(E, 0), e1f = acc_frag(E, 1);
                f32x16 Y;
#pragma unroll
                for (int r = 0; r < 16; ++r) Y[r] = 0.f;
                Y = MFMA32(a_perm(hb + HB_RRH, 144, r32, 0, hi), s00, Y);  Y = MFMA32(a_perm(hb + HB_RRH, 144, r32, 16, hi), s01, Y);
                Y = MFMA32(a_perm(hb + HB_RRH, 144, r32, 32, hi), s10, Y); Y = MFMA32(a_perm(hb + HB_RRH, 144, r32, 48, hi), s11, Y);
                Y = MFMA32(acc_frag(MbT, 0), e0f, Y); Y = MFMA32(acc_frag(MbT, 1), e1f, Y);
                Y = MFMA32(acc_frag(MkT, 0), v0f, Y); Y = MFMA32(acc_frag(MkT, 1), v1f, Y);
                LAS float* YY = (LAS float*)(lds + PK_YY + ((it - 1) & 1) * 8192);
#pragma unroll
                for (int r = 0; r < 16; ++r) YY[crow(r, hi) * 64 + 32 * vb + r32] = Y[r];
                const LAS float* GC = (const LAS float*)(hb + HB_GC);
#pragma unroll
                for (int q = 0; q < 4; ++q) { const f32x4 g0 = *(const LAS f32x4*)(GC + 8 * q + 4 * hi), g1 = *(const LAS f32x4*)(GC + 32 + 8 * q + 4 * hi);
#pragma unroll
                    for (int e = 0; e < 4; ++e) { St0[4 * q + e] *= g0[e]; St1[4 * q + e] *= g1[e]; } }
                St0 = MFMA32(b_tr(hb + HB_VBT, 0, r32, hi), e0f, St0);        St0 = MFMA32(b_tr(hb + HB_VBT, 1, r32, hi), e1f, St0);
                St0 = MFMA32(b_tr(hb + HB_VKT, 0, r32, hi), v0f, St0);        St0 = MFMA32(b_tr(hb + HB_VKT, 1, r32, hi), v1f, St0);
                St1 = MFMA32(b_tr(hb + HB_VBT + 2048, 0, r32, hi), e0f, St1); St1 = MFMA32(b_tr(hb + HB_VBT + 2048, 1, r32, hi), e1f, St1);
                St1 = MFMA32(b_tr(hb + HB_VKT + 2048, 0, r32, hi), v0f, St1); St1 = MFMA32(b_tr(hb + HB_VKT + 2048, 1, r32, hi), v1f, St1);
            }
            __syncthreads();
        }
        __builtin_amdgcn_s_setprio(0);
    }
#undef CV
    __syncthreads();
}

__global__ void __launch_bounds__(NWAVES * 64, 2) hyb_fwd(Args args) {
    extern __shared__ __attribute__((aligned(16))) unsigned char lds_raw[];
    LAS unsigned char* lds = (LAS unsigned char*)lds_raw;
    volatile LAS unsigned* MISC = (volatile LAS unsigned*)(lds + MISC_OFF);
    const int G = gridDim.x; const int bx = blockIdx.x; const int vcu = (G % 8 == 0) ? (bx % 8) * (G / 8) + bx / 8 : bx;
    unsigned char* ws = args.ws;
    for (int u = threadIdx.x; u < (LDS_BYTES - LDSCTL_OFF) / 4; u += NWAVES * 64) ((LAS unsigned*)(lds + LDSCTL_OFF))[u] = 0u;
    __syncthreads();
    XcdBarrier bar = xcd_barrier_post((unsigned*)(ws + WS_CTL) + CW_BAR, MISC + 8);
#define GRID_BAR() xcd_barrier(bar)
    bf16_t* PQ = (bf16_t*)(ws + WS_PQ); bf16_t* PR = (bf16_t*)(ws + WS_PR);
    bf16_t* XN = (bf16_t*)args.out; bf16_t* MIXED = (bf16_t*)((unsigned char*)args.out + 64 * MiB);
    bf16_t* O1 = (bf16_t*)(ws + WS_O1); bf16_t* XN2 = (bf16_t*)(ws + WS_XN2); bf16_t* Q2 = (bf16_t*)(ws + WS_Q2); bf16_t* O2 = (bf16_t*)(ws + WS_O2);
    bf16_t* ACT = (bf16_t*)(ws + WS_ACT); bf16_t* MN = (bf16_t*)(ws + WS_MN); bf16_t* KVM = (bf16_t*)(ws + WS_KVM);
    bf16_t* XB1 = (bf16_t*)(ws + WS_ACT); bf16_t* XB2 = (bf16_t*)(ws + WS_Q2);

#define FRESH_TID() int tid = threadIdx.x; asm volatile("" : "+v"(tid)); const int lane = tid & 63, wave = __builtin_amdgcn_readfirstlane(tid >> 6); (void)lane; (void)wave
#define GEMM(Aptr, Bptr, lda_, K_, Mrows, Ncols, pair_, ...) do { pg8::Gemm g{Aptr, (const bf16_t*)(Bptr), lda_, K_}; pg8::Order S; S.init(Mrows, Ncols, G, bx, pair_); \
        const pg8::Epi E{__VA_ARGS__}; pg8::gemm_phase(lds, g, S, E); } while (0)
    { FRESH_TID(); p0_prologue(args, lds, vcu, G, wave, lane); }
    GRID_BAR();
    GEMM(XN, ws + WS_W1T, DM, DM, M, NP, 0, pg8::EPI_STORE, PQ, NPQ, 0, C_Q / 256, C_Q / 256 + 4, QS_ATT, nullptr, 1, PR, NPR, NPQ / 256, 0);
    GRID_BAR();
    GEMM(MN, ws + WS_WKVT, DM, DM, MROWS, DM, 0, pg8::EPI_STORE, KVM, DM, 0, 0, 0, 1.f, nullptr, 0, nullptr, 0, 0, 0);
    if (G > 64) { if (bx >= 64) { FRESH_TID(); lora_prep(args, PR, bx - 64, G - 64, tid); } }
    else { FRESH_TID(); lora_prep(args, PR, bx, G, tid); }
    GRID_BAR();
    for (int u = vcu; u < NB * 16; u += G) { const int b = u >> 4, h = u & 15;
        { FRESH_TID(); rwkv_head_pipe(args, PQ, PR, PQ + C_R, NPQ, b, h, lds, tid); }
#if defined(ATT_2GROUP)
        { FRESH_TID(); chunk_attention_head(PQ, PR, PQ + C_Q, NPQ, args.in[I_RELB], b, h, lds, tid); }
#elif defined(ATT_8W2T)
        { FRESH_TID(); chunk_attention_head2(PQ, PR, PQ + C_Q, NPQ, args.in[I_RELB], b, h, lds, tid); }
#else
        { FRESH_TID(); chunk_attention_head3(PQ, PR, PQ + C_Q, NPQ, args.in[I_RELB], b, h, lds, tid); }
#endif
    }
    GRID_BAR();
    GEMM(XN, ws + WS_WGT, DM, DM, M, 1024, 2, pg8::EPI_SIGMOID, PR, NPR, C_GA, 0, 0, 1.f, nullptr, 0, nullptr, 0, 0, 0);
    GEMM(PQ, ws + WS_WABT, NPQ, DM, M, DM, 1, pg8::EPI_MIX, MIXED, DM, 0, 0, 0, 1.f, PR, 0, nullptr, 0, 0, NPR);
    GRID_BAR();
    GEMM(MIXED, ws + WS_WOUTT, DM, DM, M, DM, 0, pg8::EPI_STORE, O1, DM, 0, 0, 0, 1.f, nullptr, 0, nullptr, 0, 0, 0);
    GRID_BAR();
    { FRESH_TID(); norm_pass<false, true>(O1, args.in[I_X], XB1, args.in[I_GPOSTMIX], args.in[I_GPRECROSS], XN2, vcu, G, wave, lane); }
    GRID_BAR();
    GEMM(XN2, ws + WS_WQT, DM, DM, M, 512, 0, pg8::EPI_STORE, Q2, 512, 0, 0, 2, QS_MEM, nullptr, 0, nullptr, 0, 0, 0);
    GRID_BAR();
    { FRESH_TID(); cross_attention(Q2, KVM, O2, lds, vcu, G, tid); }
    GRID_BAR();
    GEMM(O2, ws + WS_WOT, 512, 512, M, DM, 0, pg8::EPI_STORE, O1, DM, 0, 0, 0, 1.f, nullptr, 0, nullptr, 0, 0, 0);
    GRID_BAR();
    { FRESH_TID(); norm_pass<true, true>(O1, XB1, XB2, args.in[I_GPOSTCROSS], args.in[I_GPREFFN], XN2, vcu, G, wave, lane); }
    GRID_BAR();
    GEMM(XN2, ws + WS_WF1T, DM, DM, M, 2 * FFH, 0, pg8::EPI_SWIGLU, ACT, FFH, 0, 0, 0, 1.f, nullptr, 0, nullptr, 0, 0, 0);
    GRID_BAR();
    GEMM(ACT, ws + WS_WF2T, FFH, FFH, M, DM, 0, pg8::EPI_STORE, O1, DM, 0, 0, 0, 1.f, nullptr, 0, nullptr, 0, 0, 0);
    GRID_BAR();
    { FRESH_TID(); norm_pass<true, false>(O1, XB2, args.out, args.in[I_GPOSTFFN], nullptr, nullptr, vcu, G, wave, lane); }
}

extern "C" void kernel_launch(void* const* d_in, const int* in_sizes, int n_in, void* d_out, int out_size, void* d_ws, size_t ws_size, hipStream_t stream) {
    static int grid = 0;
    if (grid == 0) {
        if (n_in != N_IN || in_sizes[0] != M * DM || out_size != M * DM || ws_size < WS_END) {
            fprintf(stderr, "kernel_launch: unexpected shapes (n_in %d, in0 %d, out %d, ws %zu); nothing launched\n", n_in, n_in > 0 ? in_sizes[0] : -1, out_size, ws_size); grid = -1; return; }
        int dev = 0, cus = 0;
        if (hipGetDevice(&dev) != hipSuccess || hipDeviceGetAttribute(&cus, hipDeviceAttributeMultiprocessorCount, dev) != hipSuccess) { grid = -1; return; }
        if (hipFuncSetAttribute((const void*)hyb_fwd, hipFuncAttributeMaxDynamicSharedMemorySize, LDS_BYTES) != hipSuccess) { fprintf(stderr, "kernel_launch: hipFuncSetAttribute failed\n"); grid = -1; return; }
        (void)hipGetLastError();
        grid = cus;
    }
    if (grid < 0) return;
    if (hipMemsetAsync((char*)d_ws + WS_CTL, 0, CTL_ZERO_BYTES, stream) != hipSuccess) return;
    Args a{};
    for (int i = 0; i < N_IN; ++i) a.in[i] = (const float*)d_in[i];
    a.out = (float*)d_out; a.ws = (unsigned char*)d_ws;
    hipLaunchKernelGGL(hyb_fwd, dim3(grid), dim3(NWAVES * 64), LDS_BYTES, stream, a);
}
```

```cpp
#include <hip/hip_runtime.h>
#include <hip/hip_bf16.h>
#include <cstdio>
#include <cstdint>

#define LAS __attribute__((address_space(3)))
#define GAS __attribute__((address_space(1)))
typedef unsigned short bf16_t;
typedef short bf16x8 __attribute__((ext_vector_type(8)));
typedef short s16x4 __attribute__((ext_vector_type(4)));
typedef float f32x4 __attribute__((ext_vector_type(4)));
typedef float f32x2 __attribute__((ext_vector_type(2)));
typedef float f32x16 __attribute__((ext_vector_type(16)));
typedef unsigned u32x4 __attribute__((ext_vector_type(4)));
typedef unsigned u32x2 __attribute__((ext_vector_type(2)));

constexpr int NB = 16, SEQ = 2048, DM = 1024, M = NB * SEQ;
constexpr int NP = 6656;
constexpr int NPQ = 2048, C_R = 0, C_Q = 1024;
constexpr int NPR = 4608, C_K = 0, C_V = 1024, C_L = 2048, C_KA = 2560, C_VA = 3584;
constexpr int C_GA = 0, C_GB = 1024;
constexpr int FFH = 2816, MEMT = 256, MROWS = NB * MEMT;
constexpr float NORM_EPS = 1e-6f, GN_EPS = 64e-5f;
constexpr float LOG2E = 1.4426950408889634f;
constexpr float QS_ATT = 0.125f * LOG2E;
constexpr float QS_MEM = 0.08838834764831845f * LOG2E;

constexpr size_t MiB = 1u << 20;
constexpr size_t WS_CTL = 0, CTL_ZERO_BYTES = 32 * 1024;
constexpr size_t WS_W1T = 1 * MiB;
constexpr size_t WS_WGT = 14 * MiB;
constexpr size_t WS_WABT = 18 * MiB;
constexpr size_t WS_WOUTT = 22 * MiB;
constexpr size_t WS_WQT = 24 * MiB;
constexpr size_t WS_WKVT = 25 * MiB;
constexpr size_t WS_WOT = 27 * MiB;
constexpr size_t WS_WF1T = 28 * MiB;
constexpr size_t WS_WF2T = 39 * MiB;
constexpr size_t WS_DUPT = 45 * MiB;
constexpr size_t WS_IUPT = WS_DUPT + 128 * 1024;
constexpr size_t WS_GUPT = WS_IUPT + 128 * 1024;
constexpr size_t WS_PQ = 48 * MiB;
constexpr size_t WS_PR = 176 * MiB;
constexpr size_t WS_MN = 464 * MiB;
constexpr size_t WS_KVM = 472 * MiB;
constexpr size_t WS_LORA = 480 * MiB;
constexpr size_t WS_O1 = 48 * MiB;
constexpr size_t WS_XN2 = 112 * MiB;
constexpr size_t WS_Q2 = 176 * MiB;
constexpr size_t WS_O2 = 208 * MiB;
constexpr size_t WS_ACT = 240 * MiB;
constexpr size_t WS_END = 512 * MiB;
constexpr int CW_BAR = 4096;

constexpr int RING_BYTES = 131072;
constexpr int LDSCTL_OFF = RING_BYTES, MISC_OFF = LDSCTL_OFF + 320;
constexpr int LDS_BYTES = 151552;
constexpr int NWAVES = 8;

#define RLX_AGENT __ATOMIC_RELAXED, __HIP_MEMORY_SCOPE_AGENT
#define LDS_WAIT() asm volatile("s_waitcnt lgkmcnt(0)" ::: "memory")
#define VM_WAIT() asm volatile("s_waitcnt vmcnt(0)" ::: "memory")

__device__ __forceinline__ unsigned f2bf(float f) { unsigned u = __builtin_bit_cast(unsigned, f); return (u + 0x7fffu + ((u >> 16) & 1u)) >> 16; }
__device__ __forceinline__ unsigned pk2(float lo, float hi) { return f2bf(lo) | (f2bf(hi) << 16); }
__device__ __forceinline__ float bf2f(unsigned short b) { return __builtin_bit_cast(float, (unsigned)b << 16); }
__device__ __forceinline__ float bflo(unsigned w) { return __builtin_bit_cast(float, w << 16); }
__device__ __forceinline__ float bfhi(unsigned w) { return __builtin_bit_cast(float, w & 0xffff0000u); }
typedef __bf16 bf16x2_t __attribute__((ext_vector_type(2)));
__device__ __forceinline__ unsigned cvtpk(float lo, float hi) { f32x2 v = {lo, hi}; bf16x2_t b = __builtin_convertvector(v, bf16x2_t); return __builtin_bit_cast(unsigned, b); }
__device__ __forceinline__ float wave_sum(float v) {
#pragma unroll
    for (int o = 1; o < 64; o <<= 1) v += __shfl_xor(v, o);
    return v;
}
__device__ __forceinline__ float fast_exp2(float x) { return __builtin_amdgcn_exp2f(x); }
__device__ __forceinline__ float sigmoidf_(float x) { return __builtin_amdgcn_rcpf(1.0f + __builtin_amdgcn_exp2f(-x * LOG2E)); }

#define XB_TMO      128
#define XB_XCNT(j)  (256  + 64 * (j))
#define XB_XSUB(j)  (1280 + 64 * (j))
#define XB_XGEN(j)  (2304 + 64 * (j))
#define XB_TOP      3328
#define XB_TOPGEN   3392
#define XCD_BAR_WORDS 3456
#define XB_SPIN_CAP (1u << 18)
__device__ __forceinline__ unsigned xb_ld(unsigned* p)              { return __hip_atomic_load(p, __ATOMIC_RELAXED, __HIP_MEMORY_SCOPE_AGENT); }
__device__ __forceinline__ unsigned xb_add(unsigned* p, unsigned v) { return __hip_atomic_fetch_add(p, v, __ATOMIC_RELAXED, __HIP_MEMORY_SCOPE_AGENT); }
__device__ __forceinline__ unsigned xb_xcc_id() { return (unsigned)__builtin_amdgcn_s_getreg((3 << 11) | 20) & 0xFu; }
#define XB_SPIN(cond, bar) do { unsigned _sp = 0; while (cond) { __builtin_amdgcn_s_sleep(1); \
    if ((++_sp & 255u) == 0u) { if (xb_ld(&(bar)[XB_TMO])) break; if (_sp > XB_SPIN_CAP) { atomicAdd(&(bar)[XB_TMO], 1u); break; } } } } while (0)
struct XcdBarrier { unsigned* bar; unsigned x; volatile LAS unsigned* st; };
__device__ __forceinline__ XcdBarrier xcd_barrier_post(unsigned* bar, volatile LAS unsigned* st) {
    XcdBarrier b; b.bar = bar; b.x = xb_xcc_id(); b.st = st;
    if (threadIdx.x == 0) (void)xb_add(&bar[XB_XCNT(b.x)], 1u);
    return b;
}
__device__ __forceinline__ void xcd_barrier_complete(unsigned* bar, unsigned x, unsigned& nloc, unsigned& nx) {
    const unsigned G = gridDim.x * gridDim.y * gridDim.z;
    unsigned sum, cnt, mine, sp = 0u;
    for (;;) {
        sum = 0u; cnt = 0u; mine = 0u;
#pragma unroll
        for (unsigned j = 0; j < 16; ++j) { const unsigned c = xb_ld(&bar[XB_XCNT(j)]); sum += c; cnt += (c > 0u) ? 1u : 0u; mine = (j == x) ? c : mine; }
        if (sum == G) break;
        __builtin_amdgcn_s_sleep(1);
        if ((++sp & 255u) == 0u) { if (xb_ld(&bar[XB_TMO])) break; if (sp > XB_SPIN_CAP) { atomicAdd(&bar[XB_TMO], 1u); break; } }
    }
    nloc = mine > 0u ? mine : 1u; nx = cnt > 0u ? cnt : 1u;
}
__device__ __forceinline__ void xcd_barrier(const XcdBarrier& b) {
    asm volatile("s_waitcnt vmcnt(0)" ::: "memory");
    __syncthreads();
    if (threadIdx.x == 0) {
        unsigned* bar = b.bar;
        __builtin_amdgcn_s_waitcnt(0);
        unsigned nloc = b.st[0], nx = b.st[1];
        if (nloc == 0u) { xcd_barrier_complete(bar, b.x, nloc, nx); b.st[0] = nloc; b.st[1] = nx; }
        const unsigned old = xb_add(&bar[XB_XSUB(b.x)], 1u);
        const unsigned gen = old / nloc;
        if (old + 1u == (gen + 1u) * nloc) {
            __builtin_amdgcn_fence(__ATOMIC_RELEASE, "agent");
            asm volatile("s_waitcnt vmcnt(0)" ::: "memory");
            const unsigned og = xb_add(&bar[XB_TOP], 1u);
            const unsigned tg = og / nx;
            if (og + 1u == (tg + 1u) * nx) xb_add(&bar[XB_TOPGEN], 1u);
            else XB_SPIN(xb_ld(&bar[XB_TOPGEN]) == tg, bar);
            __builtin_amdgcn_fence(__ATOMIC_ACQUIRE, "agent");
            xb_add(&bar[XB_XGEN(b.x)], 1u);
            asm volatile("s_waitcnt vmcnt(0)" ::: "memory");
        } else {
            XB_SPIN(xb_ld(&bar[XB_XGEN(b.x)]) == gen, bar);
            __builtin_amdgcn_fence(__ATOMIC_ACQUIRE, "agent");
            asm volatile("s_waitcnt vmcnt(0)" ::: "memory");
        }
    }
    __syncthreads();
}

namespace pg8 {
constexpr int BM = 256, BK = 64, HALF = 128, HTB = HALF * BK * 2, STAGE_BYTES = 8 * HTB, NXCD = 8, WGM = 4;
__host__ __device__ __forceinline__ int lds_byte(int r, int c) { const int st = (r >> 4) * 2 + (c >> 5), rr = r & 15, cc = c & 31, ob = rr * 64 + cc * 2; return st * 1024 + (ob ^ (((ob >> 9) & 1) << 5)); }
__host__ __device__ __forceinline__ void stage_rc(int b, int& R, int& C) { const int st = b / 1024, sb = b % 1024, swz = sb ^ (((sb >> 9) & 1) << 5); R = (st >> 1) * 16 + swz / 64; C = (st & 1) * 32 + (swz % 64) / 2; }
__host__ __device__ __forceinline__ int perm32(int rho) { const int n = rho >> 4, i = rho & 15; return 8 * (i >> 2) + 4 * n + (i & 3); }

struct Unit { int pm, pn, ac; };
struct Gemm { const bf16_t* A; const bf16_t* Bt; int lda, K; };

__device__ __forceinline__ void tile_of(int wgid0, int nM, int nN, int& pm, int& pn) {
    const int nwg = nM * nN; int wgid = wgid0;
    { const int q = nwg / NXCD, r = nwg % NXCD, xcd = wgid % NXCD, off = wgid / NXCD; wgid = (xcd < r ? xcd * (q + 1) : r * (q + 1) + (xcd - r) * q) + off; }
    const int nig = WGM * nN, gid = wgid / nig, fm = gid * WGM, gsz = (nM - fm) < WGM ? (nM - fm) : WGM;
    pm = fm + ((wgid % nig) % gsz); pn = (wgid % nig) / gsz;
}
#define EPI_FOR_ROWS for (int ai = 0; ai < 2; ++ai) _Pragma("unroll") for (int m = 0; m < 4; ++m)
enum { EPI_STORE = 0, EPI_SIGMOID = 1, EPI_MIX = 2, EPI_SWIGLU = 3 };
struct Epi {
    int type; bf16_t* O; int ldc; int coff; int s_lo, s_hi; float scale; const bf16_t* P; int nt; bf16_t* O2; int ldc2; int split; int pld;
    __device__ __forceinline__ void operator()(const f32x4 (&acc)[2][2][4][2], const Unit& u, int wr, int wc, int fr, int fq) const {
        const int row0 = u.pm * BM + wr * 64 + fr;
        if (type == EPI_STORE || type == EPI_SIGMOID) {
            const float sc = (u.pn >= s_lo && u.pn < s_hi) ? scale : 1.f;
            const bool hi2 = (split > 0) && (u.pn >= split); bf16_t* const Ob = hi2 ? O2 : O; const int ldo = hi2 ? ldc2 : ldc;
            const int col0 = coff + (hi2 ? u.pn - split : u.pn) * BM + wc * 32 + 8 * fq; const bool sg = (type == EPI_SIGMOID);
#pragma unroll
            EPI_FOR_ROWS { bf16_t* rowp = Ob + (size_t)(row0 + ai * HALF + m * 16) * ldo + col0;
#pragma unroll
                for (int bj = 0; bj < 2; ++bj) { f32x4 v0 = acc[ai][bj][m][0] * sc, v1 = acc[ai][bj][m][1] * sc;
                    if (sg) {
#pragma unroll
                        for (int e = 0; e < 4; ++e) { v0[e] = sigmoidf_(v0[e]); v1[e] = sigmoidf_(v1[e]); } }
                    u32x4 w; w.x = cvtpk(v0[0], v0[1]); w.y = cvtpk(v0[2], v0[3]); w.z = cvtpk(v1[0], v1[1]); w.w = cvtpk(v1[2], v1[3]);
                    if (nt) __builtin_nontemporal_store(w, (u32x4*)(rowp + bj * HALF)); else *(u32x4*)(rowp + bj * HALF) = w; } }
        } else if (type == EPI_MIX) {
            const int pn = u.pn & 3;
            const int col0 = pn * BM + wc * 32 + 8 * fq;
            const int gcol = C_GB + col0;
#pragma unroll
            for (int ai = 0; ai < 2; ++ai) {
                u32x4 gv[4][2];
#pragma unroll
                for (int m = 0; m < 4; ++m)
#pragma unroll
                    for (int bj = 0; bj < 2; ++bj) gv[m][bj] = *(const u32x4*)(P + (size_t)(row0 + ai * HALF + m * 16) * pld + gcol + bj * HALF);
#pragma unroll
                for (int m = 0; m < 4; ++m)
#pragma unroll
                    for (int bj = 0; bj < 2; ++bj) { const size_t row = (size_t)(row0 + ai * HALF + m * 16);
                        const u32x4 g = gv[m][bj];
                        f32x4 v0 = acc[ai][bj][m][0], v1 = acc[ai][bj][m][1];
                        v0[0] *= bflo(g.x); v0[1] *= bfhi(g.x); v0[2] *= bflo(g.y); v0[3] *= bfhi(g.y);
                        v1[0] *= bflo(g.z); v1[1] *= bfhi(g.z); v1[2] *= bflo(g.w); v1[3] *= bfhi(g.w);
                        u32x4 w; w.x = cvtpk(v0[0], v0[1]); w.y = cvtpk(v0[2], v0[3]); w.z = cvtpk(v1[0], v1[1]); w.w = cvtpk(v1[2], v1[3]);
                        *(u32x4*)(O + row * ldc + col0 + bj * HALF) = w; }
            }
        } else {
            const int col0 = u.pn * HALF + wc * 32 + 8 * fq;
#pragma unroll
            EPI_FOR_ROWS { bf16_t* rowp = O + (size_t)(row0 + ai * HALF + m * 16) * ldc + col0;
                f32x4 v0 = acc[ai][0][m][0], v1 = acc[ai][0][m][1]; const f32x4 u0 = acc[ai][1][m][0], u1 = acc[ai][1][m][1];
#pragma unroll
                for (int e = 0; e < 4; ++e) { v0[e] = v0[e] * sigmoidf_(v0[e]) * u0[e]; v1[e] = v1[e] * sigmoidf_(v1[e]) * u1[e]; }
                u32x4 w; w.x = cvtpk(v0[0], v0[1]); w.y = cvtpk(v0[2], v0[3]); w.z = cvtpk(v1[0], v1[1]); w.w = cvtpk(v1[2], v1[3]);
                *(u32x4*)rowp = w; }
        }
    }
    __device__ __forceinline__ bool keep(const Unit& u) const { return type == EPI_MIX && (u.pn >> 2) == 0; }
    __device__ __forceinline__ void scale_keep(f32x4 (&acc)[2][2][4][2], const Unit& u, int wr, int wc, int fr, int fq) const {
        const int row0 = u.pm * BM + wr * 64 + fr, col0 = (u.pn & 3) * BM + wc * 32 + 8 * fq;
#pragma unroll
        for (int ai = 0; ai < 2; ++ai) {
            u32x4 ga[4][2], gb[4][2];
#pragma unroll
            for (int m = 0; m < 4; ++m)
#pragma unroll
                for (int bj = 0; bj < 2; ++bj) { const bf16_t* gp = P + (size_t)(row0 + ai * HALF + m * 16) * pld + col0 + bj * HALF; ga[m][bj] = *(const u32x4*)(gp + C_GA); gb[m][bj] = *(const u32x4*)(gp + C_GB); }
#pragma unroll
            for (int m = 0; m < 4; ++m)
#pragma unroll
                for (int bj = 0; bj < 2; ++bj) { const u32x4 a = ga[m][bj], b = gb[m][bj];
                    f32x4& v0 = acc[ai][bj][m][0]; f32x4& v1 = acc[ai][bj][m][1];
                    v0[0] *= bflo(a.x) * __builtin_amdgcn_rcpf(bflo(b.x)); v0[1] *= bfhi(a.x) * __builtin_amdgcn_rcpf(bfhi(b.x)); v0[2] *= bflo(a.y) * __builtin_amdgcn_rcpf(bflo(b.y)); v0[3] *= bfhi(a.y) * __builtin_amdgcn_rcpf(bfhi(b.y));
                    v1[0] *= bflo(a.z) * __builtin_amdgcn_rcpf(bflo(b.z)); v1[1] *= bfhi(a.z) * __builtin_amdgcn_rcpf(bfhi(b.z)); v1[2] *= bflo(a.w) * __builtin_amdgcn_rcpf(bflo(b.w)); v1[3] *= bfhi(a.w) * __builtin_amdgcn_rcpf(bfhi(b.w)); }
        }
    }
};
struct Order {
    int nM, nN, nwg, G, c, pair;
    __device__ __forceinline__ void init(int M_, int N_, int G_, int c_, int pair_) { nM = M_ / BM; nN = N_ / BM; nwg = nM * nN; G = G_; c = c_; pair = pair_; }
    __device__ __forceinline__ bool next(int i, Unit& u) const {
        const int ii = pair ? (i >> 1) : i;
        const long L = (long)ii * G + c; if (L >= nwg) return false;
        int pn; tile_of((int)L, nM, nN, u.pm, pn);
        const int half = pair ? (i & 1) : 0; u.pn = half * nN + pn; u.ac = half * 1024; return true;
    }
};

__device__ __forceinline__ void gemm_phase(LAS unsigned char* lds, const Gemm& g, const Order& S, const Epi& E) {
    int tid = threadIdx.x; asm volatile("" : "+v"(tid));
    const int wid = __builtin_amdgcn_readfirstlane(tid >> 6), lane = tid & 63, wr = wid >> 2, wc = wid & 3, fr = lane & 15, fq = lane >> 4;
    const int K = g.K, lda = g.lda, nt = K / BK;
    unsigned voffA[2], voffB[2];
#pragma unroll
    for (int i = 0; i < 2; ++i) { int R, C; stage_rc(tid * 16 + i * 8192, R, C); const int Rb = (R & ~31) + perm32(R & 31);
        voffA[i] = (unsigned)(R * lda + C) * 2u; voffB[i] = (unsigned)(Rb * K + C) * 2u; }
    const size_t kstep = (size_t)(BK * 2);
    const size_t hstepA = (size_t)HALF * lda * 2, hstepB = (size_t)HALF * K * 2;
    const size_t tstepA = 2 * hstepA, tstepB = 2 * hstepB;
    const unsigned ldsw = (unsigned)wid * 1024u;
    const int aoff = lds_byte(wr * 64 + fr, fq * 8), boff = lds_byte(wc * 32 + fr, fq * 8);
#define PG8_SA(b, h) (((b) * 2 + (h)) * HTB)
#define PG8_SB(b, h) ((4 + (b) * 2 + (h)) * HTB)
#define PG8_STAGE(bufoff, gbase, voff) do { _Pragma("unroll") for (int _i = 0; _i < 2; ++_i) \
        __builtin_amdgcn_global_load_lds((const unsigned*)((const char*)(gbase) + (voff)[_i]), (LAS unsigned*)(lds + (bufoff) + ldsw + _i * 8192), 16, 0, 0); } while (0)
#define PG8_LDA(dst, b, h) do { _Pragma("unroll") for (int m = 0; m < 4; ++m) _Pragma("unroll") for (int k = 0; k < 2; ++k) dst[m][k] = *(const LAS bf16x8*)(lds + PG8_SA(b, h) + aoff + m * 2048 + k * 1024); } while (0)
#define PG8_LDB(dst, b, h) do { _Pragma("unroll") for (int n = 0; n < 2; ++n) _Pragma("unroll") for (int k = 0; k < 2; ++k) dst[n][k] = *(const LAS bf16x8*)(lds + PG8_SB(b, h) + boff + n * 2048 + k * 1024); } while (0)
#define PG8_MMA(ai, bj, At, Bt) do { __builtin_amdgcn_s_setprio(1); _Pragma("unroll") for (int m = 0; m < 4; ++m) _Pragma("unroll") for (int n = 0; n < 2; ++n) _Pragma("unroll") for (int k = 0; k < 2; ++k) \
        acc[ai][bj][m][n] = __builtin_amdgcn_mfma_f32_16x16x32_bf16(Bt[n][k], At[m][k], acc[ai][bj][m][n], 0, 0, 0); __builtin_amdgcn_s_setprio(0); } while (0)
#define PG8_WAIT_V(n) asm volatile("s_waitcnt vmcnt(" #n ")" ::: "memory")
#define PG8_WAIT_L(n) asm volatile("s_waitcnt lgkmcnt(" #n ")" ::: "memory")
#define PG8_BAR __builtin_amdgcn_s_barrier()
#define PG8_SCHED __builtin_amdgcn_sched_barrier(0)
    Unit cur, nxt; int ui = 0;
    if (!S.next(0, cur)) return;
    f32x4 acc[2][2][4][2];
#pragma unroll
    for (int a = 0; a < 2; ++a)
#pragma unroll
        for (int b = 0; b < 2; ++b)
#pragma unroll
            for (int m = 0; m < 4; ++m)
#pragma unroll
                for (int n = 0; n < 2; ++n) acc[a][b][m][n] = (f32x4){0.f, 0.f, 0.f, 0.f};
    bf16x8 At[4][2], B0[2][2], B1[2][2];
    const char* cA = (const char*)g.A + (size_t)cur.pm * tstepA + (size_t)cur.ac * 2; const char* cB = (const char*)g.Bt + (size_t)cur.pn * tstepB;
    PG8_STAGE(PG8_SB(0, 0), cB, voffB); PG8_STAGE(PG8_SB(0, 1), cB + hstepB, voffB); PG8_STAGE(PG8_SA(0, 0), cA, voffA); PG8_STAGE(PG8_SA(0, 1), cA + hstepA, voffA);
    if (wr == 1) PG8_BAR;
    PG8_WAIT_V(2); PG8_BAR;
    PG8_STAGE(PG8_SB(1, 0), cB + kstep, voffB); PG8_STAGE(PG8_SA(1, 0), cA + kstep, voffA); PG8_STAGE(PG8_SB(1, 1), cB + hstepB + kstep, voffB);
    PG8_WAIT_V(6); PG8_BAR;
    for (;;) {
        const bool has_next = S.next(ui + 1, nxt);
        const char* nA = has_next ? (const char*)g.A + (size_t)nxt.pm * tstepA + (size_t)nxt.ac * 2 : cA; const char* nB = has_next ? (const char*)g.Bt + (size_t)nxt.pn * tstepB : cB;
        for (int t = 0; t < nt; t += 2) {
            const bool last = (t == nt - 2);
            const char* a1 = cA + (size_t)(t + 1) * kstep;
            const char* a2 = last ? nA : cA + (size_t)(t + 2) * kstep; const char* b2 = last ? nB : cB + (size_t)(t + 2) * kstep;
            const char* a3 = a2 + kstep; const char* b3 = b2 + kstep;
            PG8_LDB(B0, 0, 0); PG8_LDB(B1, 0, 1); PG8_SCHED; PG8_LDA(At, 0, 0); PG8_STAGE(PG8_SA(1, 1), a1 + hstepA, voffA);
            PG8_WAIT_V(8); PG8_WAIT_L(0); PG8_BAR; PG8_MMA(0, 0, At, B0); PG8_MMA(0, 1, At, B1); PG8_BAR; PG8_SCHED;
            PG8_LDA(At, 0, 1); PG8_STAGE(PG8_SB(0, 0), b2, voffB); PG8_STAGE(PG8_SB(0, 1), b2 + hstepB, voffB); PG8_STAGE(PG8_SA(0, 0), a2, voffA);
            PG8_WAIT_V(8); PG8_WAIT_L(0); PG8_BAR; PG8_MMA(1, 0, At, B0); PG8_MMA(1, 1, At, B1); PG8_BAR; PG8_SCHED;
            PG8_LDB(B0, 1, 0); PG8_LDB(B1, 1, 1); PG8_SCHED; PG8_LDA(At, 1, 0); PG8_STAGE(PG8_SA(0, 1), a2 + hstepA, voffA);
            PG8_WAIT_V(8); PG8_WAIT_L(0); PG8_BAR; PG8_MMA(0, 0, At, B0); PG8_MMA(0, 1, At, B1); PG8_BAR; PG8_SCHED;
            PG8_LDA(At, 1, 1); PG8_STAGE(PG8_SB(1, 0), b3, voffB); PG8_STAGE(PG8_SB(1, 1), b3 + hstepB, voffB); PG8_STAGE(PG8_SA(1, 0), a3, voffA);
            PG8_WAIT_V(8); PG8_WAIT_L(0); PG8_BAR; PG8_MMA(1, 0, At, B0); PG8_MMA(1, 1, At, B1); PG8_BAR; PG8_SCHED;
        }
        if (wr == 0) PG8_BAR;
        const bool keep_acc = E.keep(cur);
        if (keep_acc) E.scale_keep(acc, cur, wr, wc, fr, fq); else E(acc, cur, wr, wc, fr, fq);
        if (!has_next) break;
        if (!keep_acc)
#pragma unroll
        for (int a = 0; a < 2; ++a)
#pragma unroll
            for (int b = 0; b < 2; ++b)
#pragma unroll
                for (int m = 0; m < 4; ++m)
#pragma unroll
                    for (int n = 0; n < 2; ++n) acc[a][b][m][n] = (f32x4){0.f, 0.f, 0.f, 0.f};
        cur = nxt; cA = nA; cB = nB; ++ui;
        if (wr == 1) PG8_BAR;
    }
    PG8_WAIT_V(0);
    PG8_BAR;
#undef PG8_SA
#undef PG8_SB
#undef PG8_STAGE
#undef PG8_LDA
#undef PG8_LDB
#undef PG8_MMA
#undef PG8_WAIT_V
#undef PG8_WAIT_L
#undef PG8_BAR
#undef PG8_SCHED
}
}

enum { I_X = 0, I_MEM, I_GPREMIX, I_GPOSTMIX, I_WIN, I_SHIFT, I_DBASE, I_DUP, I_IBASE, I_IUP, I_GUP, I_KNS, I_KIS, I_BONUS, I_LNW, I_LNB, I_RELB,
       I_WA, I_WB, I_WOUT, I_GPRECROSS, I_GPOSTCROSS, I_GMEM, I_WQM, I_WKVM, I_WOM, I_GPREFFN, I_GPOSTFFN, I_WF1, I_WF2, N_IN };
struct Args { const float* in[N_IN]; float* out; unsigned char* ws; };

__device__ __forceinline__ void p0_transpose_item(const float* W, int ldsrc, int K, int col0, bf16_t* WT, int dld, int drow0, int k0, LAS float* scr, int lane) {
    float tv[32];
#pragma unroll
    for (int i = 0; i < 32; ++i) { const int kk = 2 * i + (lane >> 5); const int k = k0 + kk;
        tv[i] = (k < K) ? __builtin_nontemporal_load(W + (size_t)k * ldsrc + col0 + (lane & 31)) : 0.f; }
#pragma unroll
    for (int i = 0; i < 32; ++i) { const int kk = 2 * i + (lane >> 5); scr[kk * 33 + (lane & 31)] = tv[i]; }
    LDS_WAIT(); asm volatile("" ::: "memory");
    const int c = lane & 7;
    if (k0 + 8 * c < K) {
#pragma unroll
        for (int j = 0; j < 4; ++j) { const int n = (lane >> 3) + 8 * j; const LAS float* s = scr + (8 * c) * 33 + n;
            u32x4 o; o.x = pk2(s[0 * 33], s[1 * 33]); o.y = pk2(s[2 * 33], s[3 * 33]); o.z = pk2(s[4 * 33], s[5 * 33]); o.w = pk2(s[6 * 33], s[7 * 33]);
            *(u32x4*)(WT + (size_t)(drow0 + n) * dld + k0 + 8 * c) = o; }
    }
    LDS_WAIT(); asm volatile("" ::: "memory");
}
constexpr int NJOBS = 19;
__device__ __forceinline__ void job_desc(const Args& a, int j, const float*& src, int& ld, int& K, int& col0, int& ncols, size_t& dst, int& drow0, int& mode) {
    mode = 0;
    switch (j) {
    case 0:  src = a.in[I_WIN]; ld = 8480; K = 1024; col0 = 0;    ncols = 1024; dst = WS_W1T; drow0 = 0; break;
    case 1:  src = a.in[I_WIN]; ld = 8480; K = 1024; col0 = 3360; ncols = 1024; dst = WS_W1T; drow0 = 1024; break;
    case 2:  src = a.in[I_WIN]; ld = 8480; K = 1024; col0 = 1024; ncols = 1024; dst = WS_W1T; drow0 = 2048; break;
    case 3:  src = a.in[I_WIN]; ld = 8480; K = 1024; col0 = 2048; ncols = 1024; dst = WS_W1T; drow0 = 3072; break;
    case 4:  src = a.in[I_WIN]; ld = 8480; K = 1024; col0 = 3072; ncols = 288;  dst = WS_W1T; drow0 = 4096; break;
    case 5:  src = a.in[I_WIN]; ld = 8480; K = 1024; col0 = 4384; ncols = 1024; dst = WS_W1T; drow0 = 4608; break;
    case 6:  src = a.in[I_WIN]; ld = 8480; K = 1024; col0 = 5408; ncols = 1024; dst = WS_W1T; drow0 = 5632; break;
    case 7:  src = a.in[I_WIN]; ld = 8480; K = 1024; col0 = 6432; ncols = 2048; dst = WS_WGT; drow0 = 0; break;
    case 8:  src = a.in[I_WA];  ld = 1024; K = 1024; col0 = 0; ncols = 1024; dst = WS_WABT; drow0 = 0; break;
    case 9:  src = a.in[I_WB];  ld = 1024; K = 1024; col0 = 0; ncols = 1024; dst = WS_WABT; drow0 = 1024; break;
    case 10: src = a.in[I_WOUT]; ld = 1024; K = 1024; col0 = 0; ncols = 1024; dst = WS_WOUTT; drow0 = 0; break;
    case 11: src = a.in[I_WQM]; ld = 512;  K = 1024; col0 = 0; ncols = 512;  dst = WS_WQT; drow0 = 0; break;
    case 12: src = a.in[I_WKVM]; ld = 1024; K = 1024; col0 = 0; ncols = 1024; dst = WS_WKVT; drow0 = 0; break;
    case 13: src = a.in[I_WOM]; ld = 1024; K = 512;  col0 = 0; ncols = 1024; dst = WS_WOT; drow0 = 0; break;
    case 14: src = a.in[I_WF1]; ld = 5632; K = 1024; col0 = 0; ncols = 5632; dst = WS_WF1T; drow0 = 0; mode = 1; break;
    case 15: src = a.in[I_WF2]; ld = 1024; K = 2816; col0 = 0; ncols = 1024; dst = WS_WF2T; drow0 = 0; break;
    case 16: src = a.in[I_DUP]; ld = 1024; K = 64;   col0 = 0; ncols = 1024; dst = WS_DUPT; drow0 = 0; break;
    case 17: src = a.in[I_IUP]; ld = 1024; K = 64;   col0 = 0; ncols = 1024; dst = WS_IUPT; drow0 = 0; break;
    default: src = a.in[I_GUP]; ld = 1024; K = 160;  col0 = 0; ncols = 1024; dst = WS_GUPT; drow0 = 0; break;
    }
}
__device__ __forceinline__ void rms_row_to_bf16(const float* xrow, const float* gain, bf16_t* orow, int lane) {
    const f32x4* xr = (const f32x4*)xrow + lane; const f32x4* gr = (const f32x4*)gain + lane;
    f32x4 v[4]; float s = 0.f;
#pragma unroll
    for (int j = 0; j < 4; ++j) { v[j] = xr[64 * j]; s += (v[j].x * v[j].x + v[j].y * v[j].y) + (v[j].z * v[j].z + v[j].w * v[j].w); }
    const float rs = 1.0f / sqrtf(wave_sum(s) * (1.f / DM) + NORM_EPS);
    u32x2* o8 = (u32x2*)orow + lane;
#pragma unroll
    for (int j = 0; j < 4; ++j) { const f32x4 g = gr[64 * j]; u32x2 w; w.x = cvtpk(v[j].x * rs * g.x, v[j].y * rs * g.y); w.y = cvtpk(v[j].z * rs * g.z, v[j].w * rs * g.w); o8[64 * j] = w; }
}
__device__ __forceinline__ void rms_row2_to_bf16(const float* xa, const float* xb, const float* gain, bf16_t* oa, bf16_t* ob, int lane) {
    const f32x4* xr0 = (const f32x4*)xa + lane; const f32x4* xr1 = (const f32x4*)xb + lane; const f32x4* gr = (const f32x4*)gain + lane;
    f32x4 v0[4], v1[4]; float s0 = 0.f, s1 = 0.f;
#pragma unroll
    for (int j = 0; j < 4; ++j) { v0[j] = __builtin_nontemporal_load(xr0 + 64 * j); v1[j] = __builtin_nontemporal_load(xr1 + 64 * j); }
#pragma unroll
    for (int j = 0; j < 4; ++j) { s0 += (v0[j].x * v0[j].x + v0[j].y * v0[j].y) + (v0[j].z * v0[j].z + v0[j].w * v0[j].w); s1 += (v1[j].x * v1[j].x + v1[j].y * v1[j].y) + (v1[j].z * v1[j].z + v1[j].w * v1[j].w); }
    const float rs0 = __builtin_amdgcn_rsqf(wave_sum(s0) * (1.f / DM) + NORM_EPS), rs1 = __builtin_amdgcn_rsqf(wave_sum(s1) * (1.f / DM) + NORM_EPS);
    u32x2* o0 = (u32x2*)oa + lane; u32x2* o1 = (u32x2*)ob + lane;
#pragma unroll
    for (int j = 0; j < 4; ++j) { const f32x4 g = gr[64 * j]; u32x2 w;
        w.x = cvtpk(v0[j].x * rs0 * g.x, v0[j].y * rs0 * g.y); w.y = cvtpk(v0[j].z * rs0 * g.z, v0[j].w * rs0 * g.w); o0[64 * j] = w;
        w.x = cvtpk(v1[j].x * rs1 * g.x, v1[j].y * rs1 * g.y); w.y = cvtpk(v1[j].z * rs1 * g.z, v1[j].w * rs1 * g.w); o1[64 * j] = w; }
}
__device__ __forceinline__ void p0_prologue(const Args& a, LAS unsigned char* lds, int vcu, int G, int wave, int lane) {
    LAS float* scr = (LAS float*)(lds + wave * 16384);
    const int gw = vcu * NWAVES + wave, NGW = G * NWAVES;
    int total = 0;
    for (int j = 0; j < NJOBS; ++j) { int ld, K, col0, ncols, drow0, mode; size_t dst; const float* src; job_desc(a, j, src, ld, K, col0, ncols, dst, drow0, mode); total += ((K + 63) / 64) * (ncols / 32); }
    for (int it = gw; it < total; it += NGW) {
        int r = it;
        for (int j = 0; j < NJOBS; ++j) {
            int ld, K, col0, ncols, drow0, mode; size_t dst; const float* src; job_desc(a, j, src, ld, K, col0, ncols, dst, drow0, mode);
            const int nblk = ncols / 32, cnt = ((K + 63) / 64) * nblk;
            if (r < cnt) {
                const int kb = r / nblk, nb = r % nblk; int n0 = 32 * nb; int drow = drow0 + n0;
                if (mode == 1) { const int up = n0 >= FFH ? 1 : 0; const int nn = n0 - up * FFH; drow = 256 * (nn / 128) + 128 * up + (nn % 128); }
                p0_transpose_item(src, ld, K, col0 + n0, (bf16_t*)(a.ws + dst), K, drow, 64 * kb, scr, lane);
                break;
            }
            r -= cnt;
        }
    }
    { u32x4* z = (u32x4*)(a.ws + WS_W1T + (size_t)4384 * 1024 * 2); const int n16 = 224 * 1024 * 2 / 16;
      for (int i = gw * 64 + lane; i < n16; i += NGW * 64) z[i] = (u32x4){0u, 0u, 0u, 0u}; }
    bf16_t* XN = (bf16_t*)a.out; bf16_t* MN = (bf16_t*)(a.ws + WS_MN);
    for (int m = gw; m < M; m += 2 * NGW) rms_row2_to_bf16(a.in[I_X] + (size_t)m * DM, a.in[I_X] + (size_t)(m + NGW) * DM, a.in[I_GPREMIX], XN + (size_t)m * DM, XN + (size_t)(m + NGW) * DM, lane);
    for (int m = gw; m < MROWS; m += NGW) rms_row_to_bf16(a.in[I_MEM] + (size_t)m * DM, a.in[I_GMEM], MN + (size_t)m * DM, lane);
}

template <bool XIB, bool XOB>
__device__ __forceinline__ void norm_pass(const bf16_t* O, const void* xres_, void* xout_, const float* g1, const float* g2, bf16_t* hn, int vcu, int G, int wave, int lane) {
    const int gw = vcu * NWAVES + wave, NGW = G * NWAVES;
    for (int m0 = gw; m0 < M; m0 += 2 * NGW) {
        f32x4 ov[2][4], xv[2][4]; float s[2] = {0.f, 0.f};
#pragma unroll
        for (int q = 0; q < 2; ++q) { const size_t m = (size_t)m0 + (size_t)q * NGW;
            const u32x2* orow = (const u32x2*)(O + m * DM) + lane;
#pragma unroll
            for (int j = 0; j < 4; ++j) { const u32x2 w = __builtin_nontemporal_load(orow + 64 * j); ov[q][j] = (f32x4){bflo(w.x), bfhi(w.x), bflo(w.y), bfhi(w.y)};
                if (XIB) { const u32x2 xw = __builtin_nontemporal_load((const u32x2*)((const bf16_t*)xres_ + m * DM) + lane + 64 * j); xv[q][j] = (f32x4){bflo(xw.x), bfhi(xw.x), bflo(xw.y), bfhi(xw.y)}; }
                else xv[q][j] = __builtin_nontemporal_load((const f32x4*)((const float*)xres_ + m * DM) + lane + 64 * j); } }
#pragma unroll
        for (int q = 0; q < 2; ++q)
#pragma unroll
            for (int j = 0; j < 4; ++j) s[q] += (ov[q][j].x * ov[q][j].x + ov[q][j].y * ov[q][j].y) + (ov[q][j].z * ov[q][j].z + ov[q][j].w * ov[q][j].w);
        const float rs[2] = {__builtin_amdgcn_rsqf(wave_sum(s[0]) * (1.f / DM) + NORM_EPS), __builtin_amdgcn_rsqf(wave_sum(s[1]) * (1.f / DM) + NORM_EPS)};
        float s2[2] = {0.f, 0.f};
#pragma unroll
        for (int q = 0; q < 2; ++q) { const size_t m = (size_t)m0 + (size_t)q * NGW;
#pragma unroll
            for (int j = 0; j < 4; ++j) { const f32x4 g = ((const f32x4*)g1 + lane)[64 * j]; xv[q][j] = xv[q][j] + ov[q][j] * rs[q] * g;
                if (XOB) { u32x2 w; w.x = cvtpk(xv[q][j].x, xv[q][j].y); w.y = cvtpk(xv[q][j].z, xv[q][j].w); __builtin_nontemporal_store(w, (u32x2*)((bf16_t*)xout_ + m * DM) + lane + 64 * j); }
                else __builtin_nontemporal_store(xv[q][j], (f32x4*)((float*)xout_ + m * DM) + lane + 64 * j);
                s2[q] += (xv[q][j].x * xv[q][j].x + xv[q][j].y * xv[q][j].y) + (xv[q][j].z * xv[q][j].z + xv[q][j].w * xv[q][j].w); } }
        if (hn) {
            const float r2[2] = {__builtin_amdgcn_rsqf(wave_sum(s2[0]) * (1.f / DM) + NORM_EPS), __builtin_amdgcn_rsqf(wave_sum(s2[1]) * (1.f / DM) + NORM_EPS)};
#pragma unroll
            for (int q = 0; q < 2; ++q) { const size_t m = (size_t)m0 + (size_t)q * NGW; u32x2* ho = (u32x2*)(hn + m * DM) + lane;
#pragma unroll
                for (int j = 0; j < 4; ++j) { const f32x4 g = ((const f32x4*)g2 + lane)[64 * j]; u32x2 w; w.x = cvtpk(xv[q][j].x * r2[q] * g.x, xv[q][j].y * r2[q] * g.y); w.y = cvtpk(xv[q][j].z * r2[q] * g.z, xv[q][j].w * r2[q] * g.w); ho[64 * j] = w; } }
        }
    }
}

__device__ __forceinline__ int crow(int r, int hi) { return (r & 3) + 8 * (r >> 2) + 4 * hi; }
typedef short v4i16_t __attribute__((ext_vector_type(4)));
__device__ __forceinline__ s16x4 vtr(const LAS unsigned char* p) { return __builtin_bit_cast(s16x4, __builtin_amdgcn_ds_read_tr16_b64_v4i16((LAS v4i16_t*)p)); }

template <int D, class BiasF>
__device__ __forceinline__ void attn_qk(const LAS unsigned char* Kb, const bf16x8 (&qr)[D / 16], float m_run, f32x16& p0, f32x16& p1, float& mx, int r32, int hi, const BiasF& biasf) {
    const LAS unsigned char* kb = Kb + hi * 1024 + r32 * 16;
    if (biasf.uniform()) {
        f32x16 ci; const float c = biasf.uval() - m_run;
#pragma unroll
        for (int r = 0; r < 16; ++r) ci[r] = c;
        p0 = __builtin_amdgcn_mfma_f32_32x32x16_bf16(*(const LAS bf16x8*)(kb), qr[0], ci, 0, 0, 0);
        p1 = __builtin_amdgcn_mfma_f32_32x32x16_bf16(*(const LAS bf16x8*)(kb + 512), qr[0], ci, 0, 0, 0);
    } else {
#pragma unroll
        for (int r = 0; r < 16; ++r) { p0[r] = biasf(crow(r, hi)) - m_run; p1[r] = biasf(crow(r, hi) + 32) - m_run; }
        p0 = __builtin_amdgcn_mfma_f32_32x32x16_bf16(*(const LAS bf16x8*)(kb), qr[0], p0, 0, 0, 0);
        p1 = __builtin_amdgcn_mfma_f32_32x32x16_bf16(*(const LAS bf16x8*)(kb + 512), qr[0], p1, 0, 0, 0);
    }
#pragma unroll
    for (int d0 = 1; d0 < D / 16; ++d0) {
        const bf16x8 b0 = *(const LAS bf16x8*)(kb + d0 * 2048);
        const bf16x8 b1 = *(const LAS bf16x8*)(kb + d0 * 2048 + 512);
        p0 = __builtin_amdgcn_mfma_f32_32x32x16_bf16(b0, qr[d0], p0, 0, 0, 0);
        p1 = __builtin_amdgcn_mfma_f32_32x32x16_bf16(b1, qr[d0], p1, 0, 0, 0);
    }
    float ma = fmaxf(fmaxf(p0[0], p0[1]), p1[0]), mb = fmaxf(fmaxf(p0[2], p0[3]), p1[1]);
    ma = fmaxf(fmaxf(ma, p1[2]), p1[3]);
#pragma unroll
    for (int r = 4; r < 16; r += 4) { ma = fmaxf(fmaxf(ma, p0[r]), p0[r + 1]); mb = fmaxf(fmaxf(mb, p0[r + 2]), p0[r + 3]); ma = fmaxf(fmaxf(ma, p1[r]), p1[r + 1]); mb = fmaxf(fmaxf(mb, p1[r + 2]), p1[r + 3]); }
    mx = fmaxf(ma, mb);
}
template <int D>
__device__ __forceinline__ void attn_pv(const LAS unsigned char* Vb, float& m_run, float& l_run, f32x16 (&o)[D / 32], f32x16& p0, f32x16& p1, float mx, LAS float* wsf, int r32, int hi, bool first) {
    mx = fmaxf(mx, __shfl_xor(mx, 32));
    float dl = 0.f;
    if (first) { m_run = mx; dl = mx; }
    else if (__any(mx > 8.0f)) {
        dl = fmaxf(mx, 0.f);
        const float alpha = fast_exp2(-dl);
        m_run += dl; l_run *= alpha;
        if (hi == 0) wsf[r32] = alpha;
        LDS_WAIT(); asm volatile("" ::: "memory");
#pragma unroll
        for (int r = 0; r < 16; ++r) { const float a = wsf[crow(r, hi)];
#pragma unroll
            for (int d = 0; d < D / 32; ++d) o[d][r] *= a; }
    }
    float ps = 0.f, ps2 = 0.f;
#pragma unroll
    for (int r = 0; r < 16; ++r) { p0[r] = fast_exp2(p0[r] - dl); p1[r] = fast_exp2(p1[r] - dl); ps += p0[r]; ps2 += p1[r]; }
    l_run += ps + ps2;
    u32x4 pw[4];
    pw[0] = (u32x4){cvtpk(p0[0], p0[1]), cvtpk(p0[2], p0[3]), cvtpk(p0[4], p0[5]), cvtpk(p0[6], p0[7])};
    pw[1] = (u32x4){cvtpk(p0[8], p0[9]), cvtpk(p0[10], p0[11]), cvtpk(p0[12], p0[13]), cvtpk(p0[14], p0[15])};
    pw[2] = (u32x4){cvtpk(p1[0], p1[1]), cvtpk(p1[2], p1[3]), cvtpk(p1[4], p1[5]), cvtpk(p1[6], p1[7])};
    pw[3] = (u32x4){cvtpk(p1[8], p1[9]), cvtpk(p1[10], p1[11]), cvtpk(p1[12], p1[13]), cvtpk(p1[14], p1[15])};
    const LAS unsigned char* vp = Vb + ((r32 >> 4) & 1) * 32 + (r32 & 3) * 8 + (4 * hi + ((r32 & 15) >> 2)) * 64;
#pragma unroll
    for (int d0 = 0; d0 < D / 32; ++d0) {
#pragma unroll
        for (int ks = 0; ks < 4; ++ks) {
            const s16x4 lo = vtr(vp + d0 * 4096 + ks * 1024), hh = vtr(vp + d0 * 4096 + ks * 1024 + 512);
            const bf16x8 vf = (bf16x8){lo[0], lo[1], lo[2], lo[3], hh[0], hh[1], hh[2], hh[3]};
            o[d0] = __builtin_amdgcn_mfma_f32_32x32x16_bf16(__builtin_bit_cast(bf16x8, pw[ks]), vf, o[d0], 0, 0, 0);
        }
    }
}
template <int D, class BiasF>
__device__ __forceinline__ void attn_tile(const LAS unsigned char* Kb, const LAS unsigned char* Vb, const bf16x8 (&qr)[D / 16], float& m_run, float& l_run, f32x16 (&o)[D / 32],
                                          LAS float* wsf, int r32, int hi, const BiasF& biasf, bool first) {
    f32x16 p0, p1; float mx;
    attn_qk<D>(Kb, qr, m_run, p0, p1, mx, r32, hi, biasf);
    attn_pv<D>(Vb, m_run, l_run, o, p0, p1, mx, wsf, r32, hi, first);
}
template <int ND>
__device__ __forceinline__ void attn_finish(float l_run, f32x16 (&o)[ND], LAS float* wsf, int r32, int hi) {
    const float l = l_run + __shfl_xor(l_run, 32);
    LDS_WAIT(); asm volatile("" ::: "memory");
    if (hi == 0) wsf[32 + r32] = 1.0f / l;
    LDS_WAIT(); asm volatile("" ::: "memory");
#pragma unroll
    for (int r = 0; r < 16; ++r) { const float a = wsf[32 + crow(r, hi)];
#pragma unroll
        for (int d = 0; d < ND; ++d) o[d][r] *= a; }
}

constexpr int ATT_GRP = 32768, ATT_K = 0, ATT_V = 16384, ATT_TB = 65536, ATT_WS = ATT_TB + 1024, ATT_OST = ATT_WS + 2048, ATT_LDS = ATT_OST + 8 * 4096;
static_assert(ATT_LDS <= RING_BYTES, "attention LDS");
struct ChunkBias {
    const LAS float* tb; int base; bool far; float farv;
    __device__ __forceinline__ bool uniform() const { return far; }
    __device__ __forceinline__ float uval() const { return farv; }
    __device__ __forceinline__ float operator()(int kin) const { int d = base - kin; d = d > 128 ? 128 : d; return tb[d + 63]; }
};
__device__ __forceinline__ void chunk_attention_head(const bf16_t* PQp, const bf16_t* PRp, bf16_t* Oout, int opitch, const float* relb, int b, int h, LAS unsigned char* lds, int tid) {
    const int lane = tid & 63, r32 = lane & 31, hi = lane >> 5; const int wid = __builtin_amdgcn_readfirstlane(tid >> 6);
    const int grp = wid >> 2, wg = wid & 3;
    LAS float* tb = (LAS float*)(lds + ATT_TB);
    LAS float* wsf = (LAS float*)(lds + ATT_WS) + wid * 64;
    LAS unsigned char* gl = lds + grp * ATT_GRP;
    if (tid < 192) tb[tid] = relb[h * 192 + tid] * LOG2E;
    const size_t rowbase = (size_t)b * SEQ;
    const bf16_t* Kh = PRp + rowbase * NPR + C_KA + h * 64; const bf16_t* Vh = PRp + rowbase * NPR + C_VA + h * 64;
    const bf16_t* ksrc = Kh + (size_t)lane * NPR + wg * 8;
    const bf16_t* vsrc = Vh + (size_t)(16 * wg + (lane >> 2)) * NPR + (lane & 3) * 8;
    const int kdst = wg * 1024 + lane * 16, vdst = wg * 1024 + lane * 16;
    __syncthreads();
    const float farv = tb[191];
    if (grp == 1) { __builtin_amdgcn_s_setprio(1); __syncthreads(); }
    for (int it = 0; it < 8; ++it) {
        const int u = 2 * it + grp, c0 = 2 * u, cw = c0 + (wg >> 1), qin = 32 * (wg & 1) + r32;
        const bf16_t* Qw = PQp + (rowbase + u * 128 + wg * 32) * NPQ + C_Q + h * 64;
        bf16_t* Ow = Oout + (rowbase + u * 128 + wg * 32) * opitch + h * 64;
        bf16x8 qr[4];
#pragma unroll
        for (int d0 = 0; d0 < 4; ++d0) qr[d0] = *(const bf16x8*)&Qw[(size_t)r32 * NPQ + d0 * 16 + hi * 8];
        float m_run = 0.f, l_run = 0.f; f32x16 o[2]; bool first = true;
#pragma unroll
        for (int r = 0; r < 16; ++r) { o[0][r] = 0.f; o[1][r] = 0.f; }
        u32x4 kA[2], vA[2], kB[2], vB[2];
#define TVALID(t) ((t) <= 9 && (c0 - 8 + (t)) >= 0)
#define TLOAD(K_, V_, t) do { if (TVALID(t)) { const size_t ro_ = (size_t)(c0 - 8 + (t)) * 64 * NPR; _Pragma("unroll") for (int j = 0; j < 2; ++j) { K_[j] = *(const u32x4*)(ksrc + ro_ + j * 32); V_[j] = *(const u32x4*)(vsrc + ro_ + j * 32); } } } while (0)
#define TWRITE(K_, V_, t) do { if (TVALID(t)) { _Pragma("unroll") for (int j = 0; j < 2; ++j) { *(LAS u32x4*)(gl + ATT_K + ((t) & 1) * 8192 + j * 4096 + kdst) = K_[j]; *(LAS u32x4*)(gl + ATT_V + ((t) & 1) * 8192 + j * 4096 + vdst) = V_[j]; } } } while (0)
#define TSTEP(t) do { const int kc_ = c0 - 8 + (t); const int dc_ = cw - kc_; const bool vis_ = (kc_ >= 0 && dc_ >= 0 && dc_ <= 8); f32x16 p0, p1; float mx_ = 0.f; \
            if (vis_) { ChunkBias bf{tb, qin + 64 * dc_, dc_ >= 3, farv}; attn_qk<64>(gl + ATT_K + ((t) & 1) * 8192, qr, m_run, p0, p1, mx_, r32, hi, bf); } \
            __syncthreads(); \
            if (vis_) { attn_pv<64>(gl + ATT_V + ((t) & 1) * 8192, m_run, l_run, o, p0, p1, mx_, wsf, r32, hi, first); first = false; } } while (0)
        TLOAD(kB, vB, 0); TWRITE(kB, vB, 0);
        TLOAD(kA, vA, 1);
        __syncthreads();
#pragma unroll 1
        for (int kk = 0; kk < 10; kk += 2) {
            TLOAD(kB, vB, kk + 2);
            TSTEP(kk);
            TWRITE(kA, vA, kk + 1);
            __syncthreads();
            TLOAD(kA, vA, kk + 3);
            TSTEP(kk + 1);
            TWRITE(kB, vB, kk + 2);
            __syncthreads();
        }
#undef TVALID
#undef TLOAD
#undef TWRITE
#undef TSTEP
        attn_finish<2>(l_run, o, wsf, r32, hi);
        LAS unsigned short* stg = (LAS unsigned short*)(lds + ATT_OST) + wid * 2048;
#pragma unroll
        for (int r = 0; r < 16; r += 1) { const int orow = crow(r, hi);
#pragma unroll
            for (int d0 = 0; d0 < 2; ++d0) stg[orow * 64 + d0 * 32 + r32] = (unsigned short)f2bf(o[d0][r]); }
        LDS_WAIT(); asm volatile("" ::: "memory");
#pragma unroll
        for (int i = 0; i < 4; ++i) { const int row = i * 8 + (lane >> 3), ch = lane & 7; const u32x4 v = *(const LAS u32x4*)(stg + row * 64 + ch * 8); *(u32x4*)(Ow + (size_t)row * opitch + ch * 8) = v; }
        LDS_WAIT(); asm volatile("" ::: "memory");
        __syncthreads();
    }
    if (grp == 0) __syncthreads(); else __builtin_amdgcn_s_setprio(0);
}

constexpr int AT2_BUF = 32768, AT2_TB = 65536, AT2_WS = AT2_TB + 1024, AT2_OST = AT2_WS + 2048, AT2_LDS = AT2_OST + 8 * 4096;
static_assert(AT2_LDS <= RING_BYTES, "attention LDS");
template <class BiasF>
__device__ __forceinline__ void attn2_scores(const LAS unsigned char* Kb, bool vis, const bf16x8 (&qr)[4], float m_run, f32x16& pa, f32x16& pb, int r32, int hi, const BiasF& bf) {
    if (vis) {
        const LAS unsigned char* kb = Kb + hi * 1024 + r32 * 16;
        if (bf.uniform()) {
            f32x16 ci; const float c = bf.uval() - m_run;
#pragma unroll
            for (int r = 0; r < 16; ++r) ci[r] = c;
            pa = __builtin_amdgcn_mfma_f32_32x32x16_bf16(*(const LAS bf16x8*)(kb), qr[0], ci, 0, 0, 0);
            pb = __builtin_amdgcn_mfma_f32_32x32x16_bf16(*(const LAS bf16x8*)(kb + 512), qr[0], ci, 0, 0, 0);
        } else {
#pragma unroll
            for (int r = 0; r < 16; ++r) { pa[r] = bf(crow(r, hi)) - m_run; pb[r] = bf(crow(r, hi) + 32) - m_run; }
            pa = __builtin_amdgcn_mfma_f32_32x32x16_bf16(*(const LAS bf16x8*)(kb), qr[0], pa, 0, 0, 0);
            pb = __builtin_amdgcn_mfma_f32_32x32x16_bf16(*(const LAS bf16x8*)(kb + 512), qr[0], pb, 0, 0, 0);
        }
#pragma unroll
        for (int d0 = 1; d0 < 4; ++d0) {
            pa = __builtin_amdgcn_mfma_f32_32x32x16_bf16(*(const LAS bf16x8*)(kb + d0 * 2048), qr[d0], pa, 0, 0, 0);
            pb = __builtin_amdgcn_mfma_f32_32x32x16_bf16(*(const LAS bf16x8*)(kb + d0 * 2048 + 512), qr[d0], pb, 0, 0, 0);
        }
    } else {
#pragma unroll
        for (int r = 0; r < 16; ++r) { pa[r] = -1e30f; pb[r] = -1e30f; }
    }
}
__device__ __forceinline__ void attn2_pv(const LAS unsigned char* Vb, float dl, float& ps, f32x16 (&o)[2], f32x16& pa, f32x16& pb, int r32, int hi) {
#pragma unroll
    for (int r = 0; r < 16; ++r) { pa[r] = fast_exp2(pa[r] - dl); pb[r] = fast_exp2(pb[r] - dl); ps += pa[r] + pb[r]; }
    const LAS unsigned char* vp = Vb + ((r32 >> 4) & 1) * 32 + (r32 & 3) * 8 + (4 * hi + ((r32 & 15) >> 2)) * 64;
#pragma unroll
    for (int ks = 0; ks < 4; ++ks) {
        const f32x16& pp = (ks < 2) ? pa : pb; const int b8 = (ks & 1) * 8;
        const bf16x8 pf = __builtin_bit_cast(bf16x8, (u32x4){cvtpk(pp[b8 + 0], pp[b8 + 1]), cvtpk(pp[b8 + 2], pp[b8 + 3]), cvtpk(pp[b8 + 4], pp[b8 + 5]), cvtpk(pp[b8 + 6], pp[b8 + 7])});
#pragma unroll
        for (int d0 = 0; d0 < 2; ++d0) {
            const s16x4 lo = vtr(vp + d0 * 4096 + ks * 1024), hh = vtr(vp + d0 * 4096 + ks * 1024 + 512);
            const bf16x8 vf = (bf16x8){lo[0], lo[1], lo[2], lo[3], hh[0], hh[1], hh[2], hh[3]};
            o[d0] = __builtin_amdgcn_mfma_f32_32x32x16_bf16(pf, vf, o[d0], 0, 0, 0);
        }
    }
}
__device__ __forceinline__ void chunk_attention_head2(const bf16_t* PQp, const bf16_t* PRp, bf16_t* Oout, int opitch, const float* relb, int b, int h, LAS unsigned char* lds, int tid) {
    const int lane = tid & 63, r32 = lane & 31, hi = lane >> 5; const int wid = __builtin_amdgcn_readfirstlane(tid >> 6);
    LAS float* tb = (LAS float*)(lds + AT2_TB);
    LAS float* wsf = (LAS float*)(lds + AT2_WS) + wid * 64;
    if (tid < 192) tb[tid] = relb[h * 192 + tid] * LOG2E;
    const size_t rowbase = (size_t)b * SEQ;
    const bf16_t* Kh = PRp + rowbase * NPR + C_KA + h * 64; const bf16_t* Vh = PRp + rowbase * NPR + C_VA + h * 64;
    const bf16_t* ksrc = Kh + (size_t)lane * NPR + wid * 8;
    const bf16_t* vsrc = Vh + (size_t)(16 * (wid & 3) + (lane >> 2)) * NPR + (wid >> 2) * 32 + (lane & 3) * 8;
    const int pdst = wid * 1024 + lane * 16;
    __syncthreads();
    const float farv = tb[191];
    for (int qb = 0; qb < 8; ++qb) {
        const int c0 = qb * 4, cw = c0 + (wid >> 1), qin = 32 * (wid & 1) + r32;
        const bf16_t* Qw = PQp + (rowbase + qb * 256 + wid * 32) * NPQ + C_Q + h * 64;
        bf16_t* Ow = Oout + (rowbase + qb * 256 + wid * 32) * opitch + h * 64;
        bf16x8 qr[4];
#pragma unroll
        for (int d0 = 0; d0 < 4; ++d0) qr[d0] = *(const bf16x8*)&Qw[(size_t)r32 * NPQ + d0 * 16 + hi * 8];
        float m_run = 0.f, l_run = 0.f; f32x16 o[2]; bool first = true;
#pragma unroll
        for (int r = 0; r < 16; ++r) { o[0][r] = 0.f; o[1][r] = 0.f; }
        u32x4 kA[2], vA[2];
#define SVALID(s_) ((s_) <= 5 && (c0 - 8 + 2 * (s_)) >= 0)
#define SLOAD(s_) do { if (SVALID(s_)) { const size_t ro_ = (size_t)(c0 - 8 + 2 * (s_)) * 64 * NPR; _Pragma("unroll") for (int j = 0; j < 2; ++j) { kA[j] = *(const u32x4*)(ksrc + ro_ + (size_t)j * 64 * NPR); vA[j] = *(const u32x4*)(vsrc + ro_ + (size_t)j * 64 * NPR); } } } while (0)
#define SWRITE(s_) do { if (SVALID(s_)) { LAS unsigned char* bb_ = lds + ((s_) & 1) * AT2_BUF; _Pragma("unroll") for (int j = 0; j < 2; ++j) { *(LAS u32x4*)(bb_ + j * 16384 + pdst) = kA[j]; *(LAS u32x4*)(bb_ + j * 16384 + 8192 + pdst) = vA[j]; } } } while (0)
        SLOAD(0); SWRITE(0);
        __syncthreads();
#pragma unroll 1
        for (int ss = 0; ss < 6; ++ss) {
            SLOAD(ss + 1);
            const int kcA = c0 - 8 + 2 * ss; const int dA = cw - kcA, dB = dA - 1;
            const bool vA_ = (kcA >= 0 && dA >= 0 && dA <= 8), vB_ = (kcA >= 0 && dB >= 0 && dB <= 8);
            if (vA_ || vB_) {
                const LAS unsigned char* bb = lds + (ss & 1) * AT2_BUF;
                f32x16 p0, p1, p2, p3;
                attn2_scores(bb, vA_, qr, m_run, p0, p1, r32, hi, ChunkBias{tb, qin + 64 * dA, dA >= 3, farv});
                attn2_scores(bb + 16384, vB_, qr, m_run, p2, p3, r32, hi, ChunkBias{tb, qin + 64 * dB, dB >= 3, farv});
                float ma = fmaxf(fmaxf(p0[0], p1[0]), p2[0]), mb = fmaxf(fmaxf(p0[1], p1[1]), p3[0]);
                mb = fmaxf(mb, fmaxf(p2[1], p3[1]));
#pragma unroll
                for (int r = 2; r < 16; r += 2) { ma = fmaxf(fmaxf(ma, p0[r]), p1[r]); mb = fmaxf(fmaxf(mb, p0[r + 1]), p1[r + 1]); ma = fmaxf(fmaxf(ma, p2[r]), p3[r]); mb = fmaxf(fmaxf(mb, p2[r + 1]), p3[r + 1]); }
                float mx = fmaxf(ma, mb);
                mx = fmaxf(mx, __shfl_xor(mx, 32));
                float dl = 0.f;
                if (first) { m_run = mx; dl = mx; first = false; }
                else if (__any(mx > 8.0f)) {
                    dl = fmaxf(mx, 0.f);
                    const float alpha = fast_exp2(-dl);
                    m_run += dl; l_run *= alpha;
                    if (hi == 0) wsf[r32] = alpha;
                    LDS_WAIT(); asm volatile("" ::: "memory");
#pragma unroll
                    for (int r = 0; r < 16; ++r) { const float a = wsf[crow(r, hi)]; o[0][r] *= a; o[1][r] *= a; }
                }
                float ps = 0.f;
                if (vA_) attn2_pv(bb + 8192, dl, ps, o, p0, p1, r32, hi);
                if (vB_) attn2_pv(bb + 24576, dl, ps, o, p2, p3, r32, hi);
                l_run += ps;
            }
            SWRITE(ss + 1);
            __syncthreads();
        }
#undef SVALID
#undef SLOAD
#undef SWRITE
        attn_finish<2>(l_run, o, wsf, r32, hi);
        LAS unsigned short* stg = (LAS unsigned short*)(lds + AT2_OST) + wid * 2048;
#pragma unroll
        for (int r = 0; r < 16; r += 1) { const int orow = crow(r, hi);
#pragma unroll
            for (int d0 = 0; d0 < 2; ++d0) stg[orow * 64 + d0 * 32 + r32] = (unsigned short)f2bf(o[d0][r]); }
        LDS_WAIT(); asm volatile("" ::: "memory");
#pragma unroll
        for (int i = 0; i < 4; ++i) { const int row = i * 8 + (lane >> 3), ch = lane & 7; const u32x4 v = *(const LAS u32x4*)(stg + row * 64 + ch * 8); *(u32x4*)(Ow + (size_t)row * opitch + ch * 8) = v; }
        LDS_WAIT(); asm volatile("" ::: "memory");
        __syncthreads();
    }
}

constexpr int A3_SLOT = 8192, A3_K = 0, A3_V = 3 * A3_SLOT, A3_WS = 6 * A3_SLOT, A3_TB = A3_WS + 2048, A3_OST = A3_TB + 4352, A3_LDS = A3_OST + 8 * 4096;
static_assert(A3_LDS <= RING_BYTES, "attention LDS");
__device__ __forceinline__ void glds16(const void* g, unsigned lds_base) {
    unsigned sv; asm volatile("s_mov_b32 %0, m0\n\ts_mov_b32 m0, %2\n\ts_nop 0\n\tglobal_load_lds_dwordx4 %1, off\n\ts_mov_b32 m0, %0" : "=&s"(sv) : "v"(g), "s"(lds_base) : "memory"); }
#define MFMA32(a, b, c) __builtin_amdgcn_mfma_f32_32x32x16_bf16(a, b, c, 0, 0, 0)
#define A3_SBAR() __builtin_amdgcn_sched_barrier(0)
#define A3_PIN(x) asm volatile("" : "+v"(x))
#define A3_WAIT_BAR(N) asm volatile("s_waitcnt vmcnt(" #N ") lgkmcnt(0)\n\ts_barrier" ::: "memory")
#define A3_MX3(a, b, c) __builtin_fmaxf(__builtin_fmaxf((a), (b)), (c))
__device__ __forceinline__ void a3_swap32(float& a, float& b) { asm volatile("s_nop 1\n\tv_permlane32_swap_b32 %0, %1\n\ts_nop 1" : "+v"(a), "+v"(b)); }
__device__ __forceinline__ float a3_rowmax(const f32x16& p0, const f32x16& p1) {
    float a = A3_MX3(p0[0], p0[1], p1[0]), b = A3_MX3(p0[2], p0[3], p1[1]); a = A3_MX3(a, p1[2], p1[3]);
#pragma unroll
    for (int r = 4; r < 16; r += 4) { a = A3_MX3(a, p0[r], p0[r + 1]); b = A3_MX3(b, p0[r + 2], p0[r + 3]); a = A3_MX3(a, p1[r], p1[r + 1]); b = A3_MX3(b, p1[r + 2], p1[r + 3]); }
    float m = __builtin_fmaxf(a, b), m2 = m; a3_swap32(m, m2);
    return __builtin_fmaxf(m, m2); }
__device__ __forceinline__ void a3_kload2(bf16x8* kf, const LAS unsigned char* kp, int d0) { kf[2 * d0] = *(const LAS bf16x8*)(kp + d0 * 2048); kf[2 * d0 + 1] = *(const LAS bf16x8*)(kp + d0 * 2048 + 512); }
__device__ __forceinline__ void chunk_attention_head3(const bf16_t* PQp, const bf16_t* PRp, bf16_t* Oout, int opitch, const float* relb, int b, int h, LAS unsigned char* lds, int tid) {
    const int lane = tid & 63, r32 = lane & 31, hi = lane >> 5; const int wid = __builtin_amdgcn_readfirstlane(tid >> 6);
    LAS float* tbx = (LAS float*)(lds + A3_TB);
    LAS float* wsf = (LAS float*)(lds + A3_WS) + wid * 64;
    __syncthreads();
    for (int i = tid; i < 1040; i += 512) { const int s = i / 260, m = i - 260 * s, n = m - s; float v = 0.f;
        if (n >= 0 && n <= 254) { int D = 191 - n; D = D > 128 ? 128 : D; v = (relb[h * 192 + D + 63] - relb[h * 192 + 191]) * LOG2E; }
        tbx[i] = v; }
    const float farv = relb[h * 192 + 191] * LOG2E;
    const size_t rowbase = (size_t)b * SEQ;
    const bf16_t* Kh = PRp + rowbase * NPR + C_KA + h * 64; const bf16_t* Vh = PRp + rowbase * NPR + C_VA + h * 64;
    const unsigned lds0 = (unsigned)(size_t)lds;
    const unsigned kdst = lds0 + A3_K + wid * 1024, vdst = lds0 + A3_V + wid * 1024;
    const LAS unsigned char* vp0 = lds + A3_V + ((lane >> 4) & 1) * 32 + (lane & 3) * 8 + (4 * hi + ((lane & 15) >> 2)) * 64;
    const LAS unsigned char* kp0 = lds + A3_K + hi * 1024 + r32 * 16;
    const int sgn = (r32 + 1) & 3;
    const LAS float* tbase = tbx + 260 * sgn + (191 - (32 * (wid & 1) + r32) + 4 * hi + sgn);
    __syncthreads();
    const bf16_t* Kl = Kh + (size_t)lane * NPR + wid * 8;
    const bf16_t* Vl = Vh + (size_t)(16 * (wid & 3) + (lane >> 2)) * NPR + (wid >> 2) * 32 + (lane & 3) * 8;
    int sl_prev = 2 * A3_SLOT, sl_cur = 0, sl_next = A3_SLOT;
    bf16x8 qr[4];
#pragma unroll 1
    for (int qb = 0; qb < 8; ++qb) {
        const int c0 = qb * 4, kstart = c0 > 8 ? c0 - 8 : 0, NT = c0 + 4 - kstart, dc0 = c0 + (wid >> 1) - kstart;
        const int knext = qb < 7 ? (c0 > 4 ? c0 - 4 : 0) : kstart + NT - 1;
        const bf16_t* Qw = PQp + (rowbase + qb * 256 + wid * 32) * NPQ + C_Q + h * 64;
        bf16_t* Ow = Oout + (rowbase + qb * 256 + wid * 32) * opitch + h * 64;
#define A3_KC(t) int t_ = (t); const int kc_ = t_ < NT ? kstart + t_ : (qb < 7 ? knext + (t_ - NT) : knext);
#define DMA_K(t, slot) do { A3_KC(t) glds16(Kl + (size_t)kc_ * 64 * NPR, (unsigned)__builtin_amdgcn_readfirstlane(kdst + (slot))); } while (0)
#define DMA_V(t, slot) do { A3_KC(t) glds16(Vl + (size_t)kc_ * 64 * NPR, (unsigned)__builtin_amdgcn_readfirstlane(vdst + (slot))); } while (0)
#define NEARADD(X0, X1, dc) do { const LAS float* tp_ = tbase - 64 * (dc); _Pragma("unroll") for (int g = 0; g < 4; ++g) { const f32x4 a_ = *(const LAS f32x4*)(tp_ + 8 * g), b_ = *(const LAS f32x4*)(tp_ + 32 + 8 * g); \
            X0[4 * g] += a_[0]; X0[4 * g + 1] += a_[1]; X0[4 * g + 2] += a_[2]; X0[4 * g + 3] += a_[3]; X1[4 * g] += b_[0]; X1[4 * g + 1] += b_[1]; X1[4 * g + 2] += b_[2]; X1[4 * g + 3] += b_[3]; } } while (0)
        if (qb == 0) { DMA_K(0, sl_cur); DMA_V(0, sl_cur); DMA_K(1, sl_next);
#pragma unroll
            for (int d0 = 0; d0 < 4; ++d0) qr[d0] = *(const bf16x8*)&Qw[(size_t)r32 * NPQ + d0 * 16 + hi * 8]; }
        float mhat = 0.f, l_reg = 0.f; f32x16 o[2];
#pragma unroll
        for (int r = 0; r < 16; ++r) { o[0][r] = 0.f; o[1][r] = 0.f; }
        f32x16 ci16;
#pragma unroll
        for (int r = 0; r < 16; ++r) ci16[r] = farv;
        A3_PIN(ci16);
        bool resc = false, first = true;
        f32x16 pA0, pA1, pB0, pB1; bf16x8 kf[8]; s16x4 vlo[8], vhi[8]; u32x4 pw0, pw1, pw2, pw3;
#define ROT() do { sl_prev = sl_cur; sl_cur = sl_next; sl_next = (sl_next == 2 * A3_SLOT) ? 0 : sl_next + A3_SLOT; } while (0)
#define EX(v) __builtin_amdgcn_exp2f(v)
#define RESC() do { if (resc) { _Pragma("unroll") for (int d_ = 0; d_ < 2; ++d_) _Pragma("unroll") for (int r = 0; r < 16; ++r) o[d_][r] *= wsf[crow(r, hi)]; } } while (0)
#define DECIDE(C0, C1, t) resc = false; \
        { const int dc_ = dc0 - (t); \
          if (dc_ >= 0 && dc_ <= 8) { if (dc_ <= 2) NEARADD(C0, C1, dc_); \
              const float rm = a3_rowmax(C0, C1); float dl = 0.f; bool mv_ = false; \
              if (first) { dl = rm; first = false; mv_ = true; } \
              else if (__builtin_expect(__any(rm > 8.0f), 0)) { dl = __builtin_fmaxf(rm, 0.f); const float f = __builtin_amdgcn_exp2f(-dl); l_reg *= f; if (hi == 0) wsf[r32] = f; resc = true; mv_ = true; } \
              if (mv_) { mhat += dl; const float cv_ = farv - mhat; \
                  _Pragma("unroll") for (int r = 0; r < 16; ++r) { C0[r] -= dl; C1[r] -= dl; ci16[r] = cv_; } A3_PIN(ci16); } } \
          else { _Pragma("unroll") for (int r = 0; r < 16; ++r) { C0[r] = -30000.f; C1[r] = -30000.f; } } }
        if (qb == 0) { DMA_K(2, sl_prev); A3_WAIT_BAR(3); }
#pragma unroll
        for (int d0 = 0; d0 < 4; ++d0) a3_kload2(kf, kp0 + sl_cur, d0);
        pA0 = MFMA32(kf[0], qr[0], ci16); pA1 = MFMA32(kf[1], qr[0], ci16); pA0 = MFMA32(kf[2], qr[1], pA0); pA1 = MFMA32(kf[3], qr[1], pA1);
        pA0 = MFMA32(kf[4], qr[2], pA0); pA1 = MFMA32(kf[5], qr[2], pA1); pA0 = MFMA32(kf[6], qr[3], pA0); pA1 = MFMA32(kf[7], qr[3], pA1);
        { DECIDE(pA0, pA1, 0)
#pragma unroll
          for (int r = 0; r < 16; ++r) { pA0[r] = EX(pA0[r]); pA1[r] = EX(pA1[r]); } }
        A3_WAIT_BAR(0);
        DMA_K(3, sl_cur); DMA_V(1, sl_next); ROT();
#pragma unroll
        for (int d0 = 0; d0 < 4; ++d0) a3_kload2(kf, kp0 + sl_cur, d0);
        A3_WAIT_BAR(2);
#define PKW(P, i) cvtpk(P[i], P[i + 1])
#define PAF(k) __builtin_bit_cast(bf16x8, pw##k)
#define VFR(i) (bf16x8){vlo[i][0], vlo[i][1], vlo[i][2], vlo[i][3], vhi[i][0], vhi[i][1], vhi[i][2], vhi[i][3]}
#define VRD(i) do { vlo[i] = vtr(vp_ + (((i) >> 2) * 4096 + ((i) & 3) * 1024)); vhi[i] = vtr(vp_ + (((i) >> 2) * 4096 + ((i) & 3) * 1024 + 512)); } while (0)
#define KRD(G, d0) do { if (G) { a3_kload2(kf, kp0 + sl_next, d0); A3_SBAR(); } } while (0)
#define GAPA(MF, a0, a1, a2, a3, W0, W1, PW) do { MF; sacc += a0; sacc += a1; sacc += a2; sacc += a3; W0; W1; A3_PIN(PW); A3_PIN(sacc); A3_SBAR(); } while (0)
#define GAPB(MF, X, i) do { MF; X[i] = EX(X[i]); X[i + 1] = EX(X[i + 1]); X[i + 2] = EX(X[i + 2]); X[i + 3] = EX(X[i + 3]); A3_PIN(X); A3_SBAR(); } while (0)
#define STEP(C0, C1, P0, P1, t, GD, GL) do { A3_SBAR(); \
        const LAS unsigned char* vp_ = vp0 + sl_prev; \
        VRD(0); A3_SBAR(); float sacc = P0[0] + P0[1]; \
                           GAPA(C0 = MFMA32(kf[0], qr[0], ci16),   P0[2], P0[3], P0[4], P0[5],     pw0[0] = PKW(P0, 0),  pw0[1] = PKW(P0, 2),  pw0); \
        VRD(4); A3_SBAR(); GAPA(C1 = MFMA32(kf[1], qr[0], ci16),   P0[6], P0[7], P0[8], P0[9],     pw0[2] = PKW(P0, 4),  pw0[3] = PKW(P0, 6),  pw0); \
        VRD(1); A3_SBAR(); GAPA(C0 = MFMA32(kf[2], qr[1], C0),    P0[10], P0[11], P0[12], P0[13], pw1[0] = PKW(P0, 8),  pw1[1] = PKW(P0, 10), pw1); \
        VRD(5); A3_SBAR(); GAPA(C1 = MFMA32(kf[3], qr[1], C1),    P0[14], P0[15], P1[0], P1[1],   pw1[2] = PKW(P0, 12), pw1[3] = PKW(P0, 14), pw1); \
        VRD(2); A3_SBAR(); GAPA(C0 = MFMA32(kf[4], qr[2], C0),    P1[2], P1[3], P1[4], P1[5],     pw2[0] = PKW(P1, 0),  pw2[1] = PKW(P1, 2),  pw2); \
        VRD(6); A3_SBAR(); GAPA(C1 = MFMA32(kf[5], qr[2], C1),    P1[6], P1[7], P1[8], P1[9],     pw2[2] = PKW(P1, 4),  pw2[3] = PKW(P1, 6),  pw2); \
        VRD(3); A3_SBAR(); GAPA(C0 = MFMA32(kf[6], qr[3], C0),    P1[10], P1[11], P1[12], P1[13], pw3[0] = PKW(P1, 8),  pw3[1] = PKW(P1, 10), pw3); \
        VRD(7); A3_SBAR(); GAPA(C1 = MFMA32(kf[7], qr[3], C1),    P1[14], P1[15], 0.f, 0.f,       pw3[2] = PKW(P1, 12), pw3[3] = PKW(P1, 14), pw3); \
        l_reg += sacc; \
        if (GD) { DMA_K((t) + 3, sl_cur); DMA_V((t) + 1, sl_next); } \
        DECIDE(C0, C1, t) \
        A3_SBAR(); \
        GAPB(o[0] = MFMA32(PAF(0), VFR(0), o[0]), C0, 0);              GAPB(o[1] = MFMA32(PAF(0), VFR(4), o[1]), C0, 4); \
        KRD(GL, 0); GAPB(o[0] = MFMA32(PAF(1), VFR(1), o[0]), C0, 8);  KRD(GL, 1); GAPB(o[1] = MFMA32(PAF(1), VFR(5), o[1]), C0, 12); \
        KRD(GL, 2); GAPB(o[0] = MFMA32(PAF(2), VFR(2), o[0]), C1, 0);  KRD(GL, 3); GAPB(o[1] = MFMA32(PAF(2), VFR(6), o[1]), C1, 4); \
        GAPB(o[0] = MFMA32(PAF(3), VFR(3), o[0]), C1, 8);              GAPB(o[1] = MFMA32(PAF(3), VFR(7), o[1]), C1, 12); \
        } while (0)
        int t = 1;
#pragma unroll 1
        for (; t + 1 < NT; t += 2) {
            STEP(pB0, pB1, pA0, pA1, t, true, true);     A3_WAIT_BAR(2); RESC(); ROT();
            STEP(pA0, pA1, pB0, pB1, t + 1, true, true); A3_WAIT_BAR(2); RESC(); ROT();
        }
        STEP(pB0, pB1, pA0, pA1, NT - 1, true, false);
        A3_WAIT_BAR(2); RESC();
        if (qb < 7) { const bf16_t* Qn = Qw + (size_t)256 * NPQ;
#pragma unroll
            for (int d0 = 0; d0 < 4; ++d0) qr[d0] = *(const bf16x8*)&Qn[(size_t)r32 * NPQ + d0 * 16 + hi * 8]; }
        { float sacc = pB0[0] + pB0[1];
#pragma unroll
          for (int r = 2; r < 16; ++r) sacc += pB0[r];
#pragma unroll
          for (int r = 0; r < 16; ++r) sacc += pB1[r];
          l_reg += sacc;
          pw0 = (u32x4){PKW(pB0, 0), PKW(pB0, 2), PKW(pB0, 4), PKW(pB0, 6)}; pw1 = (u32x4){PKW(pB0, 8), PKW(pB0, 10), PKW(pB0, 12), PKW(pB0, 14)};
          pw2 = (u32x4){PKW(pB1, 0), PKW(pB1, 2), PKW(pB1, 4), PKW(pB1, 6)}; pw3 = (u32x4){PKW(pB1, 8), PKW(pB1, 10), PKW(pB1, 12), PKW(pB1, 14)};
          const LAS unsigned char* vp_ = vp0 + sl_cur;
#pragma unroll
          for (int i = 0; i < 8; ++i) VRD(i);
          o[0] = MFMA32(PAF(0), VFR(0), o[0]); o[1] = MFMA32(PAF(0), VFR(4), o[1]); o[0] = MFMA32(PAF(1), VFR(1), o[0]); o[1] = MFMA32(PAF(1), VFR(5), o[1]);
          o[0] = MFMA32(PAF(2), VFR(2), o[0]); o[1] = MFMA32(PAF(2), VFR(6), o[1]); o[0] = MFMA32(PAF(3), VFR(3), o[0]); o[1] = MFMA32(PAF(3), VFR(7), o[1]); }
        { float l2 = l_reg; a3_swap32(l_reg, l2); l_reg += l2; }
        if (hi == 0) wsf[32 + r32] = l_reg;
        LDS_WAIT(); asm volatile("" ::: "memory");
        LAS unsigned short* stg = (LAS unsigned short*)(lds + A3_OST) + wid * 2048;
#pragma unroll
        for (int r = 0; r < 16; ++r) { const int orow = crow(r, hi); const float rl = __builtin_amdgcn_rcpf(wsf[32 + orow]);
#pragma unroll
            for (int d0 = 0; d0 < 2; ++d0) stg[orow * 64 + d0 * 32 + r32] = (unsigned short)f2bf(o[d0][r] * rl); }
        LDS_WAIT(); asm volatile("" ::: "memory");
#pragma unroll
        for (int i = 0; i < 4; ++i) { const int row = i * 8 + (lane >> 3), ch = lane & 7; const u32x4 v = *(const LAS u32x4*)(stg + row * 64 + ch * 8); *(u32x4*)(Ow + (size_t)row * opitch + ch * 8) = v; }
        ROT();
        asm volatile("s_waitcnt lgkmcnt(0)\n\ts_barrier" ::: "memory");
#undef A3_KC
#undef DMA_K
#undef DMA_V
#undef NEARADD
#undef ROT
#undef EX
#undef RESC
#undef DECIDE
#undef PKW
#undef PAF
#undef VFR
#undef VRD
#undef KRD
#undef GAPA
#undef GAPB
#undef STEP
    }
    asm volatile("s_waitcnt vmcnt(0)" ::: "memory");
}

constexpr int CA_K = 0, CA_V = 65536, CA_WS = 132096, CA_OST = CA_WS + 8 * 256;
static_assert(CA_WS >= MISC_OFF + 128 && CA_OST + 8 * 2048 <= LDS_BYTES, "CA LDS");
struct NoBias { __device__ __forceinline__ bool uniform() const { return true; } __device__ __forceinline__ float uval() const { return 0.f; } __device__ __forceinline__ float operator()(int) const { return 0.f; } };
__device__ __forceinline__ void cross_attention(const bf16_t* Q2, const bf16_t* KVM, bf16_t* O2, LAS unsigned char* lds, int vcu, int G, int tid) {
    const int lane = tid & 63, r32 = lane & 31, hi = lane >> 5; const int wid = __builtin_amdgcn_readfirstlane(tid >> 6);
    LAS float* wsf = (LAS float*)(lds + CA_WS) + wid * 64;
    for (int u = vcu; u < 256; u += G) {
        const int pair = u >> 2, b = pair >> 2, hh = pair & 3;
        const bf16_t* Kg = KVM + (size_t)b * MEMT * DM + hh * 128; const bf16_t* Vg = Kg + 512;
        __syncthreads();
#pragma unroll
        for (int i = 0; i < 8; ++i) {
            const int piece = tid + 512 * i, key = piece & 255, ch = piece >> 8;
            const u32x4 v = *(const u32x4*)(Kg + (size_t)key * DM + ch * 8);
            *(LAS u32x4*)(lds + CA_K + (key >> 6) * 16384 + ch * 1024 + (key & 63) * 16) = v;
        }
#pragma unroll
        for (int i = 0; i < 8; ++i) {
            const int piece = tid + 512 * i, pc = piece & 15, key = piece >> 4;
            const u32x4 v = *(const u32x4*)(Vg + (size_t)key * DM + pc * 8);
            *(LAS u32x4*)(lds + CA_V + (key >> 6) * 16384 + (pc >> 2) * 4096 + (key & 63) * 64 + (pc & 3) * 16) = v;
        }
        __syncthreads();
        for (int qq = 0; qq < 2; ++qq) {
            const int qblk = 2 * (u & 3) + qq;
            const size_t row0 = (size_t)b * SEQ + qblk * 256 + wid * 32;
            const bf16_t* Qw = Q2 + row0 * 512 + hh * 128;
            bf16x8 qr[8];
#pragma unroll
            for (int d0 = 0; d0 < 8; ++d0) qr[d0] = *(const bf16x8*)&Qw[(size_t)r32 * 512 + d0 * 16 + hi * 8];
            float m_run = 0.f, l_run = 0.f; f32x16 o[4];
#pragma unroll
            for (int d = 0; d < 4; ++d)
#pragma unroll
                for (int r = 0; r < 16; ++r) o[d][r] = 0.f;
            attn_tile<128>(lds + CA_K, lds + CA_V, qr, m_run, l_run, o, wsf, r32, hi, NoBias{}, true);
#pragma unroll 1
            for (int t = 1; t < 4; ++t) attn_tile<128>(lds + CA_K + t * 16384, lds + CA_V + t * 16384, qr, m_run, l_run, o, wsf, r32, hi, NoBias{}, false);
            attn_finish<4>(l_run, o, wsf, r32, hi);
            bf16_t* Ow = O2 + row0 * 512 + hh * 128;
            LAS unsigned short* stg = (LAS unsigned short*)(lds + CA_OST) + wid * 1024;
#pragma unroll
            for (int d0 = 0; d0 < 4; ++d0) {
#pragma unroll
                for (int r = 0; r < 16; ++r) stg[crow(r, hi) * 32 + r32] = (unsigned short)f2bf(o[d0][r]);
                LDS_WAIT(); asm volatile("" ::: "memory");
#pragma unroll
                for (int i = 0; i < 2; ++i) { const int row = i * 16 + (lane >> 2), ch = lane & 3; const u32x4 v = *(const LAS u32x4*)(stg + row * 32 + ch * 8); *(u32x4*)(Ow + (size_t)row * 512 + d0 * 32 + ch * 8) = v; }
                LDS_WAIT(); asm volatile("" ::: "memory");
            }
        }
    }
    __syncthreads();
}

constexpr int TC = 32;
constexpr int SC_ZR = 0, SC_ZK = 8192, SC_ZV = 16384, SC_WD = 24576, SC_AA = 32768, SC_GG = 40960, SC_KK = 49152, SC_YY = 57344;
constexpr int SC_AW = 65536;
constexpr int SC_AZ = SC_AW + 32 * 144;
constexpr int SC_AG = SC_AZ + 32 * 144;
constexpr int SC_BD = SC_AG + 32 * 336;
constexpr int SC_CARRY = SC_BD + 128;
constexpr int SC_END = SC_CARRY + 2 * 64 * 16;
static_assert(SC_END <= RING_BYTES, "scan LDS");

template <int CTRL> __device__ __forceinline__ float dpp_f(float x) { return __builtin_bit_cast(float, __builtin_amdgcn_update_dpp(__builtin_bit_cast(int, x), __builtin_bit_cast(int, x), CTRL, 0xF, 0xF, false)); }
__device__ __forceinline__ float red8(float x) { x += dpp_f<0xB1>(x); x += dpp_f<0x4E>(x); x += dpp_f<0x141>(x); return x; }
__device__ __forceinline__ float red16(float x) { x = red8(x); x += dpp_f<0x140>(x); return x; }

template <int NK>
__device__ __forceinline__ f32x16 lora_mma(const LAS unsigned char* Abase, int astride, const bf16x8* bfr, int r32, int hi) {
    f32x16 acc;
#pragma unroll
    for (int r = 0; r < 16; ++r) acc[r] = 0.f;
#pragma unroll
    for (int s = 0; s < NK; ++s) {
        const bf16x8 af = *(const LAS bf16x8*)(Abase + r32 * astride + (16 * s + 8 * hi) * 2);
        acc = __builtin_amdgcn_mfma_f32_32x32x16_bf16(af, bfr[s], acc, 0, 0, 0);
    }
    return acc;
}

__device__ __forceinline__ void lora_prep(const Args& a, const bf16_t* P, int vcu, int G, int tid) {
    bf16_t* LORA = (bf16_t*)(a.ws + WS_LORA); const float* mixp = a.in[I_SHIFT] + 3072;
    for (int gp = vcu * 512 + tid; gp < M * 36; gp += G * 512) {
        const int m = gp / 36, pc = gp - m * 36;
        const bf16_t* src = P + (size_t)m * NPR + C_L + pc * 8;
        const u32x4 cur = *(const u32x4*)src;
        u32x4 prv = (u32x4){0u, 0u, 0u, 0u};
        if ((m & (SEQ - 1)) != 0) prv = *(const u32x4*)(src - NPR);
        const f32x4 m0 = *(const f32x4*)(mixp + pc * 8), m1 = *(const f32x4*)(mixp + pc * 8 + 4);
        float z[8];
        { const unsigned cw_[4] = {cur.x, cur.y, cur.z, cur.w}, pw_[4] = {prv.x, prv.y, prv.z, prv.w}; const float mm[8] = {m0.x, m0.y, m0.z, m0.w, m1.x, m1.y, m1.z, m1.w};
#pragma unroll
          for (int e = 0; e < 4; ++e) { const float c0_ = bflo(cw_[e]), c1_ = bfhi(cw_[e]), p0_ = bflo(pw_[e]), p1_ = bfhi(pw_[e]);
              z[2 * e] = c0_ + (p0_ - c0_) * mm[2 * e]; z[2 * e + 1] = c1_ + (p1_ - c1_) * mm[2 * e + 1]; } }
        if (pc < 8) {
#pragma unroll
            for (int e = 0; e < 8; ++e) { const float ex = fast_exp2(2.f * LOG2E * z[e]); z[e] = 1.f - 2.f * __builtin_amdgcn_rcpf(ex + 1.f); }
        } else if (pc >= 16) {
#pragma unroll
            for (int e = 0; e < 8; ++e) z[e] = sigmoidf_(z[e]);
        }
        *(u32x4*)(LORA + (size_t)m * 288 + pc * 8) = (u32x4){cvtpk(z[0], z[1]), cvtpk(z[2], z[3]), cvtpk(z[4], z[5]), cvtpk(z[6], z[7])};
    }
}

constexpr int CK_RAW = 0;
constexpr int CK_CARRY = 12288;
constexpr int CK_CL = 13312, CK_AA = CK_CL + 8192, CK_GG = CK_AA + 8192, CK_YY = CK_GG + 8192;
constexpr int CK_BD = CK_YY + 8192;
constexpr int CK_GC = CK_BD + 128;
constexpr int CK_AW = CK_GC + 256, CK_AZ = CK_AW + 32 * 144, CK_AG = CK_AZ + 32 * 144;
constexpr int CK_RKK = CK_AW, CK_RBH = CK_RKK + 4608, CK_RKH = CK_RBH + 4608, CK_RRH = CK_RKH + 4608;
constexpr int CK_VKK = CK_AG + 32 * 336;
constexpr int CK_VVM = CK_VKK + 4096;
constexpr int CK_VBT = CK_VVM + 4096;
constexpr int CK_VKT = CK_VBT + 4096;
constexpr int CK_IP = CK_VKT + 4096;
constexpr int CK_IT = CK_IP + 2048, CK_ILK = CK_IT + 2048, CK_IMB = CK_ILK + 2048, CK_IMK = CK_IMB + 2048;
constexpr int CK_IG = CK_IMK + 2048;
constexpr int CK_WD = CK_IG + 4096;
constexpr int CK_WG = CK_WD + 64 * 144;
constexpr int CK_END = CK_WG + 64 * 336;
constexpr int CK_WI = 132096;
static_assert(CK_WI + 64 * 144 <= LDS_BYTES, "lora weights LDS");
static_assert(CK_RRH + 4608 <= CK_VKK && CK_END <= RING_BYTES && (CK_AW % 16) == 0 && (CK_VKK % 16) == 0, "chunked scan LDS");

__device__ __forceinline__ bf16x8 a_perm(const LAS unsigned char* img, int stride, int row, int col0, int hi) {
    const LAS unsigned char* p = img + row * stride + (col0 + 4 * hi) * 2;
    const s16x4 lo = *(const LAS s16x4*)p, hh = *(const LAS s16x4*)(p + 16);
    return (bf16x8){lo[0], lo[1], lo[2], lo[3], hh[0], hh[1], hh[2], hh[3]};
}
__device__ __forceinline__ bf16x8 b_tr(const LAS unsigned char* blk, int ks, int r32, int hi) {
    const LAS unsigned char* vp = blk + ((r32 >> 4) & 1) * 32 + (r32 & 3) * 8 + (4 * hi + ((r32 & 15) >> 2)) * 64 + ks * 1024;
    const s16x4 lo = vtr(vp), hh = vtr(vp + 512);
    return (bf16x8){lo[0], lo[1], lo[2], lo[3], hh[0], hh[1], hh[2], hh[3]};
}
__device__ __forceinline__ bf16x8 acc_frag(const f32x16& x, int s) {
    const u32x4 w = (u32x4){cvtpk(x[8 * s + 0], x[8 * s + 1]), cvtpk(x[8 * s + 2], x[8 * s + 3]), cvtpk(x[8 * s + 4], x[8 * s + 5]), cvtpk(x[8 * s + 6], x[8 * s + 7])};
    return __builtin_bit_cast(bf16x8, w);
}
__device__ __forceinline__ void img_store_t(LAS unsigned char* img, int col, int hi, const f32x16& x, float sgn) {
#pragma unroll
    for (int q = 0; q < 4; ++q) *(LAS u32x2*)(img + col * 64 + (8 * q + 4 * hi) * 2) = (u32x2){cvtpk(x[4 * q] * sgn, x[4 * q + 1] * sgn), cvtpk(x[4 * q + 2] * sgn, x[4 * q + 3] * sgn)};
}
#define MFMA32(a, b, c) __builtin_amdgcn_mfma_f32_32x32x16_bf16(a, b, c, 0, 0, 0)

constexpr int PK_HB = 39296;
constexpr int HB_RKK = 0, HB_RBH = 4608, HB_RKH = 9216, HB_RRH = 13824, HB_VKK = 18432, HB_VVM = 22528, HB_VBT = 26624, HB_VKT = 30720, HB_GC = 34816, HB_BD = 35072, HB_GG = 35200;
constexpr int PK_RAW = 2 * PK_HB, PK_CARRY = PK_RAW + 12288, PK_CL = PK_CARRY + 1024, PK_AA = PK_CL + 8192, PK_AW = PK_AA + 8192, PK_AZ = PK_AW + 4608, PK_AG = PK_AZ + 4608;
static_assert(PK_AG + 32 * 336 <= RING_BYTES, "pipelined scan LDS (ring part)");
constexpr int PK_CONST = PK_AG + 32 * 336;
static_assert(PK_CONST + 2048 <= RING_BYTES, "pipelined scan LDS (constants)");
constexpr int PK_YY = 132096;
static_assert(PK_YY + 2 * 8192 <= LDS_BYTES, "pipelined scan LDS (upper part)");
constexpr int NCH = SEQ / TC;

__device__ __forceinline__ f32x16 gram_tile(const bf16x8 (&af)[4], const bf16x8 (&bf)[4]) {
    f32x16 acc;
#pragma unroll
    for (int r = 0; r < 16; ++r) acc[r] = 0.f;
#pragma unroll
    for (int s = 0; s < 4; ++s) acc = MFMA32(af[s], bf[s], acc);
    return acc;
}
template <int MODE> __device__ __forceinline__ void tri_mask(f32x16& x, int r32, int hi, float sgn) {
#pragma unroll
    for (int r = 0; r < 16; ++r) { const int row = crow(r, hi); const bool keep = (MODE == 0) ? (r32 < row) : ((MODE == 1) ? (r32 > row) : (r32 >= row)); x[r] = keep ? x[r] * sgn : 0.f; }
}

__device__ __forceinline__ void rwkv_head_pipe(const Args& a, const bf16_t* PQp, const bf16_t* PRp, bf16_t* Yout, int ypitch, int b, int h, LAS unsigned char* lds, int tid) {
    const int lane = tid & 63, r32 = lane & 31, hi = lane >> 5; const int wid = __builtin_amdgcn_readfirstlane(tid >> 6);
    const size_t rowbase = (size_t)b * SEQ;
    if (wid < 6) {
        LAS float* CL = (LAS float*)(lds + PK_CL); LAS float* AA = (LAS float*)(lds + PK_AA);
        const int lnb = wid & 1, lch = h * 64 + 32 * lnb + r32;
        const float lbase = (wid < 2) ? a.in[I_DBASE][lch] : ((wid < 4) ? a.in[I_IBASE][lch] : 0.f);
        const int oc = tid & 7, tk = (tid >> 3) & 31, ch0 = h * 64 + 8 * oc;
        if (tid < 128) { const int v8 = tid >> 4, q = tid & 15; const float* srcv;
            switch (v8) { case 0: srcv = a.in[I_KNS]; break; case 1: srcv = a.in[I_KIS]; break; case 2: srcv = a.in[I_BONUS]; break; case 3: srcv = a.in[I_LNW]; break; case 4: srcv = a.in[I_LNB]; break;
                          case 5: srcv = a.in[I_SHIFT]; break; case 6: srcv = a.in[I_SHIFT] + 1024; break; default: srcv = a.in[I_SHIFT] + 2048; break; }
            *(LAS f32x4*)(lds + PK_CONST + v8 * 256 + q * 16) = *(const f32x4*)(srcv + h * 64 + 4 * q); }
        (void)ch0;
#define CV(v8, q) (*(const LAS f32x4*)(lds + PK_CONST + (v8) * 256 + oc * 32 + (q) * 16))
        bf16x8 bfr[10];
        { const bf16_t* up = (wid < 2) ? (const bf16_t*)(a.ws + WS_DUPT) + (size_t)lch * 64 : ((wid < 4) ? (const bf16_t*)(a.ws + WS_IUPT) + (size_t)lch * 64 : (const bf16_t*)(a.ws + WS_GUPT) + (size_t)lch * 160);
          if (wid < 4) {
#pragma unroll
              for (int s = 0; s < 4; ++s) bfr[s] = *(const bf16x8*)(up + 16 * s + 8 * hi);
#pragma unroll
              for (int s = 4; s < 10; ++s) bfr[s] = bfr[0];
          } else {
#pragma unroll
              for (int s = 0; s < 10; ++s) bfr[s] = *(const bf16x8*)(up + 16 * s + 8 * hi);
          } }
        const unsigned char* psrc[5]; unsigned pstride[5]; u32x4 pre[5];
        const bf16_t* LORA = (const bf16_t*)(a.ws + WS_LORA);
#pragma unroll
        for (int i = 0; i < 5; ++i) {
            const int p = tid + 384 * i; const int tl = p / 60, pc = p - tl * 60;
            if (pc < 8) { psrc[i] = (const unsigned char*)(PQp + (rowbase + tl) * NPQ + C_R + h * 64 + pc * 8); pstride[i] = NPQ * 2; }
            else if (pc < 24) { psrc[i] = (const unsigned char*)(PRp + (rowbase + tl) * NPR + (pc < 16 ? C_K : C_V) + h * 64 + (pc & 7) * 8); pstride[i] = NPR * 2; }
            else { psrc[i] = (const unsigned char*)(LORA + (rowbase + tl) * 288 + (pc - 24) * 8); pstride[i] = 288 * 2; }
            pre[i] = __builtin_nontemporal_load((const u32x4*)psrc[i]);
        }
        u32x4 po_g[2], po_v[2]; float po_bd[2];
#pragma unroll
        for (int i2 = 0; i2 < 2; ++i2) { po_g[i2] = (u32x4){0u, 0u, 0u, 0u}; po_v[i2] = po_g[i2]; po_bd[i2] = 0.f; }
#pragma unroll 1
        for (int it = 0; it < NCH + 2; ++it) {
            if (it >= 2 && wid >= 4) {
                const LAS unsigned char* hb = lds + (it & 1) * PK_HB;
#pragma unroll
                for (int i2 = 0; i2 < 2; ++i2) { const int tk2 = ((tid - 256) >> 3) + 16 * i2;
                    po_g[i2] = *(const LAS u32x4*)(hb + HB_GG + tk2 * 128 + oc * 16); po_v[i2] = *(const LAS u32x4*)(hb + HB_VVM + (oc >> 2) * 2048 + tk2 * 64 + (oc & 3) * 16);
                    po_bd[i2] = *(const LAS float*)(hb + HB_BD + tk2 * 4); }
            }
#ifdef X_DUPCOPY
            for (int rep_ = 0; rep_ < 2; ++rep_)
#endif
            if (it < NCH) {
#pragma unroll
                for (int i = 0; i < 5; ++i) {
                    const int p = tid + 384 * i; const int tl = p / 60, pc = p - tl * 60;
                    LAS unsigned char* dst;
                    if (pc < 24) dst = lds + PK_RAW + (tl * 24 + pc) * 16;
                    else if (pc < 32) dst = lds + PK_AW + tl * 144 + (pc - 24) * 16;
                    else if (pc < 40) dst = lds + PK_AZ + tl * 144 + (pc - 32) * 16;
                    else dst = lds + PK_AG + tl * 336 + (pc - 40) * 16;
                    *(LAS u32x4*)dst = pre[i];
                }
                if (it + 1 < NCH) {
#pragma unroll
                    for (int i = 0; i < 5; ++i) pre[i] = __builtin_nontemporal_load((const u32x4*)(psrc[i] + (size_t)((it + 1) * TC) * pstride[i]));
                }
            }
            __syncthreads();
#ifdef X_DUPJ2
            for (int rep_ = 0; rep_ < 2; ++rep_)
#endif
            if (it < NCH) {
                LAS unsigned char* hb = lds + (it & 1) * PK_HB;
                f32x16 acc;
                if (wid < 4) acc = lora_mma<4>(lds + (wid < 2 ? PK_AW : PK_AZ), 144, bfr, r32, hi);
                else acc = lora_mma<10>(lds + PK_AG, 336, bfr, r32, hi);
                if (wid < 2) {
                    float ew[16];
#pragma unroll
                    for (int r = 0; r < 16; ++r) ew[r] = (-0.6065306597126334f * LOG2E) * sigmoidf_(lbase + acc[r]);
                    float pf[16], tot[4], oth[4];
#pragma unroll
                    for (int m = 0; m < 4; ++m) { pf[4 * m] = ew[4 * m]; pf[4 * m + 1] = pf[4 * m] + ew[4 * m + 1]; pf[4 * m + 2] = pf[4 * m + 1] + ew[4 * m + 2]; pf[4 * m + 3] = pf[4 * m + 2] + ew[4 * m + 3]; tot[m] = pf[4 * m + 3]; }
#pragma unroll
                    for (int m = 0; m < 4; ++m) oth[m] = __shfl_xor(tot[m], 32);
                    float off = 0.f;
#pragma unroll
                    for (int m = 0; m < 4; ++m) { const float o_m = off + (hi ? oth[m] : 0.f);
#pragma unroll
                        for (int q = 0; q < 4; ++q) { const int r = 4 * m + q; CL[crow(r, hi) * 64 + 32 * lnb + r32] = o_m + pf[r]; }
                        off += tot[m] + oth[m]; }
                } else if (wid < 4) {
#pragma unroll
                    for (int r = 0; r < 16; ++r) AA[crow(r, hi) * 64 + 32 * lnb + r32] = sigmoidf_(lbase + acc[r]);
                } else {
#pragma unroll
                    for (int r = 0; r < 16; ++r) *(LAS unsigned short*)(hb + HB_GG + crow(r, hi) * 128 + (32 * lnb + r32) * 2) = (unsigned short)f2bf(acc[r]);
                }
            }
            __syncthreads();
            if (it < NCH && wid < 4) {
                LAS unsigned char* hb = lds + (it & 1) * PK_HB;
                const LAS unsigned char* rc = lds + PK_RAW + (tk * 24 + oc) * 16;
                const u32x4 cr = *(const LAS u32x4*)rc, ck = *(const LAS u32x4*)(rc + 128), cv = *(const LAS u32x4*)(rc + 256);
                u32x4 pr, pk, pv;
                if (tk > 0) { pr = *(const LAS u32x4*)(rc - 384); pk = *(const LAS u32x4*)(rc - 256); pv = *(const LAS u32x4*)(rc - 128); }
                else if (it > 0) { const LAS unsigned char* cc = lds + PK_CARRY + ((it - 1) & 1) * 384 + oc * 16; pr = *(const LAS u32x4*)cc; pk = *(const LAS u32x4*)(cc + 128); pv = *(const LAS u32x4*)(cc + 256); }
                else { pr = (u32x4){0u, 0u, 0u, 0u}; pk = pr; pv = pr; }
                if (tk == TC - 1) { LAS unsigned char* cc = lds + PK_CARRY + (it & 1) * 384 + oc * 16; *(LAS u32x4*)cc = cr; *(LAS u32x4*)(cc + 128) = ck; *(LAS u32x4*)(cc + 256) = cv; }
                f32x4 rv[2], zk[2], vv[2];
#define LERP8(dst, c, p, mx) do { const f32x4 c0_ = (f32x4){bflo(c.x), bfhi(c.x), bflo(c.y), bfhi(c.y)}, c1_ = (f32x4){bflo(c.z), bfhi(c.z), bflo(c.w), bfhi(c.w)}; \
                    const f32x4 p0_ = (f32x4){bflo(p.x), bfhi(p.x), bflo(p.y), bfhi(p.y)}, p1_ = (f32x4){bflo(p.z), bfhi(p.z), bflo(p.w), bfhi(p.w)}; \
                    dst[0] = c0_ + (p0_ - c0_) * mx[0]; dst[1] = c1_ + (p1_ - c1_) * mx[1]; } while (0)
                { const f32x4 mr_[2] = {CV(5, 0), CV(5, 1)}, mk_[2] = {CV(6, 0), CV(6, 1)}, mv_[2] = {CV(7, 0), CV(7, 1)}; LERP8(rv, cr, pr, mr_); LERP8(zk, ck, pk, mk_); LERP8(vv, cv, pv, mv_); }
#undef LERP8
                f32x4 kkv[2], kp[2], bb[2]; float ss = 0.f, bd = 0.f;
                f32x4 e1[2], e0[2], em[2], ec[2];
#pragma unroll
                for (int q = 0; q < 2; ++q) {
                    const f32x4 av = *(LAS f32x4*)(AA + tk * 64 + 8 * oc + 4 * q);
                    const f32x4 cl = *(LAS f32x4*)(CL + tk * 64 + 8 * oc + 4 * q), clc = *(LAS f32x4*)(CL + 31 * 64 + 8 * oc + 4 * q);
                    f32x4 clp = (f32x4){0.f, 0.f, 0.f, 0.f}; if (tk > 0) clp = *(LAS f32x4*)(CL + (tk - 1) * 64 + 8 * oc + 4 * q);
                    kkv[q] = zk[q] * CV(0, q);
                    ss += (kkv[q].x * kkv[q].x + kkv[q].y * kkv[q].y) + (kkv[q].z * kkv[q].z + kkv[q].w * kkv[q].w);
                    kp[q] = zk[q] * (1.0f + (av - 1.0f) * CV(1, q));
                    bb[q] = av;
                    const f32x4 t3 = rv[q] * kp[q] * CV(2, q); bd += (t3.x + t3.y) + (t3.z + t3.w);
#pragma unroll
                    for (int e = 0; e < 4; ++e) { e1[q][e] = fast_exp2(cl[e]); e0[q][e] = fast_exp2(clp[e]); em[q][e] = fast_exp2(-cl[e]); ec[q][e] = fast_exp2(clc[e] - cl[e]); }
                }
                ss = red8(ss); bd = red8(bd);
                const float inv = __builtin_amdgcn_rsqf(fmaxf(ss, 1e-24f));
                if (oc == 0) *(LAS float*)(hb + HB_BD + tk * 4) = bd;
                if (tk == 31) { *(LAS f32x4*)(hb + HB_GC + 32 * oc) = e1[0]; *(LAS f32x4*)(hb + HB_GC + 32 * oc + 16) = e1[1]; }
                u32x4 wkk, wbh, wkh, wrh, wbt, wkt, wvv;
                {
                    const f32x4 k0 = kkv[0] * inv, k1 = kkv[1] * inv, b0 = k0 * bb[0], b1 = k1 * bb[1];
                    const f32x4 kkh0 = k0 * e0[0], kkh1 = k1 * e0[1], bh0 = b0 * em[0], bh1 = b1 * em[1], kh0 = kp[0] * em[0], kh1 = kp[1] * em[1];
                    const f32x4 rh0 = rv[0] * e1[0], rh1 = rv[1] * e1[1], bt0 = b0 * ec[0], bt1 = b1 * ec[1], kt0 = kp[0] * ec[0], kt1 = kp[1] * ec[1];
                    wkk = (u32x4){cvtpk(kkh0.x, kkh0.y), cvtpk(kkh0.z, kkh0.w), cvtpk(kkh1.x, kkh1.y), cvtpk(kkh1.z, kkh1.w)};
                    wbh = (u32x4){cvtpk(bh0.x, bh0.y), cvtpk(bh0.z, bh0.w), cvtpk(bh1.x, bh1.y), cvtpk(bh1.z, bh1.w)};
                    wkh = (u32x4){cvtpk(kh0.x, kh0.y), cvtpk(kh0.z, kh0.w), cvtpk(kh1.x, kh1.y), cvtpk(kh1.z, kh1.w)};
                    wrh = (u32x4){cvtpk(rh0.x, rh0.y), cvtpk(rh0.z, rh0.w), cvtpk(rh1.x, rh1.y), cvtpk(rh1.z, rh1.w)};
                    wbt = (u32x4){cvtpk(-bt0.x, -bt0.y), cvtpk(-bt0.z, -bt0.w), cvtpk(-bt1.x, -bt1.y), cvtpk(-bt1.z, -bt1.w)};
                    wkt = (u32x4){cvtpk(kt0.x, kt0.y), cvtpk(kt0.z, kt0.w), cvtpk(kt1.x, kt1.y), cvtpk(kt1.z, kt1.w)};
                    wvv = (u32x4){cvtpk(vv[0].x, vv[0].y), cvtpk(vv[0].z, vv[0].w), cvtpk(vv[1].x, vv[1].y), cvtpk(vv[1].z, vv[1].w)};
                }
                const int ro = tk * 144 + 16 * oc, vo = (oc >> 2) * 2048 + tk * 64 + (oc & 3) * 16;
                *(LAS u32x4*)(hb + HB_RKK + ro) = wkk; *(LAS u32x4*)(hb + HB_RBH + ro) = wbh; *(LAS u32x4*)(hb + HB_RKH + ro) = wkh; *(LAS u32x4*)(hb + HB_RRH + ro) = wrh;
                *(LAS u32x4*)(hb + HB_VKK + vo) = wkk; *(LAS u32x4*)(hb + HB_VVM + vo) = wvv; *(LAS u32x4*)(hb + HB_VBT + vo) = wbt; *(LAS u32x4*)(hb + HB_VKT + vo) = wkt;
            }
            if (it >= 2 && wid >= 4) {
                const LAS float* YY = (const LAS float*)(lds + PK_YY + (it & 1) * 8192); const int t0p = (it - 2) * TC;
#pragma unroll
                for (int i2 = 0; i2 < 2; ++i2) { const int tk2 = ((tid - 256) >> 3) + 16 * i2;
                    const f32x4 y0 = *(const LAS f32x4*)(YY + tk2 * 64 + 8 * oc), y1 = *(const LAS f32x4*)(YY + tk2 * 64 + 8 * oc + 4);
                    const u32x4 gw = po_g[i2], vw = po_v[i2];
                    const f32x4 g0 = (f32x4){bflo(gw.x), bfhi(gw.x), bflo(gw.y), bfhi(gw.y)}, g1 = (f32x4){bflo(gw.z), bfhi(gw.z), bflo(gw.w), bfhi(gw.w)};
                    const f32x4 v0 = (f32x4){bflo(vw.x), bfhi(vw.x), bflo(vw.y), bfhi(vw.y)}, v1 = (f32x4){bflo(vw.z), bfhi(vw.z), bflo(vw.w), bfhi(vw.w)};
                    float s1 = ((y0.x + y0.y) + (y0.z + y0.w)) + ((y1.x + y1.y) + (y1.z + y1.w)); s1 = red8(s1);
                    const float mu = s1 * (1.f / 64.f);
                    const f32x4 d0 = y0 - mu, d1 = y1 - mu;
                    float s2 = ((d0.x * d0.x + d0.y * d0.y) + (d0.z * d0.z + d0.w * d0.w)) + ((d1.x * d1.x + d1.y * d1.y) + (d1.z * d1.z + d1.w * d1.w)); s2 = red8(s2);
                    const float rstd = __builtin_amdgcn_rsqf(s2 * (1.f / 64.f) + GN_EPS);
                    const float bd = po_bd[i2];
                    const f32x4 o0 = ((d0 * rstd) * CV(3, 0) + CV(4, 0) + v0 * bd) * g0, o1 = ((d1 * rstd) * CV(3, 1) + CV(4, 1) + v1 * bd) * g1;
                    *(u32x4*)(Yout + (rowbase + t0p + tk2) * ypitch + h * 64 + 8 * oc) = (u32x4){cvtpk(o0.x, o0.y), cvtpk(o0.z, o0.w), cvtpk(o1.x, o1.y), cvtpk(o1.z, o1.w)}; }
            }
            __syncthreads();
        }
    } else {
        const int vb = wid - 6;
        __builtin_amdgcn_s_setprio(2);
        f32x16 St0, St1;
#pragma unroll
        for (int r = 0; r < 16; ++r) { St0[r] = 0.f; St1[r] = 0.f; }
#pragma unroll 1
        for (int it = 0; it < NCH + 2; ++it) {
            const bool act = (it >= 1) && (it <= NCH);
            const LAS unsigned char* hb = lds + ((it - 1) & 1) * PK_HB;
            f32x16 Pw, Qw, R, Rt, LkT, MbT, MkT;
#ifdef X_DUPGRAM
            for (int rep_ = 0; rep_ < 2; ++rep_)
#endif
            if (act) {
                bf16x8 fkk[4], fbh[4], fkh[4], frh[4];
#pragma unroll
                for (int s = 0; s < 4; ++s) { const int o = r32 * 144 + (16 * s + 8 * hi) * 2;
                    fkk[s] = *(const LAS bf16x8*)(hb + HB_RKK + o); fbh[s] = *(const LAS bf16x8*)(hb + HB_RBH + o); fkh[s] = *(const LAS bf16x8*)(hb + HB_RKH + o); frh[s] = *(const LAS bf16x8*)(hb + HB_RRH + o); }
                Pw = gram_tile(fkk, fbh);  tri_mask<0>(Pw, r32, hi, 1.f);
                Qw = gram_tile(fbh, fkk);  tri_mask<1>(Qw, r32, hi, 1.f);
                LkT = gram_tile(fkh, fkk);
                MbT = gram_tile(fbh, frh);
                MkT = gram_tile(fkh, frh);
            }
            __syncthreads();
            if (act) {
#pragma unroll
                for (int r = 0; r < 16; ++r) { const float id = (crow(r, hi) == r32) ? 1.f : 0.f; R[r] = id - Pw[r]; Rt[r] = id - Qw[r]; }
                tri_mask<1>(LkT, r32, hi, 1.f); tri_mask<2>(MbT, r32, hi, -1.f); tri_mask<2>(MkT, r32, hi, 1.f);
#pragma unroll
                for (int k = 0; k < 4; ++k) {
                    const bf16x8 p0 = acc_frag(Pw, 0), p1 = acc_frag(Pw, 1), q0 = acc_frag(Qw, 0), q1 = acc_frag(Qw, 1);
                    f32x16 Pn, Qn;
#pragma unroll
                    for (int r = 0; r < 16; ++r) { Pn[r] = 0.f; Qn[r] = 0.f; }
                    Pn = MFMA32(q0, p0, Pn); Pn = MFMA32(q1, p1, Pn);
                    Qn = MFMA32(p0, q0, Qn); Qn = MFMA32(p1, q1, Qn);
                    const bf16x8 r0 = acc_frag(R, 0), r1 = acc_frag(R, 1);
                    const bf16x8 n0 = acc_frag(Qn, 0), n1 = acc_frag(Qn, 1);
                    f32x16 Rn = R, Rtn = Rt;
                    Rn = MFMA32(n0, r0, Rn);  Rn = MFMA32(n1, r1, Rn);
                    Rtn = MFMA32(r0, n0, Rtn); Rtn = MFMA32(r1, n1, Rtn);
                    R = Rn; Rt = Rtn; Pw = Pn; Qw = Qn;
                }
            }
            __syncthreads();
            if (act) {
                const bf16x8 t0f = acc_frag(Rt, 0), t1f = acc_frag(Rt, 1);
                const bf16x8 v0f = b_tr(hb + HB_VVM + vb * 2048, 0, r32, hi), v1f = b_tr(hb + HB_VVM + vb * 2048, 1, r32, hi);
                f32x16 X;
#pragma unroll
                for (int r = 0; r < 16; ++r) X[r] = 0.f;
                X = MFMA32(acc_frag(LkT, 0), v0f, X); X = MFMA32(acc_frag(LkT, 1), v1f, X);
                f32x16 E;
#pragma unroll
                for (int r = 0; r < 16; ++r) E[r] = 0.f;
                E = MFMA32(t0f, acc_frag(X, 0), E); E = MFMA32(t1f, acc_frag(X, 1), E);
                f32x16 G0, G1;
#pragma unroll
                for (int r = 0; r < 16; ++r) { G0[r] = 0.f; G1[r] = 0.f; }
                G0 = MFMA32(b_tr(hb + HB_VKK, 0, r32, hi), t0f, G0);        G0 = MFMA32(b_tr(hb + HB_VKK, 1, r32, hi), t1f, G0);
                G1 = MFMA32(b_tr(hb + HB_VKK + 2048, 0, r32, hi), t0f, G1); G1 = MFMA32(b_tr(hb + HB_VKK + 2048, 1, r32, hi), t1f, G1);
                const bf16x8 s00 = acc_frag(St0, 0), s01 = acc_frag(St0, 1), s10 = acc_frag(St1, 0), s11 = acc_frag(St1, 1);
                E = MFMA32(acc_frag(G0, 0), s00, E); E = MFMA32(acc_frag(G0, 1), s01, E);
                E = MFMA32(acc_frag(G1, 0), s10, E); E = MFMA32(acc_frag(G1, 1), s11, E);
                const bf16x8 e0f = acc_frag(E, 0), e1f = acc_frag(E, 1);
                f32x16 Y;
#pragma unroll
                for (int r = 0; r < 16; ++r) Y[r] = 0.f;
                Y = MFMA32(a_perm(hb + HB_RRH, 144, r32, 0, hi), s00, Y);  Y = MFMA32(a_perm(hb + HB_RRH, 144, r32, 16, hi), s01, Y);
                Y = MFMA32(a_perm(hb + HB_RRH, 144, r32, 32, hi), s10, Y); Y = MFMA32(a_perm(hb + HB_RRH, 144, r32, 48, hi), s11, Y);
                Y = MFMA32(acc_frag(MbT, 0), e0f, Y); Y = MFMA32(acc_frag(MbT, 1), e1f, Y);
                Y = MFMA32(acc_frag(MkT, 0), v0f, Y); Y = MFMA32(acc_frag(MkT, 1), v1f, Y);
                LAS float* YY = (LAS float*)(lds + PK_YY + ((it - 1) & 1) * 8192);
#pragma unroll
                for (int r = 0; r < 16; ++r) YY[crow(r, hi) * 64 + 32 * vb + r32] = Y[r];
                const LAS float* GC = (const LAS float*)(hb + HB_GC);
#pragma unroll
                for (int q = 0; q < 4; ++q) { const f32x4 g0 = *(const LAS f32x4*)(GC + 8 * q + 4 * hi), g1 = *(const LAS f32x4*)(GC + 32 + 8 * q + 4 * hi);
#pragma unroll
                    for (int e = 0; e < 4; ++e) { St0[4 * q + e] *= g0[e]; St1[4 * q + e] *= g1[e]; } }
                St0 = MFMA32(b_tr(hb + HB_VBT, 0, r32, hi), e0f, St0);        St0 = MFMA32(b_tr(hb + HB_VBT, 1, r32, hi), e1f, St0);
                St0 = MFMA32(b_tr(hb + HB_VKT, 0, r32, hi), v0f, St0);        St0 = MFMA32(b_tr(hb + HB_VKT, 1, r32, hi), v1f, St0);
                St1 = MFMA32(b_tr(hb + HB_VBT + 2048, 0, r32, hi), e0f, St1); St1 = MFMA32(b_tr(hb + HB_VBT + 2048, 1, r32, hi), e1f, St1);
                St1 = MFMA32(b_tr(hb + HB_VKT + 2048, 0, r32, hi), v0f, St1); St1 = MFMA32(b_tr(hb + HB_VKT + 2048, 1, r32, hi), v1f, St1);
            }
            __syncthreads();
        }
        __builtin_amdgcn_s_setprio(0);
    }
#undef CV
    __syncthreads();
}

__global__ void __launch_bounds__(NWAVES * 64, 2) hyb_fwd(Args args) {
    extern __shared__ __attribute__((aligned(16))) unsigned char lds_raw[];
    LAS unsigned char* lds = (LAS unsigned char*)lds_raw;
    volatile LAS unsigned* MISC = (volatile LAS unsigned*)(lds + MISC_OFF);
    const int G = gridDim.x; const int bx = blockIdx.x; const int vcu = (G % 8 == 0) ? (bx % 8) * (G / 8) + bx / 8 : bx;
    unsigned char* ws = args.ws;
    for (int u = threadIdx.x; u < (LDS_BYTES - LDSCTL_OFF) / 4; u += NWAVES * 64) ((LAS unsigned*)(lds + LDSCTL_OFF))[u] = 0u;
    __syncthreads();
    XcdBarrier bar = xcd_barrier_post((unsigned*)(ws + WS_CTL) + CW_BAR, MISC + 8);
#define GRID_BAR() xcd_barrier(bar)
    bf16_t* PQ = (bf16_t*)(ws + WS_PQ); bf16_t* PR = (bf16_t*)(ws + WS_PR);
    bf16_t* XN = (bf16_t*)args.out; bf16_t* MIXED = (bf16_t*)((unsigned char*)args.out + 64 * MiB);
    bf16_t* O1 = (bf16_t*)(ws + WS_O1); bf16_t* XN2 = (bf16_t*)(ws + WS_XN2); bf16_t* Q2 = (bf16_t*)(ws + WS_Q2); bf16_t* O2 = (bf16_t*)(ws + WS_O2);
    bf16_t* ACT = (bf16_t*)(ws + WS_ACT); bf16_t* MN = (bf16_t*)(ws + WS_MN); bf16_t* KVM = (bf16_t*)(ws + WS_KVM);
    bf16_t* XB1 = (bf16_t*)(ws + WS_ACT); bf16_t* XB2 = (bf16_t*)(ws + WS_Q2);

#define FRESH_TID() int tid = threadIdx.x; asm volatile("" : "+v"(tid)); const int lane = tid & 63, wave = __builtin_amdgcn_readfirstlane(tid >> 6); (void)lane; (void)wave
#define GEMM(Aptr, Bptr, lda_, K_, Mrows, Ncols, pair_, ...) do { pg8::Gemm g{Aptr, (const bf16_t*)(Bptr), lda_, K_}; pg8::Order S; S.init(Mrows, Ncols, G, bx, pair_); \
        const pg8::Epi E{__VA_ARGS__}; pg8::gemm_phase(lds, g, S, E); } while (0)
    { FRESH_TID(); p0_prologue(args, lds, vcu, G, wave, lane); }
    GRID_BAR();
    GEMM(XN, ws + WS_W1T, DM, DM, M, NP, 0, pg8::EPI_STORE, PQ, NPQ, 0, C_Q / 256, C_Q / 256 + 4, QS_ATT, nullptr, 1, PR, NPR, NPQ / 256, 0);
    GRID_BAR();
    GEMM(MN, ws + WS_WKVT, DM, DM, MROWS, DM, 0, pg8::EPI_STORE, KVM, DM, 0, 0, 0, 1.f, nullptr, 0, nullptr, 0, 0, 0);
    if (G > 64) { if (bx >= 64) { FRESH_TID(); lora_prep(args, PR, bx - 64, G - 64, tid); } }
    else { FRESH_TID(); lora_prep(args, PR, bx, G, tid); }
    GRID_BAR();
    for (int u = vcu; u < NB * 16; u += G) { const int b = u >> 4, h = u & 15;
        { FRESH_TID(); rwkv_head_pipe(args, PQ, PR, PQ + C_R, NPQ, b, h, lds, tid); }
#if defined(ATT_2GROUP)
        { FRESH_TID(); chunk_attention_head(PQ, PR, PQ + C_Q, NPQ, args.in[I_RELB], b, h, lds, tid); }
#elif defined(ATT_8W2T)
        { FRESH_TID(); chunk_attention_head2(PQ, PR, PQ + C_Q, NPQ, args.in[I_RELB], b, h, lds, tid); }
#else
        { FRESH_TID(); chunk_attention_head3(PQ, PR, PQ + C_Q, NPQ, args.in[I_RELB], b, h, lds, tid); }
#endif
    }
    GRID_BAR();
    GEMM(XN, ws + WS_WGT, DM, DM, M, 2048, 0, pg8::EPI_SIGMOID, PR, NPR, C_GA, 0, 0, 1.f, nullptr, 0, nullptr, 0, 0, 0);
    GRID_BAR();
    GEMM(PQ, ws + WS_WABT, NPQ, DM, M, DM, 1, pg8::EPI_MIX, MIXED, DM, 0, 0, 0, 1.f, PR, 0, nullptr, 0, 0, NPR);
    GRID_BAR();
    GEMM(MIXED, ws + WS_WOUTT, DM, DM, M, DM, 0, pg8::EPI_STORE, O1, DM, 0, 0, 0, 1.f, nullptr, 0, nullptr, 0, 0, 0);
    GRID_BAR();
    { FRESH_TID(); norm_pass<false, true>(O1, args.in[I_X], XB1, args.in[I_GPOSTMIX], args.in[I_GPRECROSS], XN2, vcu, G, wave, lane); }
    GRID_BAR();
    GEMM(XN2, ws + WS_WQT, DM, DM, M, 512, 0, pg8::EPI_STORE, Q2, 512, 0, 0, 2, QS_MEM, nullptr, 0, nullptr, 0, 0, 0);
    GRID_BAR();
    { FRESH_TID(); cross_attention(Q2, KVM, O2, lds, vcu, G, tid); }
    GRID_BAR();
    GEMM(O2, ws + WS_WOT, 512, 512, M, DM, 0, pg8::EPI_STORE, O1, DM, 0, 0, 0, 1.f, nullptr, 0, nullptr, 0, 0, 0);
    GRID_BAR();
    { FRESH_TID(); norm_pass<true, true>(O1, XB1, XB2, args.in[I_GPOSTCROSS], args.in[I_GPREFFN], XN2, vcu, G, wave, lane); }
    GRID_BAR();
    GEMM(XN2, ws + WS_WF1T, DM, DM, M, 2 * FFH, 0, pg8::EPI_SWIGLU, ACT, FFH, 0, 0, 0, 1.f, nullptr, 0, nullptr, 0, 0, 0);
    GRID_BAR();
    GEMM(ACT, ws + WS_WF2T, FFH, FFH, M, DM, 0, pg8::EPI_STORE, O1, DM, 0, 0, 0, 1.f, nullptr, 0, nullptr, 0, 0, 0);
    GRID_BAR();
    { FRESH_TID(); norm_pass<true, false>(O1, XB2, args.out, args.in[I_GPOSTFFN], nullptr, nullptr, vcu, G, wave, lane); }
}

extern "C" void kernel_launch(void* const* d_in, const int* in_sizes, int n_in, void* d_out, int out_size, void* d_ws, size_t ws_size, hipStream_t stream) {
    static int grid = 0;
    if (grid == 0) {
        if (n_in != N_IN || in_sizes[0] != M * DM || out_size != M * DM || ws_size < WS_END) {
            fprintf(stderr, "kernel_launch: unexpected shapes (n_in %d, in0 %d, out %d, ws %zu); nothing launched\n", n_in, n_in > 0 ? in_sizes[0] : -1, out_size, ws_size); grid = -1; return; }
        int dev = 0, cus = 0;
        if (hipGetDevice(&dev) != hipSuccess || hipDeviceGetAttribute(&cus, hipDeviceAttributeMultiprocessorCount, dev) != hipSuccess) { grid = -1; return; }
        if (hipFuncSetAttribute((const void*)hyb_fwd, hipFuncAttributeMaxDynamicSharedMemorySize, LDS_BYTES) != hipSuccess) { fprintf(stderr, "kernel_launch: hipFuncSetAttribute failed\n"); grid = -1; return; }
        (void)hipGetLastError();
        grid = cus;
    }
    if (grid < 0) return;
    if (hipMemsetAsync((char*)d_ws + WS_CTL, 0, CTL_ZERO_BYTES, stream) != hipSuccess) return;
    Args a{};
    for (int i = 0; i < N_IN; ++i) a.in[i] = (const float*)d_in[i];
    a.out = (float*)d_out; a.ws = (unsigned char*)d_ws;
    hipLaunchKernelGGL(hyb_fwd, dim3(grid), dim3(NWAVES * 64), LDS_BYTES, stream, a);
}
```

```cpp
#include <hip/hip_runtime.h>
#include <hip/hip_bf16.h>
#include <cstdio>
#include <cstdint>

#define LAS __attribute__((address_space(3)))
#define GAS __attribute__((address_space(1)))
typedef unsigned short bf16_t;
typedef short bf16x8 __attribute__((ext_vector_type(8)));
typedef short s16x4 __attribute__((ext_vector_type(4)));
typedef float f32x4 __attribute__((ext_vector_type(4)));
typedef float f32x2 __attribute__((ext_vector_type(2)));
typedef float f32x16 __attribute__((ext_vector_type(16)));
typedef unsigned u32x4 __attribute__((ext_vector_type(4)));
typedef unsigned u32x2 __attribute__((ext_vector_type(2)));

constexpr int NB = 16, SEQ = 2048, DM = 1024, M = NB * SEQ;
constexpr int NP = 6656;
constexpr int NPQ = 2048, C_R = 0, C_Q = 1024;
constexpr int NPR = 4608, C_K = 0, C_V = 1024, C_L = 2048, C_KA = 2560, C_VA = 3584;
constexpr int C_GA = 0, C_GB = 1024;
constexpr int FFH = 2816, MEMT = 256, MROWS = NB * MEMT;
constexpr float NORM_EPS = 1e-6f, GN_EPS = 64e-5f;
constexpr float LOG2E = 1.4426950408889634f;
constexpr float QS_ATT = 0.125f * LOG2E;
constexpr float QS_MEM = 0.08838834764831845f * LOG2E;

constexpr size_t MiB = 1u << 20;
constexpr size_t WS_CTL = 0, CTL_ZERO_BYTES = 32 * 1024;
constexpr size_t WS_W1T = 1 * MiB;
constexpr size_t WS_WGT = 14 * MiB;
constexpr size_t WS_WABT = 18 * MiB;
constexpr size_t WS_WOUTT = 22 * MiB;
constexpr size_t WS_WQT = 24 * MiB;
constexpr size_t WS_WKVT = 25 * MiB;
constexpr size_t WS_WOT = 27 * MiB;
constexpr size_t WS_WF1T = 28 * MiB;
constexpr size_t WS_WF2T = 39 * MiB;
constexpr size_t WS_DUPT = 45 * MiB;
constexpr size_t WS_IUPT = WS_DUPT + 128 * 1024;
constexpr size_t WS_GUPT = WS_IUPT + 128 * 1024;
constexpr size_t WS_PQ = 48 * MiB;
constexpr size_t WS_PR = 176 * MiB;
constexpr size_t WS_MN = 464 * MiB;
constexpr size_t WS_KVM = 472 * MiB;
constexpr size_t WS_LORA = 480 * MiB;
constexpr size_t WS_O1 = 48 * MiB;
constexpr size_t WS_XN2 = 112 * MiB;
constexpr size_t WS_Q2 = 176 * MiB;
constexpr size_t WS_O2 = 208 * MiB;
constexpr size_t WS_ACT = 240 * MiB;
constexpr size_t WS_END = 512 * MiB;
constexpr int CW_BAR = 4096;

constexpr int RING_BYTES = 131072;
constexpr int LDSCTL_OFF = RING_BYTES, MISC_OFF = LDSCTL_OFF + 320;
constexpr int LDS_BYTES = 151552;
constexpr int NWAVES = 8;

#define RLX_AGENT __ATOMIC_RELAXED, __HIP_MEMORY_SCOPE_AGENT
#define LDS_WAIT() asm volatile("s_waitcnt lgkmcnt(0)" ::: "memory")
#define VM_WAIT() asm volatile("s_waitcnt vmcnt(0)" ::: "memory")

__device__ __forceinline__ unsigned f2bf(float f) { unsigned u = __builtin_bit_cast(unsigned, f); return (u + 0x7fffu + ((u >> 16) & 1u)) >> 16; }
__device__ __forceinline__ unsigned pk2(float lo, float hi) { return f2bf(lo) | (f2bf(hi) << 16); }
__device__ __forceinline__ float bf2f(unsigned short b) { return __builtin_bit_cast(float, (unsigned)b << 16); }
__device__ __forceinline__ float bflo(unsigned w) { return __builtin_bit_cast(float, w << 16); }
__device__ __forceinline__ float bfhi(unsigned w) { return __builtin_bit_cast(float, w & 0xffff0000u); }
typedef __bf16 bf16x2_t __attribute__((ext_vector_type(2)));
__device__ __forceinline__ unsigned cvtpk(float lo, float hi) { f32x2 v = {lo, hi}; bf16x2_t b = __builtin_convertvector(v, bf16x2_t); return __builtin_bit_cast(unsigned, b); }
__device__ __forceinline__ float wave_sum(float v) {
#pragma unroll
    for (int o = 1; o < 64; o <<= 1) v += __shfl_xor(v, o);
    return v;
}
__device__ __forceinline__ float fast_exp2(float x) { return __builtin_amdgcn_exp2f(x); }
__device__ __forceinline__ float sigmoidf_(float x) { return __builtin_amdgcn_rcpf(1.0f + __builtin_amdgcn_exp2f(-x * LOG2E)); }

#define XB_TMO      128
#define XB_XCNT(j)  (256  + 64 * (j))
#define XB_XSUB(j)  (1280 + 64 * (j))
#define XB_XGEN(j)  (2304 + 64 * (j))
#define XB_TOP      3328
#define XB_TOPGEN   3392
#define XCD_BAR_WORDS 3456
#define XB_SPIN_CAP (1u << 18)
__device__ __forceinline__ unsigned xb_ld(unsigned* p)              { return __hip_atomic_load(p, __ATOMIC_RELAXED, __HIP_MEMORY_SCOPE_AGENT); }
__device__ __forceinline__ unsigned xb_add(unsigned* p, unsigned v) { return __hip_atomic_fetch_add(p, v, __ATOMIC_RELAXED, __HIP_MEMORY_SCOPE_AGENT); }
__device__ __forceinline__ unsigned xb_xcc_id() { return (unsigned)__builtin_amdgcn_s_getreg((3 << 11) | 20) & 0xFu; }
#define XB_SPIN(cond, bar) do { unsigned _sp = 0; while (cond) { __builtin_amdgcn_s_sleep(1); \
    if ((++_sp & 255u) == 0u) { if (xb_ld(&(bar)[XB_TMO])) break; if (_sp > XB_SPIN_CAP) { atomicAdd(&(bar)[XB_TMO], 1u); break; } } } } while (0)
struct XcdBarrier { unsigned* bar; unsigned x; volatile LAS unsigned* st; };
__device__ __forceinline__ XcdBarrier xcd_barrier_post(unsigned* bar, volatile LAS unsigned* st) {
    XcdBarrier b; b.bar = bar; b.x = xb_xcc_id(); b.st = st;
    if (threadIdx.x == 0) (void)xb_add(&bar[XB_XCNT(b.x)], 1u);
    return b;
}
__device__ __forceinline__ void xcd_barrier_complete(unsigned* bar, unsigned x, unsigned& nloc, unsigned& nx) {
    const unsigned G = gridDim.x * gridDim.y * gridDim.z;
    unsigned sum, cnt, mine, sp = 0u;
    for (;;) {
        sum = 0u; cnt = 0u; mine = 0u;
#pragma unroll
        for (unsigned j = 0; j < 16; ++j) { const unsigned c = xb_ld(&bar[XB_XCNT(j)]); sum += c; cnt += (c > 0u) ? 1u : 0u; mine = (j == x) ? c : mine; }
        if (sum == G) break;
        __builtin_amdgcn_s_sleep(1);
        if ((++sp & 255u) == 0u) { if (xb_ld(&bar[XB_TMO])) break; if (sp > XB_SPIN_CAP) { atomicAdd(&bar[XB_TMO], 1u); break; } }
    }
    nloc = mine > 0u ? mine : 1u; nx = cnt > 0u ? cnt : 1u;
}
__device__ __forceinline__ void xcd_barrier(const XcdBarrier& b) {
    asm volatile("s_waitcnt vmcnt(0)" ::: "memory");
    __syncthreads();
    if (threadIdx.x == 0) {
        unsigned* bar = b.bar;
        __builtin_amdgcn_s_waitcnt(0);
        unsigned nloc = b.st[0], nx = b.st[1];
        if (nloc == 0u) { xcd_barrier_complete(bar, b.x, nloc, nx); b.st[0] = nloc; b.st[1] = nx; }
        const unsigned old = xb_add(&bar[XB_XSUB(b.x)], 1u);
        const unsigned gen = old / nloc;
        if (old + 1u == (gen + 1u) * nloc) {
            __builtin_amdgcn_fence(__ATOMIC_RELEASE, "agent");
            asm volatile("s_waitcnt vmcnt(0)" ::: "memory");
            const unsigned og = xb_add(&bar[XB_TOP], 1u);
            const unsigned tg = og / nx;
            if (og + 1u == (tg + 1u) * nx) xb_add(&bar[XB_TOPGEN], 1u);
            else XB_SPIN(xb_ld(&bar[XB_TOPGEN]) == tg, bar);
            __builtin_amdgcn_fence(__ATOMIC_ACQUIRE, "agent");
            xb_add(&bar[XB_XGEN(b.x)], 1u);
            asm volatile("s_waitcnt vmcnt(0)" ::: "memory");
        } else {
            XB_SPIN(xb_ld(&bar[XB_XGEN(b.x)]) == gen, bar);
            __builtin_amdgcn_fence(__ATOMIC_ACQUIRE, "agent");
            asm volatile("s_waitcnt vmcnt(0)" ::: "memory");
        }
    }
    __syncthreads();
}

namespace pg8 {
constexpr int BM = 256, BK = 64, HALF = 128, HTB = HALF * BK * 2, STAGE_BYTES = 8 * HTB, NXCD = 8, WGM = 4;
__host__ __device__ __forceinline__ int lds_byte(int r, int c) { const int st = (r >> 4) * 2 + (c >> 5), rr = r & 15, cc = c & 31, ob = rr * 64 + cc * 2; return st * 1024 + (ob ^ (((ob >> 9) & 1) << 5)); }
__host__ __device__ __forceinline__ void stage_rc(int b, int& R, int& C) { const int st = b / 1024, sb = b % 1024, swz = sb ^ (((sb >> 9) & 1) << 5); R = (st >> 1) * 16 + swz / 64; C = (st & 1) * 32 + (swz % 64) / 2; }
__host__ __device__ __forceinline__ int perm32(int rho) { const int n = rho >> 4, i = rho & 15; return 8 * (i >> 2) + 4 * n + (i & 3); }

struct Unit { int pm, pn, ac; };
struct Gemm { const bf16_t* A; const bf16_t* Bt; int lda, K; };

__device__ __forceinline__ void tile_of(int wgid0, int nM, int nN, int& pm, int& pn) {
    const int nwg = nM * nN; int wgid = wgid0;
    { const int q = nwg / NXCD, r = nwg % NXCD, xcd = wgid % NXCD, off = wgid / NXCD; wgid = (xcd < r ? xcd * (q + 1) : r * (q + 1) + (xcd - r) * q) + off; }
    const int nig = WGM * nN, gid = wgid / nig, fm = gid * WGM, gsz = (nM - fm) < WGM ? (nM - fm) : WGM;
    pm = fm + ((wgid % nig) % gsz); pn = (wgid % nig) / gsz;
}
#define EPI_FOR_ROWS for (int ai = 0; ai < 2; ++ai) _Pragma("unroll") for (int m = 0; m < 4; ++m)
enum { EPI_STORE = 0, EPI_SIGMOID = 1, EPI_MIX = 2, EPI_SWIGLU = 3 };
struct Epi {
    int type; bf16_t* O; int ldc; int coff; int s_lo, s_hi; float scale; const bf16_t* P; int nt; bf16_t* O2; int ldc2; int split; int pld;
    __device__ __forceinline__ void operator()(const f32x4 (&acc)[2][2][4][2], const Unit& u, int wr, int wc, int fr, int fq) const {
        const int row0 = u.pm * BM + wr * 64 + fr;
        if (type == EPI_STORE || type == EPI_SIGMOID) {
            const float sc = (u.pn >= s_lo && u.pn < s_hi) ? scale : 1.f;
            const bool hi2 = (split > 0) && (u.pn >= split); bf16_t* const Ob = hi2 ? O2 : O; const int ldo = hi2 ? ldc2 : ldc;
            const int col0 = coff + (hi2 ? u.pn - split : u.pn) * BM + wc * 32 + 8 * fq; const bool sg = (type == EPI_SIGMOID);
#pragma unroll
            EPI_FOR_ROWS { bf16_t* rowp = Ob + (size_t)(row0 + ai * HALF + m * 16) * ldo + col0;
#pragma unroll
                for (int bj = 0; bj < 2; ++bj) { f32x4 v0 = acc[ai][bj][m][0] * sc, v1 = acc[ai][bj][m][1] * sc;
                    if (sg) {
#pragma unroll
                        for (int e = 0; e < 4; ++e) { v0[e] = sigmoidf_(v0[e]); v1[e] = sigmoidf_(v1[e]); } }
                    u32x4 w; w.x = cvtpk(v0[0], v0[1]); w.y = cvtpk(v0[2], v0[3]); w.z = cvtpk(v1[0], v1[1]); w.w = cvtpk(v1[2], v1[3]);
                    if (nt) __builtin_nontemporal_store(w, (u32x4*)(rowp + bj * HALF)); else *(u32x4*)(rowp + bj * HALF) = w; } }
        } else if (type == EPI_MIX) {
            const int pn = u.pn & 3;
            const int col0 = pn * BM + wc * 32 + 8 * fq;
            const int gcol = C_GB + col0;
#pragma unroll
            for (int ai = 0; ai < 2; ++ai) {
                u32x4 gv[4][2];
#pragma unroll
                for (int m = 0; m < 4; ++m)
#pragma unroll
                    for (int bj = 0; bj < 2; ++bj) gv[m][bj] = *(const u32x4*)(P + (size_t)(row0 + ai * HALF + m * 16) * pld + gcol + bj * HALF);
#pragma unroll
                for (int m = 0; m < 4; ++m)
#pragma unroll
                    for (int bj = 0; bj < 2; ++bj) { const size_t row = (size_t)(row0 + ai * HALF + m * 16);
                        const u32x4 g = gv[m][bj];
                        f32x4 v0 = acc[ai][bj][m][0], v1 = acc[ai][bj][m][1];
                        v0[0] *= bflo(g.x); v0[1] *= bfhi(g.x); v0[2] *= bflo(g.y); v0[3] *= bfhi(g.y);
                        v1[0] *= bflo(g.z); v1[1] *= bfhi(g.z); v1[2] *= bflo(g.w); v1[3] *= bfhi(g.w);
                        u32x4 w; w.x = cvtpk(v0[0], v0[1]); w.y = cvtpk(v0[2], v0[3]); w.z = cvtpk(v1[0], v1[1]); w.w = cvtpk(v1[2], v1[3]);
                        *(u32x4*)(O + row * ldc + col0 + bj * HALF) = w; }
            }
        } else {
            const int col0 = u.pn * HALF + wc * 32 + 8 * fq;
#pragma unroll
            EPI_FOR_ROWS { bf16_t* rowp = O + (size_t)(row0 + ai * HALF + m * 16) * ldc + col0;
                f32x4 v0 = acc[ai][0][m][0], v1 = acc[ai][0][m][1]; const f32x4 u0 = acc[ai][1][m][0], u1 = acc[ai][1][m][1];
#pragma unroll
                for (int e = 0; e < 4; ++e) { v0[e] = v0[e] * sigmoidf_(v0[e]) * u0[e]; v1[e] = v1[e] * sigmoidf_(v1[e]) * u1[e]; }
                u32x4 w; w.x = cvtpk(v0[0], v0[1]); w.y = cvtpk(v0[2], v0[3]); w.z = cvtpk(v1[0], v1[1]); w.w = cvtpk(v1[2], v1[3]);
                *(u32x4*)rowp = w; }
        }
    }
    __device__ __forceinline__ bool keep(const Unit& u) const { return type == EPI_MIX && (u.pn >> 2) == 0; }
    __device__ __forceinline__ void scale_keep(f32x4 (&acc)[2][2][4][2], const Unit& u, int wr, int wc, int fr, int fq) const {
        const int row0 = u.pm * BM + wr * 64 + fr, col0 = (u.pn & 3) * BM + wc * 32 + 8 * fq;
#pragma unroll
        for (int ai = 0; ai < 2; ++ai) {
            u32x4 ga[4][2], gb[4][2];
#pragma unroll
            for (int m = 0; m < 4; ++m)
#pragma unroll
                for (int bj = 0; bj < 2; ++bj) { const bf16_t* gp = P + (size_t)(row0 + ai * HALF + m * 16) * pld + col0 + bj * HALF; ga[m][bj] = *(const u32x4*)(gp + C_GA); gb[m][bj] = *(const u32x4*)(gp + C_GB); }
#pragma unroll
            for (int m = 0; m < 4; ++m)
#pragma unroll
                for (int bj = 0; bj < 2; ++bj) { const u32x4 a = ga[m][bj], b = gb[m][bj];
                    f32x4& v0 = acc[ai][bj][m][0]; f32x4& v1 = acc[ai][bj][m][1];
                    v0[0] *= bflo(a.x) * __builtin_amdgcn_rcpf(bflo(b.x)); v0[1] *= bfhi(a.x) * __builtin_amdgcn_rcpf(bfhi(b.x)); v0[2] *= bflo(a.y) * __builtin_amdgcn_rcpf(bflo(b.y)); v0[3] *= bfhi(a.y) * __builtin_amdgcn_rcpf(bfhi(b.y));
                    v1[0] *= bflo(a.z) * __builtin_amdgcn_rcpf(bflo(b.z)); v1[1] *= bfhi(a.z) * __builtin_amdgcn_rcpf(bfhi(b.z)); v1[2] *= bflo(a.w) * __builtin_amdgcn_rcpf(bflo(b.w)); v1[3] *= bfhi(a.w) * __builtin_amdgcn_rcpf(bfhi(b.w)); }
        }
    }
};
struct Order {
    int nM, nN, nwg, G, c, pair;
    __device__ __forceinline__ void init(int M_, int N_, int G_, int c_, int pair_) { nM = M_ / BM; nN = N_ / BM; nwg = nM * nN; G = G_; c = c_; pair = pair_; }
    __device__ __forceinline__ bool next(int i, Unit& u) const {
        const int ii = pair ? (i >> 1) : i;
        const long L = (long)ii * G + c; if (L >= nwg) return false;
        int pn; tile_of((int)L, nM, nN, u.pm, pn);
        const int half = pair ? (i & 1) : 0; u.pn = half * nN + pn; u.ac = half * 1024; return true;
    }
};

__device__ __forceinline__ void gemm_phase(LAS unsigned char* lds, const Gemm& g, const Order& S, const Epi& E) {
    int tid = threadIdx.x; asm volatile("" : "+v"(tid));
    const int wid = __builtin_amdgcn_readfirstlane(tid >> 6), lane = tid & 63, wr = wid >> 2, wc = wid & 3, fr = lane & 15, fq = lane >> 4;
    const int K = g.K, lda = g.lda, nt = K / BK;
    unsigned voffA[2], voffB[2];
#pragma unroll
    for (int i = 0; i < 2; ++i) { int R, C; stage_rc(tid * 16 + i * 8192, R, C); const int Rb = (R & ~31) + perm32(R & 31);
        voffA[i] = (unsigned)(R * lda + C) * 2u; voffB[i] = (unsigned)(Rb * K + C) * 2u; }
    const size_t kstep = (size_t)(BK * 2);
    const size_t hstepA = (size_t)HALF * lda * 2, hstepB = (size_t)HALF * K * 2;
    const size_t tstepA = 2 * hstepA, tstepB = 2 * hstepB;
    const unsigned ldsw = (unsigned)wid * 1024u;
    const int aoff = lds_byte(wr * 64 + fr, fq * 8), boff = lds_byte(wc * 32 + fr, fq * 8);
#define PG8_SA(b, h) (((b) * 2 + (h)) * HTB)
#define PG8_SB(b, h) ((4 + (b) * 2 + (h)) * HTB)
#define PG8_STAGE(bufoff, gbase, voff) do { _Pragma("unroll") for (int _i = 0; _i < 2; ++_i) \
        __builtin_amdgcn_global_load_lds((const unsigned*)((const char*)(gbase) + (voff)[_i]), (LAS unsigned*)(lds + (bufoff) + ldsw + _i * 8192), 16, 0, 0); } while (0)
#define PG8_LDA(dst, b, h) do { _Pragma("unroll") for (int m = 0; m < 4; ++m) _Pragma("unroll") for (int k = 0; k < 2; ++k) dst[m][k] = *(const LAS bf16x8*)(lds + PG8_SA(b, h) + aoff + m * 2048 + k * 1024); } while (0)
#define PG8_LDB(dst, b, h) do { _Pragma("unroll") for (int n = 0; n < 2; ++n) _Pragma("unroll") for (int k = 0; k < 2; ++k) dst[n][k] = *(const LAS bf16x8*)(lds + PG8_SB(b, h) + boff + n * 2048 + k * 1024); } while (0)
#define PG8_MMA(ai, bj, At, Bt) do { __builtin_amdgcn_s_setprio(1); _Pragma("unroll") for (int m = 0; m < 4; ++m) _Pragma("unroll") for (int n = 0; n < 2; ++n) _Pragma("unroll") for (int k = 0; k < 2; ++k) \
        acc[ai][bj][m][n] = __builtin_amdgcn_mfma_f32_16x16x32_bf16(Bt[n][k], At[m][k], acc[ai][bj][m][n], 0, 0, 0); __builtin_amdgcn_s_setprio(0); } while (0)
#define PG8_WAIT_V(n) asm volatile("s_waitcnt vmcnt(" #n ")" ::: "memory")
#define PG8_WAIT_L(n) asm volatile("s_waitcnt lgkmcnt(" #n ")" ::: "memory")
#define PG8_BAR __builtin_amdgcn_s_barrier()
#define PG8_SCHED __builtin_amdgcn_sched_barrier(0)
    Unit cur, nxt; int ui = 0;
    if (!S.next(0, cur)) return;
    f32x4 acc[2][2][4][2];
#pragma unroll
    for (int a = 0; a < 2; ++a)
#pragma unroll
        for (int b = 0; b < 2; ++b)
#pragma unroll
            for (int m = 0; m < 4; ++m)
#pragma unroll
                for (int n = 0; n < 2; ++n) acc[a][b][m][n] = (f32x4){0.f, 0.f, 0.f, 0.f};
    bf16x8 At[4][2], B0[2][2], B1[2][2];
    const char* cA = (const char*)g.A + (size_t)cur.pm * tstepA + (size_t)cur.ac * 2; const char* cB = (const char*)g.Bt + (size_t)cur.pn * tstepB;
    PG8_STAGE(PG8_SB(0, 0), cB, voffB); PG8_STAGE(PG8_SB(0, 1), cB + hstepB, voffB); PG8_STAGE(PG8_SA(0, 0), cA, voffA); PG8_STAGE(PG8_SA(0, 1), cA + hstepA, voffA);
    if (wr == 1) PG8_BAR;
    PG8_WAIT_V(2); PG8_BAR;
    PG8_STAGE(PG8_SB(1, 0), cB + kstep, voffB); PG8_STAGE(PG8_SA(1, 0), cA + kstep, voffA); PG8_STAGE(PG8_SB(1, 1), cB + hstepB + kstep, voffB);
    PG8_WAIT_V(6); PG8_BAR;
    for (;;) {
        const bool has_next = S.next(ui + 1, nxt);
        const char* nA = has_next ? (const char*)g.A + (size_t)nxt.pm * tstepA + (size_t)nxt.ac * 2 : cA; const char* nB = has_next ? (const char*)g.Bt + (size_t)nxt.pn * tstepB : cB;
        for (int t = 0; t < nt; t += 2) {
            const bool last = (t == nt - 2);
            const char* a1 = cA + (size_t)(t + 1) * kstep;
            const char* a2 = last ? nA : cA + (size_t)(t + 2) * kstep; const char* b2 = last ? nB : cB + (size_t)(t + 2) * kstep;
            const char* a3 = a2 + kstep; const char* b3 = b2 + kstep;
            PG8_LDB(B0, 0, 0); PG8_LDB(B1, 0, 1); PG8_SCHED; PG8_LDA(At, 0, 0); PG8_STAGE(PG8_SA(1, 1), a1 + hstepA, voffA);
            PG8_WAIT_V(8); PG8_WAIT_L(0); PG8_BAR; PG8_MMA(0, 0, At, B0); PG8_MMA(0, 1, At, B1); PG8_BAR; PG8_SCHED;
            PG8_LDA(At, 0, 1); PG8_STAGE(PG8_SB(0, 0), b2, voffB); PG8_STAGE(PG8_SB(0, 1), b2 + hstepB, voffB); PG8_STAGE(PG8_SA(0, 0), a2, voffA);
            PG8_WAIT_V(8); PG8_WAIT_L(0); PG8_BAR; PG8_MMA(1, 0, At, B0); PG8_MMA(1, 1, At, B1); PG8_BAR; PG8_SCHED;
            PG8_LDB(B0, 1, 0); PG8_LDB(B1, 1, 1); PG8_SCHED; PG8_LDA(At, 1, 0); PG8_STAGE(PG8_SA(0, 1), a2 + hstepA, voffA);
            PG8_WAIT_V(8); PG8_WAIT_L(0); PG8_BAR; PG8_MMA(0, 0, At, B0); PG8_MMA(0, 1, At, B1); PG8_BAR; PG8_SCHED;
            PG8_LDA(At, 1, 1); PG8_STAGE(PG8_SB(1, 0), b3, voffB); PG8_STAGE(PG8_SB(1, 1), b3 + hstepB, voffB); PG8_STAGE(PG8_SA(1, 0), a3, voffA);
            PG8_WAIT_V(8); PG8_WAIT_L(0); PG8_BAR; PG8_MMA(1, 0, At, B0); PG8_MMA(1, 1, At, B1); PG8_BAR; PG8_SCHED;
        }
        if (wr == 0) PG8_BAR;
        const bool keep_acc = E.keep(cur);
        if (keep_acc) E.scale_keep(acc, cur, wr, wc, fr, fq); else E(acc, cur, wr, wc, fr, fq);
        if (!has_next) break;
        if (!keep_acc)
#pragma unroll
        for (int a = 0; a < 2; ++a)
#pragma unroll
            for (int b = 0; b < 2; ++b)
#pragma unroll
                for (int m = 0; m < 4; ++m)
#pragma unroll
                    for (int n = 0; n < 2; ++n) acc[a][b][m][n] = (f32x4){0.f, 0.f, 0.f, 0.f};
        cur = nxt; cA = nA; cB = nB; ++ui;
        if (wr == 1) PG8_BAR;
    }
    PG8_WAIT_V(0);
    PG8_BAR;
#undef PG8_SA
#undef PG8_SB
#undef PG8_STAGE
#undef PG8_LDA
#undef PG8_LDB
#undef PG8_MMA
#undef PG8_WAIT_V
#undef PG8_WAIT_L
#undef PG8_BAR
#undef PG8_SCHED
}
}

enum { I_X = 0, I_MEM, I_GPREMIX, I_GPOSTMIX, I_WIN, I_SHIFT, I_DBASE, I_DUP, I_IBASE, I_IUP, I_GUP, I_KNS, I_KIS, I_BONUS, I_LNW, I_LNB, I_RELB,
       I_WA, I_WB, I_WOUT, I_GPRECROSS, I_GPOSTCROSS, I_GMEM, I_WQM, I_WKVM, I_WOM, I_GPREFFN, I_GPOSTFFN, I_WF1, I_WF2, N_IN };
struct Args { const float* in[N_IN]; float* out; unsigned char* ws; };

__device__ __forceinline__ void p0_transpose_item(const float* W, int ldsrc, int K, int col0, bf16_t* WT, int dld, int drow0, int k0, LAS float* scr, int lane) {
    float tv[32];
#pragma unroll
    for (int i = 0; i < 32; ++i) { const int kk = 2 * i + (lane >> 5); const int k = k0 + kk;
        tv[i] = (k < K) ? __builtin_nontemporal_load(W + (size_t)k * ldsrc + col0 + (lane & 31)) : 0.f; }
#pragma unroll
    for (int i = 0; i < 32; ++i) { const int kk = 2 * i + (lane >> 5); scr[kk * 33 + (lane & 31)] = tv[i]; }
    LDS_WAIT(); asm volatile("" ::: "memory");
    const int c = lane & 7;
    if (k0 + 8 * c < K) {
#pragma unroll
        for (int j = 0; j < 4; ++j) { const int n = (lane >> 3) + 8 * j; const LAS float* s = scr + (8 * c) * 33 + n;
            u32x4 o; o.x = pk2(s[0 * 33], s[1 * 33]); o.y = pk2(s[2 * 33], s[3 * 33]); o.z = pk2(s[4 * 33], s[5 * 33]); o.w = pk2(s[6 * 33], s[7 * 33]);
            *(u32x4*)(WT + (size_t)(drow0 + n) * dld + k0 + 8 * c) = o; }
    }
    LDS_WAIT(); asm volatile("" ::: "memory");
}
constexpr int NJOBS = 19;
__device__ __forceinline__ void job_desc(const Args& a, int j, const float*& src, int& ld, int& K, int& col0, int& ncols, size_t& dst, int& drow0, int& mode) {
    mode = 0;
    switch (j) {
    case 0:  src = a.in[I_WIN]; ld = 8480; K = 1024; col0 = 0;    ncols = 1024; dst = WS_W1T; drow0 = 0; break;
    case 1:  src = a.in[I_WIN]; ld = 8480; K = 1024; col0 = 3360; ncols = 1024; dst = WS_W1T; drow0 = 1024; break;
    case 2:  src = a.in[I_WIN]; ld = 8480; K = 1024; col0 = 1024; ncols = 1024; dst = WS_W1T; drow0 = 2048; break;
    case 3:  src = a.in[I_WIN]; ld = 8480; K = 1024; col0 = 2048; ncols = 1024; dst = WS_W1T; drow0 = 3072; break;
    case 4:  src = a.in[I_WIN]; ld = 8480; K = 1024; col0 = 3072; ncols = 288;  dst = WS_W1T; drow0 = 4096; break;
    case 5:  src = a.in[I_WIN]; ld = 8480; K = 1024; col0 = 4384; ncols = 1024; dst = WS_W1T; drow0 = 4608; break;
    case 6:  src = a.in[I_WIN]; ld = 8480; K = 1024; col0 = 5408; ncols = 1024; dst = WS_W1T; drow0 = 5632; break;
    case 7:  src = a.in[I_WIN]; ld = 8480; K = 1024; col0 = 6432; ncols = 2048; dst = WS_WGT; drow0 = 0; break;
    case 8:  src = a.in[I_WA];  ld = 1024; K = 1024; col0 = 0; ncols = 1024; dst = WS_WABT; drow0 = 0; break;
    case 9:  src = a.in[I_WB];  ld = 1024; K = 1024; col0 = 0; ncols = 1024; dst = WS_WABT; drow0 = 1024; break;
    case 10: src = a.in[I_WOUT]; ld = 1024; K = 1024; col0 = 0; ncols = 1024; dst = WS_WOUTT; drow0 = 0; break;
    case 11: src = a.in[I_WQM]; ld = 512;  K = 1024; col0 = 0; ncols = 512;  dst = WS_WQT; drow0 = 0; break;
    case 12: src = a.in[I_WKVM]; ld = 1024; K = 1024; col0 = 0; ncols = 1024; dst = WS_WKVT; drow0 = 0; break;
    case 13: src = a.in[I_WOM]; ld = 1024; K = 512;  col0 = 0; ncols = 1024; dst = WS_WOT; drow0 = 0; break;
    case 14: src = a.in[I_WF1]; ld = 5632; K = 1024; col0 = 0; ncols = 5632; dst = WS_WF1T; drow0 = 0; mode = 1; break;
    case 15: src = a.in[I_WF2]; ld = 1024; K = 2816; col0 = 0; ncols = 1024; dst = WS_WF2T; drow0 = 0; break;
    case 16: src = a.in[I_DUP]; ld = 1024; K = 64;   col0 = 0; ncols = 1024; dst = WS_DUPT; drow0 = 0; break;
    case 17: src = a.in[I_IUP]; ld = 1024; K = 64;   col0 = 0; ncols = 1024; dst = WS_IUPT; drow0 = 0; break;
    default: src = a.in[I_GUP]; ld = 1024; K = 160;  col0 = 0; ncols = 1024; dst = WS_GUPT; drow0 = 0; break;
    }
}
__device__ __forceinline__ void rms_row_to_bf16(const float* xrow, const float* gain, bf16_t* orow, int lane) {
    const f32x4* xr = (const f32x4*)xrow + lane; const f32x4* gr = (const f32x4*)gain + lane;
    f32x4 v[4]; float s = 0.f;
#pragma unroll
    for (int j = 0; j < 4; ++j) { v[j] = xr[64 * j]; s += (v[j].x * v[j].x + v[j].y * v[j].y) + (v[j].z * v[j].z + v[j].w * v[j].w); }
    const float rs = 1.0f / sqrtf(wave_sum(s) * (1.f / DM) + NORM_EPS);
    u32x2* o8 = (u32x2*)orow + lane;
#pragma unroll
    for (int j = 0; j < 4; ++j) { const f32x4 g = gr[64 * j]; u32x2 w; w.x = cvtpk(v[j].x * rs * g.x, v[j].y * rs * g.y); w.y = cvtpk(v[j].z * rs * g.z, v[j].w * rs * g.w); o8[64 * j] = w; }
}
__device__ __forceinline__ void rms_row2_to_bf16(const float* xa, const float* xb, const float* gain, bf16_t* oa, bf16_t* ob, int lane) {
    const f32x4* xr0 = (const f32x4*)xa + lane; const f32x4* xr1 = (const f32x4*)xb + lane; const f32x4* gr = (const f32x4*)gain + lane;
    f32x4 v0[4], v1[4]; float s0 = 0.f, s1 = 0.f;
#pragma unroll
    for (int j = 0; j < 4; ++j) { v0[j] = __builtin_nontemporal_load(xr0 + 64 * j); v1[j] = __builtin_nontemporal_load(xr1 + 64 * j); }
#pragma unroll
    for (int j = 0; j < 4; ++j) { s0 += (v0[j].x * v0[j].x + v0[j].y * v0[j].y) + (v0[j].z * v0[j].z + v0[j].w * v0[j].w); s1 += (v1[j].x * v1[j].x + v1[j].y * v1[j].y) + (v1[j].z * v1[j].z + v1[j].w * v1[j].w); }
    const float rs0 = __builtin_amdgcn_rsqf(wave_sum(s0) * (1.f / DM) + NORM_EPS), rs1 = __builtin_amdgcn_rsqf(wave_sum(s1) * (1.f / DM) + NORM_EPS);
    u32x2* o0 = (u32x2*)oa + lane; u32x2* o1 = (u32x2*)ob + lane;
#pragma unroll
    for (int j = 0; j < 4; ++j) { const f32x4 g = gr[64 * j]; u32x2 w;
        w.x = cvtpk(v0[j].x * rs0 * g.x, v0[j].y * rs0 * g.y); w.y = cvtpk(v0[j].z * rs0 * g.z, v0[j].w * rs0 * g.w); o0[64 * j] = w;
        w.x = cvtpk(v1[j].x * rs1 * g.x, v1[j].y * rs1 * g.y); w.y = cvtpk(v1[j].z * rs1 * g.z, v1[j].w * rs1 * g.w); o1[64 * j] = w; }
}
__device__ __forceinline__ void p0_prologue(const Args& a, LAS unsigned char* lds, int vcu, int G, int wave, int lane) {
    LAS float* scr = (LAS float*)(lds + wave * 16384);
    const int gw = vcu * NWAVES + wave, NGW = G * NWAVES;
    int total = 0;
    for (int j = 0; j < NJOBS; ++j) { int ld, K, col0, ncols, drow0, mode; size_t dst; const float* src; job_desc(a, j, src, ld, K, col0, ncols, dst, drow0, mode); total += ((K + 63) / 64) * (ncols / 32); }
    for (int it = gw; it < total; it += NGW) {
        int r = it;
        for (int j = 0; j < NJOBS; ++j) {
            int ld, K, col0, ncols, drow0, mode; size_t dst; const float* src; job_desc(a, j, src, ld, K, col0, ncols, dst, drow0, mode);
            const int nblk = ncols / 32, cnt = ((K + 63) / 64) * nblk;
            if (r < cnt) {
                const int kb = r / nblk, nb = r % nblk; int n0 = 32 * nb; int drow = drow0 + n0;
                if (mode == 1) { const int up = n0 >= FFH ? 1 : 0; const int nn = n0 - up * FFH; drow = 256 * (nn / 128) + 128 * up + (nn % 128); }
                p0_transpose_item(src, ld, K, col0 + n0, (bf16_t*)(a.ws + dst), K, drow, 64 * kb, scr, lane);
                break;
            }
            r -= cnt;
        }
    }
    { u32x4* z = (u32x4*)(a.ws + WS_W1T + (size_t)4384 * 1024 * 2); const int n16 = 224 * 1024 * 2 / 16;
      for (int i = gw * 64 + lane; i < n16; i += NGW * 64) z[i] = (u32x4){0u, 0u, 0u, 0u}; }
    bf16_t* XN = (bf16_t*)a.out; bf16_t* MN = (bf16_t*)(a.ws + WS_MN);
    for (int m = gw; m < M; m += 2 * NGW) rms_row2_to_bf16(a.in[I_X] + (size_t)m * DM, a.in[I_X] + (size_t)(m + NGW) * DM, a.in[I_GPREMIX], XN + (size_t)m * DM, XN + (size_t)(m + NGW) * DM, lane);
    for (int m = gw; m < MROWS; m += NGW) rms_row_to_bf16(a.in[I_MEM] + (size_t)m * DM, a.in[I_GMEM], MN + (size_t)m * DM, lane);
}

template <bool XIB, bool XOB>
__device__ __forceinline__ void norm_pass(const bf16_t* O, const void* xres_, void* xout_, const float* g1, const float* g2, bf16_t* hn, int vcu, int G, int wave, int lane) {
    const int gw = vcu * NWAVES + wave, NGW = G * NWAVES;
    for (int m0 = gw; m0 < M; m0 += 2 * NGW) {
        f32x4 ov[2][4], xv[2][4]; float s[2] = {0.f, 0.f};
#pragma unroll
        for (int q = 0; q < 2; ++q) { const size_t m = (size_t)m0 + (size_t)q * NGW;
            const u32x2* orow = (const u32x2*)(O + m * DM) + lane;
#pragma unroll
            for (int j = 0; j < 4; ++j) { const u32x2 w = __builtin_nontemporal_load(orow + 64 * j); ov[q][j] = (f32x4){bflo(w.x), bfhi(w.x), bflo(w.y), bfhi(w.y)};
                if (XIB) { const u32x2 xw = __builtin_nontemporal_load((const u32x2*)((const bf16_t*)xres_ + m * DM) + lane + 64 * j); xv[q][j] = (f32x4){bflo(xw.x), bfhi(xw.x), bflo(xw.y), bfhi(xw.y)}; }
                else xv[q][j] = __builtin_nontemporal_load((const f32x4*)((const float*)xres_ + m * DM) + lane + 64 * j); } }
#pragma unroll
        for (int q = 0; q < 2; ++q)
#pragma unroll
            for (int j = 0; j < 4; ++j) s[q] += (ov[q][j].x * ov[q][j].x + ov[q][j].y * ov[q][j].y) + (ov[q][j].z * ov[q][j].z + ov[q][j].w * ov[q][j].w);
        const float rs[2] = {__builtin_amdgcn_rsqf(wave_sum(s[0]) * (1.f / DM) + NORM_EPS), __builtin_amdgcn_rsqf(wave_sum(s[1]) * (1.f / DM) + NORM_EPS)};
        float s2[2] = {0.f, 0.f};
#pragma unroll
        for (int q = 0; q < 2; ++q) { const size_t m = (size_t)m0 + (size_t)q * NGW;
#pragma unroll
            for (int j = 0; j < 4; ++j) { const f32x4 g = ((const f32x4*)g1 + lane)[64 * j]; xv[q][j] = xv[q][j] + ov[q][j] * rs[q] * g;
                if (XOB) { u32x2 w; w.x = cvtpk(xv[q][j].x, xv[q][j].y); w.y = cvtpk(xv[q][j].z, xv[q][j].w); __builtin_nontemporal_store(w, (u32x2*)((bf16_t*)xout_ + m * DM) + lane + 64 * j); }
                else __builtin_nontemporal_store(xv[q][j], (f32x4*)((float*)xout_ + m * DM) + lane + 64 * j);
                s2[q] += (xv[q][j].x * xv[q][j].x + xv[q][j].y * xv[q][j].y) + (xv[q][j].z * xv[q][j].z + xv[q][j].w * xv[q][j].w); } }
        if (hn) {
            const float r2[2] = {__builtin_amdgcn_rsqf(wave_sum(s2[0]) * (1.f / DM) + NORM_EPS), __builtin_amdgcn_rsqf(wave_sum(s2[1]) * (1.f / DM) + NORM_EPS)};
#pragma unroll
            for (int q = 0; q < 2; ++q) { const size_t m = (size_t)m0 + (size_t)q * NGW; u32x2* ho = (u32x2*)(hn + m * DM) + lane;
#pragma unroll
                for (int j = 0; j < 4; ++j) { const f32x4 g = ((const f32x4*)g2 + lane)[64 * j]; u32x2 w; w.x = cvtpk(xv[q][j].x * r2[q] * g.x, xv[q][j].y * r2[q] * g.y); w.y = cvtpk(xv[q][j].z * r2[q] * g.z, xv[q][j].w * r2[q] * g.w); ho[64 * j] = w; } }
        }
    }
}

__device__ __forceinline__ int crow(int r, int hi) { return (r & 3) + 8 * (r >> 2) + 4 * hi; }
typedef short v4i16_t __attribute__((ext_vector_type(4)));
__device__ __forceinline__ s16x4 vtr(const LAS unsigned char* p) { return __builtin_bit_cast(s16x4, __builtin_amdgcn_ds_read_tr16_b64_v4i16((LAS v4i16_t*)p)); }

template <int D, class BiasF>
__device__ __forceinline__ void attn_qk(const LAS unsigned char* Kb, const bf16x8 (&qr)[D / 16], float m_run, f32x16& p0, f32x16& p1, float& mx, int r32, int hi, const BiasF& biasf) {
    const LAS unsigned char* kb = Kb + hi * 1024 + r32 * 16;
    if (biasf.uniform()) {
        f32x16 ci; const float c = biasf.uval() - m_run;
#pragma unroll
        for (int r = 0; r < 16; ++r) ci[r] = c;
        p0 = __builtin_amdgcn_mfma_f32_32x32x16_bf16(*(const LAS bf16x8*)(kb), qr[0], ci, 0, 0, 0);
        p1 = __builtin_amdgcn_mfma_f32_32x32x16_bf16(*(const LAS bf16x8*)(kb + 512), qr[0], ci, 0, 0, 0);
    } else {
#pragma unroll
        for (int r = 0; r < 16; ++r) { p0[r] = biasf(crow(r, hi)) - m_run; p1[r] = biasf(crow(r, hi) + 32) - m_run; }
        p0 = __builtin_amdgcn_mfma_f32_32x32x16_bf16(*(const LAS bf16x8*)(kb), qr[0], p0, 0, 0, 0);
        p1 = __builtin_amdgcn_mfma_f32_32x32x16_bf16(*(const LAS bf16x8*)(kb + 512), qr[0], p1, 0, 0, 0);
    }
#pragma unroll
    for (int d0 = 1; d0 < D / 16; ++d0) {
        const bf16x8 b0 = *(const LAS bf16x8*)(kb + d0 * 2048);
        const bf16x8 b1 = *(const LAS bf16x8*)(kb + d0 * 2048 + 512);
        p0 = __builtin_amdgcn_mfma_f32_32x32x16_bf16(b0, qr[d0], p0, 0, 0, 0);
        p1 = __builtin_amdgcn_mfma_f32_32x32x16_bf16(b1, qr[d0], p1, 0, 0, 0);
    }
    float ma = fmaxf(fmaxf(p0[0], p0[1]), p1[0]), mb = fmaxf(fmaxf(p0[2], p0[3]), p1[1]);
    ma = fmaxf(fmaxf(ma, p1[2]), p1[3]);
#pragma unroll
    for (int r = 4; r < 16; r += 4) { ma = fmaxf(fmaxf(ma, p0[r]), p0[r + 1]); mb = fmaxf(fmaxf(mb, p0[r + 2]), p0[r + 3]); ma = fmaxf(fmaxf(ma, p1[r]), p1[r + 1]); mb = fmaxf(fmaxf(mb, p1[r + 2]), p1[r + 3]); }
    mx = fmaxf(ma, mb);
}
template <int D>
__device__ __forceinline__ void attn_pv(const LAS unsigned char* Vb, float& m_run, float& l_run, f32x16 (&o)[D / 32], f32x16& p0, f32x16& p1, float mx, LAS float* wsf, int r32, int hi, bool first) {
    mx = fmaxf(mx, __shfl_xor(mx, 32));
    float dl = 0.f;
    if (first) { m_run = mx; dl = mx; }
    else if (__any(mx > 8.0f)) {
        dl = fmaxf(mx, 0.f);
        const float alpha = fast_exp2(-dl);
        m_run += dl; l_run *= alpha;
        if (hi == 0) wsf[r32] = alpha;
        LDS_WAIT(); asm volatile("" ::: "memory");
#pragma unroll
        for (int r = 0; r < 16; ++r) { const float a = wsf[crow(r, hi)];
#pragma unroll
            for (int d = 0; d < D / 32; ++d) o[d][r] *= a; }
    }
    float ps = 0.f, ps2 = 0.f;
#pragma unroll
    for (int r = 0; r < 16; ++r) { p0[r] = fast_exp2(p0[r] - dl); p1[r] = fast_exp2(p1[r] - dl); ps += p0[r]; ps2 += p1[r]; }
    l_run += ps + ps2;
    u32x4 pw[4];
    pw[0] = (u32x4){cvtpk(p0[0], p0[1]), cvtpk(p0[2], p0[3]), cvtpk(p0[4], p0[5]), cvtpk(p0[6], p0[7])};
    pw[1] = (u32x4){cvtpk(p0[8], p0[9]), cvtpk(p0[10], p0[11]), cvtpk(p0[12], p0[13]), cvtpk(p0[14], p0[15])};
    pw[2] = (u32x4){cvtpk(p1[0], p1[1]), cvtpk(p1[2], p1[3]), cvtpk(p1[4], p1[5]), cvtpk(p1[6], p1[7])};
    pw[3] = (u32x4){cvtpk(p1[8], p1[9]), cvtpk(p1[10], p1[11]), cvtpk(p1[12], p1[13]), cvtpk(p1[14], p1[15])};
    const LAS unsigned char* vp = Vb + ((r32 >> 4) & 1) * 32 + (r32 & 3) * 8 + (4 * hi + ((r32 & 15) >> 2)) * 64;
#pragma unroll
    for (int d0 = 0; d0 < D / 32; ++d0) {
#pragma unroll
        for (int ks = 0; ks < 4; ++ks) {
            const s16x4 lo = vtr(vp + d0 * 4096 + ks * 1024), hh = vtr(vp + d0 * 4096 + ks * 1024 + 512);
            const bf16x8 vf = (bf16x8){lo[0], lo[1], lo[2], lo[3], hh[0], hh[1], hh[2], hh[3]};
            o[d0] = __builtin_amdgcn_mfma_f32_32x32x16_bf16(__builtin_bit_cast(bf16x8, pw[ks]), vf, o[d0], 0, 0, 0);
        }
    }
}
template <int D, class BiasF>
__device__ __forceinline__ void attn_tile(const LAS unsigned char* Kb, const LAS unsigned char* Vb, const bf16x8 (&qr)[D / 16], float& m_run, float& l_run, f32x16 (&o)[D / 32],
                                          LAS float* wsf, int r32, int hi, const BiasF& biasf, bool first) {
    f32x16 p0, p1; float mx;
    attn_qk<D>(Kb, qr, m_run, p0, p1, mx, r32, hi, biasf);
    attn_pv<D>(Vb, m_run, l_run, o, p0, p1, mx, wsf, r32, hi, first);
}
template <int ND>
__device__ __forceinline__ void attn_finish(float l_run, f32x16 (&o)[ND], LAS float* wsf, int r32, int hi) {
    const float l = l_run + __shfl_xor(l_run, 32);
    LDS_WAIT(); asm volatile("" ::: "memory");
    if (hi == 0) wsf[32 + r32] = 1.0f / l;
    LDS_WAIT(); asm volatile("" ::: "memory");
#pragma unroll
    for (int r = 0; r < 16; ++r) { const float a = wsf[32 + crow(r, hi)];
#pragma unroll
        for (int d = 0; d < ND; ++d) o[d][r] *= a; }
}

constexpr int ATT_GRP = 32768, ATT_K = 0, ATT_V = 16384, ATT_TB = 65536, ATT_WS = ATT_TB + 1024, ATT_OST = ATT_WS + 2048, ATT_LDS = ATT_OST + 8 * 4096;
static_assert(ATT_LDS <= RING_BYTES, "attention LDS");
struct ChunkBias {
    const LAS float* tb; int base; bool far; float farv;
    __device__ __forceinline__ bool uniform() const { return far; }
    __device__ __forceinline__ float uval() const { return farv; }
    __device__ __forceinline__ float operator()(int kin) const { int d = base - kin; d = d > 128 ? 128 : d; return tb[d + 63]; }
};
__device__ __forceinline__ void chunk_attention_head(const bf16_t* PQp, const bf16_t* PRp, bf16_t* Oout, int opitch, const float* relb, int b, int h, LAS unsigned char* lds, int tid) {
    const int lane = tid & 63, r32 = lane & 31, hi = lane >> 5; const int wid = __builtin_amdgcn_readfirstlane(tid >> 6);
    const int grp = wid >> 2, wg = wid & 3;
    LAS float* tb = (LAS float*)(lds + ATT_TB);
    LAS float* wsf = (LAS float*)(lds + ATT_WS) + wid * 64;
    LAS unsigned char* gl = lds + grp * ATT_GRP;
    if (tid < 192) tb[tid] = relb[h * 192 + tid] * LOG2E;
    const size_t rowbase = (size_t)b * SEQ;
    const bf16_t* Kh = PRp + rowbase * NPR + C_KA + h * 64; const bf16_t* Vh = PRp + rowbase * NPR + C_VA + h * 64;
    const bf16_t* ksrc = Kh + (size_t)lane * NPR + wg * 8;
    const bf16_t* vsrc = Vh + (size_t)(16 * wg + (lane >> 2)) * NPR + (lane & 3) * 8;
    const int kdst = wg * 1024 + lane * 16, vdst = wg * 1024 + lane * 16;
    __syncthreads();
    const float farv = tb[191];
    if (grp == 1) { __builtin_amdgcn_s_setprio(1); __syncthreads(); }
    for (int it = 0; it < 8; ++it) {
        const int u = 2 * it + grp, c0 = 2 * u, cw = c0 + (wg >> 1), qin = 32 * (wg & 1) + r32;
        const bf16_t* Qw = PQp + (rowbase + u * 128 + wg * 32) * NPQ + C_Q + h * 64;
        bf16_t* Ow = Oout + (rowbase + u * 128 + wg * 32) * opitch + h * 64;
        bf16x8 qr[4];
#pragma unroll
        for (int d0 = 0; d0 < 4; ++d0) qr[d0] = *(const bf16x8*)&Qw[(size_t)r32 * NPQ + d0 * 16 + hi * 8];
        float m_run = 0.f, l_run = 0.f; f32x16 o[2]; bool first = true;
#pragma unroll
        for (int r = 0; r < 16; ++r) { o[0][r] = 0.f; o[1][r] = 0.f; }
        u32x4 kA[2], vA[2], kB[2], vB[2];
#define TVALID(t) ((t) <= 9 && (c0 - 8 + (t)) >= 0)
#define TLOAD(K_, V_, t) do { if (TVALID(t)) { const size_t ro_ = (size_t)(c0 - 8 + (t)) * 64 * NPR; _Pragma("unroll") for (int j = 0; j < 2; ++j) { K_[j] = *(const u32x4*)(ksrc + ro_ + j * 32); V_[j] = *(const u32x4*)(vsrc + ro_ + j * 32); } } } while (0)
#define TWRITE(K_, V_, t) do { if (TVALID(t)) { _Pragma("unroll") for (int j = 0; j < 2; ++j) { *(LAS u32x4*)(gl + ATT_K + ((t) & 1) * 8192 + j * 4096 + kdst) = K_[j]; *(LAS u32x4*)(gl + ATT_V + ((t) & 1) * 8192 + j * 4096 + vdst) = V_[j]; } } } while (0)
#define TSTEP(t) do { const int kc_ = c0 - 8 + (t); const int dc_ = cw - kc_; const bool vis_ = (kc_ >= 0 && dc_ >= 0 && dc_ <= 8); f32x16 p0, p1; float mx_ = 0.f; \
            if (vis_) { ChunkBias bf{tb, qin + 64 * dc_, dc_ >= 3, farv}; attn_qk<64>(gl + ATT_K + ((t) & 1) * 8192, qr, m_run, p0, p1, mx_, r32, hi, bf); } \
            __syncthreads(); \
            if (vis_) { attn_pv<64>(gl + ATT_V + ((t) & 1) * 8192, m_run, l_run, o, p0, p1, mx_, wsf, r32, hi, first); first = false; } } while (0)
        TLOAD(kB, vB, 0); TWRITE(kB, vB, 0);
        TLOAD(kA, vA, 1);
        __syncthreads();
#pragma unroll 1
        for (int kk = 0; kk < 10; kk += 2) {
            TLOAD(kB, vB, kk + 2);
            TSTEP(kk);
            TWRITE(kA, vA, kk + 1);
            __syncthreads();
            TLOAD(kA, vA, kk + 3);
            TSTEP(kk + 1);
            TWRITE(kB, vB, kk + 2);
            __syncthreads();
        }
#undef TVALID
#undef TLOAD
#undef TWRITE
#undef TSTEP
        attn_finish<2>(l_run, o, wsf, r32, hi);
        LAS unsigned short* stg = (LAS unsigned short*)(lds + ATT_OST) + wid * 2048;
#pragma unroll
        for (int r = 0; r < 16; r += 1) { const int orow = crow(r, hi);
#pragma unroll
            for (int d0 = 0; d0 < 2; ++d0) stg[orow * 64 + d0 * 32 + r32] = (unsigned short)f2bf(o[d0][r]); }
        LDS_WAIT(); asm volatile("" ::: "memory");
#pragma unroll
        for (int i = 0; i < 4; ++i) { const int row = i * 8 + (lane >> 3), ch = lane & 7; const u32x4 v = *(const LAS u32x4*)(stg + row * 64 + ch * 8); *(u32x4*)(Ow + (size_t)row * opitch + ch * 8) = v; }
        LDS_WAIT(); asm volatile("" ::: "memory");
        __syncthreads();
    }
    if (grp == 0) __syncthreads(); else __builtin_amdgcn_s_setprio(0);
}

constexpr int AT2_BUF = 32768, AT2_TB = 65536, AT2_WS = AT2_TB + 1024, AT2_OST = AT2_WS + 2048, AT2_LDS = AT2_OST + 8 * 4096;
static_assert(AT2_LDS <= RING_BYTES, "attention LDS");
template <class BiasF>
__device__ __forceinline__ void attn2_scores(const LAS unsigned char* Kb, bool vis, const bf16x8 (&qr)[4], float m_run, f32x16& pa, f32x16& pb, int r32, int hi, const BiasF& bf) {
    if (vis) {
        const LAS unsigned char* kb = Kb + hi * 1024 + r32 * 16;
        if (bf.uniform()) {
            f32x16 ci; const float c = bf.uval() - m_run;
#pragma unroll
            for (int r = 0; r < 16; ++r) ci[r] = c;
            pa = __builtin_amdgcn_mfma_f32_32x32x16_bf16(*(const LAS bf16x8*)(kb), qr[0], ci, 0, 0, 0);
            pb = __builtin_amdgcn_mfma_f32_32x32x16_bf16(*(const LAS bf16x8*)(kb + 512), qr[0], ci, 0, 0, 0);
        } else {
#pragma unroll
            for (int r = 0; r < 16; ++r) { pa[r] = bf(crow(r, hi)) - m_run; pb[r] = bf(crow(r, hi) + 32) - m_run; }
            pa = __builtin_amdgcn_mfma_f32_32x32x16_bf16(*(const LAS bf16x8*)(kb), qr[0], pa, 0, 0, 0);
            pb = __builtin_amdgcn_mfma_f32_32x32x16_bf16(*(const LAS bf16x8*)(kb + 512), qr[0], pb, 0, 0, 0);
        }
#pragma unroll
        for (int d0 = 1; d0 < 4; ++d0) {
            pa = __builtin_amdgcn_mfma_f32_32x32x16_bf16(*(const LAS bf16x8*)(kb + d0 * 2048), qr[d0], pa, 0, 0, 0);
            pb = __builtin_amdgcn_mfma_f32_32x32x16_bf16(*(const LAS bf16x8*)(kb + d0 * 2048 + 512), qr[d0], pb, 0, 0, 0);
        }
    } else {
#pragma unroll
        for (int r = 0; r < 16; ++r) { pa[r] = -1e30f; pb[r] = -1e30f; }
    }
}
__device__ __forceinline__ void attn2_pv(const LAS unsigned char* Vb, float dl, float& ps, f32x16 (&o)[2], f32x16& pa, f32x16& pb, int r32, int hi) {
#pragma unroll
    for (int r = 0; r < 16; ++r) { pa[r] = fast_exp2(pa[r] - dl); pb[r] = fast_exp2(pb[r] - dl); ps += pa[r] + pb[r]; }
    const LAS unsigned char* vp = Vb + ((r32 >> 4) & 1) * 32 + (r32 & 3) * 8 + (4 * hi + ((r32 & 15) >> 2)) * 64;
#pragma unroll
    for (int ks = 0; ks < 4; ++ks) {
        const f32x16& pp = (ks < 2) ? pa : pb; const int b8 = (ks & 1) * 8;
        const bf16x8 pf = __builtin_bit_cast(bf16x8, (u32x4){cvtpk(pp[b8 + 0], pp[b8 + 1]), cvtpk(pp[b8 + 2], pp[b8 + 3]), cvtpk(pp[b8 + 4], pp[b8 + 5]), cvtpk(pp[b8 + 6], pp[b8 + 7])});
#pragma unroll
        for (int d0 = 0; d0 < 2; ++d0) {
            const s16x4 lo = vtr(vp + d0 * 4096 + ks * 1024), hh = vtr(vp + d0 * 4096 + ks * 1024 + 512);
            const bf16x8 vf = (bf16x8){lo[0], lo[1], lo[2], lo[3], hh[0], hh[1], hh[2], hh[3]};
            o[d0] = __builtin_amdgcn_mfma_f32_32x32x16_bf16(pf, vf, o[d0], 0, 0, 0);
        }
    }
}
__device__ __forceinline__ void chunk_attention_head2(const bf16_t* PQp, const bf16_t* PRp, bf16_t* Oout, int opitch, const float* relb, int b, int h, LAS unsigned char* lds, int tid) {
    const int lane = tid & 63, r32 = lane & 31, hi = lane >> 5; const int wid = __builtin_amdgcn_readfirstlane(tid >> 6);
    LAS float* tb = (LAS float*)(lds + AT2_TB);
    LAS float* wsf = (LAS float*)(lds + AT2_WS) + wid * 64;
    if (tid < 192) tb[tid] = relb[h * 192 + tid] * LOG2E;
    const size_t rowbase = (size_t)b * SEQ;
    const bf16_t* Kh = PRp + rowbase * NPR + C_KA + h * 64; const bf16_t* Vh = PRp + rowbase * NPR + C_VA + h * 64;
    const bf16_t* ksrc = Kh + (size_t)lane * NPR + wid * 8;
    const bf16_t* vsrc = Vh + (size_t)(16 * (wid & 3) + (lane >> 2)) * NPR + (wid >> 2) * 32 + (lane & 3) * 8;
    const int pdst = wid * 1024 + lane * 16;
    __syncthreads();
    const float farv = tb[191];
    for (int qb = 0; qb < 8; ++qb) {
        const int c0 = qb * 4, cw = c0 + (wid >> 1), qin = 32 * (wid & 1) + r32;
        const bf16_t* Qw = PQp + (rowbase + qb * 256 + wid * 32) * NPQ + C_Q + h * 64;
        bf16_t* Ow = Oout + (rowbase + qb * 256 + wid * 32) * opitch + h * 64;
        bf16x8 qr[4];
#pragma unroll
        for (int d0 = 0; d0 < 4; ++d0) qr[d0] = *(const bf16x8*)&Qw[(size_t)r32 * NPQ + d0 * 16 + hi * 8];
        float m_run = 0.f, l_run = 0.f; f32x16 o[2]; bool first = true;
#pragma unroll
        for (int r = 0; r < 16; ++r) { o[0][r] = 0.f; o[1][r] = 0.f; }
        u32x4 kA[2], vA[2];
#define SVALID(s_) ((s_) <= 5 && (c0 - 8 + 2 * (s_)) >= 0)
#define SLOAD(s_) do { if (SVALID(s_)) { const size_t ro_ = (size_t)(c0 - 8 + 2 * (s_)) * 64 * NPR; _Pragma("unroll") for (int j = 0; j < 2; ++j) { kA[j] = *(const u32x4*)(ksrc + ro_ + (size_t)j * 64 * NPR); vA[j] = *(const u32x4*)(vsrc + ro_ + (size_t)j * 64 * NPR); } } } while (0)
#define SWRITE(s_) do { if (SVALID(s_)) { LAS unsigned char* bb_ = lds + ((s_) & 1) * AT2_BUF; _Pragma("unroll") for (int j = 0; j < 2; ++j) { *(LAS u32x4*)(bb_ + j * 16384 + pdst) = kA[j]; *(LAS u32x4*)(bb_ + j * 16384 + 8192 + pdst) = vA[j]; } } } while (0)
        SLOAD(0); SWRITE(0);
        __syncthreads();
#pragma unroll 1
        for (int ss = 0; ss < 6; ++ss) {
            SLOAD(ss + 1);
            const int kcA = c0 - 8 + 2 * ss; const int dA = cw - kcA, dB = dA - 1;
            const bool vA_ = (kcA >= 0 && dA >= 0 && dA <= 8), vB_ = (kcA >= 0 && dB >= 0 && dB <= 8);
            if (vA_ || vB_) {
                const LAS unsigned char* bb = lds + (ss & 1) * AT2_BUF;
                f32x16 p0, p1, p2, p3;
                attn2_scores(bb, vA_, qr, m_run, p0, p1, r32, hi, ChunkBias{tb, qin + 64 * dA, dA >= 3, farv});
                attn2_scores(bb + 16384, vB_, qr, m_run, p2, p3, r32, hi, ChunkBias{tb, qin + 64 * dB, dB >= 3, farv});
                float ma = fmaxf(fmaxf(p0[0], p1[0]), p2[0]), mb = fmaxf(fmaxf(p0[1], p1[1]), p3[0]);
                mb = fmaxf(mb, fmaxf(p2[1], p3[1]));
#pragma unroll
                for (int r = 2; r < 16; r += 2) { ma = fmaxf(fmaxf(ma, p0[r]), p1[r]); mb = fmaxf(fmaxf(mb, p0[r + 1]), p1[r + 1]); ma = fmaxf(fmaxf(ma, p2[r]), p3[r]); mb = fmaxf(fmaxf(mb, p2[r + 1]), p3[r + 1]); }
                float mx = fmaxf(ma, mb);
                mx = fmaxf(mx, __shfl_xor(mx, 32));
                float dl = 0.f;
                if (first) { m_run = mx; dl = mx; first = false; }
                else if (__any(mx > 8.0f)) {
                    dl = fmaxf(mx, 0.f);
                    const float alpha = fast_exp2(-dl);
                    m_run += dl; l_run *= alpha;
                    if (hi == 0) wsf[r32] = alpha;
                    LDS_WAIT(); asm volatile("" ::: "memory");
#pragma unroll
                    for (int r = 0; r < 16; ++r) { const float a = wsf[crow(r, hi)]; o[0][r] *= a; o[1][r] *= a; }
                }
                float ps = 0.f;
                if (vA_) attn2_pv(bb + 8192, dl, ps, o, p0, p1, r32, hi);
                if (vB_) attn2_pv(bb + 24576, dl, ps, o, p2, p3, r32, hi);
                l_run += ps;
            }
            SWRITE(ss + 1);
            __syncthreads();
        }
#undef SVALID
#undef SLOAD
#undef SWRITE
        attn_finish<2>(l_run, o, wsf, r32, hi);
        LAS unsigned short* stg = (LAS unsigned short*)(lds + AT2_OST) + wid * 2048;
#pragma unroll
        for (int r = 0; r < 16; r += 1) { const int orow = crow(r, hi);
#pragma unroll
            for (int d0 = 0; d0 < 2; ++d0) stg[orow * 64 + d0 * 32 + r32] = (unsigned short)f2bf(o[d0][r]); }
        LDS_WAIT(); asm volatile("" ::: "memory");
#pragma unroll
        for (int i = 0; i < 4; ++i) { const int row = i * 8 + (lane >> 3), ch = lane & 7; const u32x4 v = *(const LAS u32x4*)(stg + row * 64 + ch * 8); *(u32x4*)(Ow + (size_t)row * opitch + ch * 8) = v; }
        LDS_WAIT(); asm volatile("" ::: "memory");
        __syncthreads();
    }
}

constexpr int A3_SLOT = 8192, A3_K = 0, A3_V = 3 * A3_SLOT, A3_WS = 6 * A3_SLOT, A3_TB = A3_WS + 2048, A3_OST = A3_TB + 4352, A3_LDS = A3_OST + 8 * 4096;
static_assert(A3_LDS <= RING_BYTES, "attention LDS");
__device__ __forceinline__ void glds16(const void* g, unsigned lds_base) {
    unsigned sv; asm volatile("s_mov_b32 %0, m0\n\ts_mov_b32 m0, %2\n\ts_nop 0\n\tglobal_load_lds_dwordx4 %1, off\n\ts_mov_b32 m0, %0" : "=&s"(sv) : "v"(g), "s"(lds_base) : "memory"); }
#define MFMA32(a, b, c) __builtin_amdgcn_mfma_f32_32x32x16_bf16(a, b, c, 0, 0, 0)
#define A3_SBAR() __builtin_amdgcn_sched_barrier(0)
#define A3_PIN(x) asm volatile("" : "+v"(x))
#define A3_WAIT_BAR(N) asm volatile("s_waitcnt vmcnt(" #N ") lgkmcnt(0)\n\ts_barrier" ::: "memory")
#define A3_MX3(a, b, c) __builtin_fmaxf(__builtin_fmaxf((a), (b)), (c))
__device__ __forceinline__ void a3_swap32(float& a, float& b) { asm volatile("s_nop 1\n\tv_permlane32_swap_b32 %0, %1\n\ts_nop 1" : "+v"(a), "+v"(b)); }
__device__ __forceinline__ float a3_rowmax(const f32x16& p0, const f32x16& p1) {
    float a = A3_MX3(p0[0], p0[1], p1[0]), b = A3_MX3(p0[2], p0[3], p1[1]); a = A3_MX3(a, p1[2], p1[3]);
#pragma unroll
    for (int r = 4; r < 16; r += 4) { a = A3_MX3(a, p0[r], p0[r + 1]); b = A3_MX3(b, p0[r + 2], p0[r + 3]); a = A3_MX3(a, p1[r], p1[r + 1]); b = A3_MX3(b, p1[r + 2], p1[r + 3]); }
    float m = __builtin_fmaxf(a, b), m2 = m; a3_swap32(m, m2);
    return __builtin_fmaxf(m, m2); }
__device__ __forceinline__ void a3_kload2(bf16x8* kf, const LAS unsigned char* kp, int d0) { kf[2 * d0] = *(const LAS bf16x8*)(kp + d0 * 2048); kf[2 * d0 + 1] = *(const LAS bf16x8*)(kp + d0 * 2048 + 512); }
__device__ __forceinline__ void chunk_attention_head3(const bf16_t* PQp, const bf16_t* PRp, bf16_t* Oout, int opitch, const float* relb, int b, int h, LAS unsigned char* lds, int tid) {
    const int lane = tid & 63, r32 = lane & 31, hi = lane >> 5; const int wid = __builtin_amdgcn_readfirstlane(tid >> 6);
    LAS float* tbx = (LAS float*)(lds + A3_TB);
    LAS float* wsf = (LAS float*)(lds + A3_WS) + wid * 64;
    __syncthreads();
    for (int i = tid; i < 1040; i += 512) { const int s = i / 260, m = i - 260 * s, n = m - s; float v = 0.f;
        if (n >= 0 && n <= 254) { int D = 191 - n; D = D > 128 ? 128 : D; v = (relb[h * 192 + D + 63] - relb[h * 192 + 191]) * LOG2E; }
        tbx[i] = v; }
    const float farv = relb[h * 192 + 191] * LOG2E;
    const size_t rowbase = (size_t)b * SEQ;
    const bf16_t* Kh = PRp + rowbase * NPR + C_KA + h * 64; const bf16_t* Vh = PRp + rowbase * NPR + C_VA + h * 64;
    const unsigned lds0 = (unsigned)(size_t)lds;
    const unsigned kdst = lds0 + A3_K + wid * 1024, vdst = lds0 + A3_V + wid * 1024;
    const LAS unsigned char* vp0 = lds + A3_V + ((lane >> 4) & 1) * 32 + (lane & 3) * 8 + (4 * hi + ((lane & 15) >> 2)) * 64;
    const LAS unsigned char* kp0 = lds + A3_K + hi * 1024 + r32 * 16;
    const int sgn = (r32 + 1) & 3;
    const LAS float* tbase = tbx + 260 * sgn + (191 - (32 * (wid & 1) + r32) + 4 * hi + sgn);
    __syncthreads();
    const bf16_t* Kl = Kh + (size_t)lane * NPR + wid * 8;
    const bf16_t* Vl = Vh + (size_t)(16 * (wid & 3) + (lane >> 2)) * NPR + (wid >> 2) * 32 + (lane & 3) * 8;
    int sl_prev = 2 * A3_SLOT, sl_cur = 0, sl_next = A3_SLOT;
    bf16x8 qr[4];
#pragma unroll 1
    for (int qb = 0; qb < 8; ++qb) {
        const int c0 = qb * 4, kstart = c0 > 8 ? c0 - 8 : 0, NT = c0 + 4 - kstart, dc0 = c0 + (wid >> 1) - kstart;
        const int knext = qb < 7 ? (c0 > 4 ? c0 - 4 : 0) : kstart + NT - 1;
        const bf16_t* Qw = PQp + (rowbase + qb * 256 + wid * 32) * NPQ + C_Q + h * 64;
        bf16_t* Ow = Oout + (rowbase + qb * 256 + wid * 32) * opitch + h * 64;
#define A3_KC(t) int t_ = (t); const int kc_ = t_ < NT ? kstart + t_ : (qb < 7 ? knext + (t_ - NT) : knext);
#define DMA_K(t, slot) do { A3_KC(t) glds16(Kl + (size_t)kc_ * 64 * NPR, (unsigned)__builtin_amdgcn_readfirstlane(kdst + (slot))); } while (0)
#define DMA_V(t, slot) do { A3_KC(t) glds16(Vl + (size_t)kc_ * 64 * NPR, (unsigned)__builtin_amdgcn_readfirstlane(vdst + (slot))); } while (0)
#define NEARADD(X0, X1, dc) do { const LAS float* tp_ = tbase - 64 * (dc); _Pragma("unroll") for (int g = 0; g < 4; ++g) { const f32x4 a_ = *(const LAS f32x4*)(tp_ + 8 * g), b_ = *(const LAS f32x4*)(tp_ + 32 + 8 * g); \
            X0[4 * g] += a_[0]; X0[4 * g + 1] += a_[1]; X0[4 * g + 2] += a_[2]; X0[4 * g + 3] += a_[3]; X1[4 * g] += b_[0]; X1[4 * g + 1] += b_[1]; X1[4 * g + 2] += b_[2]; X1[4 * g + 3] += b_[3]; } } while (0)
        if (qb == 0) { DMA_K(0, sl_cur); DMA_V(0, sl_cur); DMA_K(1, sl_next);
#pragma unroll
            for (int d0 = 0; d0 < 4; ++d0) qr[d0] = *(const bf16x8*)&Qw[(size_t)r32 * NPQ + d0 * 16 + hi * 8]; }
        float mhat = 0.f, l_reg = 0.f; f32x16 o[2];
#pragma unroll
        for (int r = 0; r < 16; ++r) { o[0][r] = 0.f; o[1][r] = 0.f; }
        f32x16 ci16;
#pragma unroll
        for (int r = 0; r < 16; ++r) ci16[r] = farv;
        A3_PIN(ci16);
        bool resc = false, first = true;
        f32x16 pA0, pA1, pB0, pB1; bf16x8 kf[8]; s16x4 vlo[8], vhi[8]; u32x4 pw0, pw1, pw2, pw3;
#define ROT() do { sl_prev = sl_cur; sl_cur = sl_next; sl_next = (sl_next == 2 * A3_SLOT) ? 0 : sl_next + A3_SLOT; } while (0)
#define EX(v) __builtin_amdgcn_exp2f(v)
#define RESC() do { if (resc) { _Pragma("unroll") for (int d_ = 0; d_ < 2; ++d_) _Pragma("unroll") for (int r = 0; r < 16; ++r) o[d_][r] *= wsf[crow(r, hi)]; } } while (0)
#define DECIDE(C0, C1, t) resc = false; \
        { const int dc_ = dc0 - (t); \
          if (dc_ >= 0 && dc_ <= 8) { if (dc_ <= 2) NEARADD(C0, C1, dc_); \
              const float rm = a3_rowmax(C0, C1); float dl = 0.f; bool mv_ = false; \
              if (first) { dl = rm; first = false; mv_ = true; } \
              else if (__builtin_expect(__any(rm > 8.0f), 0)) { dl = __builtin_fmaxf(rm, 0.f); const float f = __builtin_amdgcn_exp2f(-dl); l_reg *= f; if (hi == 0) wsf[r32] = f; resc = true; mv_ = true; } \
              if (mv_) { mhat += dl; const float cv_ = farv - mhat; \
                  _Pragma("unroll") for (int r = 0; r < 16; ++r) { C0[r] -= dl; C1[r] -= dl; ci16[r] = cv_; } A3_PIN(ci16); } } \
          else { _Pragma("unroll") for (int r = 0; r < 16; ++r) { C0[r] = -30000.f; C1[r] = -30000.f; } } }
        if (qb == 0) { DMA_K(2, sl_prev); A3_WAIT_BAR(3); }
#pragma unroll
        for (int d0 = 0; d0 < 4; ++d0) a3_kload2(kf, kp0 + sl_cur, d0);
        pA0 = MFMA32(kf[0], qr[0], ci16); pA1 = MFMA32(kf[1], qr[0], ci16); pA0 = MFMA32(kf[2], qr[1], pA0); pA1 = MFMA32(kf[3], qr[1], pA1);
        pA0 = MFMA32(kf[4], qr[2], pA0); pA1 = MFMA32(kf[5], qr[2], pA1); pA0 = MFMA32(kf[6], qr[3], pA0); pA1 = MFMA32(kf[7], qr[3], pA1);
        { DECIDE(pA0, pA1, 0)
#pragma unroll
          for (int r = 0; r < 16; ++r) { pA0[r] = EX(pA0[r]); pA1[r] = EX(pA1[r]); } }
        A3_WAIT_BAR(0);
        DMA_K(3, sl_cur); DMA_V(1, sl_next); ROT();
#pragma unroll
        for (int d0 = 0; d0 < 4; ++d0) a3_kload2(kf, kp0 + sl_cur, d0);
        A3_WAIT_BAR(2);
#define PKW(P, i) cvtpk(P[i], P[i + 1])
#define PAF(k) __builtin_bit_cast(bf16x8, pw##k)
#define VFR(i) (bf16x8){vlo[i][0], vlo[i][1], vlo[i][2], vlo[i][3], vhi[i][0], vhi[i][1], vhi[i][2], vhi[i][3]}
#define VRD(i) do { vlo[i] = vtr(vp_ + (((i) >> 2) * 4096 + ((i) & 3) * 1024)); vhi[i] = vtr(vp_ + (((i) >> 2) * 4096 + ((i) & 3) * 1024 + 512)); } while (0)
#define KRD(G, d0) do { if (G) { a3_kload2(kf, kp0 + sl_next, d0); A3_SBAR(); } } while (0)
#define GAPA(MF, a0, a1, a2, a3, W0, W1, PW) do { MF; sacc += a0; sacc += a1; sacc += a2; sacc += a3; W0; W1; A3_PIN(PW); A3_PIN(sacc); A3_SBAR(); } while (0)
#define GAPB(MF, X, i) do { MF; X[i] = EX(X[i]); X[i + 1] = EX(X[i + 1]); X[i + 2] = EX(X[i + 2]); X[i + 3] = EX(X[i + 3]); A3_PIN(X); A3_SBAR(); } while (0)
#define STEP(C0, C1, P0, P1, t, GD, GL) do { A3_SBAR(); \
        const LAS unsigned char* vp_ = vp0 + sl_prev; \
        VRD(0); A3_SBAR(); float sacc = P0[0] + P0[1]; \
                           GAPA(C0 = MFMA32(kf[0], qr[0], ci16),   P0[2], P0[3], P0[4], P0[5],     pw0[0] = PKW(P0, 0),  pw0[1] = PKW(P0, 2),  pw0); \
        VRD(4); A3_SBAR(); GAPA(C1 = MFMA32(kf[1], qr[0], ci16),   P0[6], P0[7], P0[8], P0[9],     pw0[2] = PKW(P0, 4),  pw0[3] = PKW(P0, 6),  pw0); \
        VRD(1); A3_SBAR(); GAPA(C0 = MFMA32(kf[2], qr[1], C0),    P0[10], P0[11], P0[12], P0[13], pw1[0] = PKW(P0, 8),  pw1[1] = PKW(P0, 10), pw1); \
        VRD(5); A3_SBAR(); GAPA(C1 = MFMA32(kf[3], qr[1], C1),    P0[14], P0[15], P1[0], P1[1],   pw1[2] = PKW(P0, 12), pw1[3] = PKW(P0, 14), pw1); \
        VRD(2); A3_SBAR(); GAPA(C0 = MFMA32(kf[4], qr[2], C0),    P1[2], P1[3], P1[4], P1[5],     pw2[0] = PKW(P1, 0),  pw2[1] = PKW(P1, 2),  pw2); \
        VRD(6); A3_SBAR(); GAPA(C1 = MFMA32(kf[5], qr[2], C1),    P1[6], P1[7], P1[8], P1[9],     pw2[2] = PKW(P1, 4),  pw2[3] = PKW(P1, 6),  pw2); \
        VRD(3); A3_SBAR(); GAPA(C0 = MFMA32(kf[6], qr[3], C0),    P1[10], P1[11], P1[12], P1[13], pw3[0] = PKW(P1, 8),  pw3[1] = PKW(P1, 10), pw3); \
        VRD(7); A3_SBAR(); GAPA(C1 = MFMA32(kf[7], qr[3], C1),    P1[14], P1[15], 0.f, 0.f,       pw3[2] = PKW(P1, 12), pw3[3] = PKW(P1, 14), pw3); \
        l_reg += sacc; \
        if (GD) { DMA_K((t) + 3, sl_cur); DMA_V((t) + 1, sl_next); } \
        DECIDE(C0, C1, t) \
        A3_SBAR(); \
        GAPB(o[0] = MFMA32(PAF(0), VFR(0), o[0]), C0, 0);              GAPB(o[1] = MFMA32(PAF(0), VFR(4), o[1]), C0, 4); \
        KRD(GL, 0); GAPB(o[0] = MFMA32(PAF(1), VFR(1), o[0]), C0, 8);  KRD(GL, 1); GAPB(o[1] = MFMA32(PAF(1), VFR(5), o[1]), C0, 12); \
        KRD(GL, 2); GAPB(o[0] = MFMA32(PAF(2), VFR(2), o[0]), C1, 0);  KRD(GL, 3); GAPB(o[1] = MFMA32(PAF(2), VFR(6), o[1]), C1, 4); \
        GAPB(o[0] = MFMA32(PAF(3), VFR(3), o[0]), C1, 8);              GAPB(o[1] = MFMA32(PAF(3), VFR(7), o[1]), C1, 12); \
        } while (0)
        int t = 1;
#pragma unroll 1
        for (; t + 1 < NT; t += 2) {
            STEP(pB0, pB1, pA0, pA1, t, true, true);     A3_WAIT_BAR(2); RESC(); ROT();
            STEP(pA0, pA1, pB0, pB1, t + 1, true, true); A3_WAIT_BAR(2); RESC(); ROT();
        }
        STEP(pB0, pB1, pA0, pA1, NT - 1, true, false);
        A3_WAIT_BAR(2); RESC();
        if (qb < 7) { const bf16_t* Qn = Qw + (size_t)256 * NPQ;
#pragma unroll
            for (int d0 = 0; d0 < 4; ++d0) qr[d0] = *(const bf16x8*)&Qn[(size_t)r32 * NPQ + d0 * 16 + hi * 8]; }
        { float sacc = pB0[0] + pB0[1];
#pragma unroll
          for (int r = 2; r < 16; ++r) sacc += pB0[r];
#pragma unroll
          for (int r = 0; r < 16; ++r) sacc += pB1[r];
          l_reg += sacc;
          pw0 = (u32x4){PKW(pB0, 0), PKW(pB0, 2), PKW(pB0, 4), PKW(pB0, 6)}; pw1 = (u32x4){PKW(pB0, 8), PKW(pB0, 10), PKW(pB0, 12), PKW(pB0, 14)};
          pw2 = (u32x4){PKW(pB1, 0), PKW(pB1, 2), PKW(pB1, 4), PKW(pB1, 6)}; pw3 = (u32x4){PKW(pB1, 8), PKW(pB1, 10), PKW(pB1, 12), PKW(pB1, 14)};
          const LAS unsigned char* vp_ = vp0 + sl_cur;
#pragma unroll
          for (int i = 0; i < 8; ++i) VRD(i);
          o[0] = MFMA32(PAF(0), VFR(0), o[0]); o[1] = MFMA32(PAF(0), VFR(4), o[1]); o[0] = MFMA32(PAF(1), VFR(1), o[0]); o[1] = MFMA32(PAF(1), VFR(5), o[1]);
          o[0] = MFMA32(PAF(2), VFR(2), o[0]); o[1] = MFMA32(PAF(2), VFR(6), o[1]); o[0] = MFMA32(PAF(3), VFR(3), o[0]); o[1] = MFMA32(PAF(3), VFR(7), o[1]); }
        { float l2 = l_reg; a3_swap32(l_reg, l2); l_reg += l2; }
        if (hi == 0) wsf[32 + r32] = l_reg;
        LDS_WAIT(); asm volatile("" ::: "memory");
        LAS unsigned short* stg = (LAS unsigned short*)(lds + A3_OST) + wid * 2048;
#pragma unroll
        for (int r = 0; r < 16; ++r) { const int orow = crow(r, hi); const float rl = __builtin_amdgcn_rcpf(wsf[32 + orow]);
#pragma unroll
            for (int d0 = 0; d0 < 2; ++d0) stg[orow * 64 + d0 * 32 + r32] = (unsigned short)f2bf(o[d0][r] * rl); }
        LDS_WAIT(); asm volatile("" ::: "memory");
#pragma unroll
        for (int i = 0; i < 4; ++i) { const int row = i * 8 + (lane >> 3), ch = lane & 7; const u32x4 v = *(const LAS u32x4*)(stg + row * 64 + ch * 8); *(u32x4*)(Ow + (size_t)row * opitch + ch * 8) = v; }
        ROT();
        asm volatile("s_waitcnt lgkmcnt(0)\n\ts_barrier" ::: "memory");
#undef A3_KC
#undef DMA_K
#undef DMA_V
#undef NEARADD
#undef ROT
#undef EX
#undef RESC
#undef DECIDE
#undef PKW
#undef PAF
#undef VFR
#undef VRD
#undef KRD
#undef GAPA
#undef GAPB
#undef STEP
    }
    asm volatile("s_waitcnt vmcnt(0)" ::: "memory");
}

constexpr int CA_K = 0, CA_V = 65536, CA_WS = 132096, CA_OST = CA_WS + 8 * 256;
static_assert(CA_WS >= MISC_OFF + 128 && CA_OST + 8 * 2048 <= LDS_BYTES, "CA LDS");
struct NoBias { __device__ __forceinline__ bool uniform() const { return true; } __device__ __forceinline__ float uval() const { return 0.f; } __device__ __forceinline__ float operator()(int) const { return 0.f; } };
__device__ __forceinline__ void cross_attention(const bf16_t* Q2, const bf16_t* KVM, bf16_t* O2, LAS unsigned char* lds, int vcu, int G, int tid) {
    const int lane = tid & 63, r32 = lane & 31, hi = lane >> 5; const int wid = __builtin_amdgcn_readfirstlane(tid >> 6);
    LAS float* wsf = (LAS float*)(lds + CA_WS) + wid * 64;
    for (int u = vcu; u < 256; u += G) {
        const int pair = u >> 2, b = pair >> 2, hh = pair & 3;
        const bf16_t* Kg = KVM + (size_t)b * MEMT * DM + hh * 128; const bf16_t* Vg = Kg + 512;
        __syncthreads();
#pragma unroll
        for (int i = 0; i < 8; ++i) {
            const int piece = tid + 512 * i, key = piece & 255, ch = piece >> 8;
            const u32x4 v = *(const u32x4*)(Kg + (size_t)key * DM + ch * 8);
            *(LAS u32x4*)(lds + CA_K + (key >> 6) * 16384 + ch * 1024 + (key & 63) * 16) = v;
        }
#pragma unroll
        for (int i = 0; i < 8; ++i) {
            const int piece = tid + 512 * i, pc = piece & 15, key = piece >> 4;
            const u32x4 v = *(const u32x4*)(Vg + (size_t)key * DM + pc * 8);
            *(LAS u32x4*)(lds + CA_V + (key >> 6) * 16384 + (pc >> 2) * 4096 + (key & 63) * 64 + (pc & 3) * 16) = v;
        }
        __syncthreads();
        for (int qq = 0; qq < 2; ++qq) {
            const int qblk = 2 * (u & 3) + qq;
            const size_t row0 = (size_t)b * SEQ + qblk * 256 + wid * 32;
            const bf16_t* Qw = Q2 + row0 * 512 + hh * 128;
            bf16x8 qr[8];
#pragma unroll
            for (int d0 = 0; d0 < 8; ++d0) qr[d0] = *(const bf16x8*)&Qw[(size_t)r32 * 512 + d0 * 16 + hi * 8];
            float m_run = 0.f, l_run = 0.f; f32x16 o[4];
#pragma unroll
            for (int d = 0; d < 4; ++d)
#pragma unroll
                for (int r = 0; r < 16; ++r) o[d][r] = 0.f;
            attn_tile<128>(lds + CA_K, lds + CA_V, qr, m_run, l_run, o, wsf, r32, hi, NoBias{}, true);
#pragma unroll 1
            for (int t = 1; t < 4; ++t) attn_tile<128>(lds + CA_K + t * 16384, lds + CA_V + t * 16384, qr, m_run, l_run, o, wsf, r32, hi, NoBias{}, false);
            attn_finish<4>(l_run, o, wsf, r32, hi);
            bf16_t* Ow = O2 + row0 * 512 + hh * 128;
            LAS unsigned short* stg = (LAS unsigned short*)(lds + CA_OST) + wid * 1024;
#pragma unroll
            for (int d0 = 0; d0 < 4; ++d0) {
#pragma unroll
                for (int r = 0; r < 16; ++r) stg[crow(r, hi) * 32 + r32] = (unsigned short)f2bf(o[d0][r]);
                LDS_WAIT(); asm volatile("" ::: "memory");
#pragma unroll
                for (int i = 0; i < 2; ++i) { const int row = i * 16 + (lane >> 2), ch = lane & 3; const u32x4 v = *(const LAS u32x4*)(stg + row * 32 + ch * 8); *(u32x4*)(Ow + (size_t)row * 512 + d0 * 32 + ch * 8) = v; }
                LDS_WAIT(); asm volatile("" ::: "memory");
            }
        }
    }
    __syncthreads();
}

constexpr int TC = 32;
constexpr int SC_ZR = 0, SC_ZK = 8192, SC_ZV = 16384, SC_WD = 24576, SC_AA = 32768, SC_GG = 40960, SC_KK = 49152, SC_YY = 57344;
constexpr int SC_AW = 65536;
constexpr int SC_AZ = SC_AW + 32 * 144;
constexpr int SC_AG = SC_AZ + 32 * 144;
constexpr int SC_BD = SC_AG + 32 * 336;
constexpr int SC_CARRY = SC_BD + 128;
constexpr int SC_END = SC_CARRY + 2 * 64 * 16;
static_assert(SC_END <= RING_BYTES, "scan LDS");

template <int CTRL> __device__ __forceinline__ float dpp_f(float x) { return __builtin_bit_cast(float, __builtin_amdgcn_update_dpp(__builtin_bit_cast(int, x), __builtin_bit_cast(int, x), CTRL, 0xF, 0xF, false)); }
__device__ __forceinline__ float red8(float x) { x += dpp_f<0xB1>(x); x += dpp_f<0x4E>(x); x += dpp_f<0x141>(x); return x; }
__device__ __forceinline__ float red16(float x) { x = red8(x); x += dpp_f<0x140>(x); return x; }

template <int NK>
__device__ __forceinline__ f32x16 lora_mma(const LAS unsigned char* Abase, int astride, const bf16x8* bfr, int r32, int hi) {
    f32x16 acc;
#pragma unroll
    for (int r = 0; r < 16; ++r) acc[r] = 0.f;
#pragma unroll
    for (int s = 0; s < NK; ++s) {
        const bf16x8 af = *(const LAS bf16x8*)(Abase + r32 * astride + (16 * s + 8 * hi) * 2);
        acc = __builtin_amdgcn_mfma_f32_32x32x16_bf16(af, bfr[s], acc, 0, 0, 0);
    }
    return acc;
}

__device__ __forceinline__ void lora_prep(const Args& a, const bf16_t* P, int vcu, int G, int tid) {
    bf16_t* LORA = (bf16_t*)(a.ws + WS_LORA); const float* mixp = a.in[I_SHIFT] + 3072;
    for (int gp = vcu * 512 + tid; gp < M * 36; gp += G * 512) {
        const int m = gp / 36, pc = gp - m * 36;
        const bf16_t* src = P + (size_t)m * NPR + C_L + pc * 8;
        const u32x4 cur = *(const u32x4*)src;
        u32x4 prv = (u32x4){0u, 0u, 0u, 0u};
        if ((m & (SEQ - 1)) != 0) prv = *(const u32x4*)(src - NPR);
        const f32x4 m0 = *(const f32x4*)(mixp + pc * 8), m1 = *(const f32x4*)(mixp + pc * 8 + 4);
        float z[8];
        { const unsigned cw_[4] = {cur.x, cur.y, cur.z, cur.w}, pw_[4] = {prv.x, prv.y, prv.z, prv.w}; const float mm[8] = {m0.x, m0.y, m0.z, m0.w, m1.x, m1.y, m1.z, m1.w};
#pragma unroll
          for (int e = 0; e < 4; ++e) { const float c0_ = bflo(cw_[e]), c1_ = bfhi(cw_[e]), p0_ = bflo(pw_[e]), p1_ = bfhi(pw_[e]);
              z[2 * e] = c0_ + (p0_ - c0_) * mm[2 * e]; z[2 * e + 1] = c1_ + (p1_ - c1_) * mm[2 * e + 1]; } }
        if (pc < 8) {
#pragma unroll
            for (int e = 0; e < 8; ++e) { const float ex = fast_exp2(2.f * LOG2E * z[e]); z[e] = 1.f - 2.f * __builtin_amdgcn_rcpf(ex + 1.f); }
        } else if (pc >= 16) {
#pragma unroll
            for (int e = 0; e < 8; ++e) z[e] = sigmoidf_(z[e]);
        }
        *(u32x4*)(LORA + (size_t)m * 288 + pc * 8) = (u32x4){cvtpk(z[0], z[1]), cvtpk(z[2], z[3]), cvtpk(z[4], z[5]), cvtpk(z[6], z[7])};
    }
}

constexpr int CK_RAW = 0;
constexpr int CK_CARRY = 12288;
constexpr int CK_CL = 13312, CK_AA = CK_CL + 8192, CK_GG = CK_AA + 8192, CK_YY = CK_GG + 8192;
constexpr int CK_BD = CK_YY + 8192;
constexpr int CK_GC = CK_BD + 128;
constexpr int CK_AW = CK_GC + 256, CK_AZ = CK_AW + 32 * 144, CK_AG = CK_AZ + 32 * 144;
constexpr int CK_RKK = CK_AW, CK_RBH = CK_RKK + 4608, CK_RKH = CK_RBH + 4608, CK_RRH = CK_RKH + 4608;
constexpr int CK_VKK = CK_AG + 32 * 336;
constexpr int CK_VVM = CK_VKK + 4096;
constexpr int CK_VBT = CK_VVM + 4096;
constexpr int CK_VKT = CK_VBT + 4096;
constexpr int CK_IP = CK_VKT + 4096;
constexpr int CK_IT = CK_IP + 2048, CK_ILK = CK_IT + 2048, CK_IMB = CK_ILK + 2048, CK_IMK = CK_IMB + 2048;
constexpr int CK_IG = CK_IMK + 2048;
constexpr int CK_WD = CK_IG + 4096;
constexpr int CK_WG = CK_WD + 64 * 144;
constexpr int CK_END = CK_WG + 64 * 336;
constexpr int CK_WI = 132096;
static_assert(CK_WI + 64 * 144 <= LDS_BYTES, "lora weights LDS");
static_assert(CK_RRH + 4608 <= CK_VKK && CK_END <= RING_BYTES && (CK_AW % 16) == 0 && (CK_VKK % 16) == 0, "chunked scan LDS");

__device__ __forceinline__ bf16x8 a_perm(const LAS unsigned char* img, int stride, int row, int col0, int hi) {
    const LAS unsigned char* p = img + row * stride + (col0 + 4 * hi) * 2;
    const s16x4 lo = *(const LAS s16x4*)p, hh = *(const LAS s16x4*)(p + 16);
    return (bf16x8){lo[0], lo[1], lo[2], lo[3], hh[0], hh[1], hh[2], hh[3]};
}
__device__ __forceinline__ bf16x8 b_tr(const LAS unsigned char* blk, int ks, int r32, int hi) {
    const LAS unsigned char* vp = blk + ((r32 >> 4) & 1) * 32 + (r32 & 3) * 8 + (4 * hi + ((r32 & 15) >> 2)) * 64 + ks * 1024;
    const s16x4 lo = vtr(vp), hh = vtr(vp + 512);
    return (bf16x8){lo[0], lo[1], lo[2], lo[3], hh[0], hh[1], hh[2], hh[3]};
}
__device__ __forceinline__ bf16x8 acc_frag(const f32x16& x, int s) {
    const u32x4 w = (u32x4){cvtpk(x[8 * s + 0], x[8 * s + 1]), cvtpk(x[8 * s + 2], x[8 * s + 3]), cvtpk(x[8 * s + 4], x[8 * s + 5]), cvtpk(x[8 * s + 6], x[8 * s + 7])};
    return __builtin_bit_cast(bf16x8, w);
}
__device__ __forceinline__ void img_store_t(LAS unsigned char* img, int col, int hi, const f32x16& x, float sgn) {
#pragma unroll
    for (int q = 0; q < 4; ++q) *(LAS u32x2*)(img + col * 64 + (8 * q + 4 * hi) * 2) = (u32x2){cvtpk(x[4 * q] * sgn, x[4 * q + 1] * sgn), cvtpk(x[4 * q + 2] * sgn, x[4 * q + 3] * sgn)};
}
#define MFMA32(a, b, c) __builtin_amdgcn_mfma_f32_32x32x16_bf16(a, b, c, 0, 0, 0)

constexpr int PK_HB = 39296;
constexpr int HB_RKK = 0, HB_RBH = 4608, HB_RKH = 9216, HB_RRH = 13824, HB_VKK = 18432, HB_VVM = 22528, HB_VBT = 26624, HB_VKT = 30720, HB_GC = 34816, HB_BD = 35072, HB_GG = 35200;
constexpr int PK_RAW = 2 * PK_HB, PK_CARRY = PK_RAW + 12288, PK_CL = PK_CARRY + 1024, PK_AA = PK_CL + 8192, PK_AW = PK_AA + 8192, PK_AZ = PK_AW + 4608, PK_AG = PK_AZ + 4608;
static_assert(PK_AG + 32 * 336 <= RING_BYTES, "pipelined scan LDS (ring part)");
constexpr int PK_CONST = PK_AG + 32 * 336;
static_assert(PK_CONST + 2048 <= RING_BYTES, "pipelined scan LDS (constants)");
constexpr int PK_YY = 132096;
static_assert(PK_YY + 2 * 8192 <= LDS_BYTES, "pipelined scan LDS (upper part)");
constexpr int NCH = SEQ / TC;

__device__ __forceinline__ f32x16 gram_tile(const bf16x8 (&af)[4], const bf16x8 (&bf)[4]) {
    f32x16 acc;
#pragma unroll
    for (int r = 0; r < 16; ++r) acc[r] = 0.f;
#pragma unroll
    for (int s = 0; s < 4; ++s) acc = MFMA32(af[s], bf[s], acc);
    return acc;
}
template <int MODE> __device__ __forceinline__ void tri_mask(f32x16& x, int r32, int hi, float sgn) {
#pragma unroll
    for (int r = 0; r < 16; ++r) { const int row = crow(r, hi); const bool keep = (MODE == 0) ? (r32 < row) : ((MODE == 1) ? (r32 > row) : (r32 >= row)); x[r] = keep ? x[r] * sgn : 0.f; }
}

__device__ __forceinline__ void rwkv_head_pipe(const Args& a, const bf16_t* PQp, const bf16_t* PRp, bf16_t* Yout, int ypitch, int b, int h, LAS unsigned char* lds, int tid) {
    const int lane = tid & 63, r32 = lane & 31, hi = lane >> 5; const int wid = __builtin_amdgcn_readfirstlane(tid >> 6);
    const size_t rowbase = (size_t)b * SEQ;
    if (wid < 6) {
        LAS float* CL = (LAS float*)(lds + PK_CL); LAS float* AA = (LAS float*)(lds + PK_AA);
        const int lnb = wid & 1, lch = h * 64 + 32 * lnb + r32;
        const float lbase = (wid < 2) ? a.in[I_DBASE][lch] : ((wid < 4) ? a.in[I_IBASE][lch] : 0.f);
        const int oc = tid & 7, tk = (tid >> 3) & 31, ch0 = h * 64 + 8 * oc;
        if (tid < 128) { const int v8 = tid >> 4, q = tid & 15; const float* srcv;
            switch (v8) { case 0: srcv = a.in[I_KNS]; break; case 1: srcv = a.in[I_KIS]; break; case 2: srcv = a.in[I_BONUS]; break; case 3: srcv = a.in[I_LNW]; break; case 4: srcv = a.in[I_LNB]; break;
                          case 5: srcv = a.in[I_SHIFT]; break; case 6: srcv = a.in[I_SHIFT] + 1024; break; default: srcv = a.in[I_SHIFT] + 2048; break; }
            *(LAS f32x4*)(lds + PK_CONST + v8 * 256 + q * 16) = *(const f32x4*)(srcv + h * 64 + 4 * q); }
        (void)ch0;
#define CV(v8, q) (*(const LAS f32x4*)(lds + PK_CONST + (v8) * 256 + oc * 32 + (q) * 16))
        bf16x8 bfr[10];
        { const bf16_t* up = (wid < 2) ? (const bf16_t*)(a.ws + WS_DUPT) + (size_t)lch * 64 : ((wid < 4) ? (const bf16_t*)(a.ws + WS_IUPT) + (size_t)lch * 64 : (const bf16_t*)(a.ws + WS_GUPT) + (size_t)lch * 160);
          if (wid < 4) {
#pragma unroll
              for (int s = 0; s < 4; ++s) bfr[s] = *(const bf16x8*)(up + 16 * s + 8 * hi);
#pragma unroll
              for (int s = 4; s < 10; ++s) bfr[s] = bfr[0];
          } else {
#pragma unroll
              for (int s = 0; s < 10; ++s) bfr[s] = *(const bf16x8*)(up + 16 * s + 8 * hi);
          } }
        const unsigned char* psrc[5]; unsigned pstride[5]; u32x4 pre[5];
        const bf16_t* LORA = (const bf16_t*)(a.ws + WS_LORA);
#pragma unroll
        for (int i = 0; i < 5; ++i) {
            const int p = tid + 384 * i; const int tl = p / 60, pc = p - tl * 60;
            if (pc < 8) { psrc[i] = (const unsigned char*)(PQp + (rowbase + tl) * NPQ + C_R + h * 64 + pc * 8); pstride[i] = NPQ * 2; }
            else if (pc < 24) { psrc[i] = (const unsigned char*)(PRp + (rowbase + tl) * NPR + (pc < 16 ? C_K : C_V) + h * 64 + (pc & 7) * 8); pstride[i] = NPR * 2; }
            else { psrc[i] = (const unsigned char*)(LORA + (rowbase + tl) * 288 + (pc - 24) * 8); pstride[i] = 288 * 2; }
            pre[i] = __builtin_nontemporal_load((const u32x4*)psrc[i]);
        }
        u32x4 po_g[2], po_v[2]; float po_bd[2];
#pragma unroll
        for (int i2 = 0; i2 < 2; ++i2) { po_g[i2] = (u32x4){0u, 0u, 0u, 0u}; po_v[i2] = po_g[i2]; po_bd[i2] = 0.f; }
#pragma unroll 1
        for (int it = 0; it < NCH + 2; ++it) {
            if (it >= 2 && wid >= 4) {
                const LAS unsigned char* hb = lds + (it & 1) * PK_HB;
#pragma unroll
                for (int i2 = 0; i2 < 2; ++i2) { const int tk2 = ((tid - 256) >> 3) + 16 * i2;
                    po_g[i2] = *(const LAS u32x4*)(hb + HB_GG + tk2 * 128 + oc * 16); po_v[i2] = *(const LAS u32x4*)(hb + HB_VVM + (oc >> 2) * 2048 + tk2 * 64 + (oc & 3) * 16);
                    po_bd[i2] = *(const LAS float*)(hb + HB_BD + tk2 * 4); }
            }
#ifdef X_DUPCOPY
            for (int rep_ = 0; rep_ < 2; ++rep_)
#endif
            if (it < NCH) {
#pragma unroll
                for (int i = 0; i < 5; ++i) {
                    const int p = tid + 384 * i; const int tl = p / 60, pc = p - tl * 60;
                    LAS unsigned char* dst;
                    if (pc < 24) dst = lds + PK_RAW + (tl * 24 + pc) * 16;
                    else if (pc < 32) dst = lds + PK_AW + tl * 144 + (pc - 24) * 16;
                    else if (pc < 40) dst = lds + PK_AZ + tl * 144 + (pc - 32) * 16;
                    else dst = lds + PK_AG + tl * 336 + (pc - 40) * 16;
                    *(LAS u32x4*)dst = pre[i];
                }
                if (it + 1 < NCH) {
#pragma unroll
                    for (int i = 0; i < 5; ++i) pre[i] = __builtin_nontemporal_load((const u32x4*)(psrc[i] + (size_t)((it + 1) * TC) * pstride[i]));
                }
            }
            __syncthreads();
#ifdef X_DUPJ2
            for (int rep_ = 0; rep_ < 2; ++rep_)
#endif
            if (it < NCH) {
                LAS unsigned char* hb = lds + (it & 1) * PK_HB;
                f32x16 acc;
                if (wid < 4) acc = lora_mma<4>(lds + (wid < 2 ? PK_AW : PK_AZ), 144, bfr, r32, hi);
                else acc = lora_mma<10>(lds + PK_AG, 336, bfr, r32, hi);
                if (wid < 2) {
                    float ew[16];
#pragma unroll
                    for (int r = 0; r < 16; ++r) ew[r] = (-0.6065306597126334f * LOG2E) * sigmoidf_(lbase + acc[r]);
                    float pf[16], tot[4], oth[4];
#pragma unroll
                    for (int m = 0; m < 4; ++m) { pf[4 * m] = ew[4 * m]; pf[4 * m + 1] = pf[4 * m] + ew[4 * m + 1]; pf[4 * m + 2] = pf[4 * m + 1] + ew[4 * m + 2]; pf[4 * m + 3] = pf[4 * m + 2] + ew[4 * m + 3]; tot[m] = pf[4 * m + 3]; }
#pragma unroll
                    for (int m = 0; m < 4; ++m) oth[m] = __shfl_xor(tot[m], 32);
                    float off = 0.f;
#pragma unroll
                    for (int m = 0; m < 4; ++m) { const float o_m = off + (hi ? oth[m] : 0.f);
#pragma unroll
                        for (int q = 0; q < 4; ++q) { const int r = 4 * m + q; CL[crow(r, hi) * 64 + 32 * lnb + r32] = o_m + pf[r]; }
                        off += tot[m] + oth[m]; }
                } else if (wid < 4) {
#pragma unroll
                    for (int r = 0; r < 16; ++r) AA[crow(r, hi) * 64 + 32 * lnb + r32] = sigmoidf_(lbase + acc[r]);
                } else {
#pragma unroll
                    for (int r = 0; r < 16; ++r) *(LAS unsigned short*)(hb + HB_GG + crow(r, hi) * 128 + (32 * lnb + r32) * 2) = (unsigned short)f2bf(acc[r]);
                }
            }
            __syncthreads();
            if (it < NCH && wid < 4) {
                LAS unsigned char* hb = lds + (it & 1) * PK_HB;
                const LAS unsigned char* rc = lds + PK_RAW + (tk * 24 + oc) * 16;
                const u32x4 cr = *(const LAS u32x4*)rc, ck = *(const LAS u32x4*)(rc + 128), cv = *(const LAS u32x4*)(rc + 256);
                u32x4 pr, pk, pv;
                if (tk > 0) { pr = *(const LAS u32x4*)(rc - 384); pk = *(const LAS u32x4*)(rc - 256); pv = *(const LAS u32x4*)(rc - 128); }
                else if (it > 0) { const LAS unsigned char* cc = lds + PK_CARRY + ((it - 1) & 1) * 384 + oc * 16; pr = *(const LAS u32x4*)cc; pk = *(const LAS u32x4*)(cc + 128); pv = *(const LAS u32x4*)(cc + 256); }
                else { pr = (u32x4){0u, 0u, 0u, 0u}; pk = pr; pv = pr; }
                if (tk == TC - 1) { LAS unsigned char* cc = lds + PK_CARRY + (it & 1) * 384 + oc * 16; *(LAS u32x4*)cc = cr; *(LAS u32x4*)(cc + 128) = ck; *(LAS u32x4*)(cc + 256) = cv; }
                f32x4 rv[2], zk[2], vv[2];
#define LERP8(dst, c, p, mx) do { const f32x4 c0_ = (f32x4){bflo(c.x), bfhi(c.x), bflo(c.y), bfhi(c.y)}, c1_ = (f32x4){bflo(c.z), bfhi(c.z), bflo(c.w), bfhi(c.w)}; \
                    const f32x4 p0_ = (f32x4){bflo(p.x), bfhi(p.x), bflo(p.y), bfhi(p.y)}, p1_ = (f32x4){bflo(p.z), bfhi(p.z), bflo(p.w), bfhi(p.w)}; \
                    dst[0] = c0_ + (p0_ - c0_) * mx[0]; dst[1] = c1_ + (p1_ - c1_) * mx[1]; } while (0)
                { const f32x4 mr_[2] = {CV(5, 0), CV(5, 1)}, mk_[2] = {CV(6, 0), CV(6, 1)}, mv_[2] = {CV(7, 0), CV(7, 1)}; LERP8(rv, cr, pr, mr_); LERP8(zk, ck, pk, mk_); LERP8(vv, cv, pv, mv_); }
#undef LERP8
                f32x4 kkv[2], kp[2], bb[2]; float ss = 0.f, bd = 0.f;
                f32x4 e1[2], e0[2], em[2], ec[2];
#pragma unroll
                for (int q = 0; q < 2; ++q) {
                    const f32x4 av = *(LAS f32x4*)(AA + tk * 64 + 8 * oc + 4 * q);
                    const f32x4 cl = *(LAS f32x4*)(CL + tk * 64 + 8 * oc + 4 * q), clc = *(LAS f32x4*)(CL + 31 * 64 + 8 * oc + 4 * q);
                    f32x4 clp = (f32x4){0.f, 0.f, 0.f, 0.f}; if (tk > 0) clp = *(LAS f32x4*)(CL + (tk - 1) * 64 + 8 * oc + 4 * q);
                    kkv[q] = zk[q] * CV(0, q);
                    ss += (kkv[q].x * kkv[q].x + kkv[q].y * kkv[q].y) + (kkv[q].z * kkv[q].z + kkv[q].w * kkv[q].w);
                    kp[q] = zk[q] * (1.0f + (av - 1.0f) * CV(1, q));
                    bb[q] = av;
                    const f32x4 t3 = rv[q] * kp[q] * CV(2, q); bd += (t3.x + t3.y) + (t3.z + t3.w);
#pragma unroll
                    for (int e = 0; e < 4; ++e) { e1[q][e] = fast_exp2(cl[e]); e0[q][e] = fast_exp2(clp[e]); em[q][e] = fast_exp2(-cl[e]); ec[q][e] = fast_exp2(clc[e] - cl[e]); }
                }
                ss = red8(ss); bd = red8(bd);
                const float inv = __builtin_amdgcn_rsqf(fmaxf(ss, 1e-24f));
                if (oc == 0) *(LAS float*)(hb + HB_BD + tk * 4) = bd;
                if (tk == 31) { *(LAS f32x4*)(hb + HB_GC + 32 * oc) = e1[0]; *(LAS f32x4*)(hb + HB_GC + 32 * oc + 16) = e1[1]; }
                u32x4 wkk, wbh, wkh, wrh, wbt, wkt, wvv;
                {
                    const f32x4 k0 = kkv[0] * inv, k1 = kkv[1] * inv, b0 = k0 * bb[0], b1 = k1 * bb[1];
                    const f32x4 kkh0 = k0 * e0[0], kkh1 = k1 * e0[1], bh0 = b0 * em[0], bh1 = b1 * em[1], kh0 = kp[0] * em[0], kh1 = kp[1] * em[1];
                    const f32x4 rh0 = rv[0] * e1[0], rh1 = rv[1] * e1[1], bt0 = b0 * ec[0], bt1 = b1 * ec[1], kt0 = kp[0] * ec[0], kt1 = kp[1] * ec[1];
                    wkk = (u32x4){cvtpk(kkh0.x, kkh0.y), cvtpk(kkh0.z, kkh0.w), cvtpk(kkh1.x, kkh1.y), cvtpk(kkh1.z, kkh1.w)};
                    wbh = (u32x4){cvtpk(bh0.x, bh0.y), cvtpk(bh0.z, bh0.w), cvtpk(bh1.x, bh1.y), cvtpk(bh1.z, bh1.w)};
                    wkh = (u32x4){cvtpk(kh0.x, kh0.y), cvtpk(kh0.z, kh0.w), cvtpk(kh1.x, kh1.y), cvtpk(kh1.z, kh1.w)};
                    wrh = (u32x4){cvtpk(rh0.x, rh0.y), cvtpk(rh0.z, rh0.w), cvtpk(rh1.x, rh1.y), cvtpk(rh1.z, rh1.w)};
                    wbt = (u32x4){cvtpk(-bt0.x, -bt0.y), cvtpk(-bt0.z, -bt0.w), cvtpk(-bt1.x, -bt1.y), cvtpk(-bt1.z, -bt1.w)};
                    wkt = (u32x4){cvtpk(kt0.x, kt0.y), cvtpk(kt0.z, kt0.w), cvtpk(kt1.x, kt1.y), cvtpk(kt1.z, kt1.w)};
                    wvv = (u32x4){cvtpk(vv[0].x, vv[0].y), cvtpk(vv[0].z, vv[0].w), cvtpk(vv[1].x, vv[1].y), cvtpk(vv[1].z, vv[1].w)};
                }
                const int ro = tk * 144 + 16 * oc, vo = (oc >> 2) * 2048 + tk * 64 + (oc & 3) * 16;
                *(LAS u32x4*)(hb + HB_RKK + ro) = wkk; *(LAS u32x4*)(hb + HB_RBH + ro) = wbh; *(LAS u32x4*)(hb + HB_RKH + ro) = wkh; *(LAS u32x4*)(hb + HB_RRH + ro) = wrh;
                *(LAS u32x4*)(hb + HB_VKK + vo) = wkk; *(LAS u32x4*)(hb + HB_VVM + vo) = wvv; *(LAS u32x4*)(hb + HB_VBT + vo) = wbt; *(LAS u32x4*)(hb + HB_VKT + vo) = wkt;
            }
            if (it >= 2 && wid >= 4) {
                const LAS float* YY = (const LAS float*)(lds + PK_YY + (it & 1) * 8192); const int t0p = (it - 2) * TC;
#pragma unroll
                for (int i2 = 0; i2 < 2; ++i2) { const int tk2 = ((tid - 256) >> 3) + 16 * i2;
                    const f32x4 y0 = *(const LAS f32x4*)(YY + tk2 * 64 + 8 * oc), y1 = *(const LAS f32x4*)(YY + tk2 * 64 + 8 * oc + 4);
                    const u32x4 gw = po_g[i2], vw = po_v[i2];
                    const f32x4 g0 = (f32x4){bflo(gw.x), bfhi(gw.x), bflo(gw.y), bfhi(gw.y)}, g1 = (f32x4){bflo(gw.z), bfhi(gw.z), bflo(gw.w), bfhi(gw.w)};
                    const f32x4 v0 = (f32x4){bflo(vw.x), bfhi(vw.x), bflo(vw.y), bfhi(vw.y)}, v1 = (f32x4){bflo(vw.z), bfhi(vw.z), bflo(vw.w), bfhi(vw.w)};
                    float s1 = ((y0.x + y0.y) + (y0.z + y0.w)) + ((y1.x + y1.y) + (y1.z + y1.w)); s1 = red8(s1);
                    const float mu = s1 * (1.f / 64.f);
                    const f32x4 d0 = y0 - mu, d1 = y1 - mu;
                    float s2 = ((d0.x * d0.x + d0.y * d0.y) + (d0.z * d0.z + d0.w * d0.w)) + ((d1.x * d1.x + d1.y * d1.y) + (d1.z * d1.z + d1.w * d1.w)); s2 = red8(s2);
                    const float rstd = __builtin_amdgcn_rsqf(s2 * (1.f / 64.f) + GN_EPS);
                    const float bd = po_bd[i2];
                    const f32x4 o0 = ((d0 * rstd) * CV(3, 0) + CV(4, 0) + v0 * bd) * g0, o1 = ((d1 * rstd) * CV(3, 1) + CV(4, 1) + v1 * bd) * g1;
                    *(u32x4*)(Yout + (rowbase + t0p + tk2) * ypitch + h * 64 + 8 * oc) = (u32x4){cvtpk(o0.x, o0.y), cvtpk(o0.z, o0.w), cvtpk(o1.x, o1.y), cvtpk(o1.z, o1.w)}; }
            }
            __syncthreads();
        }
    } else {
        const int vb = wid - 6;
        __builtin_amdgcn_s_setprio(2);
        f32x16 St0, St1;
#pragma unroll
        for (int r = 0; r < 16; ++r) { St0[r] = 0.f; St1[r] = 0.f; }
#pragma unroll 1
        for (int it = 0; it < NCH + 2; ++it) {
            const bool act = (it >= 1) && (it <= NCH);
            const LAS unsigned char* hb = lds + ((it - 1) & 1) * PK_HB;
            f32x16 Pw, Qw, R, Rt, LkT, MbT, MkT, X;
#ifdef X_DUPGRAM
            for (int rep_ = 0; rep_ < 2; ++rep_)
#endif
            if (act) {
                bf16x8 fkk[4], fbh[4], fkh[4], frh[4];
#pragma unroll
                for (int s = 0; s < 4; ++s) { const int o = r32 * 144 + (16 * s + 8 * hi) * 2;
                    fkk[s] = *(const LAS bf16x8*)(hb + HB_RKK + o); fbh[s] = *(const LAS bf16x8*)(hb + HB_RBH + o); fkh[s] = *(const LAS bf16x8*)(hb + HB_RKH + o); frh[s] = *(const LAS bf16x8*)(hb + HB_RRH + o); }
                Pw = gram_tile(fkk, fbh);  tri_mask<0>(Pw, r32, hi, 1.f);
                Qw = gram_tile(fbh, fkk);  tri_mask<1>(Qw, r32, hi, 1.f);
                LkT = gram_tile(fkh, fkk);
                MbT = gram_tile(fbh, frh);
                MkT = gram_tile(fkh, frh);
            }
            __syncthreads();
            if (act) {
#pragma unroll
                for (int r = 0; r < 16; ++r) { const float id = (crow(r, hi) == r32) ? 1.f : 0.f; R[r] = id - Pw[r]; Rt[r] = id - Qw[r]; }
                tri_mask<1>(LkT, r32, hi, 1.f); tri_mask<2>(MbT, r32, hi, -1.f); tri_mask<2>(MkT, r32, hi, 1.f);
#pragma unroll
                for (int k = 0; k < 4; ++k) {
                    const bf16x8 p0 = acc_frag(Pw, 0), p1 = acc_frag(Pw, 1), q0 = acc_frag(Qw, 0), q1 = acc_frag(Qw, 1);
                    f32x16 Pn, Qn;
#pragma unroll
                    for (int r = 0; r < 16; ++r) { Pn[r] = 0.f; Qn[r] = 0.f; }
                    Pn = MFMA32(q0, p0, Pn); Pn = MFMA32(q1, p1, Pn);
                    Qn = MFMA32(p0, q0, Qn); Qn = MFMA32(p1, q1, Qn);
                    const bf16x8 r0 = acc_frag(R, 0), r1 = acc_frag(R, 1);
                    const bf16x8 n0 = acc_frag(Qn, 0), n1 = acc_frag(Qn, 1);
                    f32x16 Rn = R, Rtn = Rt;
                    Rn = MFMA32(n0, r0, Rn);  Rn = MFMA32(n1, r1, Rn);
                    Rtn = MFMA32(r0, n0, Rtn); Rtn = MFMA32(r1, n1, Rtn);
                    R = Rn; Rt = Rtn; Pw = Pn; Qw = Qn;
                }
                { const bf16x8 v0f = b_tr(hb + HB_VVM + vb * 2048, 0, r32, hi), v1f = b_tr(hb + HB_VVM + vb * 2048, 1, r32, hi);
#pragma unroll
                  for (int r = 0; r < 16; ++r) X[r] = 0.f;
                  X = MFMA32(acc_frag(LkT, 0), v0f, X); X = MFMA32(acc_frag(LkT, 1), v1f, X); }
            }
            __syncthreads();
            if (act) {
                const bf16x8 t0f = acc_frag(Rt, 0), t1f = acc_frag(Rt, 1);
                const bf16x8 v0f = b_tr(hb + HB_VVM + vb * 2048, 0, r32, hi), v1f = b_tr(hb + HB_VVM + vb * 2048, 1, r32, hi);
                f32x16 E;
#pragma unroll
                for (int r = 0; r < 16; ++r) E[r] = 0.f;
                E = MFMA32(t0f, acc_frag(X, 0), E); E = MFMA32(t1f, acc_frag(X, 1), E);
                f32x16 G0, G1;
#pragma unroll
                for (int r = 0; r < 16; ++r) { G0[r] = 0.f; G1[r] = 0.f; }
                G0 = MFMA32(b_tr(hb + HB_VKK, 0, r32, hi), t0f, G0);        G0 = MFMA32(b_tr(hb + HB_VKK, 1, r32, hi), t1f, G0);
                G1 = MFMA32(b_tr(hb + HB_VKK + 2048, 0, r32, hi), t0f, G1); G1 = MFMA32(b_tr(hb + HB_VKK + 2048, 1, r32, hi), t1f, G1);
                const bf16x8 s00 = acc_frag(St0, 0), s01 = acc_frag(St0, 1), s10 = acc_frag(St1, 0), s11 = acc_frag(St1, 1);
                E = MFMA32(acc_frag(G0, 0), s00, E); E = MFMA32(acc_frag(G0, 1), s01, E);
                E = MFMA32(acc_frag(G1, 0), s10, E); E = MFMA32(acc_frag(G1, 1), s11, E);
                const bf16x8 e0f = acc_frag(E, 0), e1f = acc_frag(E, 1);
                f32x16 Y;
#pragma unroll
                for (int r = 0; r < 16; ++r) Y[r] = 0.f;
                Y = MFMA32(a_perm(hb + HB_RRH, 144, r32, 0, hi), s00, Y);  Y = MFMA32(a_perm(hb + HB_RRH, 144, r32, 16, hi), s01, Y);
                Y = MFMA32(a_perm(hb + HB_RRH, 144, r32, 32, hi), s10, Y); Y = MFMA32(a_perm(hb + HB_RRH, 144, r32, 48, hi), s11, Y);
                Y = MFMA32(acc_frag(MbT, 0), e0f, Y); Y = MFMA32(acc_frag(MbT, 1), e1f, Y);
                Y = MFMA32(acc_frag(MkT, 0), v0f, Y); Y = MFMA32(acc_frag(MkT, 1), v1f, Y);
                LAS float* YY = (LAS float*)(lds + PK_YY + ((it - 1) & 1) * 8192);
#pragma unroll
                for (int r = 0; r < 16; ++r) YY[crow(r, hi) * 64 + 32 * vb + r32] = Y[r];
                const LAS float* GC = (const LAS float*)(hb + HB_GC);
#pragma unroll
                for (int q = 0; q < 4; ++q) { const f32x4 g0 = *(const LAS f32x4*)(GC + 8 * q + 4 * hi), g1 = *(const LAS f32x4*)(GC + 32 + 8 * q + 4 * hi);
#pragma unroll
                    for (int e = 0; e < 4; ++e) { St0[4 * q + e] *= g0[e]; St1[4 * q + e] *= g1[e]; } }
                St0 = MFMA32(b_tr(hb + HB_VBT, 0, r32, hi), e0f, St0);        St0 = MFMA32(b_tr(hb + HB_VBT, 1, r32, hi), e1f, St0);
                St0 = MFMA32(b_tr(hb + HB_VKT, 0, r32, hi), v0f, St0);        St0 = MFMA32(b_tr(hb + HB_VKT, 1, r32, hi), v1f, St0);
                St1 = MFMA32(b_tr(hb + HB_VBT + 2048, 0, r32, hi), e0f, St1); St1 = MFMA32(b_tr(hb + HB_VBT + 2048, 1, r32, hi), e1f, St1);
                St1 = MFMA32(b_tr(hb + HB_VKT + 2048, 0, r32, hi), v0f, St1); St1 = MFMA32(b_tr(hb + HB_VKT + 2048, 1, r32, hi), v1f, St1);
            }
            __syncthreads();
        }
        __builtin_amdgcn_s_setprio(0);
    }
#undef CV
    __syncthreads();
}

__global__ void __launch_bounds__(NWAVES * 64, 2) hyb_fwd(Args args) {
    extern __shared__ __attribute__((aligned(16))) unsigned char lds_raw[];
    LAS unsigned char* lds = (LAS unsigned char*)lds_raw;
    volatile LAS unsigned* MISC = (volatile LAS unsigned*)(lds + MISC_OFF);
    const int G = gridDim.x; const int bx = blockIdx.x; const int vcu = (G % 8 == 0) ? (bx % 8) * (G / 8) + bx / 8 : bx;
    unsigned char* ws = args.ws;
    for (int u = threadIdx.x; u < (LDS_BYTES - LDSCTL_OFF) / 4; u += NWAVES * 64) ((LAS unsigned*)(lds + LDSCTL_OFF))[u] = 0u;
    __syncthreads();
    XcdBarrier bar = xcd_barrier_post((unsigned*)(ws + WS_CTL) + CW_BAR, MISC + 8);
#define GRID_BAR() xcd_barrier(bar)
    bf16_t* PQ = (bf16_t*)(ws + WS_PQ); bf16_t* PR = (bf16_t*)(ws + WS_PR);
    bf16_t* XN = (bf16_t*)args.out; bf16_t* MIXED = (bf16_t*)((unsigned char*)args.out + 64 * MiB);
    bf16_t* O1 = (bf16_t*)(ws + WS_O1); bf16_t* XN2 = (bf16_t*)(ws + WS_XN2); bf16_t* Q2 = (bf16_t*)(ws + WS_Q2); bf16_t* O2 = (bf16_t*)(ws + WS_O2);
    bf16_t* ACT = (bf16_t*)(ws + WS_ACT); bf16_t* MN = (bf16_t*)(ws + WS_MN); bf16_t* KVM = (bf16_t*)(ws + WS_KVM);
    bf16_t* XB1 = (bf16_t*)(ws + WS_ACT); bf16_t* XB2 = (bf16_t*)(ws + WS_Q2);

#define FRESH_TID() int tid = threadIdx.x; asm volatile("" : "+v"(tid)); const int lane = tid & 63, wave = __builtin_amdgcn_readfirstlane(tid >> 6); (void)lane; (void)wave
#define GEMM(Aptr, Bptr, lda_, K_, Mrows, Ncols, pair_, ...) do { pg8::Gemm g{Aptr, (const bf16_t*)(Bptr), lda_, K_}; pg8::Order S; S.init(Mrows, Ncols, G, bx, pair_); \
        const pg8::Epi E{__VA_ARGS__}; pg8::gemm_phase(lds, g, S, E); } while (0)
    { FRESH_TID(); p0_prologue(args, lds, vcu, G, wave, lane); }
    GRID_BAR();
    GEMM(XN, ws + WS_W1T, DM, DM, M, NP, 0, pg8::EPI_STORE, PQ, NPQ, 0, C_Q / 256, C_Q / 256 + 4, QS_ATT, nullptr, 1, PR, NPR, NPQ / 256, 0);
    GRID_BAR();
    GEMM(MN, ws + WS_WKVT, DM, DM, MROWS, DM, 0, pg8::EPI_STORE, KVM, DM, 0, 0, 0, 1.f, nullptr, 0, nullptr, 0, 0, 0);
    if (G > 64) { if (bx >= 64) { FRESH_TID(); lora_prep(args, PR, bx - 64, G - 64, tid); } }
    else { FRESH_TID(); lora_prep(args, PR, bx, G, tid); }
    GRID_BAR();
    for (int u = vcu; u < NB * 16; u += G) { const int b = u >> 4, h = u & 15;
        { FRESH_TID(); rwkv_head_pipe(args, PQ, PR, PQ + C_R, NPQ, b, h, lds, tid); }
#if defined(ATT_2GROUP)
        { FRESH_TID(); chunk_attention_head(PQ, PR, PQ + C_Q, NPQ, args.in[I_RELB], b, h, lds, tid); }
#elif defined(ATT_8W2T)
        { FRESH_TID(); chunk_attention_head2(PQ, PR, PQ + C_Q, NPQ, args.in[I_RELB], b, h, lds, tid); }
#else
        { FRESH_TID(); chunk_attention_head3(PQ, PR, PQ + C_Q, NPQ, args.in[I_RELB], b, h, lds, tid); }
#endif
    }
    GRID_BAR();
    GEMM(XN, ws + WS_WGT, DM, DM, M, 2048, 0, pg8::EPI_SIGMOID, PR, NPR, C_GA, 0, 0, 1.f, nullptr, 0, nullptr, 0, 0, 0);
    GRID_BAR();
    GEMM(PQ, ws + WS_WABT, NPQ, DM, M, DM, 1, pg8::EPI_MIX, MIXED, DM, 0, 0, 0, 1.f, PR, 0, nullptr, 0, 0, NPR);
    GRID_BAR();
    GEMM(MIXED, ws + WS_WOUTT, DM, DM, M, DM, 0, pg8::EPI_STORE, O1, DM, 0, 0, 0, 1.f, nullptr, 0, nullptr, 0, 0, 0);
    GRID_BAR();
    { FRESH_TID(); norm_pass<false, true>(O1, args.in[I_X], XB1, args.in[I_GPOSTMIX], args.in[I_GPRECROSS], XN2, vcu, G, wave, lane); }
    GRID_BAR();
    GEMM(XN2, ws + WS_WQT, DM, DM, M, 512, 0, pg8::EPI_STORE, Q2, 512, 0, 0, 2, QS_MEM, nullptr, 0, nullptr, 0, 0, 0);
    GRID_BAR();
    { FRESH_TID(); cross_attention(Q2, KVM, O2, lds, vcu, G, tid); }
    GRID_BAR();
    GEMM(O2, ws + WS_WOT, 512, 512, M, DM, 0, pg8::EPI_STORE, O1, DM, 0, 0, 0, 1.f, nullptr, 0, nullptr, 0, 0, 0);
    GRID_BAR();
    { FRESH_TID(); norm_pass<true, true>(O1, XB1, XB2, args.in[I_GPOSTCROSS], args.in[I_GPREFFN], XN2, vcu, G, wave, lane); }
    GRID_BAR();
    GEMM(XN2, ws + WS_WF1T, DM, DM, M, 2 * FFH, 0, pg8::EPI_SWIGLU, ACT, FFH, 0, 0, 0, 1.f, nullptr, 0, nullptr, 0, 0, 0);
    GRID_BAR();
    GEMM(ACT, ws + WS_WF2T, FFH, FFH, M, DM, 0, pg8::EPI_STORE, O1, DM, 0, 0, 0, 1.f, nullptr, 0, nullptr, 0, 0, 0);
    GRID_BAR();
    { FRESH_TID(); norm_pass<true, false>(O1, XB2, args.out, args.in[I_GPOSTFFN], nullptr, nullptr, vcu, G, wave, lane); }
}

extern "C" void kernel_launch(void* const* d_in, const int* in_sizes, int n_in, void* d_out, int out_size, void* d_ws, size_t ws_size, hipStream_t stream) {
    static int grid = 0;
    if (grid == 0) {
        if (n_in != N_IN || in_sizes[0] != M * DM || out_size != M * DM || ws_size < WS_END) {
            fprintf(stderr, "kernel_launch: unexpected shapes (n_in %d, in0 %d, out %d, ws %zu); nothing launched\n", n_in, n_in > 0 ? in_sizes[0] : -1, out_size, ws_size); grid = -1; return; }
        int dev = 0, cus = 0;
        if (hipGetDevice(&dev) != hipSuccess || hipDeviceGetAttribute(&cus, hipDeviceAttributeMultiprocessorCount, dev) != hipSuccess) { grid = -1; return; }
        if (hipFuncSetAttribute((const void*)hyb_fwd, hipFuncAttributeMaxDynamicSharedMemorySize, LDS_BYTES) != hipSuccess) { fprintf(stderr, "kernel_launch: hipFuncSetAttribute failed\n"); grid = -1; return; }
        (void)hipGetLastError();
        grid = cus;
    }
    if (grid < 0) return;
    if (hipMemsetAsync((char*)d_ws + WS_CTL, 0, CTL_ZERO_BYTES, stream) != hipSuccess) return;
    Args a{};
    for (int i = 0; i < N_IN; ++i) a.in[i] = (const float*)d_in[i];
    a.out = (float*)d_out; a.ws = (unsigned char*)d_ws;
    hipLaunchKernelGGL(hyb_fwd, dim3(grid), dim3(NWAVES * 64), LDS_BYTES, stream, a);
}
```

```cpp
#include <hip/hip_runtime.h>
#include <hip/hip_bf16.h>
#include <cstdio>
#include <cstdint>

#define LAS __attribute__((address_space(3)))
#define GAS __attribute__((address_space(1)))
typedef unsigned short bf16_t;
typedef short bf16x8 __attribute__((ext_vector_type(8)));
typedef short s16x4 __attribute__((ext_vector_type(4)));
typedef float f32x4 __attribute__((ext_vector_type(4)));
typedef float f32x2 __attribute__((ext_vector_type(2)));
typedef float f32x16 __attribute__((ext_vector_type(16)));
typedef unsigned u32x4 __attribute__((ext_vector_type(4)));
typedef unsigned u32x2 __attribute__((ext_vector_type(2)));

constexpr int NB = 16, SEQ = 2048, DM = 1024, M = NB * SEQ;
constexpr int NP = 6656;
constexpr int NPQ = 2048, C_R = 0, C_Q = 1024;
constexpr int NPR = 4608, C_K = 0, C_V = 1024, C_L = 2048, C_KA = 2560, C_VA = 3584;
constexpr int C_GA = 0, C_GB = 1024;
constexpr int FFH = 2816, MEMT = 256, MROWS = NB * MEMT;
constexpr float NORM_EPS = 1e-6f, GN_EPS = 64e-5f;
constexpr float LOG2E = 1.4426950408889634f;
constexpr float QS_ATT = 0.125f * LOG2E;
constexpr float QS_MEM = 0.08838834764831845f * LOG2E;

constexpr size_t MiB = 1u << 20;
constexpr size_t WS_CTL = 0, CTL_ZERO_BYTES = 32 * 1024;
constexpr size_t WS_W1T = 1 * MiB;
constexpr size_t WS_WGT = 14 * MiB;
constexpr size_t WS_WABT = 18 * MiB;
constexpr size_t WS_WOUTT = 22 * MiB;
constexpr size_t WS_WQT = 24 * MiB;
constexpr size_t WS_WKVT = 25 * MiB;
constexpr size_t WS_WOT = 27 * MiB;
constexpr size_t WS_WF1T = 28 * MiB;
constexpr size_t WS_WF2T = 39 * MiB;
constexpr size_t WS_DUPT = 45 * MiB;
constexpr size_t WS_IUPT = WS_DUPT + 128 * 1024;
constexpr size_t WS_GUPT = WS_IUPT + 128 * 1024;
constexpr size_t WS_PQ = 48 * MiB;
constexpr size_t WS_PR = 176 * MiB;
constexpr size_t WS_MN = 464 * MiB;
constexpr size_t WS_KVM = 472 * MiB;
constexpr size_t WS_LORA = 480 * MiB;
constexpr size_t WS_O1 = 48 * MiB;
constexpr size_t WS_XN2 = 112 * MiB;
constexpr size_t WS_Q2 = 176 * MiB;
constexpr size_t WS_O2 = 208 * MiB;
constexpr size_t WS_ACT = 240 * MiB;
constexpr size_t WS_END = 512 * MiB;
constexpr int CW_BAR = 4096;

constexpr int RING_BYTES = 131072;
constexpr int LDSCTL_OFF = RING_BYTES, MISC_OFF = LDSCTL_OFF + 320;
constexpr int LDS_BYTES = 151552;
constexpr int NWAVES = 8;

#define RLX_AGENT __ATOMIC_RELAXED, __HIP_MEMORY_SCOPE_AGENT
#define LDS_WAIT() asm volatile("s_waitcnt lgkmcnt(0)" ::: "memory")
#define VM_WAIT() asm volatile("s_waitcnt vmcnt(0)" ::: "memory")

__device__ __forceinline__ unsigned f2bf(float f) { unsigned u = __builtin_bit_cast(unsigned, f); return (u + 0x7fffu + ((u >> 16) & 1u)) >> 16; }
__device__ __forceinline__ unsigned pk2(float lo, float hi) { return f2bf(lo) | (f2bf(hi) << 16); }
__device__ __forceinline__ float bf2f(unsigned short b) { return __builtin_bit_cast(float, (unsigned)b << 16); }
__device__ __forceinline__ float bflo(unsigned w) { return __builtin_bit_cast(float, w << 16); }
__device__ __forceinline__ float bfhi(unsigned w) { return __builtin_bit_cast(float, w & 0xffff0000u); }
typedef __bf16 bf16x2_t __attribute__((ext_vector_type(2)));
__device__ __forceinline__ unsigned cvtpk(float lo, float hi) { f32x2 v = {lo, hi}; bf16x2_t b = __builtin_convertvector(v, bf16x2_t); return __builtin_bit_cast(unsigned, b); }
__device__ __forceinline__ float wave_sum(float v) {
#pragma unroll
    for (int o = 1; o < 64; o <<= 1) v += __shfl_xor(v, o);
    return v;
}
__device__ __forceinline__ float fast_exp2(float x) { return __builtin_amdgcn_exp2f(x); }
__device__ __forceinline__ float sigmoidf_(float x) { return __builtin_amdgcn_rcpf(1.0f + __builtin_amdgcn_exp2f(-x * LOG2E)); }

#define XB_TMO      128
#define XB_XCNT(j)  (256  + 64 * (j))
#define XB_XSUB(j)  (1280 + 64 * (j))
#define XB_XGEN(j)  (2304 + 64 * (j))
#define XB_TOP      3328
#define XB_TOPGEN   3392
#define XCD_BAR_WORDS 3456
#define XB_SPIN_CAP (1u << 18)
__device__ __forceinline__ unsigned xb_ld(unsigned* p)              { return __hip_atomic_load(p, __ATOMIC_RELAXED, __HIP_MEMORY_SCOPE_AGENT); }
__device__ __forceinline__ unsigned xb_add(unsigned* p, unsigned v) { return __hip_atomic_fetch_add(p, v, __ATOMIC_RELAXED, __HIP_MEMORY_SCOPE_AGENT); }
__device__ __forceinline__ unsigned xb_xcc_id() { return (unsigned)__builtin_amdgcn_s_getreg((3 << 11) | 20) & 0xFu; }
#define XB_SPIN(cond, bar) do { unsigned _sp = 0; while (cond) { __builtin_amdgcn_s_sleep(1); \
    if ((++_sp & 255u) == 0u) { if (xb_ld(&(bar)[XB_TMO])) break; if (_sp > XB_SPIN_CAP) { atomicAdd(&(bar)[XB_TMO], 1u); break; } } } } while (0)
struct XcdBarrier { unsigned* bar; unsigned x; volatile LAS unsigned* st; };
__device__ __forceinline__ XcdBarrier xcd_barrier_post(unsigned* bar, volatile LAS unsigned* st) {
    XcdBarrier b; b.bar = bar; b.x = xb_xcc_id(); b.st = st;
    if (threadIdx.x == 0) (void)xb_add(&bar[XB_XCNT(b.x)], 1u);
    return b;
}
__device__ __forceinline__ void xcd_barrier_complete(unsigned* bar, unsigned x, unsigned& nloc, unsigned& nx) {
    const unsigned G = gridDim.x * gridDim.y * gridDim.z;
    unsigned sum, cnt, mine, sp = 0u;
    for (;;) {
        sum = 0u; cnt = 0u; mine = 0u;
#pragma unroll
        for (unsigned j = 0; j < 16; ++j) { const unsigned c = xb_ld(&bar[XB_XCNT(j)]); sum += c; cnt += (c > 0u) ? 1u : 0u; mine = (j == x) ? c : mine; }
        if (sum == G) break;
        __builtin_amdgcn_s_sleep(1);
        if ((++sp & 255u) == 0u) { if (xb_ld(&bar[XB_TMO])) break; if (sp > XB_SPIN_CAP) { atomicAdd(&bar[XB_TMO], 1u); break; } }
    }
    nloc = mine > 0u ? mine : 1u; nx = cnt > 0u ? cnt : 1u;
}
__device__ __forceinline__ void xcd_barrier(const XcdBarrier& b) {
    asm volatile("s_waitcnt vmcnt(0)" ::: "memory");
    __syncthreads();
    if (threadIdx.x == 0) {
        unsigned* bar = b.bar;
        __builtin_amdgcn_s_waitcnt(0);
        unsigned nloc = b.st[0], nx = b.st[1];
        if (nloc == 0u) { xcd_barrier_complete(bar, b.x, nloc, nx); b.st[0] = nloc; b.st[1] = nx; }
        const unsigned old = xb_add(&bar[XB_XSUB(b.x)], 1u);
        const unsigned gen = old / nloc;
        if (old + 1u == (gen + 1u) * nloc) {
            __builtin_amdgcn_fence(__ATOMIC_RELEASE, "agent");
            asm volatile("s_waitcnt vmcnt(0)" ::: "memory");
            const unsigned og = xb_add(&bar[XB_TOP], 1u);
            const unsigned tg = og / nx;
            if (og + 1u == (tg + 1u) * nx) xb_add(&bar[XB_TOPGEN], 1u);
            else XB_SPIN(xb_ld(&bar[XB_TOPGEN]) == tg, bar);
            __builtin_amdgcn_fence(__ATOMIC_ACQUIRE, "agent");
            xb_add(&bar[XB_XGEN(b.x)], 1u);
            asm volatile("s_waitcnt vmcnt(0)" ::: "memory");
        } else {
            XB_SPIN(xb_ld(&bar[XB_XGEN(b.x)]) == gen, bar);
            __builtin_amdgcn_fence(__ATOMIC_ACQUIRE, "agent");
            asm volatile("s_waitcnt vmcnt(0)" ::: "memory");
        }
    }
    __syncthreads();
}

namespace pg8 {
constexpr int BM = 256, BK = 64, HALF = 128, HTB = HALF * BK * 2, STAGE_BYTES = 8 * HTB, NXCD = 8, WGM = 4;
__host__ __device__ __forceinline__ int lds_byte(int r, int c) { const int st = (r >> 4) * 2 + (c >> 5), rr = r & 15, cc = c & 31, ob = rr * 64 + cc * 2; return st * 1024 + (ob ^ (((ob >> 9) & 1) << 5)); }
__host__ __device__ __forceinline__ void stage_rc(int b, int& R, int& C) { const int st = b / 1024, sb = b % 1024, swz = sb ^ (((sb >> 9) & 1) << 5); R = (st >> 1) * 16 + swz / 64; C = (st & 1) * 32 + (swz % 64) / 2; }
__host__ __device__ __forceinline__ int perm32(int rho) { const int n = rho >> 4, i = rho & 15; return 8 * (i >> 2) + 4 * n + (i & 3); }

struct Unit { int pm, pn, ac; };
struct Gemm { const bf16_t* A; const bf16_t* Bt; int lda, K; };

__device__ __forceinline__ void tile_of(int wgid0, int nM, int nN, int& pm, int& pn) {
    const int nwg = nM * nN; int wgid = wgid0;
    { const int q = nwg / NXCD, r = nwg % NXCD, xcd = wgid % NXCD, off = wgid / NXCD; wgid = (xcd < r ? xcd * (q + 1) : r * (q + 1) + (xcd - r) * q) + off; }
    const int nig = WGM * nN, gid = wgid / nig, fm = gid * WGM, gsz = (nM - fm) < WGM ? (nM - fm) : WGM;
    pm = fm + ((wgid % nig) % gsz); pn = (wgid % nig) / gsz;
}
#define EPI_FOR_ROWS for (int ai = 0; ai < 2; ++ai) _Pragma("unroll") for (int m = 0; m < 4; ++m)
enum { EPI_STORE = 0, EPI_SIGMOID = 1, EPI_MIX = 2, EPI_SWIGLU = 3 };
struct Epi {
    int type; bf16_t* O; int ldc; int coff; int s_lo, s_hi; float scale; const bf16_t* P; int nt; bf16_t* O2; int ldc2; int split; int pld;
    __device__ __forceinline__ void operator()(const f32x4 (&acc)[2][2][4][2], const Unit& u, int wr, int wc, int fr, int fq) const {
        const int row0 = u.pm * BM + wr * 64 + fr;
        if (type == EPI_STORE || type == EPI_SIGMOID) {
            const float sc = (u.pn >= s_lo && u.pn < s_hi) ? scale : 1.f;
            const bool hi2 = (split > 0) && (u.pn >= split); bf16_t* const Ob = hi2 ? O2 : O; const int ldo = hi2 ? ldc2 : ldc;
            const int col0 = coff + (hi2 ? u.pn - split : u.pn) * BM + wc * 32 + 8 * fq; const bool sg = (type == EPI_SIGMOID);
#pragma unroll
            EPI_FOR_ROWS { bf16_t* rowp = Ob + (size_t)(row0 + ai * HALF + m * 16) * ldo + col0;
#pragma unroll
                for (int bj = 0; bj < 2; ++bj) { f32x4 v0 = acc[ai][bj][m][0] * sc, v1 = acc[ai][bj][m][1] * sc;
                    if (sg) {
#pragma unroll
                        for (int e = 0; e < 4; ++e) { v0[e] = sigmoidf_(v0[e]); v1[e] = sigmoidf_(v1[e]); } }
                    u32x4 w; w.x = cvtpk(v0[0], v0[1]); w.y = cvtpk(v0[2], v0[3]); w.z = cvtpk(v1[0], v1[1]); w.w = cvtpk(v1[2], v1[3]);
                    if (nt) __builtin_nontemporal_store(w, (u32x4*)(rowp + bj * HALF)); else *(u32x4*)(rowp + bj * HALF) = w; } }
        } else if (type == EPI_MIX) {
            const int pn = u.pn & 3;
            const int col0 = pn * BM + wc * 32 + 8 * fq;
            const int gcol = C_GB + col0;
#pragma unroll
            for (int ai = 0; ai < 2; ++ai) {
                u32x4 gv[4][2];
#pragma unroll
                for (int m = 0; m < 4; ++m)
#pragma unroll
                    for (int bj = 0; bj < 2; ++bj) gv[m][bj] = *(const u32x4*)(P + (size_t)(row0 + ai * HALF + m * 16) * pld + gcol + bj * HALF);
#pragma unroll
                for (int m = 0; m < 4; ++m)
#pragma unroll
                    for (int bj = 0; bj < 2; ++bj) { const size_t row = (size_t)(row0 + ai * HALF + m * 16);
                        const u32x4 g = gv[m][bj];
                        f32x4 v0 = acc[ai][bj][m][0], v1 = acc[ai][bj][m][1];
                        v0[0] *= bflo(g.x); v0[1] *= bfhi(g.x); v0[2] *= bflo(g.y); v0[3] *= bfhi(g.y);
                        v1[0] *= bflo(g.z); v1[1] *= bfhi(g.z); v1[2] *= bflo(g.w); v1[3] *= bfhi(g.w);
                        u32x4 w; w.x = cvtpk(v0[0], v0[1]); w.y = cvtpk(v0[2], v0[3]); w.z = cvtpk(v1[0], v1[1]); w.w = cvtpk(v1[2], v1[3]);
                        *(u32x4*)(O + row * ldc + col0 + bj * HALF) = w; }
            }
        } else {
            const int col0 = u.pn * HALF + wc * 32 + 8 * fq;
#pragma unroll
            EPI_FOR_ROWS { bf16_t* rowp = O + (size_t)(row0 + ai * HALF + m * 16) * ldc + col0;
                f32x4 v0 = acc[ai][0][m][0], v1 = acc[ai][0][m][1]; const f32x4 u0 = acc[ai][1][m][0], u1 = acc[ai][1][m][1];
#pragma unroll
                for (int e = 0; e < 4; ++e) { v0[e] = v0[e] * sigmoidf_(v0[e]) * u0[e]; v1[e] = v1[e] * sigmoidf_(v1[e]) * u1[e]; }
                u32x4 w; w.x = cvtpk(v0[0], v0[1]); w.y = cvtpk(v0[2], v0[3]); w.z = cvtpk(v1[0], v1[1]); w.w = cvtpk(v1[2], v1[3]);
                *(u32x4*)rowp = w; }
        }
    }
    __device__ __forceinline__ bool keep(const Unit& u) const { return type == EPI_MIX && (u.pn >> 2) == 0; }
    __device__ __forceinline__ void scale_keep(f32x4 (&acc)[2][2][4][2], const Unit& u, int wr, int wc, int fr, int fq) const {
        const int row0 = u.pm * BM + wr * 64 + fr, col0 = (u.pn & 3) * BM + wc * 32 + 8 * fq;
#pragma unroll
        for (int ai = 0; ai < 2; ++ai) {
            u32x4 ga[4][2], gb[4][2];
#pragma unroll
            for (int m = 0; m < 4; ++m)
#pragma unroll
                for (int bj = 0; bj < 2; ++bj) { const bf16_t* gp = P + (size_t)(row0 + ai * HALF + m * 16) * pld + col0 + bj * HALF; ga[m][bj] = *(const u32x4*)(gp + C_GA); gb[m][bj] = *(const u32x4*)(gp + C_GB); }
#pragma unroll
            for (int m = 0; m < 4; ++m)
#pragma unroll
                for (int bj = 0; bj < 2; ++bj) { const u32x4 a = ga[m][bj], b = gb[m][bj];
                    f32x4& v0 = acc[ai][bj][m][0]; f32x4& v1 = acc[ai][bj][m][1];
                    v0[0] *= bflo(a.x) * __builtin_amdgcn_rcpf(bflo(b.x)); v0[1] *= bfhi(a.x) * __builtin_amdgcn_rcpf(bfhi(b.x)); v0[2] *= bflo(a.y) * __builtin_amdgcn_rcpf(bflo(b.y)); v0[3] *= bfhi(a.y) * __builtin_amdgcn_rcpf(bfhi(b.y));
                    v1[0] *= bflo(a.z) * __builtin_amdgcn_rcpf(bflo(b.z)); v1[1] *= bfhi(a.z) * __builtin_amdgcn_rcpf(bfhi(b.z)); v1[2] *= bflo(a.w) * __builtin_amdgcn_rcpf(bflo(b.w)); v1[3] *= bfhi(a.w) * __builtin_amdgcn_rcpf(bfhi(b.w)); }
        }
    }
};
struct Order {
    int nM, nN, nwg, G, c, pair;
    __device__ __forceinline__ void init(int M_, int N_, int G_, int c_, int pair_) { nM = M_ / BM; nN = N_ / BM; nwg = nM * nN; G = G_; c = c_; pair = pair_; }
    __device__ __forceinline__ bool next(int i, Unit& u) const {
        const int ii = pair ? (i >> 1) : i;
        const long L = (long)ii * G + c; if (L >= nwg) return false;
        int pn; tile_of((int)L, nM, nN, u.pm, pn);
        const int half = pair ? (i & 1) : 0; u.pn = half * nN + pn; u.ac = half * 1024; return true;
    }
};

__device__ __forceinline__ void gemm_phase(LAS unsigned char* lds, const Gemm& g, const Order& S, const Epi& E) {
    int tid = threadIdx.x; asm volatile("" : "+v"(tid));
    const int wid = __builtin_amdgcn_readfirstlane(tid >> 6), lane = tid & 63, wr = wid >> 2, wc = wid & 3, fr = lane & 15, fq = lane >> 4;
    const int K = g.K, lda = g.lda, nt = K / BK;
    unsigned voffA[2], voffB[2];
#pragma unroll
    for (int i = 0; i < 2; ++i) { int R, C; stage_rc(tid * 16 + i * 8192, R, C); const int Rb = (R & ~31) + perm32(R & 31);
        voffA[i] = (unsigned)(R * lda + C) * 2u; voffB[i] = (unsigned)(Rb * K + C) * 2u; }
    const size_t kstep = (size_t)(BK * 2);
    const size_t hstepA = (size_t)HALF * lda * 2, hstepB = (size_t)HALF * K * 2;
    const size_t tstepA = 2 * hstepA, tstepB = 2 * hstepB;
    const unsigned ldsw = (unsigned)wid * 1024u;
    const int aoff = lds_byte(wr * 64 + fr, fq * 8), boff = lds_byte(wc * 32 + fr, fq * 8);
#define PG8_SA(b, h) (((b) * 2 + (h)) * HTB)
#define PG8_SB(b, h) ((4 + (b) * 2 + (h)) * HTB)
#define PG8_STAGE(bufoff, gbase, voff) do { _Pragma("unroll") for (int _i = 0; _i < 2; ++_i) \
        __builtin_amdgcn_global_load_lds((const unsigned*)((const char*)(gbase) + (voff)[_i]), (LAS unsigned*)(lds + (bufoff) + ldsw + _i * 8192), 16, 0, 0); } while (0)
#define PG8_LDA(dst, b, h) do { _Pragma("unroll") for (int m = 0; m < 4; ++m) _Pragma("unroll") for (int k = 0; k < 2; ++k) dst[m][k] = *(const LAS bf16x8*)(lds + PG8_SA(b, h) + aoff + m * 2048 + k * 1024); } while (0)
#define PG8_LDB(dst, b, h) do { _Pragma("unroll") for (int n = 0; n < 2; ++n) _Pragma("unroll") for (int k = 0; k < 2; ++k) dst[n][k] = *(const LAS bf16x8*)(lds + PG8_SB(b, h) + boff + n * 2048 + k * 1024); } while (0)
#define PG8_MMA(ai, bj, At, Bt) do { __builtin_amdgcn_s_setprio(1); _Pragma("unroll") for (int m = 0; m < 4; ++m) _Pragma("unroll") for (int n = 0; n < 2; ++n) _Pragma("unroll") for (int k = 0; k < 2; ++k) \
        acc[ai][bj][m][n] = __builtin_amdgcn_mfma_f32_16x16x32_bf16(Bt[n][k], At[m][k], acc[ai][bj][m][n], 0, 0, 0); __builtin_amdgcn_s_setprio(0); } while (0)
#define PG8_WAIT_V(n) asm volatile("s_waitcnt vmcnt(" #n ")" ::: "memory")
#define PG8_WAIT_L(n) asm volatile("s_waitcnt lgkmcnt(" #n ")" ::: "memory")
#define PG8_BAR __builtin_amdgcn_s_barrier()
#define PG8_SCHED __builtin_amdgcn_sched_barrier(0)
    Unit cur, nxt; int ui = 0;
    if (!S.next(0, cur)) return;
    f32x4 acc[2][2][4][2];
#pragma unroll
    for (int a = 0; a < 2; ++a)
#pragma unroll
        for (int b = 0; b < 2; ++b)
#pragma unroll
            for (int m = 0; m < 4; ++m)
#pragma unroll
                for (int n = 0; n < 2; ++n) acc[a][b][m][n] = (f32x4){0.f, 0.f, 0.f, 0.f};
    bf16x8 At[4][2], B0[2][2], B1[2][2];
    const char* cA = (const char*)g.A + (size_t)cur.pm * tstepA + (size_t)cur.ac * 2; const char* cB = (const char*)g.Bt + (size_t)cur.pn * tstepB;
    PG8_STAGE(PG8_SB(0, 0), cB, voffB); PG8_STAGE(PG8_SB(0, 1), cB + hstepB, voffB); PG8_STAGE(PG8_SA(0, 0), cA, voffA); PG8_STAGE(PG8_SA(0, 1), cA + hstepA, voffA);
    if (wr == 1) PG8_BAR;
    PG8_WAIT_V(2); PG8_BAR;
    PG8_STAGE(PG8_SB(1, 0), cB + kstep, voffB); PG8_STAGE(PG8_SA(1, 0), cA + kstep, voffA); PG8_STAGE(PG8_SB(1, 1), cB + hstepB + kstep, voffB);
    PG8_WAIT_V(6); PG8_BAR;
    for (;;) {
        const bool has_next = S.next(ui + 1, nxt);
        const char* nA = has_next ? (const char*)g.A + (size_t)nxt.pm * tstepA + (size_t)nxt.ac * 2 : cA; const char* nB = has_next ? (const char*)g.Bt + (size_t)nxt.pn * tstepB : cB;
        for (int t = 0; t < nt; t += 2) {
            const bool last = (t == nt - 2);
            const char* a1 = cA + (size_t)(t + 1) * kstep;
            const char* a2 = last ? nA : cA + (size_t)(t + 2) * kstep; const char* b2 = last ? nB : cB + (size_t)(t + 2) * kstep;
            const char* a3 = a2 + kstep; const char* b3 = b2 + kstep;
            PG8_LDB(B0, 0, 0); PG8_LDB(B1, 0, 1); PG8_SCHED; PG8_LDA(At, 0, 0); PG8_STAGE(PG8_SA(1, 1), a1 + hstepA, voffA);
            PG8_WAIT_V(8); PG8_WAIT_L(0); PG8_BAR; PG8_MMA(0, 0, At, B0); PG8_MMA(0, 1, At, B1); PG8_BAR; PG8_SCHED;
            PG8_LDA(At, 0, 1); PG8_STAGE(PG8_SB(0, 0), b2, voffB); PG8_STAGE(PG8_SB(0, 1), b2 + hstepB, voffB); PG8_STAGE(PG8_SA(0, 0), a2, voffA);
            PG8_WAIT_V(8); PG8_WAIT_L(0); PG8_BAR; PG8_MMA(1, 0, At, B0); PG8_MMA(1, 1, At, B1); PG8_BAR; PG8_SCHED;
            PG8_LDB(B0, 1, 0); PG8_LDB(B1, 1, 1); PG8_SCHED; PG8_LDA(At, 1, 0); PG8_STAGE(PG8_SA(0, 1), a2 + hstepA, voffA);
            PG8_WAIT_V(8); PG8_WAIT_L(0); PG8_BAR; PG8_MMA(0, 0, At, B0); PG8_MMA(0, 1, At, B1); PG8_BAR; PG8_SCHED;
            PG8_LDA(At, 1, 1); PG8_STAGE(PG8_SB(1, 0), b3, voffB); PG8_STAGE(PG8_SB(1, 1), b3 + hstepB, voffB); PG8_STAGE(PG8_SA(1, 0), a3, voffA);
            PG8_WAIT_V(8); PG8_WAIT_L(0); PG8_BAR; PG8_MMA(1, 0, At, B0); PG8_MMA(1, 1, At, B1); PG8_BAR; PG8_SCHED;
        }
        if (wr == 0) PG8_BAR;
        const bool keep_acc = E.keep(cur);
        if (keep_acc) E.scale_keep(acc, cur, wr, wc, fr, fq); else E(acc, cur, wr, wc, fr, fq);
        if (!has_next) break;
        if (!keep_acc)
#pragma unroll
        for (int a = 0; a < 2; ++a)
#pragma unroll
            for (int b = 0; b < 2; ++b)
#pragma unroll
                for (int m = 0; m < 4; ++m)
#pragma unroll
                    for (int n = 0; n < 2; ++n) acc[a][b][m][n] = (f32x4){0.f, 0.f, 0.f, 0.f};
        cur = nxt; cA = nA; cB = nB; ++ui;
        if (wr == 1) PG8_BAR;
    }
    PG8_WAIT_V(0);
    PG8_BAR;
#undef PG8_SA
#undef PG8_SB
#undef PG8_STAGE
#undef PG8_LDA
#undef PG8_LDB
#undef PG8_MMA
#undef PG8_WAIT_V
#undef PG8_WAIT_L
#undef PG8_BAR
#undef PG8_SCHED
}
}

enum { I_X = 0, I_MEM, I_GPREMIX, I_GPOSTMIX, I_WIN, I_SHIFT, I_DBASE, I_DUP, I_IBASE, I_IUP, I_GUP, I_KNS, I_KIS, I_BONUS, I_LNW, I_LNB, I_RELB,
       I_WA, I_WB, I_WOUT, I_GPRECROSS, I_GPOSTCROSS, I_GMEM, I_WQM, I_WKVM, I_WOM, I_GPREFFN, I_GPOSTFFN, I_WF1, I_WF2, N_IN };
struct Args { const float* in[N_IN]; float* out; unsigned char* ws; };

__device__ __forceinline__ void p0_transpose_item(const float* W, int ldsrc, int K, int col0, bf16_t* WT, int dld, int drow0, int k0, LAS float* scr, int lane) {
    float tv[32];
#pragma unroll
    for (int i = 0; i < 32; ++i) { const int kk = 2 * i + (lane >> 5); const int k = k0 + kk;
        tv[i] = (k < K) ? __builtin_nontemporal_load(W + (size_t)k * ldsrc + col0 + (lane & 31)) : 0.f; }
#pragma unroll
    for (int i = 0; i < 32; ++i) { const int kk = 2 * i + (lane >> 5); scr[kk * 33 + (lane & 31)] = tv[i]; }
    LDS_WAIT(); asm volatile("" ::: "memory");
    const int c = lane & 7;
    if (k0 + 8 * c < K) {
#pragma unroll
        for (int j = 0; j < 4; ++j) { const int n = (lane >> 3) + 8 * j; const LAS float* s = scr + (8 * c) * 33 + n;
            u32x4 o; o.x = pk2(s[0 * 33], s[1 * 33]); o.y = pk2(s[2 * 33], s[3 * 33]); o.z = pk2(s[4 * 33], s[5 * 33]); o.w = pk2(s[6 * 33], s[7 * 33]);
            *(u32x4*)(WT + (size_t)(drow0 + n) * dld + k0 + 8 * c) = o; }
    }
    LDS_WAIT(); asm volatile("" ::: "memory");
}
constexpr int NJOBS = 19;
__device__ __forceinline__ void job_desc(const Args& a, int j, const float*& src, int& ld, int& K, int& col0, int& ncols, size_t& dst, int& drow0, int& mode) {
    mode = 0;
    switch (j) {
    case 0:  src = a.in[I_WIN]; ld = 8480; K = 1024; col0 = 0;    ncols = 1024; dst = WS_W1T; drow0 = 0; break;
    case 1:  src = a.in[I_WIN]; ld = 8480; K = 1024; col0 = 3360; ncols = 1024; dst = WS_W1T; drow0 = 1024; break;
    case 2:  src = a.in[I_WIN]; ld = 8480; K = 1024; col0 = 1024; ncols = 1024; dst = WS_W1T; drow0 = 2048; break;
    case 3:  src = a.in[I_WIN]; ld = 8480; K = 1024; col0 = 2048; ncols = 1024; dst = WS_W1T; drow0 = 3072; break;
    case 4:  src = a.in[I_WIN]; ld = 8480; K = 1024; col0 = 3072; ncols = 288;  dst = WS_W1T; drow0 = 4096; break;
    case 5:  src = a.in[I_WIN]; ld = 8480; K = 1024; col0 = 4384; ncols = 1024; dst = WS_W1T; drow0 = 4608; break;
    case 6:  src = a.in[I_WIN]; ld = 8480; K = 1024; col0 = 5408; ncols = 1024; dst = WS_W1T; drow0 = 5632; break;
    case 7:  src = a.in[I_WIN]; ld = 8480; K = 1024; col0 = 6432; ncols = 2048; dst = WS_WGT; drow0 = 0; break;
    case 8:  src = a.in[I_WA];  ld = 1024; K = 1024; col0 = 0; ncols = 1024; dst = WS_WABT; drow0 = 0; break;
    case 9:  src = a.in[I_WB];  ld = 1024; K = 1024; col0 = 0; ncols = 1024; dst = WS_WABT; drow0 = 1024; break;
    case 10: src = a.in[I_WOUT]; ld = 1024; K = 1024; col0 = 0; ncols = 1024; dst = WS_WOUTT; drow0 = 0; break;
    case 11: src = a.in[I_WQM]; ld = 512;  K = 1024; col0 = 0; ncols = 512;  dst = WS_WQT; drow0 = 0; break;
    case 12: src = a.in[I_WKVM]; ld = 1024; K = 1024; col0 = 0; ncols = 1024; dst = WS_WKVT; drow0 = 0; break;
    case 13: src = a.in[I_WOM]; ld = 1024; K = 512;  col0 = 0; ncols = 1024; dst = WS_WOT; drow0 = 0; break;
    case 14: src = a.in[I_WF1]; ld = 5632; K = 1024; col0 = 0; ncols = 5632; dst = WS_WF1T; drow0 = 0; mode = 1; break;
    case 15: src = a.in[I_WF2]; ld = 1024; K = 2816; col0 = 0; ncols = 1024; dst = WS_WF2T; drow0 = 0; break;
    case 16: src = a.in[I_DUP]; ld = 1024; K = 64;   col0 = 0; ncols = 1024; dst = WS_DUPT; drow0 = 0; break;
    case 17: src = a.in[I_IUP]; ld = 1024; K = 64;   col0 = 0; ncols = 1024; dst = WS_IUPT; drow0 = 0; break;
    default: src = a.in[I_GUP]; ld = 1024; K = 160;  col0 = 0; ncols = 1024; dst = WS_GUPT; drow0 = 0; break;
    }
}
__device__ __forceinline__ void rms_row_to_bf16(const float* xrow, const float* gain, bf16_t* orow, int lane) {
    const f32x4* xr = (const f32x4*)xrow + lane; const f32x4* gr = (const f32x4*)gain + lane;
    f32x4 v[4]; float s = 0.f;
#pragma unroll
    for (int j = 0; j < 4; ++j) { v[j] = xr[64 * j]; s += (v[j].x * v[j].x + v[j].y * v[j].y) + (v[j].z * v[j].z + v[j].w * v[j].w); }
    const float rs = 1.0f / sqrtf(wave_sum(s) * (1.f / DM) + NORM_EPS);
    u32x2* o8 = (u32x2*)orow + lane;
#pragma unroll
    for (int j = 0; j < 4; ++j) { const f32x4 g = gr[64 * j]; u32x2 w; w.x = cvtpk(v[j].x * rs * g.x, v[j].y * rs * g.y); w.y = cvtpk(v[j].z * rs * g.z, v[j].w * rs * g.w); o8[64 * j] = w; }
}
__device__ __forceinline__ void rms_row2_to_bf16(const float* xa, const float* xb, const float* gain, bf16_t* oa, bf16_t* ob, int lane) {
    const f32x4* xr0 = (const f32x4*)xa + lane; const f32x4* xr1 = (const f32x4*)xb + lane; const f32x4* gr = (const f32x4*)gain + lane;
    f32x4 v0[4], v1[4]; float s0 = 0.f, s1 = 0.f;
#pragma unroll
    for (int j = 0; j < 4; ++j) { v0[j] = __builtin_nontemporal_load(xr0 + 64 * j); v1[j] = __builtin_nontemporal_load(xr1 + 64 * j); }
#pragma unroll
    for (int j = 0; j < 4; ++j) { s0 += (v0[j].x * v0[j].x + v0[j].y * v0[j].y) + (v0[j].z * v0[j].z + v0[j].w * v0[j].w); s1 += (v1[j].x * v1[j].x + v1[j].y * v1[j].y) + (v1[j].z * v1[j].z + v1[j].w * v1[j].w); }
    const float rs0 = __builtin_amdgcn_rsqf(wave_sum(s0) * (1.f / DM) + NORM_EPS), rs1 = __builtin_amdgcn_rsqf(wave_sum(s1) * (1.f / DM) + NORM_EPS);
    u32x2* o0 = (u32x2*)oa + lane; u32x2* o1 = (u32x2*)ob + lane;
#pragma unroll
    for (int j = 0; j < 4; ++j) { const f32x4 g = gr[64 * j]; u32x2 w;
        w.x = cvtpk(v0[j].x * rs0 * g.x, v0[j].y * rs0 * g.y); w.y = cvtpk(v0[j].z * rs0 * g.z, v0[j].w * rs0 * g.w); o0[64 * j] = w;
        w.x = cvtpk(v1[j].x * rs1 * g.x, v1[j].y * rs1 * g.y); w.y = cvtpk(v1[j].z * rs1 * g.z, v1[j].w * rs1 * g.w); o1[64 * j] = w; }
}
__device__ __forceinline__ void p0_prologue(const Args& a, LAS unsigned char* lds, int vcu, int G, int wave, int lane) {
    LAS float* scr = (LAS float*)(lds + wave * 16384);
    const int gw = vcu * NWAVES + wave, NGW = G * NWAVES;
    int total = 0;
    for (int j = 0; j < NJOBS; ++j) { int ld, K, col0, ncols, drow0, mode; size_t dst; const float* src; job_desc(a, j, src, ld, K, col0, ncols, dst, drow0, mode); total += ((K + 63) / 64) * (ncols / 32); }
    for (int it = gw; it < total; it += NGW) {
        int r = it;
        for (int j = 0; j < NJOBS; ++j) {
            int ld, K, col0, ncols, drow0, mode; size_t dst; const float* src; job_desc(a, j, src, ld, K, col0, ncols, dst, drow0, mode);
            const int nblk = ncols / 32, cnt = ((K + 63) / 64) * nblk;
            if (r < cnt) {
                const int kb = r / nblk, nb = r % nblk; int n0 = 32 * nb; int drow = drow0 + n0;
                if (mode == 1) { const int up = n0 >= FFH ? 1 : 0; const int nn = n0 - up * FFH; drow = 256 * (nn / 128) + 128 * up + (nn % 128); }
                p0_transpose_item(src, ld, K, col0 + n0, (bf16_t*)(a.ws + dst), K, drow, 64 * kb, scr, lane);
                break;
            }
            r -= cnt;
        }
    }
    { u32x4* z = (u32x4*)(a.ws + WS_W1T + (size_t)4384 * 1024 * 2); const int n16 = 224 * 1024 * 2 / 16;
      for (int i = gw * 64 + lane; i < n16; i += NGW * 64) z[i] = (u32x4){0u, 0u, 0u, 0u}; }
    bf16_t* XN = (bf16_t*)a.out; bf16_t* MN = (bf16_t*)(a.ws + WS_MN);
    for (int m = gw; m < M; m += 2 * NGW) rms_row2_to_bf16(a.in[I_X] + (size_t)m * DM, a.in[I_X] + (size_t)(m + NGW) * DM, a.in[I_GPREMIX], XN + (size_t)m * DM, XN + (size_t)(m + NGW) * DM, lane);
    for (int m = gw; m < MROWS; m += NGW) rms_row_to_bf16(a.in[I_MEM] + (size_t)m * DM, a.in[I_GMEM], MN + (size_t)m * DM, lane);
}

template <bool XIB, bool XOB>
__device__ __forceinline__ void norm_pass(const bf16_t* O, const void* xres_, void* xout_, const float* g1, const float* g2, bf16_t* hn, int vcu, int G, int wave, int lane) {
    const int gw = vcu * NWAVES + wave, NGW = G * NWAVES;
    for (int m0 = gw; m0 < M; m0 += 2 * NGW) {
        f32x4 ov[2][4], xv[2][4]; float s[2] = {0.f, 0.f};
#pragma unroll
        for (int q = 0; q < 2; ++q) { const size_t m = (size_t)m0 + (size_t)q * NGW;
            const u32x2* orow = (const u32x2*)(O + m * DM) + lane;
#pragma unroll
            for (int j = 0; j < 4; ++j) { const u32x2 w = __builtin_nontemporal_load(orow + 64 * j); ov[q][j] = (f32x4){bflo(w.x), bfhi(w.x), bflo(w.y), bfhi(w.y)};
                if (XIB) { const u32x2 xw = __builtin_nontemporal_load((const u32x2*)((const bf16_t*)xres_ + m * DM) + lane + 64 * j); xv[q][j] = (f32x4){bflo(xw.x), bfhi(xw.x), bflo(xw.y), bfhi(xw.y)}; }
                else xv[q][j] = __builtin_nontemporal_load((const f32x4*)((const float*)xres_ + m * DM) + lane + 64 * j); } }
#pragma unroll
        for (int q = 0; q < 2; ++q)
#pragma unroll
            for (int j = 0; j < 4; ++j) s[q] += (ov[q][j].x * ov[q][j].x + ov[q][j].y * ov[q][j].y) + (ov[q][j].z * ov[q][j].z + ov[q][j].w * ov[q][j].w);
        const float rs[2] = {__builtin_amdgcn_rsqf(wave_sum(s[0]) * (1.f / DM) + NORM_EPS), __builtin_amdgcn_rsqf(wave_sum(s[1]) * (1.f / DM) + NORM_EPS)};
        float s2[2] = {0.f, 0.f};
#pragma unroll
        for (int q = 0; q < 2; ++q) { const size_t m = (size_t)m0 + (size_t)q * NGW;
#pragma unroll
            for (int j = 0; j < 4; ++j) { const f32x4 g = ((const f32x4*)g1 + lane)[64 * j]; xv[q][j] = xv[q][j] + ov[q][j] * rs[q] * g;
                if (XOB) { u32x2 w; w.x = cvtpk(xv[q][j].x, xv[q][j].y); w.y = cvtpk(xv[q][j].z, xv[q][j].w); __builtin_nontemporal_store(w, (u32x2*)((bf16_t*)xout_ + m * DM) + lane + 64 * j); }
                else __builtin_nontemporal_store(xv[q][j], (f32x4*)((float*)xout_ + m * DM) + lane + 64 * j);
                s2[q] += (xv[q][j].x * xv[q][j].x + xv[q][j].y * xv[q][j].y) + (xv[q][j].z * xv[q][j].z + xv[q][j].w * xv[q][j].w); } }
        if (hn) {
            const float r2[2] = {__builtin_amdgcn_rsqf(wave_sum(s2[0]) * (1.f / DM) + NORM_EPS), __builtin_amdgcn_rsqf(wave_sum(s2[1]) * (1.f / DM) + NORM_EPS)};
#pragma unroll
            for (int q = 0; q < 2; ++q) { const size_t m = (size_t)m0 + (size_t)q * NGW; u32x2* ho = (u32x2*)(hn + m * DM) + lane;
#pragma unroll
                for (int j = 0; j < 4; ++j) { const f32x4 g = ((const f32x4*)g2 + lane)[64 * j]; u32x2 w; w.x = cvtpk(xv[q][j].x * r2[q] * g.x, xv[q][j].y * r2[q] * g.y); w.y = cvtpk(xv[q][j].z * r2[q] * g.z, xv[q][j].w * r2[q] * g.w); ho[64 * j] = w; } }
        }
    }
}

__device__ __forceinline__ int crow(int r, int hi) { return (r & 3) + 8 * (r >> 2) + 4 * hi; }
typedef short v4i16_t __attribute__((ext_vector_type(4)));
__device__ __forceinline__ s16x4 vtr(const LAS unsigned char* p) { return __builtin_bit_cast(s16x4, __builtin_amdgcn_ds_read_tr16_b64_v4i16((LAS v4i16_t*)p)); }

template <int D, class BiasF>
__device__ __forceinline__ void attn_qk(const LAS unsigned char* Kb, const bf16x8 (&qr)[D / 16], float m_run, f32x16& p0, f32x16& p1, float& mx, int r32, int hi, const BiasF& biasf) {
    const LAS unsigned char* kb = Kb + hi * 1024 + r32 * 16;
    if (biasf.uniform()) {
        f32x16 ci; const float c = biasf.uval() - m_run;
#pragma unroll
        for (int r = 0; r < 16; ++r) ci[r] = c;
        p0 = __builtin_amdgcn_mfma_f32_32x32x16_bf16(*(const LAS bf16x8*)(kb), qr[0], ci, 0, 0, 0);
        p1 = __builtin_amdgcn_mfma_f32_32x32x16_bf16(*(const LAS bf16x8*)(kb + 512), qr[0], ci, 0, 0, 0);
    } else {
#pragma unroll
        for (int r = 0; r < 16; ++r) { p0[r] = biasf(crow(r, hi)) - m_run; p1[r] = biasf(crow(r, hi) + 32) - m_run; }
        p0 = __builtin_amdgcn_mfma_f32_32x32x16_bf16(*(const LAS bf16x8*)(kb), qr[0], p0, 0, 0, 0);
        p1 = __builtin_amdgcn_mfma_f32_32x32x16_bf16(*(const LAS bf16x8*)(kb + 512), qr[0], p1, 0, 0, 0);
    }
#pragma unroll
    for (int d0 = 1; d0 < D / 16; ++d0) {
        const bf16x8 b0 = *(const LAS bf16x8*)(kb + d0 * 2048);
        const bf16x8 b1 = *(const LAS bf16x8*)(kb + d0 * 2048 + 512);
        p0 = __builtin_amdgcn_mfma_f32_32x32x16_bf16(b0, qr[d0], p0, 0, 0, 0);
        p1 = __builtin_amdgcn_mfma_f32_32x32x16_bf16(b1, qr[d0], p1, 0, 0, 0);
    }
    float ma = fmaxf(fmaxf(p0[0], p0[1]), p1[0]), mb = fmaxf(fmaxf(p0[2], p0[3]), p1[1]);
    ma = fmaxf(fmaxf(ma, p1[2]), p1[3]);
#pragma unroll
    for (int r = 4; r < 16; r += 4) { ma = fmaxf(fmaxf(ma, p0[r]), p0[r + 1]); mb = fmaxf(fmaxf(mb, p0[r + 2]), p0[r + 3]); ma = fmaxf(fmaxf(ma, p1[r]), p1[r + 1]); mb = fmaxf(fmaxf(mb, p1[r + 2]), p1[r + 3]); }
    mx = fmaxf(ma, mb);
}
template <int D>
__device__ __forceinline__ void attn_pv(const LAS unsigned char* Vb, float& m_run, float& l_run, f32x16 (&o)[D / 32], f32x16& p0, f32x16& p1, float mx, LAS float* wsf, int r32, int hi, bool first) {
    mx = fmaxf(mx, __shfl_xor(mx, 32));
    float dl = 0.f;
    if (first) { m_run = mx; dl = mx; }
    else if (__any(mx > 8.0f)) {
        dl = fmaxf(mx, 0.f);
        const float alpha = fast_exp2(-dl);
        m_run += dl; l_run *= alpha;
        if (hi == 0) wsf[r32] = alpha;
        LDS_WAIT(); asm volatile("" ::: "memory");
#pragma unroll
        for (int r = 0; r < 16; ++r) { const float a = wsf[crow(r, hi)];
#pragma unroll
            for (int d = 0; d < D / 32; ++d) o[d][r] *= a; }
    }
    float ps = 0.f, ps2 = 0.f;
#pragma unroll
    for (int r = 0; r < 16; ++r) { p0[r] = fast_exp2(p0[r] - dl); p1[r] = fast_exp2(p1[r] - dl); ps += p0[r]; ps2 += p1[r]; }
    l_run += ps + ps2;
    u32x4 pw[4];
    pw[0] = (u32x4){cvtpk(p0[0], p0[1]), cvtpk(p0[2], p0[3]), cvtpk(p0[4], p0[5]), cvtpk(p0[6], p0[7])};
    pw[1] = (u32x4){cvtpk(p0[8], p0[9]), cvtpk(p0[10], p0[11]), cvtpk(p0[12], p0[13]), cvtpk(p0[14], p0[15])};
    pw[2] = (u32x4){cvtpk(p1[0], p1[1]), cvtpk(p1[2], p1[3]), cvtpk(p1[4], p1[5]), cvtpk(p1[6], p1[7])};
    pw[3] = (u32x4){cvtpk(p1[8], p1[9]), cvtpk(p1[10], p1[11]), cvtpk(p1[12], p1[13]), cvtpk(p1[14], p1[15])};
    const LAS unsigned char* vp = Vb + ((r32 >> 4) & 1) * 32 + (r32 & 3) * 8 + (4 * hi + ((r32 & 15) >> 2)) * 64;
#pragma unroll
    for (int d0 = 0; d0 < D / 32; ++d0) {
#pragma unroll
        for (int ks = 0; ks < 4; ++ks) {
            const s16x4 lo = vtr(vp + d0 * 4096 + ks * 1024), hh = vtr(vp + d0 * 4096 + ks * 1024 + 512);
            const bf16x8 vf = (bf16x8){lo[0], lo[1], lo[2], lo[3], hh[0], hh[1], hh[2], hh[3]};
            o[d0] = __builtin_amdgcn_mfma_f32_32x32x16_bf16(__builtin_bit_cast(bf16x8, pw[ks]), vf, o[d0], 0, 0, 0);
        }
    }
}
template <int D, class BiasF>
__device__ __forceinline__ void attn_tile(const LAS unsigned char* Kb, const LAS unsigned char* Vb, const bf16x8 (&qr)[D / 16], float& m_run, float& l_run, f32x16 (&o)[D / 32],
                                          LAS float* wsf, int r32, int hi, const BiasF& biasf, bool first) {
    f32x16 p0, p1; float mx;
    attn_qk<D>(Kb, qr, m_run, p0, p1, mx, r32, hi, biasf);
    attn_pv<D>(Vb, m_run, l_run, o, p0, p1, mx, wsf, r32, hi, first);
}
template <int ND>
__device__ __forceinline__ void attn_finish(float l_run, f32x16 (&o)[ND], LAS float* wsf, int r32, int hi) {
    const float l = l_run + __shfl_xor(l_run, 32);
    LDS_WAIT(); asm volatile("" ::: "memory");
    if (hi == 0) wsf[32 + r32] = 1.0f / l;
    LDS_WAIT(); asm volatile("" ::: "memory");
#pragma unroll
    for (int r = 0; r < 16; ++r) { const float a = wsf[32 + crow(r, hi)];
#pragma unroll
        for (int d = 0; d < ND; ++d) o[d][r] *= a; }
}

constexpr int ATT_GRP = 32768, ATT_K = 0, ATT_V = 16384, ATT_TB = 65536, ATT_WS = ATT_TB + 1024, ATT_OST = ATT_WS + 2048, ATT_LDS = ATT_OST + 8 * 4096;
static_assert(ATT_LDS <= RING_BYTES, "attention LDS");
struct ChunkBias {
    const LAS float* tb; int base; bool far; float farv;
    __device__ __forceinline__ bool uniform() const { return far; }
    __device__ __forceinline__ float uval() const { return farv; }
    __device__ __forceinline__ float operator()(int kin) const { int d = base - kin; d = d > 128 ? 128 : d; return tb[d + 63]; }
};
__device__ __forceinline__ void chunk_attention_head(const bf16_t* PQp, const bf16_t* PRp, bf16_t* Oout, int opitch, const float* relb, int b, int h, LAS unsigned char* lds, int tid) {
    const int lane = tid & 63, r32 = lane & 31, hi = lane >> 5; const int wid = __builtin_amdgcn_readfirstlane(tid >> 6);
    const int grp = wid >> 2, wg = wid & 3;
    LAS float* tb = (LAS float*)(lds + ATT_TB);
    LAS float* wsf = (LAS float*)(lds + ATT_WS) + wid * 64;
    LAS unsigned char* gl = lds + grp * ATT_GRP;
    if (tid < 192) tb[tid] = relb[h * 192 + tid] * LOG2E;
    const size_t rowbase = (size_t)b * SEQ;
    const bf16_t* Kh = PRp + rowbase * NPR + C_KA + h * 64; const bf16_t* Vh = PRp + rowbase * NPR + C_VA + h * 64;
    const bf16_t* ksrc = Kh + (size_t)lane * NPR + wg * 8;
    const bf16_t* vsrc = Vh + (size_t)(16 * wg + (lane >> 2)) * NPR + (lane & 3) * 8;
    const int kdst = wg * 1024 + lane * 16, vdst = wg * 1024 + lane * 16;
    __syncthreads();
    const float farv = tb[191];
    if (grp == 1) { __builtin_amdgcn_s_setprio(1); __syncthreads(); }
    for (int it = 0; it < 8; ++it) {
        const int u = 2 * it + grp, c0 = 2 * u, cw = c0 + (wg >> 1), qin = 32 * (wg & 1) + r32;
        const bf16_t* Qw = PQp + (rowbase + u * 128 + wg * 32) * NPQ + C_Q + h * 64;
        bf16_t* Ow = Oout + (rowbase + u * 128 + wg * 32) * opitch + h * 64;
        bf16x8 qr[4];
#pragma unroll
        for (int d0 = 0; d0 < 4; ++d0) qr[d0] = *(const bf16x8*)&Qw[(size_t)r32 * NPQ + d0 * 16 + hi * 8];
        float m_run = 0.f, l_run = 0.f; f32x16 o[2]; bool first = true;
#pragma unroll
        for (int r = 0; r < 16; ++r) { o[0][r] = 0.f; o[1][r] = 0.f; }
        u32x4 kA[2], vA[2], kB[2], vB[2];
#define TVALID(t) ((t) <= 9 && (c0 - 8 + (t)) >= 0)
#define TLOAD(K_, V_, t) do { if (TVALID(t)) { const size_t ro_ = (size_t)(c0 - 8 + (t)) * 64 * NPR; _Pragma("unroll") for (int j = 0; j < 2; ++j) { K_[j] = *(const u32x4*)(ksrc + ro_ + j * 32); V_[j] = *(const u32x4*)(vsrc + ro_ + j * 32); } } } while (0)
#define TWRITE(K_, V_, t) do { if (TVALID(t)) { _Pragma("unroll") for (int j = 0; j < 2; ++j) { *(LAS u32x4*)(gl + ATT_K + ((t) & 1) * 8192 + j * 4096 + kdst) = K_[j]; *(LAS u32x4*)(gl + ATT_V + ((t) & 1) * 8192 + j * 4096 + vdst) = V_[j]; } } } while (0)
#define TSTEP(t) do { const int kc_ = c0 - 8 + (t); const int dc_ = cw - kc_; const bool vis_ = (kc_ >= 0 && dc_ >= 0 && dc_ <= 8); f32x16 p0, p1; float mx_ = 0.f; \
            if (vis_) { ChunkBias bf{tb, qin + 64 * dc_, dc_ >= 3, farv}; attn_qk<64>(gl + ATT_K + ((t) & 1) * 8192, qr, m_run, p0, p1, mx_, r32, hi, bf); } \
            __syncthreads(); \
            if (vis_) { attn_pv<64>(gl + ATT_V + ((t) & 1) * 8192, m_run, l_run, o, p0, p1, mx_, wsf, r32, hi, first); first = false; } } while (0)
        TLOAD(kB, vB, 0); TWRITE(kB, vB, 0);
        TLOAD(kA, vA, 1);
        __syncthreads();
#pragma unroll 1
        for (int kk = 0; kk < 10; kk += 2) {
            TLOAD(kB, vB, kk + 2);
            TSTEP(kk);
            TWRITE(kA, vA, kk + 1);
            __syncthreads();
            TLOAD(kA, vA, kk + 3);
            TSTEP(kk + 1);
            TWRITE(kB, vB, kk + 2);
            __syncthreads();
        }
#undef TVALID
#undef TLOAD
#undef TWRITE
#undef TSTEP
        attn_finish<2>(l_run, o, wsf, r32, hi);
        LAS unsigned short* stg = (LAS unsigned short*)(lds + ATT_OST) + wid * 2048;
#pragma unroll
        for (int r = 0; r < 16; r += 1) { const int orow = crow(r, hi);
#pragma unroll
            for (int d0 = 0; d0 < 2; ++d0) stg[orow * 64 + d0 * 32 + r32] = (unsigned short)f2bf(o[d0][r]); }
        LDS_WAIT(); asm volatile("" ::: "memory");
#pragma unroll
        for (int i = 0; i < 4; ++i) { const int row = i * 8 + (lane >> 3), ch = lane & 7; const u32x4 v = *(const LAS u32x4*)(stg + row * 64 + ch * 8); *(u32x4*)(Ow + (size_t)row * opitch + ch * 8) = v; }
        LDS_WAIT(); asm volatile("" ::: "memory");
        __syncthreads();
    }
    if (grp == 0) __syncthreads(); else __builtin_amdgcn_s_setprio(0);
}

constexpr int AT2_BUF = 32768, AT2_TB = 65536, AT2_WS = AT2_TB + 1024, AT2_OST = AT2_WS + 2048, AT2_LDS = AT2_OST + 8 * 4096;
static_assert(AT2_LDS <= RING_BYTES, "attention LDS");
template <class BiasF>
__device__ __forceinline__ void attn2_scores(const LAS unsigned char* Kb, bool vis, const bf16x8 (&qr)[4], float m_run, f32x16& pa, f32x16& pb, int r32, int hi, const BiasF& bf) {
    if (vis) {
        const LAS unsigned char* kb = Kb + hi * 1024 + r32 * 16;
        if (bf.uniform()) {
            f32x16 ci; const float c = bf.uval() - m_run;
#pragma unroll
            for (int r = 0; r < 16; ++r) ci[r] = c;
            pa = __builtin_amdgcn_mfma_f32_32x32x16_bf16(*(const LAS bf16x8*)(kb), qr[0], ci, 0, 0, 0);
            pb = __builtin_amdgcn_mfma_f32_32x32x16_bf16(*(const LAS bf16x8*)(kb + 512), qr[0], ci, 0, 0, 0);
        } else {
#pragma unroll
            for (int r = 0; r < 16; ++r) { pa[r] = bf(crow(r, hi)) - m_run; pb[r] = bf(crow(r, hi) + 32) - m_run; }
            pa = __builtin_amdgcn_mfma_f32_32x32x16_bf16(*(const LAS bf16x8*)(kb), qr[0], pa, 0, 0, 0);
            pb = __builtin_amdgcn_mfma_f32_32x32x16_bf16(*(const LAS bf16x8*)(kb + 512), qr[0], pb, 0, 0, 0);
        }
#pragma unroll
        for (int d0 = 1; d0 < 4; ++d0) {
            pa = __builtin_amdgcn_mfma_f32_32x32x16_bf16(*(const LAS bf16x8*)(kb + d0 * 2048), qr[d0], pa, 0, 0, 0);
            pb = __builtin_amdgcn_mfma_f32_32x32x16_bf16(*(const LAS bf16x8*)(kb + d0 * 2048 + 512), qr[d0], pb, 0, 0, 0);
        }
    } else {
#pragma unroll
        for (int r = 0; r < 16; ++r) { pa[r] = -1e30f; pb[r] = -1e30f; }
    }
}
__device__ __forceinline__ void attn2_pv(const LAS unsigned char* Vb, float dl, float& ps, f32x16 (&o)[2], f32x16& pa, f32x16& pb, int r32, int hi) {
#pragma unroll
    for (int r = 0; r < 16; ++r) { pa[r] = fast_exp2(pa[r] - dl); pb[r] = fast_exp2(pb[r] - dl); ps += pa[r] + pb[r]; }
    const LAS unsigned char* vp = Vb + ((r32 >> 4) & 1) * 32 + (r32 & 3) * 8 + (4 * hi + ((r32 & 15) >> 2)) * 64;
#pragma unroll
    for (int ks = 0; ks < 4; ++ks) {
        const f32x16& pp = (ks < 2) ? pa : pb; const int b8 = (ks & 1) * 8;
        const bf16x8 pf = __builtin_bit_cast(bf16x8, (u32x4){cvtpk(pp[b8 + 0], pp[b8 + 1]), cvtpk(pp[b8 + 2], pp[b8 + 3]), cvtpk(pp[b8 + 4], pp[b8 + 5]), cvtpk(pp[b8 + 6], pp[b8 + 7])});
#pragma unroll
        for (int d0 = 0; d0 < 2; ++d0) {
            const s16x4 lo = vtr(vp + d0 * 4096 + ks * 1024), hh = vtr(vp + d0 * 4096 + ks * 1024 + 512);
            const bf16x8 vf = (bf16x8){lo[0], lo[1], lo[2], lo[3], hh[0], hh[1], hh[2], hh[3]};
            o[d0] = __builtin_amdgcn_mfma_f32_32x32x16_bf16(pf, vf, o[d0], 0, 0, 0);
        }
    }
}
__device__ __forceinline__ void chunk_attention_head2(const bf16_t* PQp, const bf16_t* PRp, bf16_t* Oout, int opitch, const float* relb, int b, int h, LAS unsigned char* lds, int tid) {
    const int lane = tid & 63, r32 = lane & 31, hi = lane >> 5; const int wid = __builtin_amdgcn_readfirstlane(tid >> 6);
    LAS float* tb = (LAS float*)(lds + AT2_TB);
    LAS float* wsf = (LAS float*)(lds + AT2_WS) + wid * 64;
    if (tid < 192) tb[tid] = relb[h * 192 + tid] * LOG2E;
    const size_t rowbase = (size_t)b * SEQ;
    const bf16_t* Kh = PRp + rowbase * NPR + C_KA + h * 64; const bf16_t* Vh = PRp + rowbase * NPR + C_VA + h * 64;
    const bf16_t* ksrc = Kh + (size_t)lane * NPR + wid * 8;
    const bf16_t* vsrc = Vh + (size_t)(16 * (wid & 3) + (lane >> 2)) * NPR + (wid >> 2) * 32 + (lane & 3) * 8;
    const int pdst = wid * 1024 + lane * 16;
    __syncthreads();
    const float farv = tb[191];
    for (int qb = 0; qb < 8; ++qb) {
        const int c0 = qb * 4, cw = c0 + (wid >> 1), qin = 32 * (wid & 1) + r32;
        const bf16_t* Qw = PQp + (rowbase + qb * 256 + wid * 32) * NPQ + C_Q + h * 64;
        bf16_t* Ow = Oout + (rowbase + qb * 256 + wid * 32) * opitch + h * 64;
        bf16x8 qr[4];
#pragma unroll
        for (int d0 = 0; d0 < 4; ++d0) qr[d0] = *(const bf16x8*)&Qw[(size_t)r32 * NPQ + d0 * 16 + hi * 8];
        float m_run = 0.f, l_run = 0.f; f32x16 o[2]; bool first = true;
#pragma unroll
        for (int r = 0; r < 16; ++r) { o[0][r] = 0.f; o[1][r] = 0.f; }
        u32x4 kA[2], vA[2];
#define SVALID(s_) ((s_) <= 5 && (c0 - 8 + 2 * (s_)) >= 0)
#define SLOAD(s_) do { if (SVALID(s_)) { const size_t ro_ = (size_t)(c0 - 8 + 2 * (s_)) * 64 * NPR; _Pragma("unroll") for (int j = 0; j < 2; ++j) { kA[j] = *(const u32x4*)(ksrc + ro_ + (size_t)j * 64 * NPR); vA[j] = *(const u32x4*)(vsrc + ro_ + (size_t)j * 64 * NPR); } } } while (0)
#define SWRITE(s_) do { if (SVALID(s_)) { LAS unsigned char* bb_ = lds + ((s_) & 1) * AT2_BUF; _Pragma("unroll") for (int j = 0; j < 2; ++j) { *(LAS u32x4*)(bb_ + j * 16384 + pdst) = kA[j]; *(LAS u32x4*)(bb_ + j * 16384 + 8192 + pdst) = vA[j]; } } } while (0)
        SLOAD(0); SWRITE(0);
        __syncthreads();
#pragma unroll 1
        for (int ss = 0; ss < 6; ++ss) {
            SLOAD(ss + 1);
            const int kcA = c0 - 8 + 2 * ss; const int dA = cw - kcA, dB = dA - 1;
            const bool vA_ = (kcA >= 0 && dA >= 0 && dA <= 8), vB_ = (kcA >= 0 && dB >= 0 && dB <= 8);
            if (vA_ || vB_) {
                const LAS unsigned char* bb = lds + (ss & 1) * AT2_BUF;
                f32x16 p0, p1, p2, p3;
                attn2_scores(bb, vA_, qr, m_run, p0, p1, r32, hi, ChunkBias{tb, qin + 64 * dA, dA >= 3, farv});
                attn2_scores(bb + 16384, vB_, qr, m_run, p2, p3, r32, hi, ChunkBias{tb, qin + 64 * dB, dB >= 3, farv});
                float ma = fmaxf(fmaxf(p0[0], p1[0]), p2[0]), mb = fmaxf(fmaxf(p0[1], p1[1]), p3[0]);
                mb = fmaxf(mb, fmaxf(p2[1], p3[1]));
#pragma unroll
                for (int r = 2; r < 16; r += 2) { ma = fmaxf(fmaxf(ma, p0[r]), p1[r]); mb = fmaxf(fmaxf(mb, p0[r + 1]), p1[r + 1]); ma = fmaxf(fmaxf(ma, p2[r]), p3[r]); mb = fmaxf(fmaxf(mb, p2[r + 1]), p3[r + 1]); }
                float mx = fmaxf(ma, mb);
                mx = fmaxf(mx, __shfl_xor(mx, 32));
                float dl = 0.f;
                if (first) { m_run = mx; dl = mx; first = false; }
                else if (__any(mx > 8.0f)) {
                    dl = fmaxf(mx, 0.f);
                    const float alpha = fast_exp2(-dl);
                    m_run += dl; l_run *= alpha;
                    if (hi == 0) wsf[r32] = alpha;
                    LDS_WAIT(); asm volatile("" ::: "memory");
#pragma unroll
                    for (int r = 0; r < 16; ++r) { const float a = wsf[crow(r, hi)]; o[0][r] *= a; o[1][r] *= a; }
                }
                float ps = 0.f;
                if (vA_) attn2_pv(bb + 8192, dl, ps, o, p0, p1, r32, hi);
                if (vB_) attn2_pv(bb + 24576, dl, ps, o, p2, p3, r32, hi);
                l_run += ps;
            }
            SWRITE(ss + 1);
            __syncthreads();
        }
#undef SVALID
#undef SLOAD
#undef SWRITE
        attn_finish<2>(l_run, o, wsf, r32, hi);
        LAS unsigned short* stg = (LAS unsigned short*)(lds + AT2_OST) + wid * 2048;
#pragma unroll
        for (int r = 0; r < 16; r += 1) { const int orow = crow(r, hi);
#pragma unroll
            for (int d0 = 0; d0 < 2; ++d0) stg[orow * 64 + d0 * 32 + r32] = (unsigned short)f2bf(o[d0][r]); }
        LDS_WAIT(); asm volatile("" ::: "memory");
#pragma unroll
        for (int i = 0; i < 4; ++i) { const int row = i * 8 + (lane >> 3), ch = lane & 7; const u32x4 v = *(const LAS u32x4*)(stg + row * 64 + ch * 8); *(u32x4*)(Ow + (size_t)row * opitch + ch * 8) = v; }
        LDS_WAIT(); asm volatile("" ::: "memory");
        __syncthreads();
    }
}

constexpr int A3_SLOT = 8192, A3_K = 0, A3_V = 3 * A3_SLOT, A3_WS = 6 * A3_SLOT, A3_TB = A3_WS + 2048, A3_OST = A3_TB + 4352, A3_LDS = A3_OST + 8 * 4096;
static_assert(A3_LDS <= RING_BYTES, "attention LDS");
__device__ __forceinline__ void glds16(const void* g, unsigned lds_base) {
    unsigned sv; asm volatile("s_mov_b32 %0, m0\n\ts_mov_b32 m0, %2\n\ts_nop 0\n\tglobal_load_lds_dwordx4 %1, off\n\ts_mov_b32 m0, %0" : "=&s"(sv) : "v"(g), "s"(lds_base) : "memory"); }
#define MFMA32(a, b, c) __builtin_amdgcn_mfma_f32_32x32x16_bf16(a, b, c, 0, 0, 0)
#define A3_SBAR() __builtin_amdgcn_sched_barrier(0)
#define A3_PIN(x) asm volatile("" : "+v"(x))
#define A3_WAIT_BAR(N) asm volatile("s_waitcnt vmcnt(" #N ") lgkmcnt(0)\n\ts_barrier" ::: "memory")
#define A3_MX3(a, b, c) __builtin_fmaxf(__builtin_fmaxf((a), (b)), (c))
__device__ __forceinline__ void a3_swap32(float& a, float& b) { asm volatile("s_nop 1\n\tv_permlane32_swap_b32 %0, %1\n\ts_nop 1" : "+v"(a), "+v"(b)); }
__device__ __forceinline__ float a3_rowmax(const f32x16& p0, const f32x16& p1) {
    float a = A3_MX3(p0[0], p0[1], p1[0]), b = A3_MX3(p0[2], p0[3], p1[1]); a = A3_MX3(a, p1[2], p1[3]);
#pragma unroll
    for (int r = 4; r < 16; r += 4) { a = A3_MX3(a, p0[r], p0[r + 1]); b = A3_MX3(b, p0[r + 2], p0[r + 3]); a = A3_MX3(a, p1[r], p1[r + 1]); b = A3_MX3(b, p1[r + 2], p1[r + 3]); }
    float m = __builtin_fmaxf(a, b), m2 = m; a3_swap32(m, m2);
    return __builtin_fmaxf(m, m2); }
__device__ __forceinline__ void a3_kload2(bf16x8* kf, const LAS unsigned char* kp, int d0) { kf[2 * d0] = *(const LAS bf16x8*)(kp + d0 * 2048); kf[2 * d0 + 1] = *(const LAS bf16x8*)(kp + d0 * 2048 + 512); }
__device__ __forceinline__ void chunk_attention_head3(const bf16_t* PQp, const bf16_t* PRp, bf16_t* Oout, int opitch, const float* relb, int b, int h, LAS unsigned char* lds, int tid) {
    const int lane = tid & 63, r32 = lane & 31, hi = lane >> 5; const int wid = __builtin_amdgcn_readfirstlane(tid >> 6);
    LAS float* tbx = (LAS float*)(lds + A3_TB);
    LAS float* wsf = (LAS float*)(lds + A3_WS) + wid * 64;
    __syncthreads();
    for (int i = tid; i < 1040; i += 512) { const int s = i / 260, m = i - 260 * s, n = m - s; float v = 0.f;
        if (n >= 0 && n <= 254) { int D = 191 - n; D = D > 128 ? 128 : D; v = (relb[h * 192 + D + 63] - relb[h * 192 + 191]) * LOG2E; }
        tbx[i] = v; }
    const float farv = relb[h * 192 + 191] * LOG2E;
    const size_t rowbase = (size_t)b * SEQ;
    const bf16_t* Kh = PRp + rowbase * NPR + C_KA + h * 64; const bf16_t* Vh = PRp + rowbase * NPR + C_VA + h * 64;
    const unsigned lds0 = (unsigned)(size_t)lds;
    const unsigned kdst = lds0 + A3_K + wid * 1024, vdst = lds0 + A3_V + wid * 1024;
    const LAS unsigned char* vp0 = lds + A3_V + ((lane >> 4) & 1) * 32 + (lane & 3) * 8 + (4 * hi + ((lane & 15) >> 2)) * 64;
    const LAS unsigned char* kp0 = lds + A3_K + hi * 1024 + r32 * 16;
    const int sgn = (r32 + 1) & 3;
    const LAS float* tbase = tbx + 260 * sgn + (191 - (32 * (wid & 1) + r32) + 4 * hi + sgn);
    __syncthreads();
    const bf16_t* Kl = Kh + (size_t)lane * NPR + wid * 8;
    const bf16_t* Vl = Vh + (size_t)(16 * (wid & 3) + (lane >> 2)) * NPR + (wid >> 2) * 32 + (lane & 3) * 8;
    int sl_prev = 2 * A3_SLOT, sl_cur = 0, sl_next = A3_SLOT;
    bf16x8 qr[4];
#pragma unroll 1
    for (int qb = 0; qb < 8; ++qb) {
        const int c0 = qb * 4, kstart = c0 > 8 ? c0 - 8 : 0, NT = c0 + 4 - kstart, dc0 = c0 + (wid >> 1) - kstart;
        const int knext = qb < 7 ? (c0 > 4 ? c0 - 4 : 0) : kstart + NT - 1;
        const bf16_t* Qw = PQp + (rowbase + qb * 256 + wid * 32) * NPQ + C_Q + h * 64;
        bf16_t* Ow = Oout + (rowbase + qb * 256 + wid * 32) * opitch + h * 64;
#define A3_KC(t) int t_ = (t); const int kc_ = t_ < NT ? kstart + t_ : (qb < 7 ? knext + (t_ - NT) : knext);
#define DMA_K(t, slot) do { A3_KC(t) glds16(Kl + (size_t)kc_ * 64 * NPR, (unsigned)__builtin_amdgcn_readfirstlane(kdst + (slot))); } while (0)
#define DMA_V(t, slot) do { A3_KC(t) glds16(Vl + (size_t)kc_ * 64 * NPR, (unsigned)__builtin_amdgcn_readfirstlane(vdst + (slot))); } while (0)
#define NEARADD(X0, X1, dc) do { const LAS float* tp_ = tbase - 64 * (dc); _Pragma("unroll") for (int g = 0; g < 4; ++g) { const f32x4 a_ = *(const LAS f32x4*)(tp_ + 8 * g), b_ = *(const LAS f32x4*)(tp_ + 32 + 8 * g); \
            X0[4 * g] += a_[0]; X0[4 * g + 1] += a_[1]; X0[4 * g + 2] += a_[2]; X0[4 * g + 3] += a_[3]; X1[4 * g] += b_[0]; X1[4 * g + 1] += b_[1]; X1[4 * g + 2] += b_[2]; X1[4 * g + 3] += b_[3]; } } while (0)
        if (qb == 0) { DMA_K(0, sl_cur); DMA_V(0, sl_cur); DMA_K(1, sl_next);
#pragma unroll
            for (int d0 = 0; d0 < 4; ++d0) qr[d0] = *(const bf16x8*)&Qw[(size_t)r32 * NPQ + d0 * 16 + hi * 8]; }
        float mhat = 0.f, l_reg = 0.f; f32x16 o[2];
#pragma unroll
        for (int r = 0; r < 16; ++r) { o[0][r] = 0.f; o[1][r] = 0.f; }
        f32x16 ci16;
#pragma unroll
        for (int r = 0; r < 16; ++r) ci16[r] = farv;
        A3_PIN(ci16);
        bool resc = false, first = true;
        f32x16 pA0, pA1, pB0, pB1; bf16x8 kf[8]; s16x4 vlo[8], vhi[8]; u32x4 pw0, pw1, pw2, pw3;
#define ROT() do { sl_prev = sl_cur; sl_cur = sl_next; sl_next = (sl_next == 2 * A3_SLOT) ? 0 : sl_next + A3_SLOT; } while (0)
#define EX(v) __builtin_amdgcn_exp2f(v)
#define RESC() do { if (resc) { _Pragma("unroll") for (int d_ = 0; d_ < 2; ++d_) _Pragma("unroll") for (int r = 0; r < 16; ++r) o[d_][r] *= wsf[crow(r, hi)]; } } while (0)
#define DECIDE(C0, C1, t) resc = false; \
        { const int dc_ = dc0 - (t); \
          if (dc_ >= 0 && dc_ <= 8) { if (dc_ <= 2) NEARADD(C0, C1, dc_); \
              const float rm = a3_rowmax(C0, C1); float dl = 0.f; bool mv_ = false; \
              if (first) { dl = rm; first = false; mv_ = true; } \
              else if (__builtin_expect(__any(rm > 8.0f), 0)) { dl = __builtin_fmaxf(rm, 0.f); const float f = __builtin_amdgcn_exp2f(-dl); l_reg *= f; if (hi == 0) wsf[r32] = f; resc = true; mv_ = true; } \
              if (mv_) { mhat += dl; const float cv_ = farv - mhat; \
                  _Pragma("unroll") for (int r = 0; r < 16; ++r) { C0[r] -= dl; C1[r] -= dl; ci16[r] = cv_; } A3_PIN(ci16); } } \
          else { _Pragma("unroll") for (int r = 0; r < 16; ++r) { C0[r] = -30000.f; C1[r] = -30000.f; } } }
        if (qb == 0) { DMA_K(2, sl_prev); A3_WAIT_BAR(3); }
#pragma unroll
        for (int d0 = 0; d0 < 4; ++d0) a3_kload2(kf, kp0 + sl_cur, d0);
        pA0 = MFMA32(kf[0], qr[0], ci16); pA1 = MFMA32(kf[1], qr[0], ci16); pA0 = MFMA32(kf[2], qr[1], pA0); pA1 = MFMA32(kf[3], qr[1], pA1);
        pA0 = MFMA32(kf[4], qr[2], pA0); pA1 = MFMA32(kf[5], qr[2], pA1); pA0 = MFMA32(kf[6], qr[3], pA0); pA1 = MFMA32(kf[7], qr[3], pA1);
        { DECIDE(pA0, pA1, 0)
#pragma unroll
          for (int r = 0; r < 16; ++r) { pA0[r] = EX(pA0[r]); pA1[r] = EX(pA1[r]); } }
        A3_WAIT_BAR(0);
        DMA_K(3, sl_cur); DMA_V(1, sl_next); ROT();
#pragma unroll
        for (int d0 = 0; d0 < 4; ++d0) a3_kload2(kf, kp0 + sl_cur, d0);
        A3_WAIT_BAR(2);
#define PKW(P, i) cvtpk(P[i], P[i + 1])
#define PAF(k) __builtin_bit_cast(bf16x8, pw##k)
#define VFR(i) (bf16x8){vlo[i][0], vlo[i][1], vlo[i][2], vlo[i][3], vhi[i][0], vhi[i][1], vhi[i][2], vhi[i][3]}
#define VRD(i) do { vlo[i] = vtr(vp_ + (((i) >> 2) * 4096 + ((i) & 3) * 1024)); vhi[i] = vtr(vp_ + (((i) >> 2) * 4096 + ((i) & 3) * 1024 + 512)); } while (0)
#define KRD(G, d0) do { if (G) { a3_kload2(kf, kp0 + sl_next, d0); A3_SBAR(); } } while (0)
#define GAPA(MF, a0, a1, a2, a3, W0, W1, PW) do { MF; sacc += a0; sacc += a1; sacc += a2; sacc += a3; W0; W1; A3_PIN(PW); A3_PIN(sacc); A3_SBAR(); } while (0)
#define GAPB(MF, X, i) do { MF; X[i] = EX(X[i]); X[i + 1] = EX(X[i + 1]); X[i + 2] = EX(X[i + 2]); X[i + 3] = EX(X[i + 3]); A3_PIN(X); A3_SBAR(); } while (0)
#define STEP(C0, C1, P0, P1, t, GD, GL) do { A3_SBAR(); \
        const LAS unsigned char* vp_ = vp0 + sl_prev; \
        VRD(0); A3_SBAR(); float sacc = P0[0] + P0[1]; \
                           GAPA(C0 = MFMA32(kf[0], qr[0], ci16),   P0[2], P0[3], P0[4], P0[5],     pw0[0] = PKW(P0, 0),  pw0[1] = PKW(P0, 2),  pw0); \
        VRD(4); A3_SBAR(); GAPA(C1 = MFMA32(kf[1], qr[0], ci16),   P0[6], P0[7], P0[8], P0[9],     pw0[2] = PKW(P0, 4),  pw0[3] = PKW(P0, 6),  pw0); \
        VRD(1); A3_SBAR(); GAPA(C0 = MFMA32(kf[2], qr[1], C0),    P0[10], P0[11], P0[12], P0[13], pw1[0] = PKW(P0, 8),  pw1[1] = PKW(P0, 10), pw1); \
        VRD(5); A3_SBAR(); GAPA(C1 = MFMA32(kf[3], qr[1], C1),    P0[14], P0[15], P1[0], P1[1],   pw1[2] = PKW(P0, 12), pw1[3] = PKW(P0, 14), pw1); \
        VRD(2); A3_SBAR(); GAPA(C0 = MFMA32(kf[4], qr[2], C0),    P1[2], P1[3], P1[4], P1[5],     pw2[0] = PKW(P1, 0),  pw2[1] = PKW(P1, 2),  pw2); \
        VRD(6); A3_SBAR(); GAPA(C1 = MFMA32(kf[5], qr[2], C1),    P1[6], P1[7], P1[8], P1[9],     pw2[2] = PKW(P1, 4),  pw2[3] = PKW(P1, 6),  pw2); \
        VRD(3); A3_SBAR(); GAPA(C0 = MFMA32(kf[6], qr[3], C0),    P1[10], P1[11], P1[12], P1[13], pw3[0] = PKW(P1, 8),  pw3[1] = PKW(P1, 10), pw3); \
        VRD(7); A3_SBAR(); GAPA(C1 = MFMA32(kf[7], qr[3], C1),    P1[14], P1[15], 0.f, 0.f,       pw3[2] = PKW(P1, 12), pw3[3] = PKW(P1, 14), pw3); \
        l_reg += sacc; \
        if (GD) { DMA_K((t) + 3, sl_cur); DMA_V((t) + 1, sl_next); } \
        DECIDE(C0, C1, t) \
        A3_SBAR(); \
        GAPB(o[0] = MFMA32(PAF(0), VFR(0), o[0]), C0, 0);              GAPB(o[1] = MFMA32(PAF(0), VFR(4), o[1]), C0, 4); \
        KRD(GL, 0); GAPB(o[0] = MFMA32(PAF(1), VFR(1), o[0]), C0, 8);  KRD(GL, 1); GAPB(o[1] = MFMA32(PAF(1), VFR(5), o[1]), C0, 12); \
        KRD(GL, 2); GAPB(o[0] = MFMA32(PAF(2), VFR(2), o[0]), C1, 0);  KRD(GL, 3); GAPB(o[1] = MFMA32(PAF(2), VFR(6), o[1]), C1, 4); \
        GAPB(o[0] = MFMA32(PAF(3), VFR(3), o[0]), C1, 8);              GAPB(o[1] = MFMA32(PAF(3), VFR(7), o[1]), C1, 12); \
        } while (0)
        int t = 1;
#pragma unroll 1
        for (; t + 1 < NT; t += 2) {
            STEP(pB0, pB1, pA0, pA1, t, true, true);     A3_WAIT_BAR(2); RESC(); ROT();
            STEP(pA0, pA1, pB0, pB1, t + 1, true, true); A3_WAIT_BAR(2); RESC(); ROT();
        }
        STEP(pB0, pB1, pA0, pA1, NT - 1, true, false);
        A3_WAIT_BAR(2); RESC();
        if (qb < 7) { const bf16_t* Qn = Qw + (size_t)256 * NPQ;
#pragma unroll
            for (int d0 = 0; d0 < 4; ++d0) qr[d0] = *(const bf16x8*)&Qn[(size_t)r32 * NPQ + d0 * 16 + hi * 8]; }
        { float sacc = pB0[0] + pB0[1];
#pragma unroll
          for (int r = 2; r < 16; ++r) sacc += pB0[r];
#pragma unroll
          for (int r = 0; r < 16; ++r) sacc += pB1[r];
          l_reg += sacc;
          pw0 = (u32x4){PKW(pB0, 0), PKW(pB0, 2), PKW(pB0, 4), PKW(pB0, 6)}; pw1 = (u32x4){PKW(pB0, 8), PKW(pB0, 10), PKW(pB0, 12), PKW(pB0, 14)};
          pw2 = (u32x4){PKW(pB1, 0), PKW(pB1, 2), PKW(pB1, 4), PKW(pB1, 6)}; pw3 = (u32x4){PKW(pB1, 8), PKW(pB1, 10), PKW(pB1, 12), PKW(pB1, 14)};
          const LAS unsigned char* vp_ = vp0 + sl_cur;
#pragma unroll
          for (int i = 0; i < 8; ++i) VRD(i);
          o[0] = MFMA32(PAF(0), VFR(0), o[0]); o[1] = MFMA32(PAF(0), VFR(4), o[1]); o[0] = MFMA32(PAF(1), VFR(1), o[0]); o[1] = MFMA32(PAF(1), VFR(5), o[1]);
          o[0] = MFMA32(PAF(2), VFR(2), o[0]); o[1] = MFMA32(PAF(2), VFR(6), o[1]); o[0] = MFMA32(PAF(3), VFR(3), o[0]); o[1] = MFMA32(PAF(3), VFR(7), o[1]); }
        { float l2 = l_reg; a3_swap32(l_reg, l2); l_reg += l2; }
        if (hi == 0) wsf[32 + r32] = l_reg;
        LDS_WAIT(); asm volatile("" ::: "memory");
        LAS unsigned short* stg = (LAS unsigned short*)(lds + A3_OST) + wid * 2048;
#pragma unroll
        for (int r = 0; r < 16; ++r) { const int orow = crow(r, hi); const float rl = __builtin_amdgcn_rcpf(wsf[32 + orow]);
#pragma unroll
            for (int d0 = 0; d0 < 2; ++d0) stg[orow * 64 + d0 * 32 + r32] = (unsigned short)f2bf(o[d0][r] * rl); }
        LDS_WAIT(); asm volatile("" ::: "memory");
#pragma unroll
        for (int i = 0; i < 4; ++i) { const int row = i * 8 + (lane >> 3), ch = lane & 7; const u32x4 v = *(const LAS u32x4*)(stg + row * 64 + ch * 8); *(u32x4*)(Ow + (size_t)row * opitch + ch * 8) = v; }
        ROT();
        asm volatile("s_waitcnt lgkmcnt(0)\n\ts_barrier" ::: "memory");
#undef A3_KC
#undef DMA_K
#undef DMA_V
#undef NEARADD
#undef ROT
#undef EX
#undef RESC
#undef DECIDE
#undef PKW
#undef PAF
#undef VFR
#undef VRD
#undef KRD
#undef GAPA
#undef GAPB
#undef STEP
    }
    asm volatile("s_waitcnt vmcnt(0)" ::: "memory");
}

constexpr int CA_K = 0, CA_V = 65536, CA_WS = 132096, CA_OST = CA_WS + 8 * 256;
static_assert(CA_WS >= MISC_OFF + 128 && CA_OST + 8 * 2048 <= LDS_BYTES, "CA LDS");
struct NoBias { __device__ __forceinline__ bool uniform() const { return true; } __device__ __forceinline__ float uval() const { return 0.f; } __device__ __forceinline__ float operator()(int) const { return 0.f; } };
__device__ __forceinline__ void cross_attention(const bf16_t* Q2, const bf16_t* KVM, bf16_t* O2, LAS unsigned char* lds, int vcu, int G, int tid) {
    const int lane = tid & 63, r32 = lane & 31, hi = lane >> 5; const int wid = __builtin_amdgcn_readfirstlane(tid >> 6);
    LAS float* wsf = (LAS float*)(lds + CA_WS) + wid * 64;
    for (int u = vcu; u < 256; u += G) {
        const int pair = u >> 2, b = pair >> 2, hh = pair & 3;
        const bf16_t* Kg = KVM + (size_t)b * MEMT * DM + hh * 128; const bf16_t* Vg = Kg + 512;
        __syncthreads();
#pragma unroll
        for (int i = 0; i < 8; ++i) {
            const int piece = tid + 512 * i, key = piece & 255, ch = piece >> 8;
            const u32x4 v = *(const u32x4*)(Kg + (size_t)key * DM + ch * 8);
            *(LAS u32x4*)(lds + CA_K + (key >> 6) * 16384 + ch * 1024 + (key & 63) * 16) = v;
        }
#pragma unroll
        for (int i = 0; i < 8; ++i) {
            const int piece = tid + 512 * i, pc = piece & 15, key = piece >> 4;
            const u32x4 v = *(const u32x4*)(Vg + (size_t)key * DM + pc * 8);
            *(LAS u32x4*)(lds + CA_V + (key >> 6) * 16384 + (pc >> 2) * 4096 + (key & 63) * 64 + (pc & 3) * 16) = v;
        }
        __syncthreads();
        for (int qq = 0; qq < 2; ++qq) {
            const int qblk = 2 * (u & 3) + qq;
            const size_t row0 = (size_t)b * SEQ + qblk * 256 + wid * 32;
            const bf16_t* Qw = Q2 + row0 * 512 + hh * 128;
            bf16x8 qr[8];
#pragma unroll
            for (int d0 = 0; d0 < 8; ++d0) qr[d0] = *(const bf16x8*)&Qw[(size_t)r32 * 512 + d0 * 16 + hi * 8];
            float m_run = 0.f, l_run = 0.f; f32x16 o[4];
#pragma unroll
            for (int d = 0; d < 4; ++d)
#pragma unroll
                for (int r = 0; r < 16; ++r) o[d][r] = 0.f;
            attn_tile<128>(lds + CA_K, lds + CA_V, qr, m_run, l_run, o, wsf, r32, hi, NoBias{}, true);
#pragma unroll 1
            for (int t = 1; t < 4; ++t) attn_tile<128>(lds + CA_K + t * 16384, lds + CA_V + t * 16384, qr, m_run, l_run, o, wsf, r32, hi, NoBias{}, false);
            attn_finish<4>(l_run, o, wsf, r32, hi);
            bf16_t* Ow = O2 + row0 * 512 + hh * 128;
            LAS unsigned short* stg = (LAS unsigned short*)(lds + CA_OST) + wid * 1024;
#pragma unroll
            for (int d0 = 0; d0 < 4; ++d0) {
#pragma unroll
                for (int r = 0; r < 16; ++r) stg[crow(r, hi) * 32 + r32] = (unsigned short)f2bf(o[d0][r]);
                LDS_WAIT(); asm volatile("" ::: "memory");
#pragma unroll
                for (int i = 0; i < 2; ++i) { const int row = i * 16 + (lane >> 2), ch = lane & 3; const u32x4 v = *(const LAS u32x4*)(stg + row * 32 + ch * 8); *(u32x4*)(Ow + (size_t)row * 512 + d0 * 32 + ch * 8) = v; }
                LDS_WAIT(); asm volatile("" ::: "memory");
            }
        }
    }
    __syncthreads();
}

constexpr int TC = 32;
constexpr int SC_ZR = 0, SC_ZK = 8192, SC_ZV = 16384, SC_WD = 24576, SC_AA = 32768, SC_GG = 40960, SC_KK = 49152, SC_YY = 57344;
constexpr int SC_AW = 65536;
constexpr int SC_AZ = SC_AW + 32 * 144;
constexpr int SC_AG = SC_AZ + 32 * 144;
constexpr int SC_BD = SC_AG + 32 * 336;
constexpr int SC_CARRY = SC_BD + 128;
constexpr int SC_END = SC_CARRY + 2 * 64 * 16;
static_assert(SC_END <= RING_BYTES, "scan LDS");

template <int CTRL> __device__ __forceinline__ float dpp_f(float x) { return __builtin_bit_cast(float, __builtin_amdgcn_update_dpp(__builtin_bit_cast(int, x), __builtin_bit_cast(int, x), CTRL, 0xF, 0xF, false)); }
__device__ __forceinline__ float red8(float x) { x += dpp_f<0xB1>(x); x += dpp_f<0x4E>(x); x += dpp_f<0x141>(x); return x; }
__device__ __forceinline__ float red16(float x) { x = red8(x); x += dpp_f<0x140>(x); return x; }

template <int NK>
__device__ __forceinline__ f32x16 lora_mma(const LAS unsigned char* Abase, int astride, const bf16x8* bfr, int r32, int hi) {
    f32x16 acc;
#pragma unroll
    for (int r = 0; r < 16; ++r) acc[r] = 0.f;
#pragma unroll
    for (int s = 0; s < NK; ++s) {
        const bf16x8 af = *(const LAS bf16x8*)(Abase + r32 * astride + (16 * s + 8 * hi) * 2);
        acc = __builtin_amdgcn_mfma_f32_32x32x16_bf16(af, bfr[s], acc, 0, 0, 0);
    }
    return acc;
}

__device__ __forceinline__ void lora_prep(const Args& a, const bf16_t* P, int vcu, int G, int tid) {
    bf16_t* LORA = (bf16_t*)(a.ws + WS_LORA); const float* mixp = a.in[I_SHIFT] + 3072;
    for (int gp = vcu * 512 + tid; gp < M * 36; gp += G * 512) {
        const int m = gp / 36, pc = gp - m * 36;
        const bf16_t* src = P + (size_t)m * NPR + C_L + pc * 8;
        const u32x4 cur = *(const u32x4*)src;
        u32x4 prv = (u32x4){0u, 0u, 0u, 0u};
        if ((m & (SEQ - 1)) != 0) prv = *(const u32x4*)(src - NPR);
        const f32x4 m0 = *(const f32x4*)(mixp + pc * 8), m1 = *(const f32x4*)(mixp + pc * 8 + 4);
        float z[8];
        { const unsigned cw_[4] = {cur.x, cur.y, cur.z, cur.w}, pw_[4] = {prv.x, prv.y, prv.z, prv.w}; const float mm[8] = {m0.x, m0.y, m0.z, m0.w, m1.x, m1.y, m1.z, m1.w};
#pragma unroll
          for (int e = 0; e < 4; ++e) { const float c0_ = bflo(cw_[e]), c1_ = bfhi(cw_[e]), p0_ = bflo(pw_[e]), p1_ = bfhi(pw_[e]);
              z[2 * e] = c0_ + (p0_ - c0_) * mm[2 * e]; z[2 * e + 1] = c1_ + (p1_ - c1_) * mm[2 * e + 1]; } }
        if (pc < 8) {
#pragma unroll
            for (int e = 0; e < 8; ++e) { const float ex = fast_exp2(2.f * LOG2E * z[e]); z[e] = 1.f - 2.f * __builtin_amdgcn_rcpf(ex + 1.f); }
        } else if (pc >= 16) {
#pragma unroll
            for (int e = 0; e < 8; ++e) z[e] = sigmoidf_(z[e]);
        }
        *(u32x4*)(LORA + (size_t)m * 288 + pc * 8) = (u32x4){cvtpk(z[0], z[1]), cvtpk(z[2], z[3]), cvtpk(z[4], z[5]), cvtpk(z[6], z[7])};
    }
}

constexpr int CK_RAW = 0;
constexpr int CK_CARRY = 12288;
constexpr int CK_CL = 13312, CK_AA = CK_CL + 8192, CK_GG = CK_AA + 8192, CK_YY = CK_GG + 8192;
constexpr int CK_BD = CK_YY + 8192;
constexpr int CK_GC = CK_BD + 128;
constexpr int CK_AW = CK_GC + 256, CK_AZ = CK_AW + 32 * 144, CK_AG = CK_AZ + 32 * 144;
constexpr int CK_RKK = CK_AW, CK_RBH = CK_RKK + 4608, CK_RKH = CK_RBH + 4608, CK_RRH = CK_RKH + 4608;
constexpr int CK_VKK = CK_AG + 32 * 336;
constexpr int CK_VVM = CK_VKK + 4096;
constexpr int CK_VBT = CK_VVM + 4096;
constexpr int CK_VKT = CK_VBT + 4096;
constexpr int CK_IP = CK_VKT + 4096;
constexpr int CK_IT = CK_IP + 2048, CK_ILK = CK_IT + 2048, CK_IMB = CK_ILK + 2048, CK_IMK = CK_IMB + 2048;
constexpr int CK_IG = CK_IMK + 2048;
constexpr int CK_WD = CK_IG + 4096;
constexpr int CK_WG = CK_WD + 64 * 144;
constexpr int CK_END = CK_WG + 64 * 336;
constexpr int CK_WI = 132096;
static_assert(CK_WI + 64 * 144 <= LDS_BYTES, "lora weights LDS");
static_assert(CK_RRH + 4608 <= CK_VKK && CK_END <= RING_BYTES && (CK_AW % 16) == 0 && (CK_VKK % 16) == 0, "chunked scan LDS");

__device__ __forceinline__ bf16x8 a_perm(const LAS unsigned char* img, int stride, int row, int col0, int hi) {
    const LAS unsigned char* p = img + row * stride + (col0 + 4 * hi) * 2;
    const s16x4 lo = *(const LAS s16x4*)p, hh = *(const LAS s16x4*)(p + 16);
    return (bf16x8){lo[0], lo[1], lo[2], lo[3], hh[0], hh[1], hh[2], hh[3]};
}
__device__ __forceinline__ bf16x8 b_tr(const LAS unsigned char* blk, int ks, int r32, int hi) {
    const LAS unsigned char* vp = blk + ((r32 >> 4) & 1) * 32 + (r32 & 3) * 8 + (4 * hi + ((r32 & 15) >> 2)) * 64 + ks * 1024;
    const s16x4 lo = vtr(vp), hh = vtr(vp + 512);
    return (bf16x8){lo[0], lo[1], lo[2], lo[3], hh[0], hh[1], hh[2], hh[3]};
}
__device__ __forceinline__ bf16x8 acc_frag(const f32x16& x, int s) {
    const u32x4 w = (u32x4){cvtpk(x[8 * s + 0], x[8 * s + 1]), cvtpk(x[8 * s + 2], x[8 * s + 3]), cvtpk(x[8 * s + 4], x[8 * s + 5]), cvtpk(x[8 * s + 6], x[8 * s + 7])};
    return __builtin_bit_cast(bf16x8, w);
}
__device__ __forceinline__ void img_store_t(LAS unsigned char* img, int col, int hi, const f32x16& x, float sgn) {
#pragma unroll
    for (int q = 0; q < 4; ++q) *(LAS u32x2*)(img + col * 64 + (8 * q + 4 * hi) * 2) = (u32x2){cvtpk(x[4 * q] * sgn, x[4 * q + 1] * sgn), cvtpk(x[4 * q + 2] * sgn, x[4 * q + 3] * sgn)};
}
#define MFMA32(a, b, c) __builtin_amdgcn_mfma_f32_32x32x16_bf16(a, b, c, 0, 0, 0)

constexpr int PK_HB = 39296;
constexpr int HB_RKK = 0, HB_RBH = 4608, HB_RKH = 9216, HB_RRH = 13824, HB_VKK = 18432, HB_VVM = 22528, HB_VBT = 26624, HB_VKT = 30720, HB_GC = 34816, HB_BD = 35072, HB_GG = 35200;
constexpr int PK_RAW = 2 * PK_HB, PK_CARRY = PK_RAW + 12288, PK_CL = PK_CARRY + 1024, PK_AA = PK_CL + 8192, PK_AW = PK_AA + 8192, PK_AZ = PK_AW + 4608, PK_AG = PK_AZ + 4608;
static_assert(PK_AG + 32 * 336 <= RING_BYTES, "pipelined scan LDS (ring part)");
constexpr int PK_CONST = PK_AG + 32 * 336;
static_assert(PK_CONST + 2048 <= RING_BYTES, "pipelined scan LDS (constants)");
constexpr int PK_YY = 132096;
static_assert(PK_YY + 2 * 8192 <= LDS_BYTES, "pipelined scan LDS (upper part)");
constexpr int NCH = SEQ / TC;

__device__ __forceinline__ f32x16 gram_tile(const bf16x8 (&af)[4], const bf16x8 (&bf)[4]) {
    f32x16 acc;
#pragma unroll
    for (int r = 0; r < 16; ++r) acc[r] = 0.f;
#pragma unroll
    for (int s = 0; s < 4; ++s) acc = MFMA32(af[s], bf[s], acc);
    return acc;
}
template <int MODE> __device__ __forceinline__ void tri_mask(f32x16& x, int r32, int hi, float sgn) {
#pragma unroll
    for (int r = 0; r < 16; ++r) { const int row = crow(r, hi); const bool keep = (MODE == 0) ? (r32 < row) : ((MODE == 1) ? (r32 > row) : (r32 >= row)); x[r] = keep ? x[r] * sgn : 0.f; }
}

__device__ __forceinline__ void rwkv_head_pipe(const Args& a, const bf16_t* PQp, const bf16_t* PRp, bf16_t* Yout, int ypitch, int b, int h, LAS unsigned char* lds, int tid) {
    const int lane = tid & 63, r32 = lane & 31, hi = lane >> 5; const int wid = __builtin_amdgcn_readfirstlane(tid >> 6);
    const size_t rowbase = (size_t)b * SEQ;
    if (wid < 6) {
        LAS float* CL = (LAS float*)(lds + PK_CL); LAS float* AA = (LAS float*)(lds + PK_AA);
        const int lnb = wid & 1, lch = h * 64 + 32 * lnb + r32;
        const float lbase = (wid < 2) ? a.in[I_DBASE][lch] : ((wid < 4) ? a.in[I_IBASE][lch] : 0.f);
        const int oc = tid & 7, tk = (tid >> 3) & 31, ch0 = h * 64 + 8 * oc;
        if (tid < 128) { const int v8 = tid >> 4, q = tid & 15; const float* srcv;
            switch (v8) { case 0: srcv = a.in[I_KNS]; break; case 1: srcv = a.in[I_KIS]; break; case 2: srcv = a.in[I_BONUS]; break; case 3: srcv = a.in[I_LNW]; break; case 4: srcv = a.in[I_LNB]; break;
                          case 5: srcv = a.in[I_SHIFT]; break; case 6: srcv = a.in[I_SHIFT] + 1024; break; default: srcv = a.in[I_SHIFT] + 2048; break; }
            *(LAS f32x4*)(lds + PK_CONST + v8 * 256 + q * 16) = *(const f32x4*)(srcv + h * 64 + 4 * q); }
        (void)ch0;
#define CV(v8, q) (*(const LAS f32x4*)(lds + PK_CONST + (v8) * 256 + oc * 32 + (q) * 16))
        bf16x8 bfr[10];
        { const bf16_t* up = (wid < 2) ? (const bf16_t*)(a.ws + WS_DUPT) + (size_t)lch * 64 : ((wid < 4) ? (const bf16_t*)(a.ws + WS_IUPT) + (size_t)lch * 64 : (const bf16_t*)(a.ws + WS_GUPT) + (size_t)lch * 160);
          if (wid < 4) {
#pragma unroll
              for (int s = 0; s < 4; ++s) bfr[s] = *(const bf16x8*)(up + 16 * s + 8 * hi);
#pragma unroll
              for (int s = 4; s < 10; ++s) bfr[s] = bfr[0];
          } else {
#pragma unroll
              for (int s = 0; s < 10; ++s) bfr[s] = *(const bf16x8*)(up + 16 * s + 8 * hi);
          } }
        const unsigned char* psrc[5]; unsigned pstride[5]; u32x4 pre[5];
        const bf16_t* LORA = (const bf16_t*)(a.ws + WS_LORA);
#pragma unroll
        for (int i = 0; i < 5; ++i) {
            const int p = tid + 384 * i; const int tl = p / 60, pc = p - tl * 60;
            if (pc < 8) { psrc[i] = (const unsigned char*)(PQp + (rowbase + tl) * NPQ + C_R + h * 64 + pc * 8); pstride[i] = NPQ * 2; }
            else if (pc < 24) { psrc[i] = (const unsigned char*)(PRp + (rowbase + tl) * NPR + (pc < 16 ? C_K : C_V) + h * 64 + (pc & 7) * 8); pstride[i] = NPR * 2; }
            else { psrc[i] = (const unsigned char*)(LORA + (rowbase + tl) * 288 + (pc - 24) * 8); pstride[i] = 288 * 2; }
            pre[i] = __builtin_nontemporal_load((const u32x4*)psrc[i]);
        }
        u32x4 po_g[2], po_v[2]; float po_bd[2];
#pragma unroll
        for (int i2 = 0; i2 < 2; ++i2) { po_g[i2] = (u32x4){0u, 0u, 0u, 0u}; po_v[i2] = po_g[i2]; po_bd[i2] = 0.f; }
#pragma unroll 1
        for (int it = 0; it < NCH + 2; ++it) {
            if (it >= 2 && wid >= 4) {
                const LAS unsigned char* hb = lds + (it & 1) * PK_HB;
#pragma unroll
                for (int i2 = 0; i2 < 2; ++i2) { const int tk2 = ((tid - 256) >> 3) + 16 * i2;
                    po_g[i2] = *(const LAS u32x4*)(hb + HB_GG + tk2 * 128 + oc * 16); po_v[i2] = *(const LAS u32x4*)(hb + HB_VVM + (oc >> 2) * 2048 + tk2 * 64 + (oc & 3) * 16);
                    po_bd[i2] = *(const LAS float*)(hb + HB_BD + tk2 * 4); }
            }
#ifdef X_DUPCOPY
            for (int rep_ = 0; rep_ < 2; ++rep_)
#endif
            if (it < NCH) {
#pragma unroll
                for (int i = 0; i < 5; ++i) {
                    const int p = tid + 384 * i; const int tl = p / 60, pc = p - tl * 60;
                    LAS unsigned char* dst;
                    if (pc < 24) dst = lds + PK_RAW + (tl * 24 + pc) * 16;
                    else if (pc < 32) dst = lds + PK_AW + tl * 144 + (pc - 24) * 16;
                    else if (pc < 40) dst = lds + PK_AZ + tl * 144 + (pc - 32) * 16;
                    else dst = lds + PK_AG + tl * 336 + (pc - 40) * 16;
                    *(LAS u32x4*)dst = pre[i];
                }
                if (it + 1 < NCH) {
#pragma unroll
                    for (int i = 0; i < 5; ++i) pre[i] = __builtin_nontemporal_load((const u32x4*)(psrc[i] + (size_t)((it + 1) * TC) * pstride[i]));
                }
            }
            __syncthreads();
#ifdef X_DUPJ2
            for (int rep_ = 0; rep_ < 2; ++rep_)
#endif
            if (it < NCH) {
                LAS unsigned char* hb = lds + (it & 1) * PK_HB;
                f32x16 acc;
                if (wid < 4) acc = lora_mma<4>(lds + (wid < 2 ? PK_AW : PK_AZ), 144, bfr, r32, hi);
                else acc = lora_mma<10>(lds + PK_AG, 336, bfr, r32, hi);
                if (wid < 2) {
                    float ew[16];
#pragma unroll
                    for (int r = 0; r < 16; ++r) ew[r] = (-0.6065306597126334f * LOG2E) * sigmoidf_(lbase + acc[r]);
                    float pf[16], tot[4], oth[4];
#pragma unroll
                    for (int m = 0; m < 4; ++m) { pf[4 * m] = ew[4 * m]; pf[4 * m + 1] = pf[4 * m] + ew[4 * m + 1]; pf[4 * m + 2] = pf[4 * m + 1] + ew[4 * m + 2]; pf[4 * m + 3] = pf[4 * m + 2] + ew[4 * m + 3]; tot[m] = pf[4 * m + 3]; }
#pragma unroll
                    for (int m = 0; m < 4; ++m) oth[m] = __shfl_xor(tot[m], 32);
                    float off = 0.f;
#pragma unroll
                    for (int m = 0; m < 4; ++m) { const float o_m = off + (hi ? oth[m] : 0.f);
#pragma unroll
                        for (int q = 0; q < 4; ++q) { const int r = 4 * m + q; CL[crow(r, hi) * 64 + 32 * lnb + r32] = fast_exp2(o_m + pf[r]); }
                        off += tot[m] + oth[m]; }
                } else if (wid < 4) {
#pragma unroll
                    for (int r = 0; r < 16; ++r) AA[crow(r, hi) * 64 + 32 * lnb + r32] = sigmoidf_(lbase + acc[r]);
                } else {
#pragma unroll
                    for (int r = 0; r < 16; ++r) *(LAS unsigned short*)(hb + HB_GG + crow(r, hi) * 128 + (32 * lnb + r32) * 2) = (unsigned short)f2bf(acc[r]);
                }
            }
            __syncthreads();
            if (it < NCH && wid < 4) {
                LAS unsigned char* hb = lds + (it & 1) * PK_HB;
                const LAS unsigned char* rc = lds + PK_RAW + (tk * 24 + oc) * 16;
                const u32x4 cr = *(const LAS u32x4*)rc, ck = *(const LAS u32x4*)(rc + 128), cv = *(const LAS u32x4*)(rc + 256);
                u32x4 pr, pk, pv;
                if (tk > 0) { pr = *(const LAS u32x4*)(rc - 384); pk = *(const LAS u32x4*)(rc - 256); pv = *(const LAS u32x4*)(rc - 128); }
                else if (it > 0) { const LAS unsigned char* cc = lds + PK_CARRY + ((it - 1) & 1) * 384 + oc * 16; pr = *(const LAS u32x4*)cc; pk = *(const LAS u32x4*)(cc + 128); pv = *(const LAS u32x4*)(cc + 256); }
                else { pr = (u32x4){0u, 0u, 0u, 0u}; pk = pr; pv = pr; }
                if (tk == TC - 1) { LAS unsigned char* cc = lds + PK_CARRY + (it & 1) * 384 + oc * 16; *(LAS u32x4*)cc = cr; *(LAS u32x4*)(cc + 128) = ck; *(LAS u32x4*)(cc + 256) = cv; }
                f32x4 rv[2], zk[2], vv[2];
#define LERP8(dst, c, p, mx) do { const f32x4 c0_ = (f32x4){bflo(c.x), bfhi(c.x), bflo(c.y), bfhi(c.y)}, c1_ = (f32x4){bflo(c.z), bfhi(c.z), bflo(c.w), bfhi(c.w)}; \
                    const f32x4 p0_ = (f32x4){bflo(p.x), bfhi(p.x), bflo(p.y), bfhi(p.y)}, p1_ = (f32x4){bflo(p.z), bfhi(p.z), bflo(p.w), bfhi(p.w)}; \
                    dst[0] = c0_ + (p0_ - c0_) * mx[0]; dst[1] = c1_ + (p1_ - c1_) * mx[1]; } while (0)
                { const f32x4 mr_[2] = {CV(5, 0), CV(5, 1)}, mk_[2] = {CV(6, 0), CV(6, 1)}, mv_[2] = {CV(7, 0), CV(7, 1)}; LERP8(rv, cr, pr, mr_); LERP8(zk, ck, pk, mk_); LERP8(vv, cv, pv, mv_); }
#undef LERP8
                f32x4 kkv[2], kp[2], bb[2]; float ss = 0.f, bd = 0.f;
                f32x4 e1[2], e0[2], em[2], ec[2];
#pragma unroll
                for (int q = 0; q < 2; ++q) {
                    const f32x4 av = *(LAS f32x4*)(AA + tk * 64 + 8 * oc + 4 * q);
                    const f32x4 cl = *(LAS f32x4*)(CL + tk * 64 + 8 * oc + 4 * q), clc = *(LAS f32x4*)(CL + 31 * 64 + 8 * oc + 4 * q);
                    f32x4 clp = (f32x4){1.f, 1.f, 1.f, 1.f}; if (tk > 0) clp = *(LAS f32x4*)(CL + (tk - 1) * 64 + 8 * oc + 4 * q);
                    kkv[q] = zk[q] * CV(0, q);
                    ss += (kkv[q].x * kkv[q].x + kkv[q].y * kkv[q].y) + (kkv[q].z * kkv[q].z + kkv[q].w * kkv[q].w);
                    kp[q] = zk[q] * (1.0f + (av - 1.0f) * CV(1, q));
                    bb[q] = av;
                    const f32x4 t3 = rv[q] * kp[q] * CV(2, q); bd += (t3.x + t3.y) + (t3.z + t3.w);
#pragma unroll
                    for (int e = 0; e < 4; ++e) { e1[q][e] = cl[e]; e0[q][e] = clp[e]; em[q][e] = __builtin_amdgcn_rcpf(cl[e]); ec[q][e] = clc[e] * em[q][e]; }
                }
                ss = red8(ss); bd = red8(bd);
                const float inv = __builtin_amdgcn_rsqf(fmaxf(ss, 1e-24f));
                if (oc == 0) *(LAS float*)(hb + HB_BD + tk * 4) = bd;
                if (tk == 31) { *(LAS f32x4*)(hb + HB_GC + 32 * oc) = e1[0]; *(LAS f32x4*)(hb + HB_GC + 32 * oc + 16) = e1[1]; }
                u32x4 wkk, wbh, wkh, wrh, wbt, wkt, wvv;
                {
                    const f32x4 k0 = kkv[0] * inv, k1 = kkv[1] * inv, b0 = k0 * bb[0], b1 = k1 * bb[1];
                    const f32x4 kkh0 = k0 * e0[0], kkh1 = k1 * e0[1], bh0 = b0 * em[0], bh1 = b1 * em[1], kh0 = kp[0] * em[0], kh1 = kp[1] * em[1];
                    const f32x4 rh0 = rv[0] * e1[0], rh1 = rv[1] * e1[1], bt0 = b0 * ec[0], bt1 = b1 * ec[1], kt0 = kp[0] * ec[0], kt1 = kp[1] * ec[1];
                    wkk = (u32x4){cvtpk(kkh0.x, kkh0.y), cvtpk(kkh0.z, kkh0.w), cvtpk(kkh1.x, kkh1.y), cvtpk(kkh1.z, kkh1.w)};
                    wbh = (u32x4){cvtpk(bh0.x, bh0.y), cvtpk(bh0.z, bh0.w), cvtpk(bh1.x, bh1.y), cvtpk(bh1.z, bh1.w)};
                    wkh = (u32x4){cvtpk(kh0.x, kh0.y), cvtpk(kh0.z, kh0.w), cvtpk(kh1.x, kh1.y), cvtpk(kh1.z, kh1.w)};
                    wrh = (u32x4){cvtpk(rh0.x, rh0.y), cvtpk(rh0.z, rh0.w), cvtpk(rh1.x, rh1.y), cvtpk(rh1.z, rh1.w)};
                    wbt = (u32x4){cvtpk(-bt0.x, -bt0.y), cvtpk(-bt0.z, -bt0.w), cvtpk(-bt1.x, -bt1.y), cvtpk(-bt1.z, -bt1.w)};
                    wkt = (u32x4){cvtpk(kt0.x, kt0.y), cvtpk(kt0.z, kt0.w), cvtpk(kt1.x, kt1.y), cvtpk(kt1.z, kt1.w)};
                    wvv = (u32x4){cvtpk(vv[0].x, vv[0].y), cvtpk(vv[0].z, vv[0].w), cvtpk(vv[1].x, vv[1].y), cvtpk(vv[1].z, vv[1].w)};
                }
                const int ro = tk * 144 + 16 * oc, vo = (oc >> 2) * 2048 + tk * 64 + (oc & 3) * 16;
                *(LAS u32x4*)(hb + HB_RKK + ro) = wkk; *(LAS u32x4*)(hb + HB_RBH + ro) = wbh; *(LAS u32x4*)(hb + HB_RKH + ro) = wkh; *(LAS u32x4*)(hb + HB_RRH + ro) = wrh;
                *(LAS u32x4*)(hb + HB_VKK + vo) = wkk; *(LAS u32x4*)(hb + HB_VVM + vo) = wvv; *(LAS u32x4*)(hb + HB_VBT + vo) = wbt; *(LAS u32x4*)(hb + HB_VKT + vo) = wkt;
            }
            if (it >= 2 && wid >= 4) {
                const LAS float* YY = (const LAS float*)(lds + PK_YY + (it & 1) * 8192); const int t0p = (it - 2) * TC;
#pragma unroll
                for (int i2 = 0; i2 < 2; ++i2) { const int tk2 = ((tid - 256) >> 3) + 16 * i2;
                    const f32x4 y0 = *(const LAS f32x4*)(YY + tk2 * 64 + 8 * oc), y1 = *(const LAS f32x4*)(YY + tk2 * 64 + 8 * oc + 4);
                    const u32x4 gw = po_g[i2], vw = po_v[i2];
                    const f32x4 g0 = (f32x4){bflo(gw.x), bfhi(gw.x), bflo(gw.y), bfhi(gw.y)}, g1 = (f32x4){bflo(gw.z), bfhi(gw.z), bflo(gw.w), bfhi(gw.w)};
                    const f32x4 v0 = (f32x4){bflo(vw.x), bfhi(vw.x), bflo(vw.y), bfhi(vw.y)}, v1 = (f32x4){bflo(vw.z), bfhi(vw.z), bflo(vw.w), bfhi(vw.w)};
                    float s1 = ((y0.x + y0.y) + (y0.z + y0.w)) + ((y1.x + y1.y) + (y1.z + y1.w)); s1 = red8(s1);
                    const float mu = s1 * (1.f / 64.f);
                    const f32x4 d0 = y0 - mu, d1 = y1 - mu;
                    float s2 = ((d0.x * d0.x + d0.y * d0.y) + (d0.z * d0.z + d0.w * d0.w)) + ((d1.x * d1.x + d1.y * d1.y) + (d1.z * d1.z + d1.w * d1.w)); s2 = red8(s2);
                    const float rstd = __builtin_amdgcn_rsqf(s2 * (1.f / 64.f) + GN_EPS);
                    const float bd = po_bd[i2];
                    const f32x4 o0 = ((d0 * rstd) * CV(3, 0) + CV(4, 0) + v0 * bd) * g0, o1 = ((d1 * rstd) * CV(3, 1) + CV(4, 1) + v1 * bd) * g1;
                    *(u32x4*)(Yout + (rowbase + t0p + tk2) * ypitch + h * 64 + 8 * oc) = (u32x4){cvtpk(o0.x, o0.y), cvtpk(o0.z, o0.w), cvtpk(o1.x, o1.y), cvtpk(o1.z, o1.w)}; }
            }
            __syncthreads();
        }
    } else {
        const int vb = wid - 6;
        __builtin_amdgcn_s_setprio(2);
        f32x16 St0, St1;
#pragma unroll
        for (int r = 0; r < 16; ++r) { St0[r] = 0.f; St1[r] = 0.f; }
#pragma unroll 1
        for (int it = 0; it < NCH + 2; ++it) {
            const bool act = (it >= 1) && (it <= NCH);
            const LAS unsigned char* hb = lds + ((it - 1) & 1) * PK_HB;
            f32x16 Pw, Qw, R, Rt, LkT, MbT, MkT, X;
#ifdef X_DUPGRAM
            for (int rep_ = 0; rep_ < 2; ++rep_)
#endif
            if (act) {
                bf16x8 fkk[4], fbh[4], fkh[4], frh[4];
#pragma unroll
                for (int s = 0; s < 4; ++s) { const int o = r32 * 144 + (16 * s + 8 * hi) * 2;
                    fkk[s] = *(const LAS bf16x8*)(hb + HB_RKK + o); fbh[s] = *(const LAS bf16x8*)(hb + HB_RBH + o); fkh[s] = *(const LAS bf16x8*)(hb + HB_RKH + o); frh[s] = *(const LAS bf16x8*)(hb + HB_RRH + o); }
                Pw = gram_tile(fkk, fbh);  tri_mask<0>(Pw, r32, hi, 1.f);
                Qw = gram_tile(fbh, fkk);  tri_mask<1>(Qw, r32, hi, 1.f);
                LkT = gram_tile(fkh, fkk);
                MbT = gram_tile(fbh, frh);
                MkT = gram_tile(fkh, frh);
            }
            __syncthreads();
            if (act) {
#pragma unroll
                for (int r = 0; r < 16; ++r) { const float id = (crow(r, hi) == r32) ? 1.f : 0.f; R[r] = id - Pw[r]; Rt[r] = id - Qw[r]; }
                tri_mask<1>(LkT, r32, hi, 1.f); tri_mask<2>(MbT, r32, hi, -1.f); tri_mask<2>(MkT, r32, hi, 1.f);
#pragma unroll
                for (int k = 0; k < 4; ++k) {
                    const bf16x8 p0 = acc_frag(Pw, 0), p1 = acc_frag(Pw, 1), q0 = acc_frag(Qw, 0), q1 = acc_frag(Qw, 1);
                    f32x16 Pn, Qn;
#pragma unroll
                    for (int r = 0; r < 16; ++r) { Pn[r] = 0.f; Qn[r] = 0.f; }
                    Pn = MFMA32(q0, p0, Pn); Pn = MFMA32(q1, p1, Pn);
                    Qn = MFMA32(p0, q0, Qn); Qn = MFMA32(p1, q1, Qn);
                    const bf16x8 r0 = acc_frag(R, 0), r1 = acc_frag(R, 1);
                    const bf16x8 n0 = acc_frag(Qn, 0), n1 = acc_frag(Qn, 1);
                    f32x16 Rn = R, Rtn = Rt;
                    Rn = MFMA32(n0, r0, Rn);  Rn = MFMA32(n1, r1, Rn);
                    Rtn = MFMA32(r0, n0, Rtn); Rtn = MFMA32(r1, n1, Rtn);
                    R = Rn; Rt = Rtn; Pw = Pn; Qw = Qn;
                }
                { const bf16x8 v0f = b_tr(hb + HB_VVM + vb * 2048, 0, r32, hi), v1f = b_tr(hb + HB_VVM + vb * 2048, 1, r32, hi);
#pragma unroll
                  for (int r = 0; r < 16; ++r) X[r] = 0.f;
                  X = MFMA32(acc_frag(LkT, 0), v0f, X); X = MFMA32(acc_frag(LkT, 1), v1f, X); }
            }
            __syncthreads();
            if (act) {
                const bf16x8 t0f = acc_frag(Rt, 0), t1f = acc_frag(Rt, 1);
                const bf16x8 v0f = b_tr(hb + HB_VVM + vb * 2048, 0, r32, hi), v1f = b_tr(hb + HB_VVM + vb * 2048, 1, r32, hi);
                f32x16 E;
#pragma unroll
                for (int r = 0; r < 16; ++r) E[r] = 0.f;
                E = MFMA32(t0f, acc_frag(X, 0), E); E = MFMA32(t1f, acc_frag(X, 1), E);
                f32x16 G0, G1;
#pragma unroll
                for (int r = 0; r < 16; ++r) { G0[r] = 0.f; G1[r] = 0.f; }
                G0 = MFMA32(b_tr(hb + HB_VKK, 0, r32, hi), t0f, G0);        G0 = MFMA32(b_tr(hb + HB_VKK, 1, r32, hi), t1f, G0);
                G1 = MFMA32(b_tr(hb + HB_VKK + 2048, 0, r32, hi), t0f, G1); G1 = MFMA32(b_tr(hb + HB_VKK + 2048, 1, r32, hi), t1f, G1);
                const bf16x8 s00 = acc_frag(St0, 0), s01 = acc_frag(St0, 1), s10 = acc_frag(St1, 0), s11 = acc_frag(St1, 1);
                E = MFMA32(acc_frag(G0, 0), s00, E); E = MFMA32(acc_frag(G0, 1), s01, E);
                E = MFMA32(acc_frag(G1, 0), s10, E); E = MFMA32(acc_frag(G1, 1), s11, E);
                const bf16x8 e0f = acc_frag(E, 0), e1f = acc_frag(E, 1);
                f32x16 Y;
#pragma unroll
                for (int r = 0; r < 16; ++r) Y[r] = 0.f;
                Y = MFMA32(a_perm(hb + HB_RRH, 144, r32, 0, hi), s00, Y);  Y = MFMA32(a_perm(hb + HB_RRH, 144, r32, 16, hi), s01, Y);
                Y = MFMA32(a_perm(hb + HB_RRH, 144, r32, 32, hi), s10, Y); Y = MFMA32(a_perm(hb + HB_RRH, 144, r32, 48, hi), s11, Y);
                Y = MFMA32(acc_frag(MbT, 0), e0f, Y); Y = MFMA32(acc_frag(MbT, 1), e1f, Y);
                Y = MFMA32(acc_frag(MkT, 0), v0f, Y); Y = MFMA32(acc_frag(MkT, 1), v1f, Y);
                LAS float* YY = (LAS float*)(lds + PK_YY + ((it - 1) & 1) * 8192);
#pragma unroll
                for (int r = 0; r < 16; ++r) YY[crow(r, hi) * 64 + 32 * vb + r32] = Y[r];
                const LAS float* GC = (const LAS float*)(hb + HB_GC);
#pragma unroll
                for (int q = 0; q < 4; ++q) { const f32x4 g0 = *(const LAS f32x4*)(GC + 8 * q + 4 * hi), g1 = *(const LAS f32x4*)(GC + 32 + 8 * q + 4 * hi);
#pragma unroll
                    for (int e = 0; e < 4; ++e) { St0[4 * q + e] *= g0[e]; St1[4 * q + e] *= g1[e]; } }
                St0 = MFMA32(b_tr(hb + HB_VBT, 0, r32, hi), e0f, St0);        St0 = MFMA32(b_tr(hb + HB_VBT, 1, r32, hi), e1f, St0);
                St0 = MFMA32(b_tr(hb + HB_VKT, 0, r32, hi), v0f, St0);        St0 = MFMA32(b_tr(hb + HB_VKT, 1, r32, hi), v1f, St0);
                St1 = MFMA32(b_tr(hb + HB_VBT + 2048, 0, r32, hi), e0f, St1); St1 = MFMA32(b_tr(hb + HB_VBT + 2048, 1, r32, hi), e1f, St1);
                St1 = MFMA32(b_tr(hb + HB_VKT + 2048, 0, r32, hi), v0f, St1); St1 = MFMA32(b_tr(hb + HB_VKT + 2048, 1, r32, hi), v1f, St1);
            }
            __syncthreads();
        }
        __builtin_amdgcn_s_setprio(0);
    }
#undef CV
    __syncthreads();
}

__global__ void __launch_bounds__(NWAVES * 64, 2) hyb_fwd(Args args) {
    extern __shared__ __attribute__((aligned(16))) unsigned char lds_raw[];
    LAS unsigned char* lds = (LAS unsigned char*)lds_raw;
    volatile LAS unsigned* MISC = (volatile LAS unsigned*)(lds + MISC_OFF);
    const int G = gridDim.x; const int bx = blockIdx.x; const int vcu = (G % 8 == 0) ? (bx % 8) * (G / 8) + bx / 8 : bx;
    unsigned char* ws = args.ws;
    for (int u = threadIdx.x; u < (LDS_BYTES - LDSCTL_OFF) / 4; u += NWAVES * 64) ((LAS unsigned*)(lds + LDSCTL_OFF))[u] = 0u;
    __syncthreads();
    XcdBarrier bar = xcd_barrier_post((unsigned*)(ws + WS_CTL) + CW_BAR, MISC + 8);
#define GRID_BAR() xcd_barrier(bar)
    bf16_t* PQ = (bf16_t*)(ws + WS_PQ); bf16_t* PR = (bf16_t*)(ws + WS_PR);
    bf16_t* XN = (bf16_t*)args.out; bf16_t* MIXED = (bf16_t*)((unsigned char*)args.out + 64 * MiB);
    bf16_t* O1 = (bf16_t*)(ws + WS_O1); bf16_t* XN2 = (bf16_t*)(ws + WS_XN2); bf16_t* Q2 = (bf16_t*)(ws + WS_Q2); bf16_t* O2 = (bf16_t*)(ws + WS_O2);
    bf16_t* ACT = (bf16_t*)(ws + WS_ACT); bf16_t* MN = (bf16_t*)(ws + WS_MN); bf16_t* KVM = (bf16_t*)(ws + WS_KVM);
    bf16_t* XB1 = (bf16_t*)(ws + WS_ACT); bf16_t* XB2 = (bf16_t*)(ws + WS_Q2);

#define FRESH_TID() int tid = threadIdx.x; asm volatile("" : "+v"(tid)); const int lane = tid & 63, wave = __builtin_amdgcn_readfirstlane(tid >> 6); (void)lane; (void)wave
#define GEMM(Aptr, Bptr, lda_, K_, Mrows, Ncols, pair_, ...) do { pg8::Gemm g{Aptr, (const bf16_t*)(Bptr), lda_, K_}; pg8::Order S; S.init(Mrows, Ncols, G, bx, pair_); \
        const pg8::Epi E{__VA_ARGS__}; pg8::gemm_phase(lds, g, S, E); } while (0)
    { FRESH_TID(); p0_prologue(args, lds, vcu, G, wave, lane); }
    GRID_BAR();
    GEMM(XN, ws + WS_W1T, DM, DM, M, NP, 0, pg8::EPI_STORE, PQ, NPQ, 0, C_Q / 256, C_Q / 256 + 4, QS_ATT, nullptr, 1, PR, NPR, NPQ / 256, 0);
    GRID_BAR();
    GEMM(MN, ws + WS_WKVT, DM, DM, MROWS, DM, 0, pg8::EPI_STORE, KVM, DM, 0, 0, 0, 1.f, nullptr, 0, nullptr, 0, 0, 0);
    if (G > 64) { if (bx >= 64) { FRESH_TID(); lora_prep(args, PR, bx - 64, G - 64, tid); } }
    else { FRESH_TID(); lora_prep(args, PR, bx, G, tid); }
    GRID_BAR();
    for (int u = vcu; u < NB * 16; u += G) { const int b = u >> 4, h = u & 15;
        { FRESH_TID(); rwkv_head_pipe(args, PQ, PR, PQ + C_R, NPQ, b, h, lds, tid); }
#if defined(ATT_2GROUP)
        { FRESH_TID(); chunk_attention_head(PQ, PR, PQ + C_Q, NPQ, args.in[I_RELB], b, h, lds, tid); }
#elif defined(ATT_8W2T)
        { FRESH_TID(); chunk_attention_head2(PQ, PR, PQ + C_Q, NPQ, args.in[I_RELB], b, h, lds, tid); }
#else
        { FRESH_TID(); chunk_attention_head3(PQ, PR, PQ + C_Q, NPQ, args.in[I_RELB], b, h, lds, tid); }
#endif
    }
    GRID_BAR();
    GEMM(XN, ws + WS_WGT, DM, DM, M, 2048, 0, pg8::EPI_SIGMOID, PR, NPR, C_GA, 0, 0, 1.f, nullptr, 0, nullptr, 0, 0, 0);
    GRID_BAR();
    GEMM(PQ, ws + WS_WABT, NPQ, DM, M, DM, 1, pg8::EPI_MIX, MIXED, DM, 0, 0, 0, 1.f, PR, 0, nullptr, 0, 0, NPR);
    GRID_BAR();
    GEMM(MIXED, ws + WS_WOUTT, DM, DM, M, DM, 0, pg8::EPI_STORE, O1, DM, 0, 0, 0, 1.f, nullptr, 0, nullptr, 0, 0, 0);
    GRID_BAR();
    { FRESH_TID(); norm_pass<false, true>(O1, args.in[I_X], XB1, args.in[I_GPOSTMIX], args.in[I_GPRECROSS], XN2, vcu, G, wave, lane); }
    GRID_BAR();
    GEMM(XN2, ws + WS_WQT, DM, DM, M, 512, 0, pg8::EPI_STORE, Q2, 512, 0, 0, 2, QS_MEM, nullptr, 0, nullptr, 0, 0, 0);
    GRID_BAR();
    { FRESH_TID(); cross_attention(Q2, KVM, O2, lds, vcu, G, tid); }
    GRID_BAR();
    GEMM(O2, ws + WS_WOT, 512, 512, M, DM, 0, pg8::EPI_STORE, O1, DM, 0, 0, 0, 1.f, nullptr, 0, nullptr, 0, 0, 0);
    GRID_BAR();
    { FRESH_TID(); norm_pass<true, true>(O1, XB1, XB2, args.in[I_GPOSTCROSS], args.in[I_GPREFFN], XN2, vcu, G, wave, lane); }
    GRID_BAR();
    GEMM(XN2, ws + WS_WF1T, DM, DM, M, 2 * FFH, 0, pg8::EPI_SWIGLU, ACT, FFH, 0, 0, 0, 1.f, nullptr, 0, nullptr, 0, 0, 0);
    GRID_BAR();
    GEMM(ACT, ws + WS_WF2T, FFH, FFH, M, DM, 0, pg8::EPI_STORE, O1, DM, 0, 0, 0, 1.f, nullptr, 0, nullptr, 0, 0, 0);
    GRID_BAR();
    { FRESH_TID(); norm_pass<true, false>(O1, XB2, args.out, args.in[I_GPOSTFFN], nullptr, nullptr, vcu, G, wave, lane); }
}

extern "C" void kernel_launch(void* const* d_in, const int* in_sizes, int n_in, void* d_out, int out_size, void* d_ws, size_t ws_size, hipStream_t stream) {
    static int grid = 0;
    if (grid == 0) {
        if (n_in != N_IN || in_sizes[0] != M * DM || out_size != M * DM || ws_size < WS_END) {
            fprintf(stderr, "kernel_launch: unexpected shapes (n_in %d, in0 %d, out %d, ws %zu); nothing launched\n", n_in, n_in > 0 ? in_sizes[0] : -1, out_size, ws_size); grid = -1; return; }
        int dev = 0, cus = 0;
        if (hipGetDevice(&dev) != hipSuccess || hipDeviceGetAttribute(&cus, hipDeviceAttributeMultiprocessorCount, dev) != hipSuccess) { grid = -1; return; }
        if (hipFuncSetAttribute((const void*)hyb_fwd, hipFuncAttributeMaxDynamicSharedMemorySize, LDS_BYTES) != hipSuccess) { fprintf(stderr, "kernel_launch: hipFuncSetAttribute failed\n"); grid = -1; return; }
        (void)hipGetLastError();
        grid = cus;
    }
    if (grid < 0) return;
    if (hipMemsetAsync((char*)d_ws + WS_CTL, 0, CTL_ZERO_BYTES, stream) != hipSuccess) return;
    Args a{};
    for (int i = 0; i < N_IN; ++i) a.in[i] = (const float*)d_in[i];
    a.out = (float*)d_out; a.ws = (unsigned char*)d_ws;
    hipLaunchKernelGGL(hyb_fwd, dim3(grid), dim3(NWAVES * 64), LDS_BYTES, stream, a);
}
```

```cpp
#include <hip/hip_runtime.h>
#include <hip/hip_bf16.h>
#include <cstdio>
#include <cstdint>

#define LAS __attribute__((address_space(3)))
#define GAS __attribute__((address_space(1)))
typedef unsigned short bf16_t;
typedef short bf16x8 __attribute__((ext_vector_type(8)));
typedef short s16x4 __attribute__((ext_vector_type(4)));
typedef float f32x4 __attribute__((ext_vector_type(4)));
typedef float f32x2 __attribute__((ext_vector_type(2)));
typedef float f32x16 __attribute__((ext_vector_type(16)));
typedef unsigned u32x4 __attribute__((ext_vector_type(4)));
typedef unsigned u32x2 __attribute__((ext_vector_type(2)));

constexpr int NB = 16, SEQ = 2048, DM = 1024, M = NB * SEQ;
constexpr int NP = 6656;
constexpr int NPQ = 2048, C_R = 0, C_Q = 1024;
constexpr int NPR = 4608, C_K = 0, C_V = 1024, C_L = 2048, C_KA = 2560, C_VA = 3584;
constexpr int C_GA = 0, C_GB = 1024;
constexpr int FFH = 2816, MEMT = 256, MROWS = NB * MEMT;
constexpr float NORM_EPS = 1e-6f, GN_EPS = 64e-5f;
constexpr float LOG2E = 1.4426950408889634f;
constexpr float QS_ATT = 0.125f * LOG2E;
constexpr float QS_MEM = 0.08838834764831845f * LOG2E;

constexpr size_t MiB = 1u << 20;
constexpr size_t WS_CTL = 0, CTL_ZERO_BYTES = 32 * 1024;
constexpr size_t WS_W1T = 1 * MiB;
constexpr size_t WS_WGT = 14 * MiB;
constexpr size_t WS_WABT = 18 * MiB;
constexpr size_t WS_WOUTT = 22 * MiB;
constexpr size_t WS_WQT = 24 * MiB;
constexpr size_t WS_WKVT = 25 * MiB;
constexpr size_t WS_WOT = 27 * MiB;
constexpr size_t WS_WF1T = 28 * MiB;
constexpr size_t WS_WF2T = 39 * MiB;
constexpr size_t WS_DUPT = 45 * MiB;
constexpr size_t WS_IUPT = WS_DUPT + 128 * 1024;
constexpr size_t WS_GUPT = WS_IUPT + 128 * 1024;
constexpr size_t WS_PQ = 48 * MiB;
constexpr size_t WS_PR = 176 * MiB;
constexpr size_t WS_MN = 464 * MiB;
constexpr size_t WS_KVM = 472 * MiB;
constexpr size_t WS_LORA = 480 * MiB;
constexpr size_t WS_O1 = 48 * MiB;
constexpr size_t WS_XN2 = 112 * MiB;
constexpr size_t WS_Q2 = 176 * MiB;
constexpr size_t WS_O2 = 208 * MiB;
constexpr size_t WS_ACT = 240 * MiB;
constexpr size_t WS_END = 512 * MiB;
constexpr int CW_BAR = 4096;

constexpr int RING_BYTES = 131072;
constexpr int LDSCTL_OFF = RING_BYTES, MISC_OFF = LDSCTL_OFF + 320;
constexpr int LDS_BYTES = 151552;
constexpr int NWAVES = 8;

#define RLX_AGENT __ATOMIC_RELAXED, __HIP_MEMORY_SCOPE_AGENT
#define LDS_WAIT() asm volatile("s_waitcnt lgkmcnt(0)" ::: "memory")
#define VM_WAIT() asm volatile("s_waitcnt vmcnt(0)" ::: "memory")

__device__ __forceinline__ unsigned f2bf(float f) { unsigned u = __builtin_bit_cast(unsigned, f); return (u + 0x7fffu + ((u >> 16) & 1u)) >> 16; }
__device__ __forceinline__ unsigned pk2(float lo, float hi) { return f2bf(lo) | (f2bf(hi) << 16); }
__device__ __forceinline__ float bf2f(unsigned short b) { return __builtin_bit_cast(float, (unsigned)b << 16); }
__device__ __forceinline__ float bflo(unsigned w) { return __builtin_bit_cast(float, w << 16); }
__device__ __forceinline__ float bfhi(unsigned w) { return __builtin_bit_cast(float, w & 0xffff0000u); }
typedef __bf16 bf16x2_t __attribute__((ext_vector_type(2)));
__device__ __forceinline__ unsigned cvtpk(float lo, float hi) { f32x2 v = {lo, hi}; bf16x2_t b = __builtin_convertvector(v, bf16x2_t); return __builtin_bit_cast(unsigned, b); }
__device__ __forceinline__ float wave_sum(float v) {
#pragma unroll
    for (int o = 1; o < 64; o <<= 1) v += __shfl_xor(v, o);
    return v;
}
__device__ __forceinline__ float fast_exp2(float x) { return __builtin_amdgcn_exp2f(x); }
__device__ __forceinline__ float sigmoidf_(float x) { return __builtin_amdgcn_rcpf(1.0f + __builtin_amdgcn_exp2f(-x * LOG2E)); }

#define XB_TMO      128
#define XB_XCNT(j)  (256  + 64 * (j))
#define XB_XSUB(j)  (1280 + 64 * (j))
#define XB_XGEN(j)  (2304 + 64 * (j))
#define XB_TOP      3328
#define XB_TOPGEN   3392
#define XCD_BAR_WORDS 3456
#define XB_SPIN_CAP (1u << 18)
__device__ __forceinline__ unsigned xb_ld(unsigned* p)              { return __hip_atomic_load(p, __ATOMIC_RELAXED, __HIP_MEMORY_SCOPE_AGENT); }
__device__ __forceinline__ unsigned xb_add(unsigned* p, unsigned v) { return __hip_atomic_fetch_add(p, v, __ATOMIC_RELAXED, __HIP_MEMORY_SCOPE_AGENT); }
__device__ __forceinline__ unsigned xb_xcc_id() { return (unsigned)__builtin_amdgcn_s_getreg((3 << 11) | 20) & 0xFu; }
#define XB_SPIN(cond, bar) do { unsigned _sp = 0; while (cond) { __builtin_amdgcn_s_sleep(1); \
    if ((++_sp & 255u) == 0u) { if (xb_ld(&(bar)[XB_TMO])) break; if (_sp > XB_SPIN_CAP) { atomicAdd(&(bar)[XB_TMO], 1u); break; } } } } while (0)
struct XcdBarrier { unsigned* bar; unsigned x; volatile LAS unsigned* st; };
__device__ __forceinline__ XcdBarrier xcd_barrier_post(unsigned* bar, volatile LAS unsigned* st) {
    XcdBarrier b; b.bar = bar; b.x = xb_xcc_id(); b.st = st;
    if (threadIdx.x == 0) (void)xb_add(&bar[XB_XCNT(b.x)], 1u);
    return b;
}
__device__ __forceinline__ void xcd_barrier_complete(unsigned* bar, unsigned x, unsigned& nloc, unsigned& nx) {
    const unsigned G = gridDim.x * gridDim.y * gridDim.z;
    unsigned sum, cnt, mine, sp = 0u;
    for (;;) {
        sum = 0u; cnt = 0u; mine = 0u;
#pragma unroll
        for (unsigned j = 0; j < 16; ++j) { const unsigned c = xb_ld(&bar[XB_XCNT(j)]); sum += c; cnt += (c > 0u) ? 1u : 0u; mine = (j == x) ? c : mine; }
        if (sum == G) break;
        __builtin_amdgcn_s_sleep(1);
        if ((++sp & 255u) == 0u) { if (xb_ld(&bar[XB_TMO])) break; if (sp > XB_SPIN_CAP) { atomicAdd(&bar[XB_TMO], 1u); break; } }
    }
    nloc = mine > 0u ? mine : 1u; nx = cnt > 0u ? cnt : 1u;
}
__device__ __forceinline__ void xcd_barrier(const XcdBarrier& b) {
    asm volatile("s_waitcnt vmcnt(0)" ::: "memory");
    __syncthreads();
    if (threadIdx.x == 0) {
        unsigned* bar = b.bar;
        __builtin_amdgcn_s_waitcnt(0);
        unsigned nloc = b.st[0], nx = b.st[1];
        if (nloc == 0u) { xcd_barrier_complete(bar, b.x, nloc, nx); b.st[0] = nloc; b.st[1] = nx; }
        const unsigned old = xb_add(&bar[XB_XSUB(b.x)], 1u);
        const unsigned gen = old / nloc;
        if (old + 1u == (gen + 1u) * nloc) {
            __builtin_amdgcn_fence(__ATOMIC_RELEASE, "agent");
            asm volatile("s_waitcnt vmcnt(0)" ::: "memory");
            const unsigned og = xb_add(&bar[XB_TOP], 1u);
            const unsigned tg = og / nx;
            if (og + 1u == (tg + 1u) * nx) xb_add(&bar[XB_TOPGEN], 1u);
            else XB_SPIN(xb_ld(&bar[XB_TOPGEN]) == tg, bar);
            __builtin_amdgcn_fence(__ATOMIC_ACQUIRE, "agent");
            xb_add(&bar[XB_XGEN(b.x)], 1u);
            asm volatile("s_waitcnt vmcnt(0)" ::: "memory");
        } else {
            XB_SPIN(xb_ld(&bar[XB_XGEN(b.x)]) == gen, bar);
            __builtin_amdgcn_fence(__ATOMIC_ACQUIRE, "agent");
            asm volatile("s_waitcnt vmcnt(0)" ::: "memory");
        }
    }
    __syncthreads();
}

namespace pg8 {
constexpr int BM = 256, BK = 64, HALF = 128, HTB = HALF * BK * 2, STAGE_BYTES = 8 * HTB, NXCD = 8, WGM = 4;
__host__ __device__ __forceinline__ int lds_byte(int r, int c) { const int st = (r >> 4) * 2 + (c >> 5), rr = r & 15, cc = c & 31, ob = rr * 64 + cc * 2; return st * 1024 + (ob ^ (((ob >> 9) & 1) << 5)); }
__host__ __device__ __forceinline__ void stage_rc(int b, int& R, int& C) { const int st = b / 1024, sb = b % 1024, swz = sb ^ (((sb >> 9) & 1) << 5); R = (st >> 1) * 16 + swz / 64; C = (st & 1) * 32 + (swz % 64) / 2; }
__host__ __device__ __forceinline__ int perm32(int rho) { const int n = rho >> 4, i = rho & 15; return 8 * (i >> 2) + 4 * n + (i & 3); }

struct Unit { int pm, pn, ac; };
struct Gemm { const bf16_t* A; const bf16_t* Bt; int lda, K; };

__device__ __forceinline__ void tile_of(int wgid0, int nM, int nN, int& pm, int& pn) {
    const int nwg = nM * nN; int wgid = wgid0;
    { const int q = nwg / NXCD, r = nwg % NXCD, xcd = wgid % NXCD, off = wgid / NXCD; wgid = (xcd < r ? xcd * (q + 1) : r * (q + 1) + (xcd - r) * q) + off; }
    const int nig = WGM * nN, gid = wgid / nig, fm = gid * WGM, gsz = (nM - fm) < WGM ? (nM - fm) : WGM;
    pm = fm + ((wgid % nig) % gsz); pn = (wgid % nig) / gsz;
}
#define EPI_FOR_ROWS for (int ai = 0; ai < 2; ++ai) _Pragma("unroll") for (int m = 0; m < 4; ++m)
enum { EPI_STORE = 0, EPI_SIGMOID = 1, EPI_MIX = 2, EPI_SWIGLU = 3 };
struct Epi {
    int type; bf16_t* O; int ldc; int coff; int s_lo, s_hi; float scale; const bf16_t* P; int nt; bf16_t* O2; int ldc2; int split; int pld;
    __device__ __forceinline__ void operator()(const f32x4 (&acc)[2][2][4][2], const Unit& u, int wr, int wc, int fr, int fq) const {
        const int row0 = u.pm * BM + wr * 64 + fr;
        if (type == EPI_STORE || type == EPI_SIGMOID) {
            const float sc = (u.pn >= s_lo && u.pn < s_hi) ? scale : 1.f;
            const bool hi2 = (split > 0) && (u.pn >= split); bf16_t* const Ob = hi2 ? O2 : O; const int ldo = hi2 ? ldc2 : ldc;
            const int col0 = coff + (hi2 ? u.pn - split : u.pn) * BM + wc * 32 + 8 * fq; const bool sg = (type == EPI_SIGMOID);
#pragma unroll
            EPI_FOR_ROWS { bf16_t* rowp = Ob + (size_t)(row0 + ai * HALF + m * 16) * ldo + col0;
#pragma unroll
                for (int bj = 0; bj < 2; ++bj) { f32x4 v0 = acc[ai][bj][m][0] * sc, v1 = acc[ai][bj][m][1] * sc;
                    if (sg) {
#pragma unroll
                        for (int e = 0; e < 4; ++e) { v0[e] = sigmoidf_(v0[e]); v1[e] = sigmoidf_(v1[e]); } }
                    u32x4 w; w.x = cvtpk(v0[0], v0[1]); w.y = cvtpk(v0[2], v0[3]); w.z = cvtpk(v1[0], v1[1]); w.w = cvtpk(v1[2], v1[3]);
                    if (nt) __builtin_nontemporal_store(w, (u32x4*)(rowp + bj * HALF)); else *(u32x4*)(rowp + bj * HALF) = w; } }
        } else if (type == EPI_MIX) {
            const int pn = u.pn & 3;
            const int col0 = pn * BM + wc * 32 + 8 * fq;
            const int gcol = C_GB + col0;
#pragma unroll
            for (int ai = 0; ai < 2; ++ai) {
                u32x4 gv[4][2];
#pragma unroll
                for (int m = 0; m < 4; ++m)
#pragma unroll
                    for (int bj = 0; bj < 2; ++bj) gv[m][bj] = *(const u32x4*)(P + (size_t)(row0 + ai * HALF + m * 16) * pld + gcol + bj * HALF);
#pragma unroll
                for (int m = 0; m < 4; ++m)
#pragma unroll
                    for (int bj = 0; bj < 2; ++bj) { const size_t row = (size_t)(row0 + ai * HALF + m * 16);
                        const u32x4 g = gv[m][bj];
                        f32x4 v0 = acc[ai][bj][m][0], v1 = acc[ai][bj][m][1];
                        v0[0] *= bflo(g.x); v0[1] *= bfhi(g.x); v0[2] *= bflo(g.y); v0[3] *= bfhi(g.y);
                        v1[0] *= bflo(g.z); v1[1] *= bfhi(g.z); v1[2] *= bflo(g.w); v1[3] *= bfhi(g.w);
                        u32x4 w; w.x = cvtpk(v0[0], v0[1]); w.y = cvtpk(v0[2], v0[3]); w.z = cvtpk(v1[0], v1[1]); w.w = cvtpk(v1[2], v1[3]);
                        *(u32x4*)(O + row * ldc + col0 + bj * HALF) = w; }
            }
        } else {
            const int col0 = u.pn * HALF + wc * 32 + 8 * fq;
#pragma unroll
            EPI_FOR_ROWS { bf16_t* rowp = O + (size_t)(row0 + ai * HALF + m * 16) * ldc + col0;
                f32x4 v0 = acc[ai][0][m][0], v1 = acc[ai][0][m][1]; const f32x4 u0 = acc[ai][1][m][0], u1 = acc[ai][1][m][1];
#pragma unroll
                for (int e = 0; e < 4; ++e) { v0[e] = v0[e] * sigmoidf_(v0[e]) * u0[e]; v1[e] = v1[e] * sigmoidf_(v1[e]) * u1[e]; }
                u32x4 w; w.x = cvtpk(v0[0], v0[1]); w.y = cvtpk(v0[2], v0[3]); w.z = cvtpk(v1[0], v1[1]); w.w = cvtpk(v1[2], v1[3]);
                *(u32x4*)rowp = w; }
        }
    }
    __device__ __forceinline__ bool keep(const Unit& u) const { return type == EPI_MIX && (u.pn >> 2) == 0; }
    __device__ __forceinline__ void scale_keep(f32x4 (&acc)[2][2][4][2], const Unit& u, int wr, int wc, int fr, int fq) const {
        const int row0 = u.pm * BM + wr * 64 + fr, col0 = (u.pn & 3) * BM + wc * 32 + 8 * fq;
#pragma unroll
        for (int ai = 0; ai < 2; ++ai) {
            u32x4 ga[4][2], gb[4][2];
#pragma unroll
            for (int m = 0; m < 4; ++m)
#pragma unroll
                for (int bj = 0; bj < 2; ++bj) { const bf16_t* gp = P + (size_t)(row0 + ai * HALF + m * 16) * pld + col0 + bj * HALF; ga[m][bj] = *(const u32x4*)(gp + C_GA); gb[m][bj] = *(const u32x4*)(gp + C_GB); }
#pragma unroll
            for (int m = 0; m < 4; ++m)
#pragma unroll
                for (int bj = 0; bj < 2; ++bj) { const u32x4 a = ga[m][bj], b = gb[m][bj];
                    f32x4& v0 = acc[ai][bj][m][0]; f32x4& v1 = acc[ai][bj][m][1];
                    v0[0] *= bflo(a.x) * __builtin_amdgcn_rcpf(bflo(b.x)); v0[1] *= bfhi(a.x) * __builtin_amdgcn_rcpf(bfhi(b.x)); v0[2] *= bflo(a.y) * __builtin_amdgcn_rcpf(bflo(b.y)); v0[3] *= bfhi(a.y) * __builtin_amdgcn_rcpf(bfhi(b.y));
                    v1[0] *= bflo(a.z) * __builtin_amdgcn_rcpf(bflo(b.z)); v1[1] *= bfhi(a.z) * __builtin_amdgcn_rcpf(bfhi(b.z)); v1[2] *= bflo(a.w) * __builtin_amdgcn_rcpf(bflo(b.w)); v1[3] *= bfhi(a.w) * __builtin_amdgcn_rcpf(bfhi(b.w)); }
        }
    }
};
struct Order {
    int nM, nN, nwg, G, c, pair;
    __device__ __forceinline__ void init(int M_, int N_, int G_, int c_, int pair_) { nM = M_ / BM; nN = N_ / BM; nwg = nM * nN; G = G_; c = c_; pair = pair_; }
    __device__ __forceinline__ bool next(int i, Unit& u) const {
        const int ii = pair ? (i >> 1) : i;
        const long L = (long)ii * G + c; if (L >= nwg) return false;
        int pn; tile_of((int)L, nM, nN, u.pm, pn);
        const int half = pair ? (i & 1) : 0; u.pn = half * nN + pn; u.ac = half * 1024; return true;
    }
};

__device__ __forceinline__ void gemm_phase(LAS unsigned char* lds, const Gemm& g, const Order& S, const Epi& E) {
    int tid = threadIdx.x; asm volatile("" : "+v"(tid));
    const int wid = __builtin_amdgcn_readfirstlane(tid >> 6), lane = tid & 63, wr = wid >> 2, wc = wid & 3, fr = lane & 15, fq = lane >> 4;
    const int K = g.K, lda = g.lda, nt = K / BK;
    unsigned voffA[2], voffB[2];
#pragma unroll
    for (int i = 0; i < 2; ++i) { int R, C; stage_rc(tid * 16 + i * 8192, R, C); const int Rb = (R & ~31) + perm32(R & 31);
        voffA[i] = (unsigned)(R * lda + C) * 2u; voffB[i] = (unsigned)(Rb * K + C) * 2u; }
    const size_t kstep = (size_t)(BK * 2);
    const size_t hstepA = (size_t)HALF * lda * 2, hstepB = (size_t)HALF * K * 2;
    const size_t tstepA = 2 * hstepA, tstepB = 2 * hstepB;
    const unsigned ldsw = (unsigned)wid * 1024u;
    const int aoff = lds_byte(wr * 64 + fr, fq * 8), boff = lds_byte(wc * 32 + fr, fq * 8);
#define PG8_SA(b, h) (((b) * 2 + (h)) * HTB)
#define PG8_SB(b, h) ((4 + (b) * 2 + (h)) * HTB)
#define PG8_STAGE(bufoff, gbase, voff) do { _Pragma("unroll") for (int _i = 0; _i < 2; ++_i) \
        __builtin_amdgcn_global_load_lds((const unsigned*)((const char*)(gbase) + (voff)[_i]), (LAS unsigned*)(lds + (bufoff) + ldsw + _i * 8192), 16, 0, 0); } while (0)
#define PG8_LDA(dst, b, h) do { _Pragma("unroll") for (int m = 0; m < 4; ++m) _Pragma("unroll") for (int k = 0; k < 2; ++k) dst[m][k] = *(const LAS bf16x8*)(lds + PG8_SA(b, h) + aoff + m * 2048 + k * 1024); } while (0)
#define PG8_LDB(dst, b, h) do { _Pragma("unroll") for (int n = 0; n < 2; ++n) _Pragma("unroll") for (int k = 0; k < 2; ++k) dst[n][k] = *(const LAS bf16x8*)(lds + PG8_SB(b, h) + boff + n * 2048 + k * 1024); } while (0)
#define PG8_MMA(ai, bj, At, Bt) do { __builtin_amdgcn_s_setprio(1); _Pragma("unroll") for (int m = 0; m < 4; ++m) _Pragma("unroll") for (int n = 0; n < 2; ++n) _Pragma("unroll") for (int k = 0; k < 2; ++k) \
        acc[ai][bj][m][n] = __builtin_amdgcn_mfma_f32_16x16x32_bf16(Bt[n][k], At[m][k], acc[ai][bj][m][n], 0, 0, 0); __builtin_amdgcn_s_setprio(0); } while (0)
#define PG8_WAIT_V(n) asm volatile("s_waitcnt vmcnt(" #n ")" ::: "memory")
#define PG8_WAIT_L(n) asm volatile("s_waitcnt lgkmcnt(" #n ")" ::: "memory")
#define PG8_BAR __builtin_amdgcn_s_barrier()
#define PG8_SCHED __builtin_amdgcn_sched_barrier(0)
    Unit cur, nxt; int ui = 0;
    if (!S.next(0, cur)) return;
    f32x4 acc[2][2][4][2];
#pragma unroll
    for (int a = 0; a < 2; ++a)
#pragma unroll
        for (int b = 0; b < 2; ++b)
#pragma unroll
            for (int m = 0; m < 4; ++m)
#pragma unroll
                for (int n = 0; n < 2; ++n) acc[a][b][m][n] = (f32x4){0.f, 0.f, 0.f, 0.f};
    bf16x8 At[4][2], B0[2][2], B1[2][2];
    const char* cA = (const char*)g.A + (size_t)cur.pm * tstepA + (size_t)cur.ac * 2; const char* cB = (const char*)g.Bt + (size_t)cur.pn * tstepB;
    PG8_STAGE(PG8_SB(0, 0), cB, voffB); PG8_STAGE(PG8_SB(0, 1), cB + hstepB, voffB); PG8_STAGE(PG8_SA(0, 0), cA, voffA); PG8_STAGE(PG8_SA(0, 1), cA + hstepA, voffA);
    if (wr == 1) PG8_BAR;
    PG8_WAIT_V(2); PG8_BAR;
    PG8_STAGE(PG8_SB(1, 0), cB + kstep, voffB); PG8_STAGE(PG8_SA(1, 0), cA + kstep, voffA); PG8_STAGE(PG8_SB(1, 1), cB + hstepB + kstep, voffB);
    PG8_WAIT_V(6); PG8_BAR;
    for (;;) {
        const bool has_next = S.next(ui + 1, nxt);
        const char* nA = has_next ? (const char*)g.A + (size_t)nxt.pm * tstepA + (size_t)nxt.ac * 2 : cA; const char* nB = has_next ? (const char*)g.Bt + (size_t)nxt.pn * tstepB : cB;
        for (int t = 0; t < nt; t += 2) {
            const bool last = (t == nt - 2);
            const char* a1 = cA + (size_t)(t + 1) * kstep;
            const char* a2 = last ? nA : cA + (size_t)(t + 2) * kstep; const char* b2 = last ? nB : cB + (size_t)(t + 2) * kstep;
            const char* a3 = a2 + kstep; const char* b3 = b2 + kstep;
            PG8_LDB(B0, 0, 0); PG8_LDB(B1, 0, 1); PG8_SCHED; PG8_LDA(At, 0, 0); PG8_STAGE(PG8_SA(1, 1), a1 + hstepA, voffA);
            PG8_WAIT_V(8); PG8_WAIT_L(0); PG8_BAR; PG8_MMA(0, 0, At, B0); PG8_MMA(0, 1, At, B1); PG8_BAR; PG8_SCHED;
            PG8_LDA(At, 0, 1); PG8_STAGE(PG8_SB(0, 0), b2, voffB); PG8_STAGE(PG8_SB(0, 1), b2 + hstepB, voffB); PG8_STAGE(PG8_SA(0, 0), a2, voffA);
            PG8_WAIT_V(8); PG8_WAIT_L(0); PG8_BAR; PG8_MMA(1, 0, At, B0); PG8_MMA(1, 1, At, B1); PG8_BAR; PG8_SCHED;
            PG8_LDB(B0, 1, 0); PG8_LDB(B1, 1, 1); PG8_SCHED; PG8_LDA(At, 1, 0); PG8_STAGE(PG8_SA(0, 1), a2 + hstepA, voffA);
            PG8_WAIT_V(8); PG8_WAIT_L(0); PG8_BAR; PG8_MMA(0, 0, At, B0); PG8_MMA(0, 1, At, B1); PG8_BAR; PG8_SCHED;
            PG8_LDA(At, 1, 1); PG8_STAGE(PG8_SB(1, 0), b3, voffB); PG8_STAGE(PG8_SB(1, 1), b3 + hstepB, voffB); PG8_STAGE(PG8_SA(1, 0), a3, voffA);
            PG8_WAIT_V(8); PG8_WAIT_L(0); PG8_BAR; PG8_MMA(1, 0, At, B0); PG8_MMA(1, 1, At, B1); PG8_BAR; PG8_SCHED;
        }
        if (wr == 0) PG8_BAR;
        const bool keep_acc = E.keep(cur);
        if (keep_acc) E.scale_keep(acc, cur, wr, wc, fr, fq); else E(acc, cur, wr, wc, fr, fq);
        if (!has_next) break;
        if (!keep_acc)
#pragma unroll
        for (int a = 0; a < 2; ++a)
#pragma unroll
            for (int b = 0; b < 2; ++b)
#pragma unroll
                for (int m = 0; m < 4; ++m)
#pragma unroll
                    for (int n = 0; n < 2; ++n) acc[a][b][m][n] = (f32x4){0.f, 0.f, 0.f, 0.f};
        cur = nxt; cA = nA; cB = nB; ++ui;
        if (wr == 1) PG8_BAR;
    }
    PG8_WAIT_V(0);
    PG8_BAR;
#undef PG8_SA
#undef PG8_SB
#undef PG8_STAGE
#undef PG8_LDA
#undef PG8_LDB
#undef PG8_MMA
#undef PG8_WAIT_V
#undef PG8_WAIT_L
#undef PG8_BAR
#undef PG8_SCHED
}
}

enum { I_X = 0, I_MEM, I_GPREMIX, I_GPOSTMIX, I_WIN, I_SHIFT, I_DBASE, I_DUP, I_IBASE, I_IUP, I_GUP, I_KNS, I_KIS, I_BONUS, I_LNW, I_LNB, I_RELB,
       I_WA, I_WB, I_WOUT, I_GPRECROSS, I_GPOSTCROSS, I_GMEM, I_WQM, I_WKVM, I_WOM, I_GPREFFN, I_GPOSTFFN, I_WF1, I_WF2, N_IN };
struct Args { const float* in[N_IN]; float* out; unsigned char* ws; };

__device__ __forceinline__ void p0_transpose_item(const float* W, int ldsrc, int K, int col0, bf16_t* WT, int dld, int drow0, int k0, LAS float* scr, int lane) {
    float tv[32];
#pragma unroll
    for (int i = 0; i < 32; ++i) { const int kk = 2 * i + (lane >> 5); const int k = k0 + kk;
        tv[i] = (k < K) ? __builtin_nontemporal_load(W + (size_t)k * ldsrc + col0 + (lane & 31)) : 0.f; }
#pragma unroll
    for (int i = 0; i < 32; ++i) { const int kk = 2 * i + (lane >> 5); scr[kk * 33 + (lane & 31)] = tv[i]; }
    LDS_WAIT(); asm volatile("" ::: "memory");
    const int c = lane & 7;
    if (k0 + 8 * c < K) {
#pragma unroll
        for (int j = 0; j < 4; ++j) { const int n = (lane >> 3) + 8 * j; const LAS float* s = scr + (8 * c) * 33 + n;
            u32x4 o; o.x = pk2(s[0 * 33], s[1 * 33]); o.y = pk2(s[2 * 33], s[3 * 33]); o.z = pk2(s[4 * 33], s[5 * 33]); o.w = pk2(s[6 * 33], s[7 * 33]);
            *(u32x4*)(WT + (size_t)(drow0 + n) * dld + k0 + 8 * c) = o; }
    }
    LDS_WAIT(); asm volatile("" ::: "memory");
}
constexpr int NJOBS = 19;
__device__ __forceinline__ void job_desc(const Args& a, int j, const float*& src, int& ld, int& K, int& col0, int& ncols, size_t& dst, int& drow0, int& mode) {
    mode = 0;
    switch (j) {
    case 0:  src = a.in[I_WIN]; ld = 8480; K = 1024; col0 = 0;    ncols = 1024; dst = WS_W1T; drow0 = 0; break;
    case 1:  src = a.in[I_WIN]; ld = 8480; K = 1024; col0 = 3360; ncols = 1024; dst = WS_W1T; drow0 = 1024; break;
    case 2:  src = a.in[I_WIN]; ld = 8480; K = 1024; col0 = 1024; ncols = 1024; dst = WS_W1T; drow0 = 2048; break;
    case 3:  src = a.in[I_WIN]; ld = 8480; K = 1024; col0 = 2048; ncols = 1024; dst = WS_W1T; drow0 = 3072; break;
    case 4:  src = a.in[I_WIN]; ld = 8480; K = 1024; col0 = 3072; ncols = 288;  dst = WS_W1T; drow0 = 4096; break;
    case 5:  src = a.in[I_WIN]; ld = 8480; K = 1024; col0 = 4384; ncols = 1024; dst = WS_W1T; drow0 = 4608; break;
    case 6:  src = a.in[I_WIN]; ld = 8480; K = 1024; col0 = 5408; ncols = 1024; dst = WS_W1T; drow0 = 5632; break;
    case 7:  src = a.in[I_WIN]; ld = 8480; K = 1024; col0 = 6432; ncols = 2048; dst = WS_WGT; drow0 = 0; break;
    case 8:  src = a.in[I_WA];  ld = 1024; K = 1024; col0 = 0; ncols = 1024; dst = WS_WABT; drow0 = 0; break;
    case 9:  src = a.in[I_WB];  ld = 1024; K = 1024; col0 = 0; ncols = 1024; dst = WS_WABT; drow0 = 1024; break;
    case 10: src = a.in[I_WOUT]; ld = 1024; K = 1024; col0 = 0; ncols = 1024; dst = WS_WOUTT; drow0 = 0; break;
    case 11: src = a.in[I_WQM]; ld = 512;  K = 1024; col0 = 0; ncols = 512;  dst = WS_WQT; drow0 = 0; break;
    case 12: src = a.in[I_WKVM]; ld = 1024; K = 1024; col0 = 0; ncols = 1024; dst = WS_WKVT; drow0 = 0; break;
    case 13: src = a.in[I_WOM]; ld = 1024; K = 512;  col0 = 0; ncols = 1024; dst = WS_WOT; drow0 = 0; break;
    case 14: src = a.in[I_WF1]; ld = 5632; K = 1024; col0 = 0; ncols = 5632; dst = WS_WF1T; drow0 = 0; mode = 1; break;
    case 15: src = a.in[I_WF2]; ld = 1024; K = 2816; col0 = 0; ncols = 1024; dst = WS_WF2T; drow0 = 0; break;
    case 16: src = a.in[I_DUP]; ld = 1024; K = 64;   col0 = 0; ncols = 1024; dst = WS_DUPT; drow0 = 0; break;
    case 17: src = a.in[I_IUP]; ld = 1024; K = 64;   col0 = 0; ncols = 1024; dst = WS_IUPT; drow0 = 0; break;
    default: src = a.in[I_GUP]; ld = 1024; K = 160;  col0 = 0; ncols = 1024; dst = WS_GUPT; drow0 = 0; break;
    }
}
__device__ __forceinline__ void rms_row_to_bf16(const float* xrow, const float* gain, bf16_t* orow, int lane) {
    const f32x4* xr = (const f32x4*)xrow + lane; const f32x4* gr = (const f32x4*)gain + lane;
    f32x4 v[4]; float s = 0.f;
#pragma unroll
    for (int j = 0; j < 4; ++j) { v[j] = xr[64 * j]; s += (v[j].x * v[j].x + v[j].y * v[j].y) + (v[j].z * v[j].z + v[j].w * v[j].w); }
    const float rs = 1.0f / sqrtf(wave_sum(s) * (1.f / DM) + NORM_EPS);
    u32x2* o8 = (u32x2*)orow + lane;
#pragma unroll
    for (int j = 0; j < 4; ++j) { const f32x4 g = gr[64 * j]; u32x2 w; w.x = cvtpk(v[j].x * rs * g.x, v[j].y * rs * g.y); w.y = cvtpk(v[j].z * rs * g.z, v[j].w * rs * g.w); o8[64 * j] = w; }
}
__device__ __forceinline__ void rms_row2_to_bf16(const float* xa, const float* xb, const float* gain, bf16_t* oa, bf16_t* ob, int lane) {
    const f32x4* xr0 = (const f32x4*)xa + lane; const f32x4* xr1 = (const f32x4*)xb + lane; const f32x4* gr = (const f32x4*)gain + lane;
    f32x4 v0[4], v1[4]; float s0 = 0.f, s1 = 0.f;
#pragma unroll
    for (int j = 0; j < 4; ++j) { v0[j] = __builtin_nontemporal_load(xr0 + 64 * j); v1[j] = __builtin_nontemporal_load(xr1 + 64 * j); }
#pragma unroll
    for (int j = 0; j < 4; ++j) { s0 += (v0[j].x * v0[j].x + v0[j].y * v0[j].y) + (v0[j].z * v0[j].z + v0[j].w * v0[j].w); s1 += (v1[j].x * v1[j].x + v1[j].y * v1[j].y) + (v1[j].z * v1[j].z + v1[j].w * v1[j].w); }
    const float rs0 = __builtin_amdgcn_rsqf(wave_sum(s0) * (1.f / DM) + NORM_EPS), rs1 = __builtin_amdgcn_rsqf(wave_sum(s1) * (1.f / DM) + NORM_EPS);
    u32x2* o0 = (u32x2*)oa + lane; u32x2* o1 = (u32x2*)ob + lane;
#pragma unroll
    for (int j = 0; j < 4; ++j) { const f32x4 g = gr[64 * j]; u32x2 w;
        w.x = cvtpk(v0[j].x * rs0 * g.x, v0[j].y * rs0 * g.y); w.y = cvtpk(v0[j].z * rs0 * g.z, v0[j].w * rs0 * g.w); o0[64 * j] = w;
        w.x = cvtpk(v1[j].x * rs1 * g.x, v1[j].y * rs1 * g.y); w.y = cvtpk(v1[j].z * rs1 * g.z, v1[j].w * rs1 * g.w); o1[64 * j] = w; }
}
__device__ __forceinline__ void p0_prologue(const Args& a, LAS unsigned char* lds, int vcu, int G, int wave, int lane) {
    LAS float* scr = (LAS float*)(lds + wave * 16384);
    const int gw = vcu * NWAVES + wave, NGW = G * NWAVES;
    int total = 0;
    for (int j = 0; j < NJOBS; ++j) { int ld, K, col0, ncols, drow0, mode; size_t dst; const float* src; job_desc(a, j, src, ld, K, col0, ncols, dst, drow0, mode); total += ((K + 63) / 64) * (ncols / 32); }
    for (int it = gw; it < total; it += NGW) {
        int r = it;
        for (int j = 0; j < NJOBS; ++j) {
            int ld, K, col0, ncols, drow0, mode; size_t dst; const float* src; job_desc(a, j, src, ld, K, col0, ncols, dst, drow0, mode);
            const int nblk = ncols / 32, cnt = ((K + 63) / 64) * nblk;
            if (r < cnt) {
                const int kb = r / nblk, nb = r % nblk; int n0 = 32 * nb; int drow = drow0 + n0;
                if (mode == 1) { const int up = n0 >= FFH ? 1 : 0; const int nn = n0 - up * FFH; drow = 256 * (nn / 128) + 128 * up + (nn % 128); }
                p0_transpose_item(src, ld, K, col0 + n0, (bf16_t*)(a.ws + dst), K, drow, 64 * kb, scr, lane);
                break;
            }
            r -= cnt;
        }
    }
    { u32x4* z = (u32x4*)(a.ws + WS_W1T + (size_t)4384 * 1024 * 2); const int n16 = 224 * 1024 * 2 / 16;
      for (int i = gw * 64 + lane; i < n16; i += NGW * 64) z[i] = (u32x4){0u, 0u, 0u, 0u}; }
    bf16_t* XN = (bf16_t*)a.out; bf16_t* MN = (bf16_t*)(a.ws + WS_MN);
    for (int m = gw; m < M; m += 2 * NGW) rms_row2_to_bf16(a.in[I_X] + (size_t)m * DM, a.in[I_X] + (size_t)(m + NGW) * DM, a.in[I_GPREMIX], XN + (size_t)m * DM, XN + (size_t)(m + NGW) * DM, lane);
    for (int m = gw; m < MROWS; m += NGW) rms_row_to_bf16(a.in[I_MEM] + (size_t)m * DM, a.in[I_GMEM], MN + (size_t)m * DM, lane);
}

template <bool XIB, bool XOB>
__device__ __forceinline__ void norm_pass(const bf16_t* O, const void* xres_, void* xout_, const float* g1, const float* g2, bf16_t* hn, int vcu, int G, int wave, int lane) {
    const int gw = vcu * NWAVES + wave, NGW = G * NWAVES;
    for (int m0 = gw; m0 < M; m0 += 2 * NGW) {
        f32x4 ov[2][4], xv[2][4]; float s[2] = {0.f, 0.f};
#pragma unroll
        for (int q = 0; q < 2; ++q) { const size_t m = (size_t)m0 + (size_t)q * NGW;
            const u32x2* orow = (const u32x2*)(O + m * DM) + lane;
#pragma unroll
            for (int j = 0; j < 4; ++j) { const u32x2 w = __builtin_nontemporal_load(orow + 64 * j); ov[q][j] = (f32x4){bflo(w.x), bfhi(w.x), bflo(w.y), bfhi(w.y)};
                if (XIB) { const u32x2 xw = __builtin_nontemporal_load((const u32x2*)((const bf16_t*)xres_ + m * DM) + lane + 64 * j); xv[q][j] = (f32x4){bflo(xw.x), bfhi(xw.x), bflo(xw.y), bfhi(xw.y)}; }
                else xv[q][j] = __builtin_nontemporal_load((const f32x4*)((const float*)xres_ + m * DM) + lane + 64 * j); } }
#pragma unroll
        for (int q = 0; q < 2; ++q)
#pragma unroll
            for (int j = 0; j < 4; ++j) s[q] += (ov[q][j].x * ov[q][j].x + ov[q][j].y * ov[q][j].y) + (ov[q][j].z * ov[q][j].z + ov[q][j].w * ov[q][j].w);
        const float rs[2] = {__builtin_amdgcn_rsqf(wave_sum(s[0]) * (1.f / DM) + NORM_EPS), __builtin_amdgcn_rsqf(wave_sum(s[1]) * (1.f / DM) + NORM_EPS)};
        float s2[2] = {0.f, 0.f};
#pragma unroll
        for (int q = 0; q < 2; ++q) { const size_t m = (size_t)m0 + (size_t)q * NGW;
#pragma unroll
            for (int j = 0; j < 4; ++j) { const f32x4 g = ((const f32x4*)g1 + lane)[64 * j]; xv[q][j] = xv[q][j] + ov[q][j] * rs[q] * g;
                if (XOB) { u32x2 w; w.x = cvtpk(xv[q][j].x, xv[q][j].y); w.y = cvtpk(xv[q][j].z, xv[q][j].w); __builtin_nontemporal_store(w, (u32x2*)((bf16_t*)xout_ + m * DM) + lane + 64 * j); }
                else __builtin_nontemporal_store(xv[q][j], (f32x4*)((float*)xout_ + m * DM) + lane + 64 * j);
                s2[q] += (xv[q][j].x * xv[q][j].x + xv[q][j].y * xv[q][j].y) + (xv[q][j].z * xv[q][j].z + xv[q][j].w * xv[q][j].w); } }
        if (hn) {
            const float r2[2] = {__builtin_amdgcn_rsqf(wave_sum(s2[0]) * (1.f / DM) + NORM_EPS), __builtin_amdgcn_rsqf(wave_sum(s2[1]) * (1.f / DM) + NORM_EPS)};
#pragma unroll
            for (int q = 0; q < 2; ++q) { const size_t m = (size_t)m0 + (size_t)q * NGW; u32x2* ho = (u32x2*)(hn + m * DM) + lane;
#pragma unroll
                for (int j = 0; j < 4; ++j) { const f32x4 g = ((const f32x4*)g2 + lane)[64 * j]; u32x2 w; w.x = cvtpk(xv[q][j].x * r2[q] * g.x, xv[q][j].y * r2[q] * g.y); w.y = cvtpk(xv[q][j].z * r2[q] * g.z, xv[q][j].w * r2[q] * g.w); ho[64 * j] = w; } }
        }
    }
}

__device__ __forceinline__ int crow(int r, int hi) { return (r & 3) + 8 * (r >> 2) + 4 * hi; }
typedef short v4i16_t __attribute__((ext_vector_type(4)));
__device__ __forceinline__ s16x4 vtr(const LAS unsigned char* p) { return __builtin_bit_cast(s16x4, __builtin_amdgcn_ds_read_tr16_b64_v4i16((LAS v4i16_t*)p)); }

template <int D, class BiasF>
__device__ __forceinline__ void attn_qk(const LAS unsigned char* Kb, const bf16x8 (&qr)[D / 16], float m_run, f32x16& p0, f32x16& p1, float& mx, int r32, int hi, const BiasF& biasf) {
    const LAS unsigned char* kb = Kb + hi * 1024 + r32 * 16;
    if (biasf.uniform()) {
        f32x16 ci; const float c = biasf.uval() - m_run;
#pragma unroll
        for (int r = 0; r < 16; ++r) ci[r] = c;
        p0 = __builtin_amdgcn_mfma_f32_32x32x16_bf16(*(const LAS bf16x8*)(kb), qr[0], ci, 0, 0, 0);
        p1 = __builtin_amdgcn_mfma_f32_32x32x16_bf16(*(const LAS bf16x8*)(kb + 512), qr[0], ci, 0, 0, 0);
    } else {
#pragma unroll
        for (int r = 0; r < 16; ++r) { p0[r] = biasf(crow(r, hi)) - m_run; p1[r] = biasf(crow(r, hi) + 32) - m_run; }
        p0 = __builtin_amdgcn_mfma_f32_32x32x16_bf16(*(const LAS bf16x8*)(kb), qr[0], p0, 0, 0, 0);
        p1 = __builtin_amdgcn_mfma_f32_32x32x16_bf16(*(const LAS bf16x8*)(kb + 512), qr[0], p1, 0, 0, 0);
    }
#pragma unroll
    for (int d0 = 1; d0 < D / 16; ++d0) {
        const bf16x8 b0 = *(const LAS bf16x8*)(kb + d0 * 2048);
        const bf16x8 b1 = *(const LAS bf16x8*)(kb + d0 * 2048 + 512);
        p0 = __builtin_amdgcn_mfma_f32_32x32x16_bf16(b0, qr[d0], p0, 0, 0, 0);
        p1 = __builtin_amdgcn_mfma_f32_32x32x16_bf16(b1, qr[d0], p1, 0, 0, 0);
    }
    float ma = fmaxf(fmaxf(p0[0], p0[1]), p1[0]), mb = fmaxf(fmaxf(p0[2], p0[3]), p1[1]);
    ma = fmaxf(fmaxf(ma, p1[2]), p1[3]);
#pragma unroll
    for (int r = 4; r < 16; r += 4) { ma = fmaxf(fmaxf(ma, p0[r]), p0[r + 1]); mb = fmaxf(fmaxf(mb, p0[r + 2]), p0[r + 3]); ma = fmaxf(fmaxf(ma, p1[r]), p1[r + 1]); mb = fmaxf(fmaxf(mb, p1[r + 2]), p1[r + 3]); }
    mx = fmaxf(ma, mb);
}
template <int D>
__device__ __forceinline__ void attn_pv(const LAS unsigned char* Vb, float& m_run, float& l_run, f32x16 (&o)[D / 32], f32x16& p0, f32x16& p1, float mx, LAS float* wsf, int r32, int hi, bool first) {
    mx = fmaxf(mx, __shfl_xor(mx, 32));
    float dl = 0.f;
    if (first) { m_run = mx; dl = mx; }
    else if (__any(mx > 8.0f)) {
        dl = fmaxf(mx, 0.f);
        const float alpha = fast_exp2(-dl);
        m_run += dl; l_run *= alpha;
        if (hi == 0) wsf[r32] = alpha;
        LDS_WAIT(); asm volatile("" ::: "memory");
#pragma unroll
        for (int r = 0; r < 16; ++r) { const float a = wsf[crow(r, hi)];
#pragma unroll
            for (int d = 0; d < D / 32; ++d) o[d][r] *= a; }
    }
    float ps = 0.f, ps2 = 0.f;
#pragma unroll
    for (int r = 0; r < 16; ++r) { p0[r] = fast_exp2(p0[r] - dl); p1[r] = fast_exp2(p1[r] - dl); ps += p0[r]; ps2 += p1[r]; }
    l_run += ps + ps2;
    u32x4 pw[4];
    pw[0] = (u32x4){cvtpk(p0[0], p0[1]), cvtpk(p0[2], p0[3]), cvtpk(p0[4], p0[5]), cvtpk(p0[6], p0[7])};
    pw[1] = (u32x4){cvtpk(p0[8], p0[9]), cvtpk(p0[10], p0[11]), cvtpk(p0[12], p0[13]), cvtpk(p0[14], p0[15])};
    pw[2] = (u32x4){cvtpk(p1[0], p1[1]), cvtpk(p1[2], p1[3]), cvtpk(p1[4], p1[5]), cvtpk(p1[6], p1[7])};
    pw[3] = (u32x4){cvtpk(p1[8], p1[9]), cvtpk(p1[10], p1[11]), cvtpk(p1[12], p1[13]), cvtpk(p1[14], p1[15])};
    const LAS unsigned char* vp = Vb + ((r32 >> 4) & 1) * 32 + (r32 & 3) * 8 + (4 * hi + ((r32 & 15) >> 2)) * 64;
#pragma unroll
    for (int d0 = 0; d0 < D / 32; ++d0) {
#pragma unroll
        for (int ks = 0; ks < 4; ++ks) {
            const s16x4 lo = vtr(vp + d0 * 4096 + ks * 1024), hh = vtr(vp + d0 * 4096 + ks * 1024 + 512);
            const bf16x8 vf = (bf16x8){lo[0], lo[1], lo[2], lo[3], hh[0], hh[1], hh[2], hh[3]};
            o[d0] = __builtin_amdgcn_mfma_f32_32x32x16_bf16(__builtin_bit_cast(bf16x8, pw[ks]), vf, o[d0], 0, 0, 0);
        }
    }
}
template <int D, class BiasF>
__device__ __forceinline__ void attn_tile(const LAS unsigned char* Kb, const LAS unsigned char* Vb, const bf16x8 (&qr)[D / 16], float& m_run, float& l_run, f32x16 (&o)[D / 32],
                                          LAS float* wsf, int r32, int hi, const BiasF& biasf, bool first) {
    f32x16 p0, p1; float mx;
    attn_qk<D>(Kb, qr, m_run, p0, p1, mx, r32, hi, biasf);
    attn_pv<D>(Vb, m_run, l_run, o, p0, p1, mx, wsf, r32, hi, first);
}
template <int ND>
__device__ __forceinline__ void attn_finish(float l_run, f32x16 (&o)[ND], LAS float* wsf, int r32, int hi) {
    const float l = l_run + __shfl_xor(l_run, 32);
    LDS_WAIT(); asm volatile("" ::: "memory");
    if (hi == 0) wsf[32 + r32] = 1.0f / l;
    LDS_WAIT(); asm volatile("" ::: "memory");
#pragma unroll
    for (int r = 0; r < 16; ++r) { const float a = wsf[32 + crow(r, hi)];
#pragma unroll
        for (int d = 0; d < ND; ++d) o[d][r] *= a; }
}

constexpr int ATT_GRP = 32768, ATT_K = 0, ATT_V = 16384, ATT_TB = 65536, ATT_WS = ATT_TB + 1024, ATT_OST = ATT_WS + 2048, ATT_LDS = ATT_OST + 8 * 4096;
static_assert(ATT_LDS <= RING_BYTES, "attention LDS");
struct ChunkBias {
    const LAS float* tb; int base; bool far; float farv;
    __device__ __forceinline__ bool uniform() const { return far; }
    __device__ __forceinline__ float uval() const { return farv; }
    __device__ __forceinline__ float operator()(int kin) const { int d = base - kin; d = d > 128 ? 128 : d; return tb[d + 63]; }
};
__device__ __forceinline__ void chunk_attention_head(const bf16_t* PQp, const bf16_t* PRp, bf16_t* Oout, int opitch, const float* relb, int b, int h, LAS unsigned char* lds, int tid) {
    const int lane = tid & 63, r32 = lane & 31, hi = lane >> 5; const int wid = __builtin_amdgcn_readfirstlane(tid >> 6);
    const int grp = wid >> 2, wg = wid & 3;
    LAS float* tb = (LAS float*)(lds + ATT_TB);
    LAS float* wsf = (LAS float*)(lds + ATT_WS) + wid * 64;
    LAS unsigned char* gl = lds + grp * ATT_GRP;
    if (tid < 192) tb[tid] = relb[h * 192 + tid] * LOG2E;
    const size_t rowbase = (size_t)b * SEQ;
    const bf16_t* Kh = PRp + rowbase * NPR + C_KA + h * 64; const bf16_t* Vh = PRp + rowbase * NPR + C_VA + h * 64;
    const bf16_t* ksrc = Kh + (size_t)lane * NPR + wg * 8;
    const bf16_t* vsrc = Vh + (size_t)(16 * wg + (lane >> 2)) * NPR + (lane & 3) * 8;
    const int kdst = wg * 1024 + lane * 16, vdst = wg * 1024 + lane * 16;
    __syncthreads();
    const float farv = tb[191];
    if (grp == 1) { __builtin_amdgcn_s_setprio(1); __syncthreads(); }
    for (int it = 0; it < 8; ++it) {
        const int u = 2 * it + grp, c0 = 2 * u, cw = c0 + (wg >> 1), qin = 32 * (wg & 1) + r32;
        const bf16_t* Qw = PQp + (rowbase + u * 128 + wg * 32) * NPQ + C_Q + h * 64;
        bf16_t* Ow = Oout + (rowbase + u * 128 + wg * 32) * opitch + h * 64;
        bf16x8 qr[4];
#pragma unroll
        for (int d0 = 0; d0 < 4; ++d0) qr[d0] = *(const bf16x8*)&Qw[(size_t)r32 * NPQ + d0 * 16 + hi * 8];
        float m_run = 0.f, l_run = 0.f; f32x16 o[2]; bool first = true;
#pragma unroll
        for (int r = 0; r < 16; ++r) { o[0][r] = 0.f; o[1][r] = 0.f; }
        u32x4 kA[2], vA[2], kB[2], vB[2];
#define TVALID(t) ((t) <= 9 && (c0 - 8 + (t)) >= 0)
#define TLOAD(K_, V_, t) do { if (TVALID(t)) { const size_t ro_ = (size_t)(c0 - 8 + (t)) * 64 * NPR; _Pragma("unroll") for (int j = 0; j < 2; ++j) { K_[j] = *(const u32x4*)(ksrc + ro_ + j * 32); V_[j] = *(const u32x4*)(vsrc + ro_ + j * 32); } } } while (0)
#define TWRITE(K_, V_, t) do { if (TVALID(t)) { _Pragma("unroll") for (int j = 0; j < 2; ++j) { *(LAS u32x4*)(gl + ATT_K + ((t) & 1) * 8192 + j * 4096 + kdst) = K_[j]; *(LAS u32x4*)(gl + ATT_V + ((t) & 1) * 8192 + j * 4096 + vdst) = V_[j]; } } } while (0)
#define TSTEP(t) do { const int kc_ = c0 - 8 + (t); const int dc_ = cw - kc_; const bool vis_ = (kc_ >= 0 && dc_ >= 0 && dc_ <= 8); f32x16 p0, p1; float mx_ = 0.f; \
            if (vis_) { ChunkBias bf{tb, qin + 64 * dc_, dc_ >= 3, farv}; attn_qk<64>(gl + ATT_K + ((t) & 1) * 8192, qr, m_run, p0, p1, mx_, r32, hi, bf); } \
            __syncthreads(); \
            if (vis_) { attn_pv<64>(gl + ATT_V + ((t) & 1) * 8192, m_run, l_run, o, p0, p1, mx_, wsf, r32, hi, first); first = false; } } while (0)
        TLOAD(kB, vB, 0); TWRITE(kB, vB, 0);
        TLOAD(kA, vA, 1);
        __syncthreads();
#pragma unroll 1
        for (int kk = 0; kk < 10; kk += 2) {
            TLOAD(kB, vB, kk + 2);
            TSTEP(kk);
            TWRITE(kA, vA, kk + 1);
            __syncthreads();
            TLOAD(kA, vA, kk + 3);
            TSTEP(kk + 1);
            TWRITE(kB, vB, kk + 2);
            __syncthreads();
        }
#undef TVALID
#undef TLOAD
#undef TWRITE
#undef TSTEP
        attn_finish<2>(l_run, o, wsf, r32, hi);
        LAS unsigned short* stg = (LAS unsigned short*)(lds + ATT_OST) + wid * 2048;
#pragma unroll
        for (int r = 0; r < 16; r += 1) { const int orow = crow(r, hi);
#pragma unroll
            for (int d0 = 0; d0 < 2; ++d0) stg[orow * 64 + d0 * 32 + r32] = (unsigned short)f2bf(o[d0][r]); }
        LDS_WAIT(); asm volatile("" ::: "memory");
#pragma unroll
        for (int i = 0; i < 4; ++i) { const int row = i * 8 + (lane >> 3), ch = lane & 7; const u32x4 v = *(const LAS u32x4*)(stg + row * 64 + ch * 8); *(u32x4*)(Ow + (size_t)row * opitch + ch * 8) = v; }
        LDS_WAIT(); asm volatile("" ::: "memory");
        __syncthreads();
    }
    if (grp == 0) __syncthreads(); else __builtin_amdgcn_s_setprio(0);
}

constexpr int AT2_BUF = 32768, AT2_TB = 65536, AT2_WS = AT2_TB + 1024, AT2_OST = AT2_WS + 2048, AT2_LDS = AT2_OST + 8 * 4096;
static_assert(AT2_LDS <= RING_BYTES, "attention LDS");
template <class BiasF>
__device__ __forceinline__ void attn2_scores(const LAS unsigned char* Kb, bool vis, const bf16x8 (&qr)[4], float m_run, f32x16& pa, f32x16& pb, int r32, int hi, const BiasF& bf) {
    if (vis) {
        const LAS unsigned char* kb = Kb + hi * 1024 + r32 * 16;
        if (bf.uniform()) {
            f32x16 ci; const float c = bf.uval() - m_run;
#pragma unroll
            for (int r = 0; r < 16; ++r) ci[r] = c;
            pa = __builtin_amdgcn_mfma_f32_32x32x16_bf16(*(const LAS bf16x8*)(kb), qr[0], ci, 0, 0, 0);
            pb = __builtin_amdgcn_mfma_f32_32x32x16_bf16(*(const LAS bf16x8*)(kb + 512), qr[0], ci, 0, 0, 0);
        } else {
#pragma unroll
            for (int r = 0; r < 16; ++r) { pa[r] = bf(crow(r, hi)) - m_run; pb[r] = bf(crow(r, hi) + 32) - m_run; }
            pa = __builtin_amdgcn_mfma_f32_32x32x16_bf16(*(const LAS bf16x8*)(kb), qr[0], pa, 0, 0, 0);
            pb = __builtin_amdgcn_mfma_f32_32x32x16_bf16(*(const LAS bf16x8*)(kb + 512), qr[0], pb, 0, 0, 0);
        }
#pragma unroll
        for (int d0 = 1; d0 < 4; ++d0) {
            pa = __builtin_amdgcn_mfma_f32_32x32x16_bf16(*(const LAS bf16x8*)(kb + d0 * 2048), qr[d0], pa, 0, 0, 0);
            pb = __builtin_amdgcn_mfma_f32_32x32x16_bf16(*(const LAS bf16x8*)(kb + d0 * 2048 + 512), qr[d0], pb, 0, 0, 0);
        }
    } else {
#pragma unroll
        for (int r = 0; r < 16; ++r) { pa[r] = -1e30f; pb[r] = -1e30f; }
    }
}
__device__ __forceinline__ void attn2_pv(const LAS unsigned char* Vb, float dl, float& ps, f32x16 (&o)[2], f32x16& pa, f32x16& pb, int r32, int hi) {
#pragma unroll
    for (int r = 0; r < 16; ++r) { pa[r] = fast_exp2(pa[r] - dl); pb[r] = fast_exp2(pb[r] - dl); ps += pa[r] + pb[r]; }
    const LAS unsigned char* vp = Vb + ((r32 >> 4) & 1) * 32 + (r32 & 3) * 8 + (4 * hi + ((r32 & 15) >> 2)) * 64;
#pragma unroll
    for (int ks = 0; ks < 4; ++ks) {
        const f32x16& pp = (ks < 2) ? pa : pb; const int b8 = (ks & 1) * 8;
        const bf16x8 pf = __builtin_bit_cast(bf16x8, (u32x4){cvtpk(pp[b8 + 0], pp[b8 + 1]), cvtpk(pp[b8 + 2], pp[b8 + 3]), cvtpk(pp[b8 + 4], pp[b8 + 5]), cvtpk(pp[b8 + 6], pp[b8 + 7])});
#pragma unroll
        for (int d0 = 0; d0 < 2; ++d0) {
            const s16x4 lo = vtr(vp + d0 * 4096 + ks * 1024), hh = vtr(vp + d0 * 4096 + ks * 1024 + 512);
            const bf16x8 vf = (bf16x8){lo[0], lo[1], lo[2], lo[3], hh[0], hh[1], hh[2], hh[3]};
            o[d0] = __builtin_amdgcn_mfma_f32_32x32x16_bf16(pf, vf, o[d0], 0, 0, 0);
        }
    }
}
__device__ __forceinline__ void chunk_attention_head2(const bf16_t* PQp, const bf16_t* PRp, bf16_t* Oout, int opitch, const float* relb, int b, int h, LAS unsigned char* lds, int tid) {
    const int lane = tid & 63, r32 = lane & 31, hi = lane >> 5; const int wid = __builtin_amdgcn_readfirstlane(tid >> 6);
    LAS float* tb = (LAS float*)(lds + AT2_TB);
    LAS float* wsf = (LAS float*)(lds + AT2_WS) + wid * 64;
    if (tid < 192) tb[tid] = relb[h * 192 + tid] * LOG2E;
    const size_t rowbase = (size_t)b * SEQ;
    const bf16_t* Kh = PRp + rowbase * NPR + C_KA + h * 64; const bf16_t* Vh = PRp + rowbase * NPR + C_VA + h * 64;
    const bf16_t* ksrc = Kh + (size_t)lane * NPR + wid * 8;
    const bf16_t* vsrc = Vh + (size_t)(16 * (wid & 3) + (lane >> 2)) * NPR + (wid >> 2) * 32 + (lane & 3) * 8;
    const int pdst = wid * 1024 + lane * 16;
    __syncthreads();
    const float farv = tb[191];
    for (int qb = 0; qb < 8; ++qb) {
        const int c0 = qb * 4, cw = c0 + (wid >> 1), qin = 32 * (wid & 1) + r32;
        const bf16_t* Qw = PQp + (rowbase + qb * 256 + wid * 32) * NPQ + C_Q + h * 64;
        bf16_t* Ow = Oout + (rowbase + qb * 256 + wid * 32) * opitch + h * 64;
        bf16x8 qr[4];
#pragma unroll
        for (int d0 = 0; d0 < 4; ++d0) qr[d0] = *(const bf16x8*)&Qw[(size_t)r32 * NPQ + d0 * 16 + hi * 8];
        float m_run = 0.f, l_run = 0.f; f32x16 o[2]; bool first = true;
#pragma unroll
        for (int r = 0; r < 16; ++r) { o[0][r] = 0.f; o[1][r] = 0.f; }
        u32x4 kA[2], vA[2];
#define SVALID(s_) ((s_) <= 5 && (c0 - 8 + 2 * (s_)) >= 0)
#define SLOAD(s_) do { if (SVALID(s_)) { const size_t ro_ = (size_t)(c0 - 8 + 2 * (s_)) * 64 * NPR; _Pragma("unroll") for (int j = 0; j < 2; ++j) { kA[j] = *(const u32x4*)(ksrc + ro_ + (size_t)j * 64 * NPR); vA[j] = *(const u32x4*)(vsrc + ro_ + (size_t)j * 64 * NPR); } } } while (0)
#define SWRITE(s_) do { if (SVALID(s_)) { LAS unsigned char* bb_ = lds + ((s_) & 1) * AT2_BUF; _Pragma("unroll") for (int j = 0; j < 2; ++j) { *(LAS u32x4*)(bb_ + j * 16384 + pdst) = kA[j]; *(LAS u32x4*)(bb_ + j * 16384 + 8192 + pdst) = vA[j]; } } } while (0)
        SLOAD(0); SWRITE(0);
        __syncthreads();
#pragma unroll 1
        for (int ss = 0; ss < 6; ++ss) {
            SLOAD(ss + 1);
            const int kcA = c0 - 8 + 2 * ss; const int dA = cw - kcA, dB = dA - 1;
            const bool vA_ = (kcA >= 0 && dA >= 0 && dA <= 8), vB_ = (kcA >= 0 && dB >= 0 && dB <= 8);
            if (vA_ || vB_) {
                const LAS unsigned char* bb = lds + (ss & 1) * AT2_BUF;
                f32x16 p0, p1, p2, p3;
                attn2_scores(bb, vA_, qr, m_run, p0, p1, r32, hi, ChunkBias{tb, qin + 64 * dA, dA >= 3, farv});
                attn2_scores(bb + 16384, vB_, qr, m_run, p2, p3, r32, hi, ChunkBias{tb, qin + 64 * dB, dB >= 3, farv});
                float ma = fmaxf(fmaxf(p0[0], p1[0]), p2[0]), mb = fmaxf(fmaxf(p0[1], p1[1]), p3[0]);
                mb = fmaxf(mb, fmaxf(p2[1], p3[1]));
#pragma unroll
                for (int r = 2; r < 16; r += 2) { ma = fmaxf(fmaxf(ma, p0[r]), p1[r]); mb = fmaxf(fmaxf(mb, p0[r + 1]), p1[r + 1]); ma = fmaxf(fmaxf(ma, p2[r]), p3[r]); mb = fmaxf(fmaxf(mb, p2[r + 1]), p3[r + 1]); }
                float mx = fmaxf(ma, mb);
                mx = fmaxf(mx, __shfl_xor(mx, 32));
                float dl = 0.f;
                if (first) { m_run = mx; dl = mx; first = false; }
                else if (__any(mx > 8.0f)) {
                    dl = fmaxf(mx, 0.f);
                    const float alpha = fast_exp2(-dl);
                    m_run += dl; l_run *= alpha;
                    if (hi == 0) wsf[r32] = alpha;
                    LDS_WAIT(); asm volatile("" ::: "memory");
#pragma unroll
                    for (int r = 0; r < 16; ++r) { const float a = wsf[crow(r, hi)]; o[0][r] *= a; o[1][r] *= a; }
                }
                float ps = 0.f;
                if (vA_) attn2_pv(bb + 8192, dl, ps, o, p0, p1, r32, hi);
                if (vB_) attn2_pv(bb + 24576, dl, ps, o, p2, p3, r32, hi);
                l_run += ps;
            }
            SWRITE(ss + 1);
            __syncthreads();
        }
#undef SVALID
#undef SLOAD
#undef SWRITE
        attn_finish<2>(l_run, o, wsf, r32, hi);
        LAS unsigned short* stg = (LAS unsigned short*)(lds + AT2_OST) + wid * 2048;
#pragma unroll
        for (int r = 0; r < 16; r += 1) { const int orow = crow(r, hi);
#pragma unroll
            for (int d0 = 0; d0 < 2; ++d0) stg[orow * 64 + d0 * 32 + r32] = (unsigned short)f2bf(o[d0][r]); }
        LDS_WAIT(); asm volatile("" ::: "memory");
#pragma unroll
        for (int i = 0; i < 4; ++i) { const int row = i * 8 + (lane >> 3), ch = lane & 7; const u32x4 v = *(const LAS u32x4*)(stg + row * 64 + ch * 8); *(u32x4*)(Ow + (size_t)row * opitch + ch * 8) = v; }
        LDS_WAIT(); asm volatile("" ::: "memory");
        __syncthreads();
    }
}

constexpr int A3_SLOT = 8192, A3_K = 0, A3_V = 3 * A3_SLOT, A3_WS = 6 * A3_SLOT, A3_TB = A3_WS + 2048, A3_OST = A3_TB + 4352, A3_LDS = A3_OST + 8 * 4096;
static_assert(A3_LDS <= RING_BYTES, "attention LDS");
__device__ __forceinline__ void glds16(const void* g, unsigned lds_base) {
    unsigned sv; asm volatile("s_mov_b32 %0, m0\n\ts_mov_b32 m0, %2\n\ts_nop 0\n\tglobal_load_lds_dwordx4 %1, off\n\ts_mov_b32 m0, %0" : "=&s"(sv) : "v"(g), "s"(lds_base) : "memory"); }
#define MFMA32(a, b, c) __builtin_amdgcn_mfma_f32_32x32x16_bf16(a, b, c, 0, 0, 0)
#define A3_SBAR() __builtin_amdgcn_sched_barrier(0)
#define A3_PIN(x) asm volatile("" : "+v"(x))
#define A3_WAIT_BAR(N) asm volatile("s_waitcnt vmcnt(" #N ") lgkmcnt(0)\n\ts_barrier" ::: "memory")
#define A3_MX3(a, b, c) __builtin_fmaxf(__builtin_fmaxf((a), (b)), (c))
__device__ __forceinline__ void a3_swap32(float& a, float& b) { asm volatile("s_nop 1\n\tv_permlane32_swap_b32 %0, %1\n\ts_nop 1" : "+v"(a), "+v"(b)); }
__device__ __forceinline__ float a3_rowmax(const f32x16& p0, const f32x16& p1) {
    float a = A3_MX3(p0[0], p0[1], p1[0]), b = A3_MX3(p0[2], p0[3], p1[1]); a = A3_MX3(a, p1[2], p1[3]);
#pragma unroll
    for (int r = 4; r < 16; r += 4) { a = A3_MX3(a, p0[r], p0[r + 1]); b = A3_MX3(b, p0[r + 2], p0[r + 3]); a = A3_MX3(a, p1[r], p1[r + 1]); b = A3_MX3(b, p1[r + 2], p1[r + 3]); }
    float m = __builtin_fmaxf(a, b), m2 = m; a3_swap32(m, m2);
    return __builtin_fmaxf(m, m2); }
__device__ __forceinline__ void a3_kload2(bf16x8* kf, const LAS unsigned char* kp, int d0) { kf[2 * d0] = *(const LAS bf16x8*)(kp + d0 * 2048); kf[2 * d0 + 1] = *(const LAS bf16x8*)(kp + d0 * 2048 + 512); }
__device__ __forceinline__ void chunk_attention_head3(const bf16_t* PQp, const bf16_t* PRp, bf16_t* Oout, int opitch, const float* relb, int b, int h, LAS unsigned char* lds, int tid) {
    const int lane = tid & 63, r32 = lane & 31, hi = lane >> 5; const int wid = __builtin_amdgcn_readfirstlane(tid >> 6);
    LAS float* tbx = (LAS float*)(lds + A3_TB);
    LAS float* wsf = (LAS float*)(lds + A3_WS) + wid * 64;
    __syncthreads();
    for (int i = tid; i < 1040; i += 512) { const int s = i / 260, m = i - 260 * s, n = m - s; float v = 0.f;
        if (n >= 0 && n <= 254) { int D = 191 - n; D = D > 128 ? 128 : D; v = (relb[h * 192 + D + 63] - relb[h * 192 + 191]) * LOG2E; }
        tbx[i] = v; }
    const float farv = relb[h * 192 + 191] * LOG2E;
    const size_t rowbase = (size_t)b * SEQ;
    const bf16_t* Kh = PRp + rowbase * NPR + C_KA + h * 64; const bf16_t* Vh = PRp + rowbase * NPR + C_VA + h * 64;
    const unsigned lds0 = (unsigned)(size_t)lds;
    const unsigned kdst = lds0 + A3_K + wid * 1024, vdst = lds0 + A3_V + wid * 1024;
    const LAS unsigned char* vp0 = lds + A3_V + ((lane >> 4) & 1) * 32 + (lane & 3) * 8 + (4 * hi + ((lane & 15) >> 2)) * 64;
    const LAS unsigned char* kp0 = lds + A3_K + hi * 1024 + r32 * 16;
    const int sgn = (r32 + 1) & 3;
    const LAS float* tbase = tbx + 260 * sgn + (191 - (32 * (wid & 1) + r32) + 4 * hi + sgn);
    __syncthreads();
    const bf16_t* Kl = Kh + (size_t)lane * NPR + wid * 8;
    const bf16_t* Vl = Vh + (size_t)(16 * (wid & 3) + (lane >> 2)) * NPR + (wid >> 2) * 32 + (lane & 3) * 8;
    int sl_prev = 2 * A3_SLOT, sl_cur = 0, sl_next = A3_SLOT;
    bf16x8 qr[4];
#pragma unroll 1
    for (int qb = 0; qb < 8; ++qb) {
        const int c0 = qb * 4, kstart = c0 > 8 ? c0 - 8 : 0, NT = c0 + 4 - kstart, dc0 = c0 + (wid >> 1) - kstart;
        const int knext = qb < 7 ? (c0 > 4 ? c0 - 4 : 0) : kstart + NT - 1;
        const bf16_t* Qw = PQp + (rowbase + qb * 256 + wid * 32) * NPQ + C_Q + h * 64;
        bf16_t* Ow = Oout + (rowbase + qb * 256 + wid * 32) * opitch + h * 64;
#define A3_KC(t) int t_ = (t); const int kc_ = t_ < NT ? kstart + t_ : (qb < 7 ? knext + (t_ - NT) : knext);
#define DMA_K(t, slot) do { A3_KC(t) glds16(Kl + (size_t)kc_ * 64 * NPR, (unsigned)__builtin_amdgcn_readfirstlane(kdst + (slot))); } while (0)
#define DMA_V(t, slot) do { A3_KC(t) glds16(Vl + (size_t)kc_ * 64 * NPR, (unsigned)__builtin_amdgcn_readfirstlane(vdst + (slot))); } while (0)
#define NEARADD(X0, X1, dc) do { const LAS float* tp_ = tbase - 64 * (dc); _Pragma("unroll") for (int g = 0; g < 4; ++g) { const f32x4 a_ = *(const LAS f32x4*)(tp_ + 8 * g), b_ = *(const LAS f32x4*)(tp_ + 32 + 8 * g); \
            X0[4 * g] += a_[0]; X0[4 * g + 1] += a_[1]; X0[4 * g + 2] += a_[2]; X0[4 * g + 3] += a_[3]; X1[4 * g] += b_[0]; X1[4 * g + 1] += b_[1]; X1[4 * g + 2] += b_[2]; X1[4 * g + 3] += b_[3]; } } while (0)
        if (qb == 0) { DMA_K(0, sl_cur); DMA_V(0, sl_cur); DMA_K(1, sl_next);
#pragma unroll
            for (int d0 = 0; d0 < 4; ++d0) qr[d0] = *(const bf16x8*)&Qw[(size_t)r32 * NPQ + d0 * 16 + hi * 8]; }
        float mhat = 0.f, l_reg = 0.f; f32x16 o[2];
#pragma unroll
        for (int r = 0; r < 16; ++r) { o[0][r] = 0.f; o[1][r] = 0.f; }
        f32x16 ci16;
#pragma unroll
        for (int r = 0; r < 16; ++r) ci16[r] = farv;
        A3_PIN(ci16);
        bool resc = false, first = true;
        f32x16 pA0, pA1, pB0, pB1; bf16x8 kf[8]; s16x4 vlo[8], vhi[8]; u32x4 pw0, pw1, pw2, pw3;
#define ROT() do { sl_prev = sl_cur; sl_cur = sl_next; sl_next = (sl_next == 2 * A3_SLOT) ? 0 : sl_next + A3_SLOT; } while (0)
#define EX(v) __builtin_amdgcn_exp2f(v)
#define RESC() do { if (resc) { _Pragma("unroll") for (int d_ = 0; d_ < 2; ++d_) _Pragma("unroll") for (int r = 0; r < 16; ++r) o[d_][r] *= wsf[crow(r, hi)]; } } while (0)
#define DECIDE(C0, C1, t) resc = false; \
        { const int dc_ = dc0 - (t); \
          if (dc_ >= 0 && dc_ <= 8) { if (dc_ <= 2) NEARADD(C0, C1, dc_); \
              const float rm = a3_rowmax(C0, C1); float dl = 0.f; bool mv_ = false; \
              if (first) { dl = rm; first = false; mv_ = true; } \
              else if (__builtin_expect(__any(rm > 8.0f), 0)) { dl = __builtin_fmaxf(rm, 0.f); const float f = __builtin_amdgcn_exp2f(-dl); l_reg *= f; if (hi == 0) wsf[r32] = f; resc = true; mv_ = true; } \
              if (mv_) { mhat += dl; const float cv_ = farv - mhat; \
                  _Pragma("unroll") for (int r = 0; r < 16; ++r) { C0[r] -= dl; C1[r] -= dl; ci16[r] = cv_; } A3_PIN(ci16); } } \
          else { _Pragma("unroll") for (int r = 0; r < 16; ++r) { C0[r] = -30000.f; C1[r] = -30000.f; } } }
        if (qb == 0) { DMA_K(2, sl_prev); A3_WAIT_BAR(3); }
#pragma unroll
        for (int d0 = 0; d0 < 4; ++d0) a3_kload2(kf, kp0 + sl_cur, d0);
        pA0 = MFMA32(kf[0], qr[0], ci16); pA1 = MFMA32(kf[1], qr[0], ci16); pA0 = MFMA32(kf[2], qr[1], pA0); pA1 = MFMA32(kf[3], qr[1], pA1);
        pA0 = MFMA32(kf[4], qr[2], pA0); pA1 = MFMA32(kf[5], qr[2], pA1); pA0 = MFMA32(kf[6], qr[3], pA0); pA1 = MFMA32(kf[7], qr[3], pA1);
        { DECIDE(pA0, pA1, 0)
#pragma unroll
          for (int r = 0; r < 16; ++r) { pA0[r] = EX(pA0[r]); pA1[r] = EX(pA1[r]); } }
        A3_WAIT_BAR(0);
        DMA_K(3, sl_cur); DMA_V(1, sl_next); ROT();
#pragma unroll
        for (int d0 = 0; d0 < 4; ++d0) a3_kload2(kf, kp0 + sl_cur, d0);
        A3_WAIT_BAR(2);
#define PKW(P, i) cvtpk(P[i], P[i + 1])
#define PAF(k) __builtin_bit_cast(bf16x8, pw##k)
#define VFR(i) (bf16x8){vlo[i][0], vlo[i][1], vlo[i][2], vlo[i][3], vhi[i][0], vhi[i][1], vhi[i][2], vhi[i][3]}
#define VRD(i) do { vlo[i] = vtr(vp_ + (((i) >> 2) * 4096 + ((i) & 3) * 1024)); vhi[i] = vtr(vp_ + (((i) >> 2) * 4096 + ((i) & 3) * 1024 + 512)); } while (0)
#define KRD(G, d0) do { if (G) { a3_kload2(kf, kp0 + sl_next, d0); A3_SBAR(); } } while (0)
#define GAPA(MF, a0, a1, a2, a3, W0, W1, PW) do { MF; sacc += a0; sacc += a1; sacc += a2; sacc += a3; W0; W1; A3_PIN(PW); A3_PIN(sacc); A3_SBAR(); } while (0)
#define GAPB(MF, X, i) do { MF; X[i] = EX(X[i]); X[i + 1] = EX(X[i + 1]); X[i + 2] = EX(X[i + 2]); X[i + 3] = EX(X[i + 3]); A3_PIN(X); A3_SBAR(); } while (0)
#define STEP(C0, C1, P0, P1, t, GD, GL) do { A3_SBAR(); \
        const LAS unsigned char* vp_ = vp0 + sl_prev; \
        VRD(0); A3_SBAR(); float sacc = P0[0] + P0[1]; \
                           GAPA(C0 = MFMA32(kf[0], qr[0], ci16),   P0[2], P0[3], P0[4], P0[5],     pw0[0] = PKW(P0, 0),  pw0[1] = PKW(P0, 2),  pw0); \
        VRD(4); A3_SBAR(); GAPA(C1 = MFMA32(kf[1], qr[0], ci16),   P0[6], P0[7], P0[8], P0[9],     pw0[2] = PKW(P0, 4),  pw0[3] = PKW(P0, 6),  pw0); \
        VRD(1); A3_SBAR(); GAPA(C0 = MFMA32(kf[2], qr[1], C0),    P0[10], P0[11], P0[12], P0[13], pw1[0] = PKW(P0, 8),  pw1[1] = PKW(P0, 10), pw1); \
        VRD(5); A3_SBAR(); GAPA(C1 = MFMA32(kf[3], qr[1], C1),    P0[14], P0[15], P1[0], P1[1],   pw1[2] = PKW(P0, 12), pw1[3] = PKW(P0, 14), pw1); \
        VRD(2); A3_SBAR(); GAPA(C0 = MFMA32(kf[4], qr[2], C0),    P1[2], P1[3], P1[4], P1[5],     pw2[0] = PKW(P1, 0),  pw2[1] = PKW(P1, 2),  pw2); \
        VRD(6); A3_SBAR(); GAPA(C1 = MFMA32(kf[5], qr[2], C1),    P1[6], P1[7], P1[8], P1[9],     pw2[2] = PKW(P1, 4),  pw2[3] = PKW(P1, 6),  pw2); \
        VRD(3); A3_SBAR(); GAPA(C0 = MFMA32(kf[6], qr[3], C0),    P1[10], P1[11], P1[12], P1[13], pw3[0] = PKW(P1, 8),  pw3[1] = PKW(P1, 10), pw3); \
        VRD(7); A3_SBAR(); GAPA(C1 = MFMA32(kf[7], qr[3], C1),    P1[14], P1[15], 0.f, 0.f,       pw3[2] = PKW(P1, 12), pw3[3] = PKW(P1, 14), pw3); \
        l_reg += sacc; \
        if (GD) { DMA_K((t) + 3, sl_cur); DMA_V((t) + 1, sl_next); } \
        DECIDE(C0, C1, t) \
        A3_SBAR(); \
        GAPB(o[0] = MFMA32(PAF(0), VFR(0), o[0]), C0, 0);              GAPB(o[1] = MFMA32(PAF(0), VFR(4), o[1]), C0, 4); \
        KRD(GL, 0); GAPB(o[0] = MFMA32(PAF(1), VFR(1), o[0]), C0, 8);  KRD(GL, 1); GAPB(o[1] = MFMA32(PAF(1), VFR(5), o[1]), C0, 12); \
        KRD(GL, 2); GAPB(o[0] = MFMA32(PAF(2), VFR(2), o[0]), C1, 0);  KRD(GL, 3); GAPB(o[1] = MFMA32(PAF(2), VFR(6), o[1]), C1, 4); \
        GAPB(o[0] = MFMA32(PAF(3), VFR(3), o[0]), C1, 8);              GAPB(o[1] = MFMA32(PAF(3), VFR(7), o[1]), C1, 12); \
        } while (0)
        int t = 1;
#pragma unroll 1
        for (; t + 1 < NT; t += 2) {
            STEP(pB0, pB1, pA0, pA1, t, true, true);     A3_WAIT_BAR(2); RESC(); ROT();
            STEP(pA0, pA1, pB0, pB1, t + 1, true, true); A3_WAIT_BAR(2); RESC(); ROT();
        }
        STEP(pB0, pB1, pA0, pA1, NT - 1, true, false);
        A3_WAIT_BAR(2); RESC();
        if (qb < 7) { const bf16_t* Qn = Qw + (size_t)256 * NPQ;
#pragma unroll
            for (int d0 = 0; d0 < 4; ++d0) qr[d0] = *(const bf16x8*)&Qn[(size_t)r32 * NPQ + d0 * 16 + hi * 8]; }
        { float sacc = pB0[0] + pB0[1];
#pragma unroll
          for (int r = 2; r < 16; ++r) sacc += pB0[r];
#pragma unroll
          for (int r = 0; r < 16; ++r) sacc += pB1[r];
          l_reg += sacc;
          pw0 = (u32x4){PKW(pB0, 0), PKW(pB0, 2), PKW(pB0, 4), PKW(pB0, 6)}; pw1 = (u32x4){PKW(pB0, 8), PKW(pB0, 10), PKW(pB0, 12), PKW(pB0, 14)};
          pw2 = (u32x4){PKW(pB1, 0), PKW(pB1, 2), PKW(pB1, 4), PKW(pB1, 6)}; pw3 = (u32x4){PKW(pB1, 8), PKW(pB1, 10), PKW(pB1, 12), PKW(pB1, 14)};
          const LAS unsigned char* vp_ = vp0 + sl_cur;
#pragma unroll
          for (int i = 0; i < 8; ++i) VRD(i);
          o[0] = MFMA32(PAF(0), VFR(0), o[0]); o[1] = MFMA32(PAF(0), VFR(4), o[1]); o[0] = MFMA32(PAF(1), VFR(1), o[0]); o[1] = MFMA32(PAF(1), VFR(5), o[1]);
          o[0] = MFMA32(PAF(2), VFR(2), o[0]); o[1] = MFMA32(PAF(2), VFR(6), o[1]); o[0] = MFMA32(PAF(3), VFR(3), o[0]); o[1] = MFMA32(PAF(3), VFR(7), o[1]); }
        { float l2 = l_reg; a3_swap32(l_reg, l2); l_reg += l2; }
        if (hi == 0) wsf[32 + r32] = l_reg;
        LDS_WAIT(); asm volatile("" ::: "memory");
        LAS unsigned short* stg = (LAS unsigned short*)(lds + A3_OST) + wid * 2048;
#pragma unroll
        for (int r = 0; r < 16; ++r) { const int orow = crow(r, hi); const float rl = __builtin_amdgcn_rcpf(wsf[32 + orow]);
#pragma unroll
            for (int d0 = 0; d0 < 2; ++d0) stg[orow * 64 + d0 * 32 + r32] = (unsigned short)f2bf(o[d0][r] * rl); }
        LDS_WAIT(); asm volatile("" ::: "memory");
#pragma unroll
        for (int i = 0; i < 4; ++i) { const int row = i * 8 + (lane >> 3), ch = lane & 7; const u32x4 v = *(const LAS u32x4*)(stg + row * 64 + ch * 8); *(u32x4*)(Ow + (size_t)row * opitch + ch * 8) = v; }
        ROT();
        asm volatile("s_waitcnt lgkmcnt(0)\n\ts_barrier" ::: "memory");
#undef A3_KC
#undef DMA_K
#undef DMA_V
#undef NEARADD
#undef ROT
#undef EX
#undef RESC
#undef DECIDE
#undef PKW
#undef PAF
#undef VFR
#undef VRD
#undef KRD
#undef GAPA
#undef GAPB
#undef STEP
    }
    asm volatile("s_waitcnt vmcnt(0)" ::: "memory");
}

constexpr int CA_K = 0, CA_V = 65536, CA_WS = 132096, CA_OST = CA_WS + 8 * 256;
static_assert(CA_WS >= MISC_OFF + 128 && CA_OST + 8 * 2048 <= LDS_BYTES, "CA LDS");
struct NoBias { __device__ __forceinline__ bool uniform() const { return true; } __device__ __forceinline__ float uval() const { return 0.f; } __device__ __forceinline__ float operator()(int) const { return 0.f; } };
__device__ __forceinline__ void cross_attention(const bf16_t* Q2, const bf16_t* KVM, bf16_t* O2, LAS unsigned char* lds, int vcu, int G, int tid) {
    const int lane = tid & 63, r32 = lane & 31, hi = lane >> 5; const int wid = __builtin_amdgcn_readfirstlane(tid >> 6);
    LAS float* wsf = (LAS float*)(lds + CA_WS) + wid * 64;
    for (int u = vcu; u < 256; u += G) {
        const int pair = u >> 2, b = pair >> 2, hh = pair & 3;
        const bf16_t* Kg = KVM + (size_t)b * MEMT * DM + hh * 128; const bf16_t* Vg = Kg + 512;
        __syncthreads();
#pragma unroll
        for (int i = 0; i < 8; ++i) {
            const int piece = tid + 512 * i, key = piece & 255, ch = piece >> 8;
            const u32x4 v = *(const u32x4*)(Kg + (size_t)key * DM + ch * 8);
            *(LAS u32x4*)(lds + CA_K + (key >> 6) * 16384 + ch * 1024 + (key & 63) * 16) = v;
        }
#pragma unroll
        for (int i = 0; i < 8; ++i) {
            const int piece = tid + 512 * i, pc = piece & 15, key = piece >> 4;
            const u32x4 v = *(const u32x4*)(Vg + (size_t)key * DM + pc * 8);
            *(LAS u32x4*)(lds + CA_V + (key >> 6) * 16384 + (pc >> 2) * 4096 + (key & 63) * 64 + (pc & 3) * 16) = v;
        }
        __syncthreads();
        for (int qq = 0; qq < 2; ++qq) {
            const int qblk = 2 * (u & 3) + qq;
            const size_t row0 = (size_t)b * SEQ + qblk * 256 + wid * 32;
            const bf16_t* Qw = Q2 + row0 * 512 + hh * 128;
            bf16x8 qr[8];
#pragma unroll
            for (int d0 = 0; d0 < 8; ++d0) qr[d0] = *(const bf16x8*)&Qw[(size_t)r32 * 512 + d0 * 16 + hi * 8];
            float m_run = 0.f, l_run = 0.f; f32x16 o[4];
#pragma unroll
            for (int d = 0; d < 4; ++d)
#pragma unroll
                for (int r = 0; r < 16; ++r) o[d][r] = 0.f;
            attn_tile<128>(lds + CA_K, lds + CA_V, qr, m_run, l_run, o, wsf, r32, hi, NoBias{}, true);
#pragma unroll 1
            for (int t = 1; t < 4; ++t) attn_tile<128>(lds + CA_K + t * 16384, lds + CA_V + t * 16384, qr, m_run, l_run, o, wsf, r32, hi, NoBias{}, false);
            attn_finish<4>(l_run, o, wsf, r32, hi);
            bf16_t* Ow = O2 + row0 * 512 + hh * 128;
            LAS unsigned short* stg = (LAS unsigned short*)(lds + CA_OST) + wid * 1024;
#pragma unroll
            for (int d0 = 0; d0 < 4; ++d0) {
#pragma unroll
                for (int r = 0; r < 16; ++r) stg[crow(r, hi) * 32 + r32] = (unsigned short)f2bf(o[d0][r]);
                LDS_WAIT(); asm volatile("" ::: "memory");
#pragma unroll
                for (int i = 0; i < 2; ++i) { const int row = i * 16 + (lane >> 2), ch = lane & 3; const u32x4 v = *(const LAS u32x4*)(stg + row * 32 + ch * 8); *(u32x4*)(Ow + (size_t)row * 512 + d0 * 32 + ch * 8) = v; }
                LDS_WAIT(); asm volatile("" ::: "memory");
            }
        }
    }
    __syncthreads();
}

constexpr int TC = 32;
constexpr int SC_ZR = 0, SC_ZK = 8192, SC_ZV = 16384, SC_WD = 24576, SC_AA = 32768, SC_GG = 40960, SC_KK = 49152, SC_YY = 57344;
constexpr int SC_AW = 65536;
constexpr int SC_AZ = SC_AW + 32 * 144;
constexpr int SC_AG = SC_AZ + 32 * 144;
constexpr int SC_BD = SC_AG + 32 * 336;
constexpr int SC_CARRY = SC_BD + 128;
constexpr int SC_END = SC_CARRY + 2 * 64 * 16;
static_assert(SC_END <= RING_BYTES, "scan LDS");

template <int CTRL> __device__ __forceinline__ float dpp_f(float x) { return __builtin_bit_cast(float, __builtin_amdgcn_update_dpp(__builtin_bit_cast(int, x), __builtin_bit_cast(int, x), CTRL, 0xF, 0xF, false)); }
__device__ __forceinline__ float red8(float x) { x += dpp_f<0xB1>(x); x += dpp_f<0x4E>(x); x += dpp_f<0x141>(x); return x; }
__device__ __forceinline__ float red16(float x) { x = red8(x); x += dpp_f<0x140>(x); return x; }

template <int NK>
__device__ __forceinline__ f32x16 lora_mma(const LAS unsigned char* Abase, int astride, const bf16x8* bfr, int r32, int hi) {
    f32x16 acc;
#pragma unroll
    for (int r = 0; r < 16; ++r) acc[r] = 0.f;
#pragma unroll
    for (int s = 0; s < NK; ++s) {
        const bf16x8 af = *(const LAS bf16x8*)(Abase + r32 * astride + (16 * s + 8 * hi) * 2);
        acc = __builtin_amdgcn_mfma_f32_32x32x16_bf16(af, bfr[s], acc, 0, 0, 0);
    }
    return acc;
}

__device__ __forceinline__ void lora_prep(const Args& a, const bf16_t* P, int vcu, int G, int tid) {
    bf16_t* LORA = (bf16_t*)(a.ws + WS_LORA); const float* mixp = a.in[I_SHIFT] + 3072;
    for (int gp = vcu * 512 + tid; gp < M * 36; gp += G * 512) {
        const int m = gp / 36, pc = gp - m * 36;
        const bf16_t* src = P + (size_t)m * NPR + C_L + pc * 8;
        const u32x4 cur = *(const u32x4*)src;
        u32x4 prv = (u32x4){0u, 0u, 0u, 0u};
        if ((m & (SEQ - 1)) != 0) prv = *(const u32x4*)(src - NPR);
        const f32x4 m0 = *(const f32x4*)(mixp + pc * 8), m1 = *(const f32x4*)(mixp + pc * 8 + 4);
        float z[8];
        { const unsigned cw_[4] = {cur.x, cur.y, cur.z, cur.w}, pw_[4] = {prv.x, prv.y, prv.z, prv.w}; const float mm[8] = {m0.x, m0.y, m0.z, m0.w, m1.x, m1.y, m1.z, m1.w};
#pragma unroll
          for (int e = 0; e < 4; ++e) { const float c0_ = bflo(cw_[e]), c1_ = bfhi(cw_[e]), p0_ = bflo(pw_[e]), p1_ = bfhi(pw_[e]);
              z[2 * e] = c0_ + (p0_ - c0_) * mm[2 * e]; z[2 * e + 1] = c1_ + (p1_ - c1_) * mm[2 * e + 1]; } }
        if (pc < 8) {
#pragma unroll
            for (int e = 0; e < 8; ++e) { const float ex = fast_exp2(2.f * LOG2E * z[e]); z[e] = 1.f - 2.f * __builtin_amdgcn_rcpf(ex + 1.f); }
        } else if (pc >= 16) {
#pragma unroll
            for (int e = 0; e < 8; ++e) z[e] = sigmoidf_(z[e]);
        }
        *(u32x4*)(LORA + (size_t)m * 288 + pc * 8) = (u32x4){cvtpk(z[0], z[1]), cvtpk(z[2], z[3]), cvtpk(z[4], z[5]), cvtpk(z[6], z[7])};
    }
}

constexpr int CK_RAW = 0;
constexpr int CK_CARRY = 12288;
constexpr int CK_CL = 13312, CK_AA = CK_CL + 8192, CK_GG = CK_AA + 8192, CK_YY = CK_GG + 8192;
constexpr int CK_BD = CK_YY + 8192;
constexpr int CK_GC = CK_BD + 128;
constexpr int CK_AW = CK_GC + 256, CK_AZ = CK_AW + 32 * 144, CK_AG = CK_AZ + 32 * 144;
constexpr int CK_RKK = CK_AW, CK_RBH = CK_RKK + 4608, CK_RKH = CK_RBH + 4608, CK_RRH = CK_RKH + 4608;
constexpr int CK_VKK = CK_AG + 32 * 336;
constexpr int CK_VVM = CK_VKK + 4096;
constexpr int CK_VBT = CK_VVM + 4096;
constexpr int CK_VKT = CK_VBT + 4096;
constexpr int CK_IP = CK_VKT + 4096;
constexpr int CK_IT = CK_IP + 2048, CK_ILK = CK_IT + 2048, CK_IMB = CK_ILK + 2048, CK_IMK = CK_IMB + 2048;
constexpr int CK_IG = CK_IMK + 2048;
constexpr int CK_WD = CK_IG + 4096;
constexpr int CK_WG = CK_WD + 64 * 144;
constexpr int CK_END = CK_WG + 64 * 336;
constexpr int CK_WI = 132096;
static_assert(CK_WI + 64 * 144 <= LDS_BYTES, "lora weights LDS");
static_assert(CK_RRH + 4608 <= CK_VKK && CK_END <= RING_BYTES && (CK_AW % 16) == 0 && (CK_VKK % 16) == 0, "chunked scan LDS");

__device__ __forceinline__ bf16x8 a_perm(const LAS unsigned char* img, int stride, int row, int col0, int hi) {
    const LAS unsigned char* p = img + row * stride + (col0 + 4 * hi) * 2;
    const s16x4 lo = *(const LAS s16x4*)p, hh = *(const LAS s16x4*)(p + 16);
    return (bf16x8){lo[0], lo[1], lo[2], lo[3], hh[0], hh[1], hh[2], hh[3]};
}
__device__ __forceinline__ bf16x8 b_tr(const LAS unsigned char* blk, int ks, int r32, int hi) {
    const LAS unsigned char* vp = blk + ((r32 >> 4) & 1) * 32 + (r32 & 3) * 8 + (4 * hi + ((r32 & 15) >> 2)) * 64 + ks * 1024;
    const s16x4 lo = vtr(vp), hh = vtr(vp + 512);
    return (bf16x8){lo[0], lo[1], lo[2], lo[3], hh[0], hh[1], hh[2], hh[3]};
}
__device__ __forceinline__ bf16x8 acc_frag(const f32x16& x, int s) {
    const u32x4 w = (u32x4){cvtpk(x[8 * s + 0], x[8 * s + 1]), cvtpk(x[8 * s + 2], x[8 * s + 3]), cvtpk(x[8 * s + 4], x[8 * s + 5]), cvtpk(x[8 * s + 6], x[8 * s + 7])};
    return __builtin_bit_cast(bf16x8, w);
}
__device__ __forceinline__ void img_store_t(LAS unsigned char* img, int col, int hi, const f32x16& x, float sgn) {
#pragma unroll
    for (int q = 0; q < 4; ++q) *(LAS u32x2*)(img + col * 64 + (8 * q + 4 * hi) * 2) = (u32x2){cvtpk(x[4 * q] * sgn, x[4 * q + 1] * sgn), cvtpk(x[4 * q + 2] * sgn, x[4 * q + 3] * sgn)};
}
#define MFMA32(a, b, c) __builtin_amdgcn_mfma_f32_32x32x16_bf16(a, b, c, 0, 0, 0)

constexpr int PK_HB = 39296;
constexpr int HB_RKK = 0, HB_RBH = 4608, HB_RKH = 9216, HB_RRH = 13824, HB_VKK = 18432, HB_VVM = 22528, HB_VBT = 26624, HB_VKT = 30720, HB_GC = 34816, HB_BD = 35072, HB_GG = 35200;
constexpr int PK_RAW = 2 * PK_HB, PK_CARRY = PK_RAW + 12288, PK_CL = PK_CARRY + 1024, PK_AA = PK_CL + 8192, PK_AW = PK_AA + 8192, PK_AZ = PK_AW + 4608, PK_AG = PK_AZ + 4608;
static_assert(PK_AG + 32 * 336 <= RING_BYTES, "pipelined scan LDS (ring part)");
constexpr int PK_CONST = PK_AG + 32 * 336;
static_assert(PK_CONST + 2048 <= RING_BYTES, "pipelined scan LDS (constants)");
constexpr int PK_YY = 132096;
static_assert(PK_YY + 2 * 8192 <= LDS_BYTES, "pipelined scan LDS (upper part)");
constexpr int NCH = SEQ / TC;

__device__ __forceinline__ f32x16 gram_tile(const bf16x8 (&af)[4], const bf16x8 (&bf)[4]) {
    f32x16 acc;
#pragma unroll
    for (int r = 0; r < 16; ++r) acc[r] = 0.f;
#pragma unroll
    for (int s = 0; s < 4; ++s) acc = MFMA32(af[s], bf[s], acc);
    return acc;
}
template <int MODE> __device__ __forceinline__ void tri_mask(f32x16& x, int r32, int hi, float sgn) {
#pragma unroll
    for (int r = 0; r < 16; ++r) { const int row = crow(r, hi); const bool keep = (MODE == 0) ? (r32 < row) : ((MODE == 1) ? (r32 > row) : (r32 >= row)); x[r] = keep ? x[r] * sgn : 0.f; }
}

__device__ __forceinline__ void rwkv_head_pipe(const Args& a, const bf16_t* PQp, const bf16_t* PRp, bf16_t* Yout, int ypitch, int b, int h, LAS unsigned char* lds, int tid) {
    const int lane = tid & 63, r32 = lane & 31, hi = lane >> 5; const int wid = __builtin_amdgcn_readfirstlane(tid >> 6);
    const size_t rowbase = (size_t)b * SEQ;
    if (wid < 6) {
        LAS float* CL = (LAS float*)(lds + PK_CL); LAS float* AA = (LAS float*)(lds + PK_AA);
        const int lnb = wid & 1, lch = h * 64 + 32 * lnb + r32;
        const float lbase = (wid < 2) ? a.in[I_DBASE][lch] : ((wid < 4) ? a.in[I_IBASE][lch] : 0.f);
        const int oc = tid & 7, tk = (tid >> 3) & 31, ch0 = h * 64 + 8 * oc;
        if (tid < 128) { const int v8 = tid >> 4, q = tid & 15; const float* srcv;
            switch (v8) { case 0: srcv = a.in[I_KNS]; break; case 1: srcv = a.in[I_KIS]; break; case 2: srcv = a.in[I_BONUS]; break; case 3: srcv = a.in[I_LNW]; break; case 4: srcv = a.in[I_LNB]; break;
                          case 5: srcv = a.in[I_SHIFT]; break; case 6: srcv = a.in[I_SHIFT] + 1024; break; default: srcv = a.in[I_SHIFT] + 2048; break; }
            *(LAS f32x4*)(lds + PK_CONST + v8 * 256 + q * 16) = *(const f32x4*)(srcv + h * 64 + 4 * q); }
        (void)ch0;
        f32x4 cvr[6];
        { const int cb = h * 64 + 8 * oc;
#pragma unroll
          for (int j = 0; j < 3; ++j) { cvr[2 * j] = *(const f32x4*)(a.in[I_SHIFT] + j * 1024 + cb); cvr[2 * j + 1] = *(const f32x4*)(a.in[I_SHIFT] + j * 1024 + cb + 4); } }
#define CV(v8, q) (*(const LAS f32x4*)(lds + PK_CONST + (v8) * 256 + oc * 32 + (q) * 16))
        bf16x8 bfr[10];
        { const bf16_t* up = (wid < 2) ? (const bf16_t*)(a.ws + WS_DUPT) + (size_t)lch * 64 : ((wid < 4) ? (const bf16_t*)(a.ws + WS_IUPT) + (size_t)lch * 64 : (const bf16_t*)(a.ws + WS_GUPT) + (size_t)lch * 160);
          if (wid < 4) {
#pragma unroll
              for (int s = 0; s < 4; ++s) bfr[s] = *(const bf16x8*)(up + 16 * s + 8 * hi);
#pragma unroll
              for (int s = 4; s < 10; ++s) bfr[s] = bfr[0];
          } else {
#pragma unroll
              for (int s = 0; s < 10; ++s) bfr[s] = *(const bf16x8*)(up + 16 * s + 8 * hi);
          } }
        const unsigned char* psrc[5]; unsigned pstride[5]; u32x4 pre[5];
        const bf16_t* LORA = (const bf16_t*)(a.ws + WS_LORA);
#pragma unroll
        for (int i = 0; i < 5; ++i) {
            const int p = tid + 384 * i; const int tl = p / 60, pc = p - tl * 60;
            if (pc < 8) { psrc[i] = (const unsigned char*)(PQp + (rowbase + tl) * NPQ + C_R + h * 64 + pc * 8); pstride[i] = NPQ * 2; }
            else if (pc < 24) { psrc[i] = (const unsigned char*)(PRp + (rowbase + tl) * NPR + (pc < 16 ? C_K : C_V) + h * 64 + (pc & 7) * 8); pstride[i] = NPR * 2; }
            else { psrc[i] = (const unsigned char*)(LORA + (rowbase + tl) * 288 + (pc - 24) * 8); pstride[i] = 288 * 2; }
            pre[i] = __builtin_nontemporal_load((const u32x4*)psrc[i]);
        }
        u32x4 po_g[2], po_v[2]; float po_bd[2];
#pragma unroll
        for (int i2 = 0; i2 < 2; ++i2) { po_g[i2] = (u32x4){0u, 0u, 0u, 0u}; po_v[i2] = po_g[i2]; po_bd[i2] = 0.f; }
#pragma unroll 1
        for (int it = 0; it < NCH + 2; ++it) {
            if (it >= 2 && wid >= 4) {
                const LAS unsigned char* hb = lds + (it & 1) * PK_HB;
#pragma unroll
                for (int i2 = 0; i2 < 2; ++i2) { const int tk2 = ((tid - 256) >> 3) + 16 * i2;
                    po_g[i2] = *(const LAS u32x4*)(hb + HB_GG + tk2 * 128 + oc * 16); po_v[i2] = *(const LAS u32x4*)(hb + HB_VVM + (oc >> 2) * 2048 + tk2 * 64 + (oc & 3) * 16);
                    po_bd[i2] = *(const LAS float*)(hb + HB_BD + tk2 * 4); }
            }
#ifdef X_DUPCOPY
            for (int rep_ = 0; rep_ < 2; ++rep_)
#endif
            if (it < NCH) {
#pragma unroll
                for (int i = 0; i < 5; ++i) {
                    const int p = tid + 384 * i; const int tl = p / 60, pc = p - tl * 60;
                    LAS unsigned char* dst;
                    if (pc < 24) dst = lds + PK_RAW + (tl * 24 + pc) * 16;
                    else if (pc < 32) dst = lds + PK_AW + tl * 144 + (pc - 24) * 16;
                    else if (pc < 40) dst = lds + PK_AZ + tl * 144 + (pc - 32) * 16;
                    else dst = lds + PK_AG + tl * 336 + (pc - 40) * 16;
                    *(LAS u32x4*)dst = pre[i];
                }
                if (it + 1 < NCH) {
#pragma unroll
                    for (int i = 0; i < 5; ++i) pre[i] = __builtin_nontemporal_load((const u32x4*)(psrc[i] + (size_t)((it + 1) * TC) * pstride[i]));
                }
            }
            __syncthreads();
#ifdef X_DUPJ2
            for (int rep_ = 0; rep_ < 2; ++rep_)
#endif
            if (it < NCH) {
                LAS unsigned char* hb = lds + (it & 1) * PK_HB;
                f32x16 acc;
                if (wid < 4) acc = lora_mma<4>(lds + (wid < 2 ? PK_AW : PK_AZ), 144, bfr, r32, hi);
                else acc = lora_mma<10>(lds + PK_AG, 336, bfr, r32, hi);
                if (wid < 2) {
                    float ew[16];
#pragma unroll
                    for (int r = 0; r < 16; ++r) ew[r] = (-0.6065306597126334f * LOG2E) * sigmoidf_(lbase + acc[r]);
                    float pf[16], tot[4], oth[4];
#pragma unroll
                    for (int m = 0; m < 4; ++m) { pf[4 * m] = ew[4 * m]; pf[4 * m + 1] = pf[4 * m] + ew[4 * m + 1]; pf[4 * m + 2] = pf[4 * m + 1] + ew[4 * m + 2]; pf[4 * m + 3] = pf[4 * m + 2] + ew[4 * m + 3]; tot[m] = pf[4 * m + 3]; }
#pragma unroll
                    for (int m = 0; m < 4; ++m) oth[m] = __shfl_xor(tot[m], 32);
                    float off = 0.f;
#pragma unroll
                    for (int m = 0; m < 4; ++m) { const float o_m = off + (hi ? oth[m] : 0.f);
#pragma unroll
                        for (int q = 0; q < 4; ++q) { const int r = 4 * m + q; CL[crow(r, hi) * 64 + 32 * lnb + r32] = fast_exp2(o_m + pf[r]); }
                        off += tot[m] + oth[m]; }
                } else if (wid < 4) {
#pragma unroll
                    for (int r = 0; r < 16; ++r) AA[crow(r, hi) * 64 + 32 * lnb + r32] = sigmoidf_(lbase + acc[r]);
                } else {
#pragma unroll
                    for (int r = 0; r < 16; ++r) *(LAS unsigned short*)(hb + HB_GG + crow(r, hi) * 128 + (32 * lnb + r32) * 2) = (unsigned short)f2bf(acc[r]);
                }
            }
            __syncthreads();
            if (it < NCH && wid < 4) {
                LAS unsigned char* hb = lds + (it & 1) * PK_HB;
                const LAS unsigned char* rc = lds + PK_RAW + (tk * 24 + oc) * 16;
                const u32x4 cr = *(const LAS u32x4*)rc, ck = *(const LAS u32x4*)(rc + 128), cv = *(const LAS u32x4*)(rc + 256);
                u32x4 pr, pk, pv;
                if (tk > 0) { pr = *(const LAS u32x4*)(rc - 384); pk = *(const LAS u32x4*)(rc - 256); pv = *(const LAS u32x4*)(rc - 128); }
                else if (it > 0) { const LAS unsigned char* cc = lds + PK_CARRY + ((it - 1) & 1) * 384 + oc * 16; pr = *(const LAS u32x4*)cc; pk = *(const LAS u32x4*)(cc + 128); pv = *(const LAS u32x4*)(cc + 256); }
                else { pr = (u32x4){0u, 0u, 0u, 0u}; pk = pr; pv = pr; }
                if (tk == TC - 1) { LAS unsigned char* cc = lds + PK_CARRY + (it & 1) * 384 + oc * 16; *(LAS u32x4*)cc = cr; *(LAS u32x4*)(cc + 128) = ck; *(LAS u32x4*)(cc + 256) = cv; }
                f32x4 rv[2], zk[2], vv[2];
#define LERP8(dst, c, p, mx) do { const f32x4 c0_ = (f32x4){bflo(c.x), bfhi(c.x), bflo(c.y), bfhi(c.y)}, c1_ = (f32x4){bflo(c.z), bfhi(c.z), bflo(c.w), bfhi(c.w)}; \
                    const f32x4 p0_ = (f32x4){bflo(p.x), bfhi(p.x), bflo(p.y), bfhi(p.y)}, p1_ = (f32x4){bflo(p.z), bfhi(p.z), bflo(p.w), bfhi(p.w)}; \
                    dst[0] = c0_ + (p0_ - c0_) * mx[0]; dst[1] = c1_ + (p1_ - c1_) * mx[1]; } while (0)
                { const f32x4 mr_[2] = {cvr[0], cvr[1]}, mk_[2] = {cvr[2], cvr[3]}, mv_[2] = {cvr[4], cvr[5]}; LERP8(rv, cr, pr, mr_); LERP8(zk, ck, pk, mk_); LERP8(vv, cv, pv, mv_); }
#undef LERP8
                f32x4 kkv[2], kp[2], bb[2]; float ss = 0.f, bd = 0.f;
                f32x4 e1[2], e0[2], em[2], ec[2];
#pragma unroll
                for (int q = 0; q < 2; ++q) {
                    const f32x4 av = *(LAS f32x4*)(AA + tk * 64 + 8 * oc + 4 * q);
                    const f32x4 cl = *(LAS f32x4*)(CL + tk * 64 + 8 * oc + 4 * q), clc = *(LAS f32x4*)(CL + 31 * 64 + 8 * oc + 4 * q);
                    f32x4 clp = (f32x4){1.f, 1.f, 1.f, 1.f}; if (tk > 0) clp = *(LAS f32x4*)(CL + (tk - 1) * 64 + 8 * oc + 4 * q);
                    kkv[q] = zk[q] * CV(0, q);
                    ss += (kkv[q].x * kkv[q].x + kkv[q].y * kkv[q].y) + (kkv[q].z * kkv[q].z + kkv[q].w * kkv[q].w);
                    kp[q] = zk[q] * (1.0f + (av - 1.0f) * CV(1, q));
                    bb[q] = av;
                    const f32x4 t3 = rv[q] * kp[q] * CV(2, q); bd += (t3.x + t3.y) + (t3.z + t3.w);
#pragma unroll
                    for (int e = 0; e < 4; ++e) { e1[q][e] = cl[e]; e0[q][e] = clp[e]; em[q][e] = __builtin_amdgcn_rcpf(cl[e]); ec[q][e] = clc[e] * em[q][e]; }
                }
                ss = red8(ss); bd = red8(bd);
                const float inv = __builtin_amdgcn_rsqf(fmaxf(ss, 1e-24f));
                if (oc == 0) *(LAS float*)(hb + HB_BD + tk * 4) = bd;
                if (tk == 31) { *(LAS f32x4*)(hb + HB_GC + 32 * oc) = e1[0]; *(LAS f32x4*)(hb + HB_GC + 32 * oc + 16) = e1[1]; }
                u32x4 wkk, wbh, wkh, wrh, wbt, wkt, wvv;
                {
                    const f32x4 k0 = kkv[0] * inv, k1 = kkv[1] * inv, b0 = k0 * bb[0], b1 = k1 * bb[1];
                    const f32x4 kkh0 = k0 * e0[0], kkh1 = k1 * e0[1], bh0 = b0 * em[0], bh1 = b1 * em[1], kh0 = kp[0] * em[0], kh1 = kp[1] * em[1];
                    const f32x4 rh0 = rv[0] * e1[0], rh1 = rv[1] * e1[1], bt0 = b0 * ec[0], bt1 = b1 * ec[1], kt0 = kp[0] * ec[0], kt1 = kp[1] * ec[1];
                    wkk = (u32x4){cvtpk(kkh0.x, kkh0.y), cvtpk(kkh0.z, kkh0.w), cvtpk(kkh1.x, kkh1.y), cvtpk(kkh1.z, kkh1.w)};
                    wbh = (u32x4){cvtpk(bh0.x, bh0.y), cvtpk(bh0.z, bh0.w), cvtpk(bh1.x, bh1.y), cvtpk(bh1.z, bh1.w)};
                    wkh = (u32x4){cvtpk(kh0.x, kh0.y), cvtpk(kh0.z, kh0.w), cvtpk(kh1.x, kh1.y), cvtpk(kh1.z, kh1.w)};
                    wrh = (u32x4){cvtpk(rh0.x, rh0.y), cvtpk(rh0.z, rh0.w), cvtpk(rh1.x, rh1.y), cvtpk(rh1.z, rh1.w)};
                    wbt = (u32x4){cvtpk(-bt0.x, -bt0.y), cvtpk(-bt0.z, -bt0.w), cvtpk(-bt1.x, -bt1.y), cvtpk(-bt1.z, -bt1.w)};
                    wkt = (u32x4){cvtpk(kt0.x, kt0.y), cvtpk(kt0.z, kt0.w), cvtpk(kt1.x, kt1.y), cvtpk(kt1.z, kt1.w)};
                    wvv = (u32x4){cvtpk(vv[0].x, vv[0].y), cvtpk(vv[0].z, vv[0].w), cvtpk(vv[1].x, vv[1].y), cvtpk(vv[1].z, vv[1].w)};
                }
                const int ro = tk * 144 + 16 * oc, vo = (oc >> 2) * 2048 + tk * 64 + (oc & 3) * 16;
                *(LAS u32x4*)(hb + HB_RKK + ro) = wkk; *(LAS u32x4*)(hb + HB_RBH + ro) = wbh; *(LAS u32x4*)(hb + HB_RKH + ro) = wkh; *(LAS u32x4*)(hb + HB_RRH + ro) = wrh;
                *(LAS u32x4*)(hb + HB_VKK + vo) = wkk; *(LAS u32x4*)(hb + HB_VVM + vo) = wvv; *(LAS u32x4*)(hb + HB_VBT + vo) = wbt; *(LAS u32x4*)(hb + HB_VKT + vo) = wkt;
            }
            if (it >= 2 && wid >= 4) {
                const LAS float* YY = (const LAS float*)(lds + PK_YY + (it & 1) * 8192); const int t0p = (it - 2) * TC;
#pragma unroll
                for (int i2 = 0; i2 < 2; ++i2) { const int tk2 = ((tid - 256) >> 3) + 16 * i2;
                    const f32x4 y0 = *(const LAS f32x4*)(YY + tk2 * 64 + 8 * oc), y1 = *(const LAS f32x4*)(YY + tk2 * 64 + 8 * oc + 4);
                    const u32x4 gw = po_g[i2], vw = po_v[i2];
                    const f32x4 g0 = (f32x4){bflo(gw.x), bfhi(gw.x), bflo(gw.y), bfhi(gw.y)}, g1 = (f32x4){bflo(gw.z), bfhi(gw.z), bflo(gw.w), bfhi(gw.w)};
                    const f32x4 v0 = (f32x4){bflo(vw.x), bfhi(vw.x), bflo(vw.y), bfhi(vw.y)}, v1 = (f32x4){bflo(vw.z), bfhi(vw.z), bflo(vw.w), bfhi(vw.w)};
                    float s1 = ((y0.x + y0.y) + (y0.z + y0.w)) + ((y1.x + y1.y) + (y1.z + y1.w)); s1 = red8(s1);
                    const float mu = s1 * (1.f / 64.f);
                    const f32x4 d0 = y0 - mu, d1 = y1 - mu;
                    float s2 = ((d0.x * d0.x + d0.y * d0.y) + (d0.z * d0.z + d0.w * d0.w)) + ((d1.x * d1.x + d1.y * d1.y) + (d1.z * d1.z + d1.w * d1.w)); s2 = red8(s2);
                    const float rstd = __builtin_amdgcn_rsqf(s2 * (1.f / 64.f) + GN_EPS);
                    const float bd = po_bd[i2];
                    const f32x4 o0 = ((d0 * rstd) * CV(3, 0) + CV(4, 0) + v0 * bd) * g0, o1 = ((d1 * rstd) * CV(3, 1) + CV(4, 1) + v1 * bd) * g1;
                    *(u32x4*)(Yout + (rowbase + t0p + tk2) * ypitch + h * 64 + 8 * oc) = (u32x4){cvtpk(o0.x, o0.y), cvtpk(o0.z, o0.w), cvtpk(o1.x, o1.y), cvtpk(o1.z, o1.w)}; }
            }
            __syncthreads();
        }
    } else {
        const int vb = wid - 6;
        __builtin_amdgcn_s_setprio(2);
        f32x16 St0, St1;
#pragma unroll
        for (int r = 0; r < 16; ++r) { St0[r] = 0.f; St1[r] = 0.f; }
#pragma unroll 1
        for (int it = 0; it < NCH + 2; ++it) {
            const bool act = (it >= 1) && (it <= NCH);
            const LAS unsigned char* hb = lds + ((it - 1) & 1) * PK_HB;
            f32x16 Pw, Qw, R, Rt, LkT, MbT, MkT, X;
#ifdef X_DUPGRAM
            for (int rep_ = 0; rep_ < 2; ++rep_)
#endif
            if (act) {
                bf16x8 fkk[4], fbh[4], fkh[4], frh[4];
#pragma unroll
                for (int s = 0; s < 4; ++s) { const int o = r32 * 144 + (16 * s + 8 * hi) * 2;
                    fkk[s] = *(const LAS bf16x8*)(hb + HB_RKK + o); fbh[s] = *(const LAS bf16x8*)(hb + HB_RBH + o); fkh[s] = *(const LAS bf16x8*)(hb + HB_RKH + o); frh[s] = *(const LAS bf16x8*)(hb + HB_RRH + o); }
                Pw = gram_tile(fkk, fbh);  tri_mask<0>(Pw, r32, hi, 1.f);
                Qw = gram_tile(fbh, fkk);  tri_mask<1>(Qw, r32, hi, 1.f);
                LkT = gram_tile(fkh, fkk);
                MbT = gram_tile(fbh, frh);
                MkT = gram_tile(fkh, frh);
            }
            __syncthreads();
            if (act) {
#pragma unroll
                for (int r = 0; r < 16; ++r) { const float id = (crow(r, hi) == r32) ? 1.f : 0.f; R[r] = id - Pw[r]; Rt[r] = id - Qw[r]; }
                tri_mask<1>(LkT, r32, hi, 1.f); tri_mask<2>(MbT, r32, hi, -1.f); tri_mask<2>(MkT, r32, hi, 1.f);
#pragma unroll
                for (int k = 0; k < 4; ++k) {
                    const bf16x8 p0 = acc_frag(Pw, 0), p1 = acc_frag(Pw, 1), q0 = acc_frag(Qw, 0), q1 = acc_frag(Qw, 1);
                    f32x16 Pn, Qn;
#pragma unroll
                    for (int r = 0; r < 16; ++r) { Pn[r] = 0.f; Qn[r] = 0.f; }
                    Pn = MFMA32(q0, p0, Pn); Pn = MFMA32(q1, p1, Pn);
                    Qn = MFMA32(p0, q0, Qn); Qn = MFMA32(p1, q1, Qn);
                    const bf16x8 r0 = acc_frag(R, 0), r1 = acc_frag(R, 1);
                    const bf16x8 n0 = acc_frag(Qn, 0), n1 = acc_frag(Qn, 1);
                    f32x16 Rn = R, Rtn = Rt;
                    Rn = MFMA32(n0, r0, Rn);  Rn = MFMA32(n1, r1, Rn);
                    Rtn = MFMA32(r0, n0, Rtn); Rtn = MFMA32(r1, n1, Rtn);
                    R = Rn; Rt = Rtn; Pw = Pn; Qw = Qn;
                }
                { const bf16x8 v0f = b_tr(hb + HB_VVM + vb * 2048, 0, r32, hi), v1f = b_tr(hb + HB_VVM + vb * 2048, 1, r32, hi);
#pragma unroll
                  for (int r = 0; r < 16; ++r) X[r] = 0.f;
                  X = MFMA32(acc_frag(LkT, 0), v0f, X); X = MFMA32(acc_frag(LkT, 1), v1f, X); }
            }
            __syncthreads();
            if (act) {
                const bf16x8 t0f = acc_frag(Rt, 0), t1f = acc_frag(Rt, 1);
                const bf16x8 v0f = b_tr(hb + HB_VVM + vb * 2048, 0, r32, hi), v1f = b_tr(hb + HB_VVM + vb * 2048, 1, r32, hi);
                f32x16 E;
#pragma unroll
                for (int r = 0; r < 16; ++r) E[r] = 0.f;
                E = MFMA32(t0f, acc_frag(X, 0), E); E = MFMA32(t1f, acc_frag(X, 1), E);
                f32x16 G0, G1;
#pragma unroll
                for (int r = 0; r < 16; ++r) { G0[r] = 0.f; G1[r] = 0.f; }
                G0 = MFMA32(b_tr(hb + HB_VKK, 0, r32, hi), t0f, G0);        G0 = MFMA32(b_tr(hb + HB_VKK, 1, r32, hi), t1f, G0);
                G1 = MFMA32(b_tr(hb + HB_VKK + 2048, 0, r32, hi), t0f, G1); G1 = MFMA32(b_tr(hb + HB_VKK + 2048, 1, r32, hi), t1f, G1);
                const bf16x8 s00 = acc_frag(St0, 0), s01 = acc_frag(St0, 1), s10 = acc_frag(St1, 0), s11 = acc_frag(St1, 1);
                E = MFMA32(acc_frag(G0, 0), s00, E); E = MFMA32(acc_frag(G0, 1), s01, E);
                E = MFMA32(acc_frag(G1, 0), s10, E); E = MFMA32(acc_frag(G1, 1), s11, E);
                const bf16x8 e0f = acc_frag(E, 0), e1f = acc_frag(E, 1);
                f32x16 Y;
#pragma unroll
                for (int r = 0; r < 16; ++r) Y[r] = 0.f;
                Y = MFMA32(a_perm(hb + HB_RRH, 144, r32, 0, hi), s00, Y);  Y = MFMA32(a_perm(hb + HB_RRH, 144, r32, 16, hi), s01, Y);
                Y = MFMA32(a_perm(hb + HB_RRH, 144, r32, 32, hi), s10, Y); Y = MFMA32(a_perm(hb + HB_RRH, 144, r32, 48, hi), s11, Y);
                Y = MFMA32(acc_frag(MbT, 0), e0f, Y); Y = MFMA32(acc_frag(MbT, 1), e1f, Y);
                Y = MFMA32(acc_frag(MkT, 0), v0f, Y); Y = MFMA32(acc_frag(MkT, 1), v1f, Y);
                LAS float* YY = (LAS float*)(lds + PK_YY + ((it - 1) & 1) * 8192);
#pragma unroll
                for (int r = 0; r < 16; ++r) YY[crow(r, hi) * 64 + 32 * vb + r32] = Y[r];
                const LAS float* GC = (const LAS float*)(hb + HB_GC);
#pragma unroll
                for (int q = 0; q < 4; ++q) { const f32x4 g0 = *(const LAS f32x4*)(GC + 8 * q + 4 * hi), g1 = *(const LAS f32x4*)(GC + 32 + 8 * q + 4 * hi);
#pragma unroll
                    for (int e = 0; e < 4; ++e) { St0[4 * q + e] *= g0[e]; St1[4 * q + e] *= g1[e]; } }
                St0 = MFMA32(b_tr(hb + HB_VBT, 0, r32, hi), e0f, St0);        St0 = MFMA32(b_tr(hb + HB_VBT, 1, r32, hi), e1f, St0);
                St0 = MFMA32(b_tr(hb + HB_VKT, 0, r32, hi), v0f, St0);        St0 = MFMA32(b_tr(hb + HB_VKT, 1, r32, hi), v1f, St0);
                St1 = MFMA32(b_tr(hb + HB_VBT + 2048, 0, r32, hi), e0f, St1); St1 = MFMA32(b_tr(hb + HB_VBT + 2048, 1, r32, hi), e1f, St1);
                St1 = MFMA32(b_tr(hb + HB_VKT + 2048, 0, r32, hi), v0f, St1); St1 = MFMA32(b_tr(hb + HB_VKT + 2048, 1, r32, hi), v1f, St1);
            }
            __syncthreads();
        }
        __builtin_amdgcn_s_setprio(0);
    }
#undef CV
    __syncthreads();
}

__global__ void __launch_bounds__(NWAVES * 64, 2) hyb_fwd(Args args) {
    extern __shared__ __attribute__((aligned(16))) unsigned char lds_raw[];
    LAS unsigned char* lds = (LAS unsigned char*)lds_raw;
    volatile LAS unsigned* MISC = (volatile LAS unsigned*)(lds + MISC_OFF);
    const int G = gridDim.x; const int bx = blockIdx.x; const int vcu = (G % 8 == 0) ? (bx % 8) * (G / 8) + bx / 8 : bx;
    unsigned char* ws = args.ws;
    for (int u = threadIdx.x; u < (LDS_BYTES - LDSCTL_OFF) / 4; u += NWAVES * 64) ((LAS unsigned*)(lds + LDSCTL_OFF))[u] = 0u;
    __syncthreads();
    XcdBarrier bar = xcd_barrier_post((unsigned*)(ws + WS_CTL) + CW_BAR, MISC + 8);
#define GRID_BAR() xcd_barrier(bar)
    bf16_t* PQ = (bf16_t*)(ws + WS_PQ); bf16_t* PR = (bf16_t*)(ws + WS_PR);
    bf16_t* XN = (bf16_t*)args.out; bf16_t* MIXED = (bf16_t*)((unsigned char*)args.out + 64 * MiB);
    bf16_t* O1 = (bf16_t*)(ws + WS_O1); bf16_t* XN2 = (bf16_t*)(ws + WS_XN2); bf16_t* Q2 = (bf16_t*)(ws + WS_Q2); bf16_t* O2 = (bf16_t*)(ws + WS_O2);
    bf16_t* ACT = (bf16_t*)(ws + WS_ACT); bf16_t* MN = (bf16_t*)(ws + WS_MN); bf16_t* KVM = (bf16_t*)(ws + WS_KVM);
    bf16_t* XB1 = (bf16_t*)(ws + WS_ACT); bf16_t* XB2 = (bf16_t*)(ws + WS_Q2);

#define FRESH_TID() int tid = threadIdx.x; asm volatile("" : "+v"(tid)); const int lane = tid & 63, wave = __builtin_amdgcn_readfirstlane(tid >> 6); (void)lane; (void)wave
#define GEMM(Aptr, Bptr, lda_, K_, Mrows, Ncols, pair_, ...) do { pg8::Gemm g{Aptr, (const bf16_t*)(Bptr), lda_, K_}; pg8::Order S; S.init(Mrows, Ncols, G, bx, pair_); \
        const pg8::Epi E{__VA_ARGS__}; pg8::gemm_phase(lds, g, S, E); } while (0)
    { FRESH_TID(); p0_prologue(args, lds, vcu, G, wave, lane); }
    GRID_BAR();
    GEMM(XN, ws + WS_W1T, DM, DM, M, NP, 0, pg8::EPI_STORE, PQ, NPQ, 0, C_Q / 256, C_Q / 256 + 4, QS_ATT, nullptr, 1, PR, NPR, NPQ / 256, 0);
    GRID_BAR();
    GEMM(MN, ws + WS_WKVT, DM, DM, MROWS, DM, 0, pg8::EPI_STORE, KVM, DM, 0, 0, 0, 1.f, nullptr, 0, nullptr, 0, 0, 0);
    if (G > 64) { if (bx >= 64) { FRESH_TID(); lora_prep(args, PR, bx - 64, G - 64, tid); } }
    else { FRESH_TID(); lora_prep(args, PR, bx, G, tid); }
    GRID_BAR();
    for (int u = vcu; u < NB * 16; u += G) { const int b = u >> 4, h = u & 15;
        { FRESH_TID(); rwkv_head_pipe(args, PQ, PR, PQ + C_R, NPQ, b, h, lds, tid); }
#if defined(ATT_2GROUP)
        { FRESH_TID(); chunk_attention_head(PQ, PR, PQ + C_Q, NPQ, args.in[I_RELB], b, h, lds, tid); }
#elif defined(ATT_8W2T)
        { FRESH_TID(); chunk_attention_head2(PQ, PR, PQ + C_Q, NPQ, args.in[I_RELB], b, h, lds, tid); }
#else
        { FRESH_TID(); chunk_attention_head3(PQ, PR, PQ + C_Q, NPQ, args.in[I_RELB], b, h, lds, tid); }
#endif
    }
    GRID_BAR();
    GEMM(XN, ws + WS_WGT, DM, DM, M, 2048, 0, pg8::EPI_SIGMOID, PR, NPR, C_GA, 0, 0, 1.f, nullptr, 0, nullptr, 0, 0, 0);
    GRID_BAR();
    GEMM(PQ, ws + WS_WABT, NPQ, DM, M, DM, 1, pg8::EPI_MIX, MIXED, DM, 0, 0, 0, 1.f, PR, 0, nullptr, 0, 0, NPR);
    GRID_BAR();
    GEMM(MIXED, ws + WS_WOUTT, DM, DM, M, DM, 0, pg8::EPI_STORE, O1, DM, 0, 0, 0, 1.f, nullptr, 0, nullptr, 0, 0, 0);
    GRID_BAR();
    { FRESH_TID(); norm_pass<false, true>(O1, args.in[I_X], XB1, args.in[I_GPOSTMIX], args.in[I_GPRECROSS], XN2, vcu, G, wave, lane); }
    GRID_BAR();
    GEMM(XN2, ws + WS_WQT, DM, DM, M, 512, 0, pg8::EPI_STORE, Q2, 512, 0, 0, 2, QS_MEM, nullptr, 0, nullptr, 0, 0, 0);
    GRID_BAR();
    { FRESH_TID(); cross_attention(Q2, KVM, O2, lds, vcu, G, tid); }
    GRID_BAR();
    GEMM(O2, ws + WS_WOT, 512, 512, M, DM, 0, pg8::EPI_STORE, O1, DM, 0, 0, 0, 1.f, nullptr, 0, nullptr, 0, 0, 0);
    GRID_BAR();
    { FRESH_TID(); norm_pass<true, true>(O1, XB1, XB2, args.in[I_GPOSTCROSS], args.in[I_GPREFFN], XN2, vcu, G, wave, lane); }
    GRID_BAR();
    GEMM(XN2, ws + WS_WF1T, DM, DM, M, 2 * FFH, 0, pg8::EPI_SWIGLU, ACT, FFH, 0, 0, 0, 1.f, nullptr, 0, nullptr, 0, 0, 0);
    GRID_BAR();
    GEMM(ACT, ws + WS_WF2T, FFH, FFH, M, DM, 0, pg8::EPI_STORE, O1, DM, 0, 0, 0, 1.f, nullptr, 0, nullptr, 0, 0, 0);
    GRID_BAR();
    { FRESH_TID(); norm_pass<true, false>(O1, XB2, args.out, args.in[I_GPOSTFFN], nullptr, nullptr, vcu, G, wave, lane); }
}

extern "C" void kernel_launch(void* const* d_in, const int* in_sizes, int n_in, void* d_out, int out_size, void* d_ws, size_t ws_size, hipStream_t stream) {
    static int grid = 0;
    if (grid == 0) {
        if (n_in != N_IN || in_sizes[0] != M * DM || out_size != M * DM || ws_size < WS_END) {
            fprintf(stderr, "kernel_launch: unexpected shapes (n_in %d, in0 %d, out %d, ws %zu); nothing launched\n", n_in, n_in > 0 ? in_sizes[0] : -1, out_size, ws_size); grid = -1; return; }
        int dev = 0, cus = 0;
        if (hipGetDevice(&dev) != hipSuccess || hipDeviceGetAttribute(&cus, hipDeviceAttributeMultiprocessorCount, dev) != hipSuccess) { grid = -1; return; }
        if (hipFuncSetAttribute((const void*)hyb_fwd, hipFuncAttributeMaxDynamicSharedMemorySize, LDS_BYTES) != hipSuccess) { fprintf(stderr, "kernel_launch: hipFuncSetAttribute failed\n"); grid = -1; return; }
        (void)hipGetLastError();
        grid = cus;
    }
    if (grid < 0) return;
    if (hipMemsetAsync((char*)d_ws + WS_CTL, 0, CTL_ZERO_BYTES, stream) != hipSuccess) return;
    Args a{};
    for (int i = 0; i < N_IN; ++i) a.in[i] = (const float*)d_in[i];
    a.out = (float*)d_out; a.ws = (unsigned char*)d_ws;
    hipLaunchKernelGGL(hyb_fwd, dim3(grid), dim3(NWAVES * 64), LDS_BYTES, stream, a);
}
```

```cpp
#include <hip/hip_runtime.h>
#include <hip/hip_bf16.h>
#include <cstdio>
#include <cstdint>

#define LAS __attribute__((address_space(3)))
#define GAS __attribute__((address_space(1)))
typedef unsigned short bf16_t;
typedef short bf16x8 __attribute__((ext_vector_type(8)));
typedef short s16x4 __attribute__((ext_vector_type(4)));
typedef float f32x4 __attribute__((ext_vector_type(4)));
typedef float f32x2 __attribute__((ext_vector_type(2)));
typedef float f32x16 __attribute__((ext_vector_type(16)));
typedef unsigned u32x4 __attribute__((ext_vector_type(4)));
typedef unsigned u32x2 __attribute__((ext_vector_type(2)));

constexpr int NB = 16, SEQ = 2048, DM = 1024, M = NB * SEQ;
constexpr int NP = 6656;
constexpr int NPQ = 2048, C_R = 0, C_Q = 1024;
constexpr int NPR = 4608, C_K = 0, C_V = 1024, C_L = 2048, C_KA = 2560, C_VA = 3584;
constexpr int C_GA = 0, C_GB = 1024;
constexpr int FFH = 2816, MEMT = 256, MROWS = NB * MEMT;
constexpr float NORM_EPS = 1e-6f, GN_EPS = 64e-5f;
constexpr float LOG2E = 1.4426950408889634f;
constexpr float QS_ATT = 0.125f * LOG2E;
constexpr float QS_MEM = 0.08838834764831845f * LOG2E;

constexpr size_t MiB = 1u << 20;
constexpr size_t WS_CTL = 0, CTL_ZERO_BYTES = 32 * 1024;
constexpr size_t WS_W1T = 1 * MiB;
constexpr size_t WS_WGT = 14 * MiB;
constexpr size_t WS_WABT = 18 * MiB;
constexpr size_t WS_WOUTT = 22 * MiB;
constexpr size_t WS_WQT = 24 * MiB;
constexpr size_t WS_WKVT = 25 * MiB;
constexpr size_t WS_WOT = 27 * MiB;
constexpr size_t WS_WF1T = 28 * MiB;
constexpr size_t WS_WF2T = 39 * MiB;
constexpr size_t WS_DUPT = 45 * MiB;
constexpr size_t WS_IUPT = WS_DUPT + 128 * 1024;
constexpr size_t WS_GUPT = WS_IUPT + 128 * 1024;
constexpr size_t WS_PQ = 48 * MiB;
constexpr size_t WS_PR = 176 * MiB;
constexpr size_t WS_MN = 464 * MiB;
constexpr size_t WS_KVM = 472 * MiB;
constexpr size_t WS_LORA = 480 * MiB;
constexpr size_t WS_O1 = 48 * MiB;
constexpr size_t WS_XN2 = 112 * MiB;
constexpr size_t WS_Q2 = 176 * MiB;
constexpr size_t WS_O2 = 208 * MiB;
constexpr size_t WS_ACT = 240 * MiB;
constexpr size_t WS_END = 512 * MiB;
constexpr int CW_BAR = 4096;

constexpr int RING_BYTES = 131072;
constexpr int LDSCTL_OFF = RING_BYTES, MISC_OFF = LDSCTL_OFF + 320;
constexpr int LDS_BYTES = 151552;
constexpr int NWAVES = 8;

#define RLX_AGENT __ATOMIC_RELAXED, __HIP_MEMORY_SCOPE_AGENT
#define LDS_WAIT() asm volatile("s_waitcnt lgkmcnt(0)" ::: "memory")
#define VM_WAIT() asm volatile("s_waitcnt vmcnt(0)" ::: "memory")

__device__ __forceinline__ unsigned f2bf(float f) { unsigned u = __builtin_bit_cast(unsigned, f); return (u + 0x7fffu + ((u >> 16) & 1u)) >> 16; }
__device__ __forceinline__ unsigned pk2(float lo, float hi) { return f2bf(lo) | (f2bf(hi) << 16); }
__device__ __forceinline__ float bf2f(unsigned short b) { return __builtin_bit_cast(float, (unsigned)b << 16); }
__device__ __forceinline__ float bflo(unsigned w) { return __builtin_bit_cast(float, w << 16); }
__device__ __forceinline__ float bfhi(unsigned w) { return __builtin_bit_cast(float, w & 0xffff0000u); }
typedef __bf16 bf16x2_t __attribute__((ext_vector_type(2)));
__device__ __forceinline__ unsigned cvtpk(float lo, float hi) { f32x2 v = {lo, hi}; bf16x2_t b = __builtin_convertvector(v, bf16x2_t); return __builtin_bit_cast(unsigned, b); }
__device__ __forceinline__ float wave_sum(float v) {
#pragma unroll
    for (int o = 1; o < 64; o <<= 1) v += __shfl_xor(v, o);
    return v;
}
__device__ __forceinline__ float fast_exp2(float x) { return __builtin_amdgcn_exp2f(x); }
__device__ __forceinline__ float sigmoidf_(float x) { return __builtin_amdgcn_rcpf(1.0f + __builtin_amdgcn_exp2f(-x * LOG2E)); }

#define XB_TMO      128
#define XB_XCNT(j)  (256  + 64 * (j))
#define XB_XSUB(j)  (1280 + 64 * (j))
#define XB_XGEN(j)  (2304 + 64 * (j))
#define XB_TOP      3328
#define XB_TOPGEN   3392
#define XCD_BAR_WORDS 3456
#define XB_SPIN_CAP (1u << 18)
__device__ __forceinline__ unsigned xb_ld(unsigned* p)              { return __hip_atomic_load(p, __ATOMIC_RELAXED, __HIP_MEMORY_SCOPE_AGENT); }
__device__ __forceinline__ unsigned xb_add(unsigned* p, unsigned v) { return __hip_atomic_fetch_add(p, v, __ATOMIC_RELAXED, __HIP_MEMORY_SCOPE_AGENT); }
__device__ __forceinline__ unsigned xb_xcc_id() { return (unsigned)__builtin_amdgcn_s_getreg((3 << 11) | 20) & 0xFu; }
#define XB_SPIN(cond, bar) do { unsigned _sp = 0; while (cond) { __builtin_amdgcn_s_sleep(1); \
    if ((++_sp & 255u) == 0u) { if (xb_ld(&(bar)[XB_TMO])) break; if (_sp > XB_SPIN_CAP) { atomicAdd(&(bar)[XB_TMO], 1u); break; } } } } while (0)
struct XcdBarrier { unsigned* bar; unsigned x; volatile LAS unsigned* st; };
__device__ __forceinline__ XcdBarrier xcd_barrier_post(unsigned* bar, volatile LAS unsigned* st) {
    XcdBarrier b; b.bar = bar; b.x = xb_xcc_id(); b.st = st;
    if (threadIdx.x == 0) (void)xb_add(&bar[XB_XCNT(b.x)], 1u);
    return b;
}
__device__ __forceinline__ void xcd_barrier_complete(unsigned* bar, unsigned x, unsigned& nloc, unsigned& nx) {
    const unsigned G = gridDim.x * gridDim.y * gridDim.z;
    unsigned sum, cnt, mine, sp = 0u;
    for (;;) {
        sum = 0u; cnt = 0u; mine = 0u;
#pragma unroll
        for (unsigned j = 0; j < 16; ++j) { const unsigned c = xb_ld(&bar[XB_XCNT(j)]); sum += c; cnt += (c > 0u) ? 1u : 0u; mine = (j == x) ? c : mine; }
        if (sum == G) break;
        __builtin_amdgcn_s_sleep(1);
        if ((++sp & 255u) == 0u) { if (xb_ld(&bar[XB_TMO])) break; if (sp > XB_SPIN_CAP) { atomicAdd(&bar[XB_TMO], 1u); break; } }
    }
    nloc = mine > 0u ? mine : 1u; nx = cnt > 0u ? cnt : 1u;
}
__device__ __forceinline__ void xcd_barrier(const XcdBarrier& b) {
    asm volatile("s_waitcnt vmcnt(0)" ::: "memory");
    __syncthreads();
    if (threadIdx.x == 0) {
        unsigned* bar = b.bar;
        __builtin_amdgcn_s_waitcnt(0);
        unsigned nloc = b.st[0], nx = b.st[1];
        if (nloc == 0u) { xcd_barrier_complete(bar, b.x, nloc, nx); b.st[0] = nloc; b.st[1] = nx; }
        const unsigned old = xb_add(&bar[XB_XSUB(b.x)], 1u);
        const unsigned gen = old / nloc;
        if (old + 1u == (gen + 1u) * nloc) {
            __builtin_amdgcn_fence(__ATOMIC_RELEASE, "agent");
            asm volatile("s_waitcnt vmcnt(0)" ::: "memory");
            const unsigned og = xb_add(&bar[XB_TOP], 1u);
            const unsigned tg = og / nx;
            if (og + 1u == (tg + 1u) * nx) xb_add(&bar[XB_TOPGEN], 1u);
            else XB_SPIN(xb_ld(&bar[XB_TOPGEN]) == tg, bar);
            __builtin_amdgcn_fence(__ATOMIC_ACQUIRE, "agent");
            xb_add(&bar[XB_XGEN(b.x)], 1u);
            asm volatile("s_waitcnt vmcnt(0)" ::: "memory");
        } else {
            XB_SPIN(xb_ld(&bar[XB_XGEN(b.x)]) == gen, bar);
            __builtin_amdgcn_fence(__ATOMIC_ACQUIRE, "agent");
            asm volatile("s_waitcnt vmcnt(0)" ::: "memory");
        }
    }
    __syncthreads();
}

namespace pg8 {
constexpr int BM = 256, BK = 64, HALF = 128, HTB = HALF * BK * 2, STAGE_BYTES = 8 * HTB, NXCD = 8, WGM_BIG = 6;
__host__ __device__ __forceinline__ int lds_byte(int r, int c) { const int st = (r >> 4) * 2 + (c >> 5), rr = r & 15, cc = c & 31, ob = rr * 64 + cc * 2; return st * 1024 + (ob ^ (((ob >> 9) & 1) << 5)); }
__host__ __device__ __forceinline__ void stage_rc(int b, int& R, int& C) { const int st = b / 1024, sb = b % 1024, swz = sb ^ (((sb >> 9) & 1) << 5); R = (st >> 1) * 16 + swz / 64; C = (st & 1) * 32 + (swz % 64) / 2; }
__host__ __device__ __forceinline__ int perm32(int rho) { const int n = rho >> 4, i = rho & 15; return 8 * (i >> 2) + 4 * n + (i & 3); }

struct Unit { int pm, pn, ac; };
struct Gemm { const bf16_t* A; const bf16_t* Bt; int lda, K; };

#ifndef WGM_SMALL
#define WGM_SMALL 4
#endif
__device__ __forceinline__ void tile_of(int wgid0, int nM, int nN, int& pm, int& pn) {
    const int WGM = (nN >= 16) ? pg8::WGM_BIG : WGM_SMALL;
    const int nwg = nM * nN; int wgid = wgid0;
    { const int q = nwg / NXCD, r = nwg % NXCD, xcd = wgid % NXCD, off = wgid / NXCD; wgid = (xcd < r ? xcd * (q + 1) : r * (q + 1) + (xcd - r) * q) + off; }
    const int nig = WGM * nN, gid = wgid / nig, fm = gid * WGM, gsz = (nM - fm) < WGM ? (nM - fm) : WGM;
    pm = fm + ((wgid % nig) % gsz); pn = (wgid % nig) / gsz;
}
#define EPI_FOR_ROWS for (int ai = 0; ai < 2; ++ai) _Pragma("unroll") for (int m = 0; m < 4; ++m)
enum { EPI_STORE = 0, EPI_SIGMOID = 1, EPI_MIX = 2, EPI_SWIGLU = 3 };
struct Epi {
    int type; bf16_t* O; int ldc; int coff; int s_lo, s_hi; float scale; const bf16_t* P; int nt; bf16_t* O2; int ldc2; int split; int pld;
    __device__ __forceinline__ void operator()(const f32x4 (&acc)[2][2][4][2], const Unit& u, int wr, int wc, int fr, int fq) const {
        const int row0 = u.pm * BM + wr * 64 + fr;
        if (type == EPI_STORE || type == EPI_SIGMOID) {
            const float sc = (u.pn >= s_lo && u.pn < s_hi) ? scale : 1.f;
            const bool hi2 = (split > 0) && (u.pn >= split); bf16_t* const Ob = hi2 ? O2 : O; const int ldo = hi2 ? ldc2 : ldc;
            const int col0 = coff + (hi2 ? u.pn - split : u.pn) * BM + wc * 32 + 8 * fq; const bool sg = (type == EPI_SIGMOID);
#pragma unroll
            EPI_FOR_ROWS { bf16_t* rowp = Ob + (size_t)(row0 + ai * HALF + m * 16) * ldo + col0;
#pragma unroll
                for (int bj = 0; bj < 2; ++bj) { f32x4 v0 = acc[ai][bj][m][0] * sc, v1 = acc[ai][bj][m][1] * sc;
                    if (sg) {
#pragma unroll
                        for (int e = 0; e < 4; ++e) { v0[e] = sigmoidf_(v0[e]); v1[e] = sigmoidf_(v1[e]); } }
                    u32x4 w; w.x = cvtpk(v0[0], v0[1]); w.y = cvtpk(v0[2], v0[3]); w.z = cvtpk(v1[0], v1[1]); w.w = cvtpk(v1[2], v1[3]);
                    if (nt) __builtin_nontemporal_store(w, (u32x4*)(rowp + bj * HALF)); else *(u32x4*)(rowp + bj * HALF) = w; } }
        } else if (type == EPI_MIX) {
            const int pn = u.pn & 3;
            const int col0 = pn * BM + wc * 32 + 8 * fq;
            const int gcol = C_GB + col0;
#pragma unroll
            for (int ai = 0; ai < 2; ++ai) {
                u32x4 gv[4][2];
#pragma unroll
                for (int m = 0; m < 4; ++m)
#pragma unroll
                    for (int bj = 0; bj < 2; ++bj) gv[m][bj] = *(const u32x4*)(P + (size_t)(row0 + ai * HALF + m * 16) * pld + gcol + bj * HALF);
#pragma unroll
                for (int m = 0; m < 4; ++m)
#pragma unroll
                    for (int bj = 0; bj < 2; ++bj) { const size_t row = (size_t)(row0 + ai * HALF + m * 16);
                        const u32x4 g = gv[m][bj];
                        f32x4 v0 = acc[ai][bj][m][0], v1 = acc[ai][bj][m][1];
                        v0[0] *= bflo(g.x); v0[1] *= bfhi(g.x); v0[2] *= bflo(g.y); v0[3] *= bfhi(g.y);
                        v1[0] *= bflo(g.z); v1[1] *= bfhi(g.z); v1[2] *= bflo(g.w); v1[3] *= bfhi(g.w);
                        u32x4 w; w.x = cvtpk(v0[0], v0[1]); w.y = cvtpk(v0[2], v0[3]); w.z = cvtpk(v1[0], v1[1]); w.w = cvtpk(v1[2], v1[3]);
                        *(u32x4*)(O + row * ldc + col0 + bj * HALF) = w; }
            }
        } else {
            const int col0 = u.pn * HALF + wc * 32 + 8 * fq;
#pragma unroll
            EPI_FOR_ROWS { bf16_t* rowp = O + (size_t)(row0 + ai * HALF + m * 16) * ldc + col0;
                f32x4 v0 = acc[ai][0][m][0], v1 = acc[ai][0][m][1]; const f32x4 u0 = acc[ai][1][m][0], u1 = acc[ai][1][m][1];
#pragma unroll
                for (int e = 0; e < 4; ++e) { v0[e] = v0[e] * sigmoidf_(v0[e]) * u0[e]; v1[e] = v1[e] * sigmoidf_(v1[e]) * u1[e]; }
                u32x4 w; w.x = cvtpk(v0[0], v0[1]); w.y = cvtpk(v0[2], v0[3]); w.z = cvtpk(v1[0], v1[1]); w.w = cvtpk(v1[2], v1[3]);
                *(u32x4*)rowp = w; }
        }
    }
    __device__ __forceinline__ bool keep(const Unit& u) const { return type == EPI_MIX && (u.pn >> 2) == 0; }
    __device__ __forceinline__ void scale_keep(f32x4 (&acc)[2][2][4][2], const Unit& u, int wr, int wc, int fr, int fq) const {
        const int row0 = u.pm * BM + wr * 64 + fr, col0 = (u.pn & 3) * BM + wc * 32 + 8 * fq;
#pragma unroll
        for (int ai = 0; ai < 2; ++ai) {
            u32x4 ga[4][2], gb[4][2];
#pragma unroll
            for (int m = 0; m < 4; ++m)
#pragma unroll
                for (int bj = 0; bj < 2; ++bj) { const bf16_t* gp = P + (size_t)(row0 + ai * HALF + m * 16) * pld + col0 + bj * HALF; ga[m][bj] = *(const u32x4*)(gp + C_GA); gb[m][bj] = *(const u32x4*)(gp + C_GB); }
#pragma unroll
            for (int m = 0; m < 4; ++m)
#pragma unroll
                for (int bj = 0; bj < 2; ++bj) { const u32x4 a = ga[m][bj], b = gb[m][bj];
                    f32x4& v0 = acc[ai][bj][m][0]; f32x4& v1 = acc[ai][bj][m][1];
                    v0[0] *= bflo(a.x) * __builtin_amdgcn_rcpf(bflo(b.x)); v0[1] *= bfhi(a.x) * __builtin_amdgcn_rcpf(bfhi(b.x)); v0[2] *= bflo(a.y) * __builtin_amdgcn_rcpf(bflo(b.y)); v0[3] *= bfhi(a.y) * __builtin_amdgcn_rcpf(bfhi(b.y));
                    v1[0] *= bflo(a.z) * __builtin_amdgcn_rcpf(bflo(b.z)); v1[1] *= bfhi(a.z) * __builtin_amdgcn_rcpf(bfhi(b.z)); v1[2] *= bflo(a.w) * __builtin_amdgcn_rcpf(bflo(b.w)); v1[3] *= bfhi(a.w) * __builtin_amdgcn_rcpf(bfhi(b.w)); }
        }
    }
};
struct Order {
    int nM, nN, nwg, G, c, pair;
    __device__ __forceinline__ void init(int M_, int N_, int G_, int c_, int pair_) { nM = M_ / BM; nN = N_ / BM; nwg = nM * nN; G = G_; c = c_; pair = pair_; }
    __device__ __forceinline__ bool next(int i, Unit& u) const {
        const int ii = pair ? (i >> 1) : i;
        const long L = (long)ii * G + c; if (L >= nwg) return false;
        int pn; tile_of((int)L, nM, nN, u.pm, pn);
        const int half = pair ? (i & 1) : 0; u.pn = half * nN + pn; u.ac = half * 1024; return true;
    }
};

__device__ __forceinline__ void gemm_phase(LAS unsigned char* lds, const Gemm& g, const Order& S, const Epi& E) {
    int tid = threadIdx.x; asm volatile("" : "+v"(tid));
    const int wid = __builtin_amdgcn_readfirstlane(tid >> 6), lane = tid & 63, wr = wid >> 2, wc = wid & 3, fr = lane & 15, fq = lane >> 4;
    const int K = g.K, lda = g.lda, nt = K / BK;
    unsigned voffA[2], voffB[2];
#pragma unroll
    for (int i = 0; i < 2; ++i) { int R, C; stage_rc(tid * 16 + i * 8192, R, C); const int Rb = (R & ~31) + perm32(R & 31);
        voffA[i] = (unsigned)(R * lda + C) * 2u; voffB[i] = (unsigned)(Rb * K + C) * 2u; }
    const size_t kstep = (size_t)(BK * 2);
    const size_t hstepA = (size_t)HALF * lda * 2, hstepB = (size_t)HALF * K * 2;
    const size_t tstepA = 2 * hstepA, tstepB = 2 * hstepB;
    const unsigned ldsw = (unsigned)wid * 1024u;
    const int aoff = lds_byte(wr * 64 + fr, fq * 8), boff = lds_byte(wc * 32 + fr, fq * 8);
#define PG8_SA(b, h) (((b) * 2 + (h)) * HTB)
#define PG8_SB(b, h) ((4 + (b) * 2 + (h)) * HTB)
#define PG8_STAGE(bufoff, gbase, voff) do { _Pragma("unroll") for (int _i = 0; _i < 2; ++_i) \
        __builtin_amdgcn_global_load_lds((const unsigned*)((const char*)(gbase) + (voff)[_i]), (LAS unsigned*)(lds + (bufoff) + ldsw + _i * 8192), 16, 0, 0); } while (0)
#define PG8_LDA(dst, b, h) do { _Pragma("unroll") for (int m = 0; m < 4; ++m) _Pragma("unroll") for (int k = 0; k < 2; ++k) dst[m][k] = *(const LAS bf16x8*)(lds + PG8_SA(b, h) + aoff + m * 2048 + k * 1024); } while (0)
#define PG8_LDB(dst, b, h) do { _Pragma("unroll") for (int n = 0; n < 2; ++n) _Pragma("unroll") for (int k = 0; k < 2; ++k) dst[n][k] = *(const LAS bf16x8*)(lds + PG8_SB(b, h) + boff + n * 2048 + k * 1024); } while (0)
#define PG8_MMA(ai, bj, At, Bt) do { __builtin_amdgcn_s_setprio(1); _Pragma("unroll") for (int m = 0; m < 4; ++m) _Pragma("unroll") for (int n = 0; n < 2; ++n) _Pragma("unroll") for (int k = 0; k < 2; ++k) \
        acc[ai][bj][m][n] = __builtin_amdgcn_mfma_f32_16x16x32_bf16(Bt[n][k], At[m][k], acc[ai][bj][m][n], 0, 0, 0); __builtin_amdgcn_s_setprio(0); } while (0)
#define PG8_WAIT_V(n) asm volatile("s_waitcnt vmcnt(" #n ")" ::: "memory")
#define PG8_WAIT_L(n) asm volatile("s_waitcnt lgkmcnt(" #n ")" ::: "memory")
#define PG8_BAR __builtin_amdgcn_s_barrier()
#define PG8_SCHED __builtin_amdgcn_sched_barrier(0)
    Unit cur, nxt; int ui = 0;
    if (!S.next(0, cur)) return;
    f32x4 acc[2][2][4][2];
#pragma unroll
    for (int a = 0; a < 2; ++a)
#pragma unroll
        for (int b = 0; b < 2; ++b)
#pragma unroll
            for (int m = 0; m < 4; ++m)
#pragma unroll
                for (int n = 0; n < 2; ++n) acc[a][b][m][n] = (f32x4){0.f, 0.f, 0.f, 0.f};
    bf16x8 At[4][2], B0[2][2], B1[2][2];
    const char* cA = (const char*)g.A + (size_t)cur.pm * tstepA + (size_t)cur.ac * 2; const char* cB = (const char*)g.Bt + (size_t)cur.pn * tstepB;
    PG8_STAGE(PG8_SB(0, 0), cB, voffB); PG8_STAGE(PG8_SB(0, 1), cB + hstepB, voffB); PG8_STAGE(PG8_SA(0, 0), cA, voffA); PG8_STAGE(PG8_SA(0, 1), cA + hstepA, voffA);
    if (wr == 1) PG8_BAR;
    PG8_WAIT_V(2); PG8_BAR;
    PG8_STAGE(PG8_SB(1, 0), cB + kstep, voffB); PG8_STAGE(PG8_SA(1, 0), cA + kstep, voffA); PG8_STAGE(PG8_SB(1, 1), cB + hstepB + kstep, voffB);
    PG8_WAIT_V(6); PG8_BAR;
    for (;;) {
        const bool has_next = S.next(ui + 1, nxt);
        const char* nA = has_next ? (const char*)g.A + (size_t)nxt.pm * tstepA + (size_t)nxt.ac * 2 : cA; const char* nB = has_next ? (const char*)g.Bt + (size_t)nxt.pn * tstepB : cB;
        for (int t = 0; t < nt; t += 2) {
            const bool last = (t == nt - 2);
            const char* a1 = cA + (size_t)(t + 1) * kstep;
            const char* a2 = last ? nA : cA + (size_t)(t + 2) * kstep; const char* b2 = last ? nB : cB + (size_t)(t + 2) * kstep;
            const char* a3 = a2 + kstep; const char* b3 = b2 + kstep;
            PG8_LDB(B0, 0, 0); PG8_LDB(B1, 0, 1); PG8_SCHED; PG8_LDA(At, 0, 0); PG8_STAGE(PG8_SA(1, 1), a1 + hstepA, voffA);
            PG8_WAIT_V(8); PG8_WAIT_L(0); PG8_BAR; PG8_MMA(0, 0, At, B0); PG8_MMA(0, 1, At, B1); PG8_BAR; PG8_SCHED;
            PG8_LDA(At, 0, 1); PG8_STAGE(PG8_SB(0, 0), b2, voffB); PG8_STAGE(PG8_SB(0, 1), b2 + hstepB, voffB); PG8_STAGE(PG8_SA(0, 0), a2, voffA);
            PG8_WAIT_V(8); PG8_WAIT_L(0); PG8_BAR; PG8_MMA(1, 0, At, B0); PG8_MMA(1, 1, At, B1); PG8_BAR; PG8_SCHED;
            PG8_LDB(B0, 1, 0); PG8_LDB(B1, 1, 1); PG8_SCHED; PG8_LDA(At, 1, 0); PG8_STAGE(PG8_SA(0, 1), a2 + hstepA, voffA);
            PG8_WAIT_V(8); PG8_WAIT_L(0); PG8_BAR; PG8_MMA(0, 0, At, B0); PG8_MMA(0, 1, At, B1); PG8_BAR; PG8_SCHED;
            PG8_LDA(At, 1, 1); PG8_STAGE(PG8_SB(1, 0), b3, voffB); PG8_STAGE(PG8_SB(1, 1), b3 + hstepB, voffB); PG8_STAGE(PG8_SA(1, 0), a3, voffA);
            PG8_WAIT_V(8); PG8_WAIT_L(0); PG8_BAR; PG8_MMA(1, 0, At, B0); PG8_MMA(1, 1, At, B1); PG8_BAR; PG8_SCHED;
        }
        if (wr == 0) PG8_BAR;
        const bool keep_acc = E.keep(cur);
        if (keep_acc) E.scale_keep(acc, cur, wr, wc, fr, fq); else E(acc, cur, wr, wc, fr, fq);
        if (!has_next) break;
        if (!keep_acc)
#pragma unroll
        for (int a = 0; a < 2; ++a)
#pragma unroll
            for (int b = 0; b < 2; ++b)
#pragma unroll
                for (int m = 0; m < 4; ++m)
#pragma unroll
                    for (int n = 0; n < 2; ++n) acc[a][b][m][n] = (f32x4){0.f, 0.f, 0.f, 0.f};
        cur = nxt; cA = nA; cB = nB; ++ui;
        if (wr == 1) PG8_BAR;
    }
    PG8_WAIT_V(0);
    PG8_BAR;
#undef PG8_SA
#undef PG8_SB
#undef PG8_STAGE
#undef PG8_LDA
#undef PG8_LDB
#undef PG8_MMA
#undef PG8_WAIT_V
#undef PG8_WAIT_L
#undef PG8_BAR
#undef PG8_SCHED
}
}

enum { I_X = 0, I_MEM, I_GPREMIX, I_GPOSTMIX, I_WIN, I_SHIFT, I_DBASE, I_DUP, I_IBASE, I_IUP, I_GUP, I_KNS, I_KIS, I_BONUS, I_LNW, I_LNB, I_RELB,
       I_WA, I_WB, I_WOUT, I_GPRECROSS, I_GPOSTCROSS, I_GMEM, I_WQM, I_WKVM, I_WOM, I_GPREFFN, I_GPOSTFFN, I_WF1, I_WF2, N_IN };
struct Args { const float* in[N_IN]; float* out; unsigned char* ws; };

__device__ __forceinline__ void p0_transpose_item(const float* W, int ldsrc, int K, int col0, bf16_t* WT, int dld, int drow0, int k0, LAS float* scr, int lane) {
    float tv[32];
#pragma unroll
    for (int i = 0; i < 32; ++i) { const int kk = 2 * i + (lane >> 5); const int k = k0 + kk;
        tv[i] = (k < K) ? __builtin_nontemporal_load(W + (size_t)k * ldsrc + col0 + (lane & 31)) : 0.f; }
#pragma unroll
    for (int i = 0; i < 32; ++i) { const int kk = 2 * i + (lane >> 5); scr[kk * 33 + (lane & 31)] = tv[i]; }
    LDS_WAIT(); asm volatile("" ::: "memory");
    const int c = lane & 7;
    if (k0 + 8 * c < K) {
#pragma unroll
        for (int j = 0; j < 4; ++j) { const int n = (lane >> 3) + 8 * j; const LAS float* s = scr + (8 * c) * 33 + n;
            u32x4 o; o.x = pk2(s[0 * 33], s[1 * 33]); o.y = pk2(s[2 * 33], s[3 * 33]); o.z = pk2(s[4 * 33], s[5 * 33]); o.w = pk2(s[6 * 33], s[7 * 33]);
            *(u32x4*)(WT + (size_t)(drow0 + n) * dld + k0 + 8 * c) = o; }
    }
    LDS_WAIT(); asm volatile("" ::: "memory");
}
constexpr int NJOBS = 19;
__device__ __forceinline__ void job_desc(const Args& a, int j, const float*& src, int& ld, int& K, int& col0, int& ncols, size_t& dst, int& drow0, int& mode) {
    mode = 0;
    switch (j) {
    case 0:  src = a.in[I_WIN]; ld = 8480; K = 1024; col0 = 0;    ncols = 1024; dst = WS_W1T; drow0 = 0; break;
    case 1:  src = a.in[I_WIN]; ld = 8480; K = 1024; col0 = 3360; ncols = 1024; dst = WS_W1T; drow0 = 1024; break;
    case 2:  src = a.in[I_WIN]; ld = 8480; K = 1024; col0 = 1024; ncols = 1024; dst = WS_W1T; drow0 = 2048; break;
    case 3:  src = a.in[I_WIN]; ld = 8480; K = 1024; col0 = 2048; ncols = 1024; dst = WS_W1T; drow0 = 3072; break;
    case 4:  src = a.in[I_WIN]; ld = 8480; K = 1024; col0 = 3072; ncols = 288;  dst = WS_W1T; drow0 = 4096; break;
    case 5:  src = a.in[I_WIN]; ld = 8480; K = 1024; col0 = 4384; ncols = 1024; dst = WS_W1T; drow0 = 4608; break;
    case 6:  src = a.in[I_WIN]; ld = 8480; K = 1024; col0 = 5408; ncols = 1024; dst = WS_W1T; drow0 = 5632; break;
    case 7:  src = a.in[I_WIN]; ld = 8480; K = 1024; col0 = 6432; ncols = 2048; dst = WS_WGT; drow0 = 0; break;
    case 8:  src = a.in[I_WA];  ld = 1024; K = 1024; col0 = 0; ncols = 1024; dst = WS_WABT; drow0 = 0; break;
    case 9:  src = a.in[I_WB];  ld = 1024; K = 1024; col0 = 0; ncols = 1024; dst = WS_WABT; drow0 = 1024; break;
    case 10: src = a.in[I_WOUT]; ld = 1024; K = 1024; col0 = 0; ncols = 1024; dst = WS_WOUTT; drow0 = 0; break;
    case 11: src = a.in[I_WQM]; ld = 512;  K = 1024; col0 = 0; ncols = 512;  dst = WS_WQT; drow0 = 0; break;
    case 12: src = a.in[I_WKVM]; ld = 1024; K = 1024; col0 = 0; ncols = 1024; dst = WS_WKVT; drow0 = 0; break;
    case 13: src = a.in[I_WOM]; ld = 1024; K = 512;  col0 = 0; ncols = 1024; dst = WS_WOT; drow0 = 0; break;
    case 14: src = a.in[I_WF1]; ld = 5632; K = 1024; col0 = 0; ncols = 5632; dst = WS_WF1T; drow0 = 0; mode = 1; break;
    case 15: src = a.in[I_WF2]; ld = 1024; K = 2816; col0 = 0; ncols = 1024; dst = WS_WF2T; drow0 = 0; break;
    case 16: src = a.in[I_DUP]; ld = 1024; K = 64;   col0 = 0; ncols = 1024; dst = WS_DUPT; drow0 = 0; break;
    case 17: src = a.in[I_IUP]; ld = 1024; K = 64;   col0 = 0; ncols = 1024; dst = WS_IUPT; drow0 = 0; break;
    default: src = a.in[I_GUP]; ld = 1024; K = 160;  col0 = 0; ncols = 1024; dst = WS_GUPT; drow0 = 0; break;
    }
}
__device__ __forceinline__ void rms_row_to_bf16(const float* xrow, const float* gain, bf16_t* orow, int lane) {
    const f32x4* xr = (const f32x4*)xrow + lane; const f32x4* gr = (const f32x4*)gain + lane;
    f32x4 v[4]; float s = 0.f;
#pragma unroll
    for (int j = 0; j < 4; ++j) { v[j] = xr[64 * j]; s += (v[j].x * v[j].x + v[j].y * v[j].y) + (v[j].z * v[j].z + v[j].w * v[j].w); }
    const float rs = 1.0f / sqrtf(wave_sum(s) * (1.f / DM) + NORM_EPS);
    u32x2* o8 = (u32x2*)orow + lane;
#pragma unroll
    for (int j = 0; j < 4; ++j) { const f32x4 g = gr[64 * j]; u32x2 w; w.x = cvtpk(v[j].x * rs * g.x, v[j].y * rs * g.y); w.y = cvtpk(v[j].z * rs * g.z, v[j].w * rs * g.w); o8[64 * j] = w; }
}
__device__ __forceinline__ void rms_row2_to_bf16(const float* xa, const float* xb, const float* gain, bf16_t* oa, bf16_t* ob, int lane) {
    const f32x4* xr0 = (const f32x4*)xa + lane; const f32x4* xr1 = (const f32x4*)xb + lane; const f32x4* gr = (const f32x4*)gain + lane;
    f32x4 v0[4], v1[4]; float s0 = 0.f, s1 = 0.f;
#pragma unroll
    for (int j = 0; j < 4; ++j) { v0[j] = __builtin_nontemporal_load(xr0 + 64 * j); v1[j] = __builtin_nontemporal_load(xr1 + 64 * j); }
#pragma unroll
    for (int j = 0; j < 4; ++j) { s0 += (v0[j].x * v0[j].x + v0[j].y * v0[j].y) + (v0[j].z * v0[j].z + v0[j].w * v0[j].w); s1 += (v1[j].x * v1[j].x + v1[j].y * v1[j].y) + (v1[j].z * v1[j].z + v1[j].w * v1[j].w); }
    const float rs0 = __builtin_amdgcn_rsqf(wave_sum(s0) * (1.f / DM) + NORM_EPS), rs1 = __builtin_amdgcn_rsqf(wave_sum(s1) * (1.f / DM) + NORM_EPS);
    u32x2* o0 = (u32x2*)oa + lane; u32x2* o1 = (u32x2*)ob + lane;
#pragma unroll
    for (int j = 0; j < 4; ++j) { const f32x4 g = gr[64 * j]; u32x2 w;
        w.x = cvtpk(v0[j].x * rs0 * g.x, v0[j].y * rs0 * g.y); w.y = cvtpk(v0[j].z * rs0 * g.z, v0[j].w * rs0 * g.w); o0[64 * j] = w;
        w.x = cvtpk(v1[j].x * rs1 * g.x, v1[j].y * rs1 * g.y); w.y = cvtpk(v1[j].z * rs1 * g.z, v1[j].w * rs1 * g.w); o1[64 * j] = w; }
}
__device__ __forceinline__ void p0_prologue(const Args& a, LAS unsigned char* lds, int vcu, int G, int wave, int lane) {
    LAS float* scr = (LAS float*)(lds + wave * 16384);
    const int gw = vcu * NWAVES + wave, NGW = G * NWAVES;
    int total = 0;
    for (int j = 0; j < NJOBS; ++j) { int ld, K, col0, ncols, drow0, mode; size_t dst; const float* src; job_desc(a, j, src, ld, K, col0, ncols, dst, drow0, mode); total += ((K + 63) / 64) * (ncols / 32); }
    for (int it = gw; it < total; it += NGW) {
        int r = it;
        for (int j = 0; j < NJOBS; ++j) {
            int ld, K, col0, ncols, drow0, mode; size_t dst; const float* src; job_desc(a, j, src, ld, K, col0, ncols, dst, drow0, mode);
            const int nblk = ncols / 32, cnt = ((K + 63) / 64) * nblk;
            if (r < cnt) {
                const int kb = r / nblk, nb = r % nblk; int n0 = 32 * nb; int drow = drow0 + n0;
                if (mode == 1) { const int up = n0 >= FFH ? 1 : 0; const int nn = n0 - up * FFH; drow = 256 * (nn / 128) + 128 * up + (nn % 128); }
                p0_transpose_item(src, ld, K, col0 + n0, (bf16_t*)(a.ws + dst), K, drow, 64 * kb, scr, lane);
                break;
            }
            r -= cnt;
        }
    }
    { u32x4* z = (u32x4*)(a.ws + WS_W1T + (size_t)4384 * 1024 * 2); const int n16 = 224 * 1024 * 2 / 16;
      for (int i = gw * 64 + lane; i < n16; i += NGW * 64) z[i] = (u32x4){0u, 0u, 0u, 0u}; }
    bf16_t* XN = (bf16_t*)a.out; bf16_t* MN = (bf16_t*)(a.ws + WS_MN);
    for (int m = gw; m < M; m += 2 * NGW) rms_row2_to_bf16(a.in[I_X] + (size_t)m * DM, a.in[I_X] + (size_t)(m + NGW) * DM, a.in[I_GPREMIX], XN + (size_t)m * DM, XN + (size_t)(m + NGW) * DM, lane);
    for (int m = gw; m < MROWS; m += NGW) rms_row_to_bf16(a.in[I_MEM] + (size_t)m * DM, a.in[I_GMEM], MN + (size_t)m * DM, lane);
}

template <bool XIB, bool XOB>
__device__ __forceinline__ void norm_pass(const bf16_t* O, const void* xres_, void* xout_, const float* g1, const float* g2, bf16_t* hn, int vcu, int G, int wave, int lane) {
    const int gw = vcu * NWAVES + wave, NGW = G * NWAVES;
    for (int m0 = gw; m0 < M; m0 += 2 * NGW) {
        f32x4 ov[2][4], xv[2][4]; float s[2] = {0.f, 0.f};
#pragma unroll
        for (int q = 0; q < 2; ++q) { const size_t m = (size_t)m0 + (size_t)q * NGW;
            const u32x2* orow = (const u32x2*)(O + m * DM) + lane;
#pragma unroll
            for (int j = 0; j < 4; ++j) { const u32x2 w = __builtin_nontemporal_load(orow + 64 * j); ov[q][j] = (f32x4){bflo(w.x), bfhi(w.x), bflo(w.y), bfhi(w.y)};
                if (XIB) { const u32x2 xw = __builtin_nontemporal_load((const u32x2*)((const bf16_t*)xres_ + m * DM) + lane + 64 * j); xv[q][j] = (f32x4){bflo(xw.x), bfhi(xw.x), bflo(xw.y), bfhi(xw.y)}; }
                else xv[q][j] = __builtin_nontemporal_load((const f32x4*)((const float*)xres_ + m * DM) + lane + 64 * j); } }
#pragma unroll
        for (int q = 0; q < 2; ++q)
#pragma unroll
            for (int j = 0; j < 4; ++j) s[q] += (ov[q][j].x * ov[q][j].x + ov[q][j].y * ov[q][j].y) + (ov[q][j].z * ov[q][j].z + ov[q][j].w * ov[q][j].w);
        const float rs[2] = {__builtin_amdgcn_rsqf(wave_sum(s[0]) * (1.f / DM) + NORM_EPS), __builtin_amdgcn_rsqf(wave_sum(s[1]) * (1.f / DM) + NORM_EPS)};
        float s2[2] = {0.f, 0.f};
#pragma unroll
        for (int q = 0; q < 2; ++q) { const size_t m = (size_t)m0 + (size_t)q * NGW;
#pragma unroll
            for (int j = 0; j < 4; ++j) { const f32x4 g = ((const f32x4*)g1 + lane)[64 * j]; xv[q][j] = xv[q][j] + ov[q][j] * rs[q] * g;
                if (XOB) { u32x2 w; w.x = cvtpk(xv[q][j].x, xv[q][j].y); w.y = cvtpk(xv[q][j].z, xv[q][j].w); __builtin_nontemporal_store(w, (u32x2*)((bf16_t*)xout_ + m * DM) + lane + 64 * j); }
                else __builtin_nontemporal_store(xv[q][j], (f32x4*)((float*)xout_ + m * DM) + lane + 64 * j);
                s2[q] += (xv[q][j].x * xv[q][j].x + xv[q][j].y * xv[q][j].y) + (xv[q][j].z * xv[q][j].z + xv[q][j].w * xv[q][j].w); } }
        if (hn) {
            const float r2[2] = {__builtin_amdgcn_rsqf(wave_sum(s2[0]) * (1.f / DM) + NORM_EPS), __builtin_amdgcn_rsqf(wave_sum(s2[1]) * (1.f / DM) + NORM_EPS)};
#pragma unroll
            for (int q = 0; q < 2; ++q) { const size_t m = (size_t)m0 + (size_t)q * NGW; u32x2* ho = (u32x2*)(hn + m * DM) + lane;
#pragma unroll
                for (int j = 0; j < 4; ++j) { const f32x4 g = ((const f32x4*)g2 + lane)[64 * j]; u32x2 w; w.x = cvtpk(xv[q][j].x * r2[q] * g.x, xv[q][j].y * r2[q] * g.y); w.y = cvtpk(xv[q][j].z * r2[q] * g.z, xv[q][j].w * r2[q] * g.w); ho[64 * j] = w; } }
        }
    }
}

__device__ __forceinline__ int crow(int r, int hi) { return (r & 3) + 8 * (r >> 2) + 4 * hi; }
typedef short v4i16_t __attribute__((ext_vector_type(4)));
__device__ __forceinline__ s16x4 vtr(const LAS unsigned char* p) { return __builtin_bit_cast(s16x4, __builtin_amdgcn_ds_read_tr16_b64_v4i16((LAS v4i16_t*)p)); }

template <int D, class BiasF>
__device__ __forceinline__ void attn_qk(const LAS unsigned char* Kb, const bf16x8 (&qr)[D / 16], float m_run, f32x16& p0, f32x16& p1, float& mx, int r32, int hi, const BiasF& biasf) {
    const LAS unsigned char* kb = Kb + hi * 1024 + r32 * 16;
    if (biasf.uniform()) {
        f32x16 ci; const float c = biasf.uval() - m_run;
#pragma unroll
        for (int r = 0; r < 16; ++r) ci[r] = c;
        p0 = __builtin_amdgcn_mfma_f32_32x32x16_bf16(*(const LAS bf16x8*)(kb), qr[0], ci, 0, 0, 0);
        p1 = __builtin_amdgcn_mfma_f32_32x32x16_bf16(*(const LAS bf16x8*)(kb + 512), qr[0], ci, 0, 0, 0);
    } else {
#pragma unroll
        for (int r = 0; r < 16; ++r) { p0[r] = biasf(crow(r, hi)) - m_run; p1[r] = biasf(crow(r, hi) + 32) - m_run; }
        p0 = __builtin_amdgcn_mfma_f32_32x32x16_bf16(*(const LAS bf16x8*)(kb), qr[0], p0, 0, 0, 0);
        p1 = __builtin_amdgcn_mfma_f32_32x32x16_bf16(*(const LAS bf16x8*)(kb + 512), qr[0], p1, 0, 0, 0);
    }
#pragma unroll
    for (int d0 = 1; d0 < D / 16; ++d0) {
        const bf16x8 b0 = *(const LAS bf16x8*)(kb + d0 * 2048);
        const bf16x8 b1 = *(const LAS bf16x8*)(kb + d0 * 2048 + 512);
        p0 = __builtin_amdgcn_mfma_f32_32x32x16_bf16(b0, qr[d0], p0, 0, 0, 0);
        p1 = __builtin_amdgcn_mfma_f32_32x32x16_bf16(b1, qr[d0], p1, 0, 0, 0);
    }
    float ma = fmaxf(fmaxf(p0[0], p0[1]), p1[0]), mb = fmaxf(fmaxf(p0[2], p0[3]), p1[1]);
    ma = fmaxf(fmaxf(ma, p1[2]), p1[3]);
#pragma unroll
    for (int r = 4; r < 16; r += 4) { ma = fmaxf(fmaxf(ma, p0[r]), p0[r + 1]); mb = fmaxf(fmaxf(mb, p0[r + 2]), p0[r + 3]); ma = fmaxf(fmaxf(ma, p1[r]), p1[r + 1]); mb = fmaxf(fmaxf(mb, p1[r + 2]), p1[r + 3]); }
    mx = fmaxf(ma, mb);
}
template <int D>
__device__ __forceinline__ void attn_pv(const LAS unsigned char* Vb, float& m_run, float& l_run, f32x16 (&o)[D / 32], f32x16& p0, f32x16& p1, float mx, LAS float* wsf, int r32, int hi, bool first) {
    mx = fmaxf(mx, __shfl_xor(mx, 32));
    float dl = 0.f;
    if (first) { m_run = mx; dl = mx; }
    else if (__any(mx > 8.0f)) {
        dl = fmaxf(mx, 0.f);
        const float alpha = fast_exp2(-dl);
        m_run += dl; l_run *= alpha;
        if (hi == 0) wsf[r32] = alpha;
        LDS_WAIT(); asm volatile("" ::: "memory");
#pragma unroll
        for (int r = 0; r < 16; ++r) { const float a = wsf[crow(r, hi)];
#pragma unroll
            for (int d = 0; d < D / 32; ++d) o[d][r] *= a; }
    }
    float ps = 0.f, ps2 = 0.f;
#pragma unroll
    for (int r = 0; r < 16; ++r) { p0[r] = fast_exp2(p0[r] - dl); p1[r] = fast_exp2(p1[r] - dl); ps += p0[r]; ps2 += p1[r]; }
    l_run += ps + ps2;
    u32x4 pw[4];
    pw[0] = (u32x4){cvtpk(p0[0], p0[1]), cvtpk(p0[2], p0[3]), cvtpk(p0[4], p0[5]), cvtpk(p0[6], p0[7])};
    pw[1] = (u32x4){cvtpk(p0[8], p0[9]), cvtpk(p0[10], p0[11]), cvtpk(p0[12], p0[13]), cvtpk(p0[14], p0[15])};
    pw[2] = (u32x4){cvtpk(p1[0], p1[1]), cvtpk(p1[2], p1[3]), cvtpk(p1[4], p1[5]), cvtpk(p1[6], p1[7])};
    pw[3] = (u32x4){cvtpk(p1[8], p1[9]), cvtpk(p1[10], p1[11]), cvtpk(p1[12], p1[13]), cvtpk(p1[14], p1[15])};
    const LAS unsigned char* vp = Vb + ((r32 >> 4) & 1) * 32 + (r32 & 3) * 8 + (4 * hi + ((r32 & 15) >> 2)) * 64;
#pragma unroll
    for (int d0 = 0; d0 < D / 32; ++d0) {
#pragma unroll
        for (int ks = 0; ks < 4; ++ks) {
            const s16x4 lo = vtr(vp + d0 * 4096 + ks * 1024), hh = vtr(vp + d0 * 4096 + ks * 1024 + 512);
            const bf16x8 vf = (bf16x8){lo[0], lo[1], lo[2], lo[3], hh[0], hh[1], hh[2], hh[3]};
            o[d0] = __builtin_amdgcn_mfma_f32_32x32x16_bf16(__builtin_bit_cast(bf16x8, pw[ks]), vf, o[d0], 0, 0, 0);
        }
    }
}
template <int D, class BiasF>
__device__ __forceinline__ void attn_tile(const LAS unsigned char* Kb, const LAS unsigned char* Vb, const bf16x8 (&qr)[D / 16], float& m_run, float& l_run, f32x16 (&o)[D / 32],
                                          LAS float* wsf, int r32, int hi, const BiasF& biasf, bool first) {
    f32x16 p0, p1; float mx;
    attn_qk<D>(Kb, qr, m_run, p0, p1, mx, r32, hi, biasf);
    attn_pv<D>(Vb, m_run, l_run, o, p0, p1, mx, wsf, r32, hi, first);
}
template <int ND>
__device__ __forceinline__ void attn_finish(float l_run, f32x16 (&o)[ND], LAS float* wsf, int r32, int hi) {
    const float l = l_run + __shfl_xor(l_run, 32);
    LDS_WAIT(); asm volatile("" ::: "memory");
    if (hi == 0) wsf[32 + r32] = 1.0f / l;
    LDS_WAIT(); asm volatile("" ::: "memory");
#pragma unroll
    for (int r = 0; r < 16; ++r) { const float a = wsf[32 + crow(r, hi)];
#pragma unroll
        for (int d = 0; d < ND; ++d) o[d][r] *= a; }
}

constexpr int ATT_GRP = 32768, ATT_K = 0, ATT_V = 16384, ATT_TB = 65536, ATT_WS = ATT_TB + 1024, ATT_OST = ATT_WS + 2048, ATT_LDS = ATT_OST + 8 * 4096;
static_assert(ATT_LDS <= RING_BYTES, "attention LDS");
struct ChunkBias {
    const LAS float* tb; int base; bool far; float farv;
    __device__ __forceinline__ bool uniform() const { return far; }
    __device__ __forceinline__ float uval() const { return farv; }
    __device__ __forceinline__ float operator()(int kin) const { int d = base - kin; d = d > 128 ? 128 : d; return tb[d + 63]; }
};
__device__ __forceinline__ void chunk_attention_head(const bf16_t* PQp, const bf16_t* PRp, bf16_t* Oout, int opitch, const float* relb, int b, int h, LAS unsigned char* lds, int tid) {
    const int lane = tid & 63, r32 = lane & 31, hi = lane >> 5; const int wid = __builtin_amdgcn_readfirstlane(tid >> 6);
    const int grp = wid >> 2, wg = wid & 3;
    LAS float* tb = (LAS float*)(lds + ATT_TB);
    LAS float* wsf = (LAS float*)(lds + ATT_WS) + wid * 64;
    LAS unsigned char* gl = lds + grp * ATT_GRP;
    if (tid < 192) tb[tid] = relb[h * 192 + tid] * LOG2E;
    const size_t rowbase = (size_t)b * SEQ;
    const bf16_t* Kh = PRp + rowbase * NPR + C_KA + h * 64; const bf16_t* Vh = PRp + rowbase * NPR + C_VA + h * 64;
    const bf16_t* ksrc = Kh + (size_t)lane * NPR + wg * 8;
    const bf16_t* vsrc = Vh + (size_t)(16 * wg + (lane >> 2)) * NPR + (lane & 3) * 8;
    const int kdst = wg * 1024 + lane * 16, vdst = wg * 1024 + lane * 16;
    __syncthreads();
    const float farv = tb[191];
    if (grp == 1) { __builtin_amdgcn_s_setprio(1); __syncthreads(); }
    for (int it = 0; it < 8; ++it) {
        const int u = 2 * it + grp, c0 = 2 * u, cw = c0 + (wg >> 1), qin = 32 * (wg & 1) + r32;
        const bf16_t* Qw = PQp + (rowbase + u * 128 + wg * 32) * NPQ + C_Q + h * 64;
        bf16_t* Ow = Oout + (rowbase + u * 128 + wg * 32) * opitch + h * 64;
        bf16x8 qr[4];
#pragma unroll
        for (int d0 = 0; d0 < 4; ++d0) qr[d0] = *(const bf16x8*)&Qw[(size_t)r32 * NPQ + d0 * 16 + hi * 8];
        float m_run = 0.f, l_run = 0.f; f32x16 o[2]; bool first = true;
#pragma unroll
        for (int r = 0; r < 16; ++r) { o[0][r] = 0.f; o[1][r] = 0.f; }
        u32x4 kA[2], vA[2], kB[2], vB[2];
#define TVALID(t) ((t) <= 9 && (c0 - 8 + (t)) >= 0)
#define TLOAD(K_, V_, t) do { if (TVALID(t)) { const size_t ro_ = (size_t)(c0 - 8 + (t)) * 64 * NPR; _Pragma("unroll") for (int j = 0; j < 2; ++j) { K_[j] = *(const u32x4*)(ksrc + ro_ + j * 32); V_[j] = *(const u32x4*)(vsrc + ro_ + j * 32); } } } while (0)
#define TWRITE(K_, V_, t) do { if (TVALID(t)) { _Pragma("unroll") for (int j = 0; j < 2; ++j) { *(LAS u32x4*)(gl + ATT_K + ((t) & 1) * 8192 + j * 4096 + kdst) = K_[j]; *(LAS u32x4*)(gl + ATT_V + ((t) & 1) * 8192 + j * 4096 + vdst) = V_[j]; } } } while (0)
#define TSTEP(t) do { const int kc_ = c0 - 8 + (t); const int dc_ = cw - kc_; const bool vis_ = (kc_ >= 0 && dc_ >= 0 && dc_ <= 8); f32x16 p0, p1; float mx_ = 0.f; \
            if (vis_) { ChunkBias bf{tb, qin + 64 * dc_, dc_ >= 3, farv}; attn_qk<64>(gl + ATT_K + ((t) & 1) * 8192, qr, m_run, p0, p1, mx_, r32, hi, bf); } \
            __syncthreads(); \
            if (vis_) { attn_pv<64>(gl + ATT_V + ((t) & 1) * 8192, m_run, l_run, o, p0, p1, mx_, wsf, r32, hi, first); first = false; } } while (0)
        TLOAD(kB, vB, 0); TWRITE(kB, vB, 0);
        TLOAD(kA, vA, 1);
        __syncthreads();
#pragma unroll 1
        for (int kk = 0; kk < 10; kk += 2) {
            TLOAD(kB, vB, kk + 2);
            TSTEP(kk);
            TWRITE(kA, vA, kk + 1);
            __syncthreads();
            TLOAD(kA, vA, kk + 3);
            TSTEP(kk + 1);
            TWRITE(kB, vB, kk + 2);
            __syncthreads();
        }
#undef TVALID
#undef TLOAD
#undef TWRITE
#undef TSTEP
        attn_finish<2>(l_run, o, wsf, r32, hi);
        LAS unsigned short* stg = (LAS unsigned short*)(lds + ATT_OST) + wid * 2048;
#pragma unroll
        for (int r = 0; r < 16; r += 1) { const int orow = crow(r, hi);
#pragma unroll
            for (int d0 = 0; d0 < 2; ++d0) stg[orow * 64 + d0 * 32 + r32] = (unsigned short)f2bf(o[d0][r]); }
        LDS_WAIT(); asm volatile("" ::: "memory");
#pragma unroll
        for (int i = 0; i < 4; ++i) { const int row = i * 8 + (lane >> 3), ch = lane & 7; const u32x4 v = *(const LAS u32x4*)(stg + row * 64 + ch * 8); *(u32x4*)(Ow + (size_t)row * opitch + ch * 8) = v; }
        LDS_WAIT(); asm volatile("" ::: "memory");
        __syncthreads();
    }
    if (grp == 0) __syncthreads(); else __builtin_amdgcn_s_setprio(0);
}

constexpr int AT2_BUF = 32768, AT2_TB = 65536, AT2_WS = AT2_TB + 1024, AT2_OST = AT2_WS + 2048, AT2_LDS = AT2_OST + 8 * 4096;
static_assert(AT2_LDS <= RING_BYTES, "attention LDS");
template <class BiasF>
__device__ __forceinline__ void attn2_scores(const LAS unsigned char* Kb, bool vis, const bf16x8 (&qr)[4], float m_run, f32x16& pa, f32x16& pb, int r32, int hi, const BiasF& bf) {
    if (vis) {
        const LAS unsigned char* kb = Kb + hi * 1024 + r32 * 16;
        if (bf.uniform()) {
            f32x16 ci; const float c = bf.uval() - m_run;
#pragma unroll
            for (int r = 0; r < 16; ++r) ci[r] = c;
            pa = __builtin_amdgcn_mfma_f32_32x32x16_bf16(*(const LAS bf16x8*)(kb), qr[0], ci, 0, 0, 0);
            pb = __builtin_amdgcn_mfma_f32_32x32x16_bf16(*(const LAS bf16x8*)(kb + 512), qr[0], ci, 0, 0, 0);
        } else {
#pragma unroll
            for (int r = 0; r < 16; ++r) { pa[r] = bf(crow(r, hi)) - m_run; pb[r] = bf(crow(r, hi) + 32) - m_run; }
            pa = __builtin_amdgcn_mfma_f32_32x32x16_bf16(*(const LAS bf16x8*)(kb), qr[0], pa, 0, 0, 0);
            pb = __builtin_amdgcn_mfma_f32_32x32x16_bf16(*(const LAS bf16x8*)(kb + 512), qr[0], pb, 0, 0, 0);
        }
#pragma unroll
        for (int d0 = 1; d0 < 4; ++d0) {
            pa = __builtin_amdgcn_mfma_f32_32x32x16_bf16(*(const LAS bf16x8*)(kb + d0 * 2048), qr[d0], pa, 0, 0, 0);
            pb = __builtin_amdgcn_mfma_f32_32x32x16_bf16(*(const LAS bf16x8*)(kb + d0 * 2048 + 512), qr[d0], pb, 0, 0, 0);
        }
    } else {
#pragma unroll
        for (int r = 0; r < 16; ++r) { pa[r] = -1e30f; pb[r] = -1e30f; }
    }
}
__device__ __forceinline__ void attn2_pv(const LAS unsigned char* Vb, float dl, float& ps, f32x16 (&o)[2], f32x16& pa, f32x16& pb, int r32, int hi) {
#pragma unroll
    for (int r = 0; r < 16; ++r) { pa[r] = fast_exp2(pa[r] - dl); pb[r] = fast_exp2(pb[r] - dl); ps += pa[r] + pb[r]; }
    const LAS unsigned char* vp = Vb + ((r32 >> 4) & 1) * 32 + (r32 & 3) * 8 + (4 * hi + ((r32 & 15) >> 2)) * 64;
#pragma unroll
    for (int ks = 0; ks < 4; ++ks) {
        const f32x16& pp = (ks < 2) ? pa : pb; const int b8 = (ks & 1) * 8;
        const bf16x8 pf = __builtin_bit_cast(bf16x8, (u32x4){cvtpk(pp[b8 + 0], pp[b8 + 1]), cvtpk(pp[b8 + 2], pp[b8 + 3]), cvtpk(pp[b8 + 4], pp[b8 + 5]), cvtpk(pp[b8 + 6], pp[b8 + 7])});
#pragma unroll
        for (int d0 = 0; d0 < 2; ++d0) {
            const s16x4 lo = vtr(vp + d0 * 4096 + ks * 1024), hh = vtr(vp + d0 * 4096 + ks * 1024 + 512);
            const bf16x8 vf = (bf16x8){lo[0], lo[1], lo[2], lo[3], hh[0], hh[1], hh[2], hh[3]};
            o[d0] = __builtin_amdgcn_mfma_f32_32x32x16_bf16(pf, vf, o[d0], 0, 0, 0);
        }
    }
}
__device__ __forceinline__ void chunk_attention_head2(const bf16_t* PQp, const bf16_t* PRp, bf16_t* Oout, int opitch, const float* relb, int b, int h, LAS unsigned char* lds, int tid) {
    const int lane = tid & 63, r32 = lane & 31, hi = lane >> 5; const int wid = __builtin_amdgcn_readfirstlane(tid >> 6);
    LAS float* tb = (LAS float*)(lds + AT2_TB);
    LAS float* wsf = (LAS float*)(lds + AT2_WS) + wid * 64;
    if (tid < 192) tb[tid] = relb[h * 192 + tid] * LOG2E;
    const size_t rowbase = (size_t)b * SEQ;
    const bf16_t* Kh = PRp + rowbase * NPR + C_KA + h * 64; const bf16_t* Vh = PRp + rowbase * NPR + C_VA + h * 64;
    const bf16_t* ksrc = Kh + (size_t)lane * NPR + wid * 8;
    const bf16_t* vsrc = Vh + (size_t)(16 * (wid & 3) + (lane >> 2)) * NPR + (wid >> 2) * 32 + (lane & 3) * 8;
    const int pdst = wid * 1024 + lane * 16;
    __syncthreads();
    const float farv = tb[191];
    for (int qb = 0; qb < 8; ++qb) {
        const int c0 = qb * 4, cw = c0 + (wid >> 1), qin = 32 * (wid & 1) + r32;
        const bf16_t* Qw = PQp + (rowbase + qb * 256 + wid * 32) * NPQ + C_Q + h * 64;
        bf16_t* Ow = Oout + (rowbase + qb * 256 + wid * 32) * opitch + h * 64;
        bf16x8 qr[4];
#pragma unroll
        for (int d0 = 0; d0 < 4; ++d0) qr[d0] = *(const bf16x8*)&Qw[(size_t)r32 * NPQ + d0 * 16 + hi * 8];
        float m_run = 0.f, l_run = 0.f; f32x16 o[2]; bool first = true;
#pragma unroll
        for (int r = 0; r < 16; ++r) { o[0][r] = 0.f; o[1][r] = 0.f; }
        u32x4 kA[2], vA[2];
#define SVALID(s_) ((s_) <= 5 && (c0 - 8 + 2 * (s_)) >= 0)
#define SLOAD(s_) do { if (SVALID(s_)) { const size_t ro_ = (size_t)(c0 - 8 + 2 * (s_)) * 64 * NPR; _Pragma("unroll") for (int j = 0; j < 2; ++j) { kA[j] = *(const u32x4*)(ksrc + ro_ + (size_t)j * 64 * NPR); vA[j] = *(const u32x4*)(vsrc + ro_ + (size_t)j * 64 * NPR); } } } while (0)
#define SWRITE(s_) do { if (SVALID(s_)) { LAS unsigned char* bb_ = lds + ((s_) & 1) * AT2_BUF; _Pragma("unroll") for (int j = 0; j < 2; ++j) { *(LAS u32x4*)(bb_ + j * 16384 + pdst) = kA[j]; *(LAS u32x4*)(bb_ + j * 16384 + 8192 + pdst) = vA[j]; } } } while (0)
        SLOAD(0); SWRITE(0);
        __syncthreads();
#pragma unroll 1
        for (int ss = 0; ss < 6; ++ss) {
            SLOAD(ss + 1);
            const int kcA = c0 - 8 + 2 * ss; const int dA = cw - kcA, dB = dA - 1;
            const bool vA_ = (kcA >= 0 && dA >= 0 && dA <= 8), vB_ = (kcA >= 0 && dB >= 0 && dB <= 8);
            if (vA_ || vB_) {
                const LAS unsigned char* bb = lds + (ss & 1) * AT2_BUF;
                f32x16 p0, p1, p2, p3;
                attn2_scores(bb, vA_, qr, m_run, p0, p1, r32, hi, ChunkBias{tb, qin + 64 * dA, dA >= 3, farv});
                attn2_scores(bb + 16384, vB_, qr, m_run, p2, p3, r32, hi, ChunkBias{tb, qin + 64 * dB, dB >= 3, farv});
                float ma = fmaxf(fmaxf(p0[0], p1[0]), p2[0]), mb = fmaxf(fmaxf(p0[1], p1[1]), p3[0]);
                mb = fmaxf(mb, fmaxf(p2[1], p3[1]));
#pragma unroll
                for (int r = 2; r < 16; r += 2) { ma = fmaxf(fmaxf(ma, p0[r]), p1[r]); mb = fmaxf(fmaxf(mb, p0[r + 1]), p1[r + 1]); ma = fmaxf(fmaxf(ma, p2[r]), p3[r]); mb = fmaxf(fmaxf(mb, p2[r + 1]), p3[r + 1]); }
                float mx = fmaxf(ma, mb);
                mx = fmaxf(mx, __shfl_xor(mx, 32));
                float dl = 0.f;
                if (first) { m_run = mx; dl = mx; first = false; }
                else if (__any(mx > 8.0f)) {
                    dl = fmaxf(mx, 0.f);
                    const float alpha = fast_exp2(-dl);
                    m_run += dl; l_run *= alpha;
                    if (hi == 0) wsf[r32] = alpha;
                    LDS_WAIT(); asm volatile("" ::: "memory");
#pragma unroll
                    for (int r = 0; r < 16; ++r) { const float a = wsf[crow(r, hi)]; o[0][r] *= a; o[1][r] *= a; }
                }
                float ps = 0.f;
                if (vA_) attn2_pv(bb + 8192, dl, ps, o, p0, p1, r32, hi);
                if (vB_) attn2_pv(bb + 24576, dl, ps, o, p2, p3, r32, hi);
                l_run += ps;
            }
            SWRITE(ss + 1);
            __syncthreads();
        }
#undef SVALID
#undef SLOAD
#undef SWRITE
        attn_finish<2>(l_run, o, wsf, r32, hi);
        LAS unsigned short* stg = (LAS unsigned short*)(lds + AT2_OST) + wid * 2048;
#pragma unroll
        for (int r = 0; r < 16; r += 1) { const int orow = crow(r, hi);
#pragma unroll
            for (int d0 = 0; d0 < 2; ++d0) stg[orow * 64 + d0 * 32 + r32] = (unsigned short)f2bf(o[d0][r]); }
        LDS_WAIT(); asm volatile("" ::: "memory");
#pragma unroll
        for (int i = 0; i < 4; ++i) { const int row = i * 8 + (lane >> 3), ch = lane & 7; const u32x4 v = *(const LAS u32x4*)(stg + row * 64 + ch * 8); *(u32x4*)(Ow + (size_t)row * opitch + ch * 8) = v; }
        LDS_WAIT(); asm volatile("" ::: "memory");
        __syncthreads();
    }
}

constexpr int A3_SLOT = 8192, A3_K = 0, A3_V = 3 * A3_SLOT, A3_WS = 6 * A3_SLOT, A3_TB = A3_WS + 2048, A3_OST = A3_TB + 4352, A3_LDS = A3_OST + 8 * 4096;
static_assert(A3_LDS <= RING_BYTES, "attention LDS");
__device__ __forceinline__ void glds16(const void* g, unsigned lds_base) {
    unsigned sv; asm volatile("s_mov_b32 %0, m0\n\ts_mov_b32 m0, %2\n\ts_nop 0\n\tglobal_load_lds_dwordx4 %1, off\n\ts_mov_b32 m0, %0" : "=&s"(sv) : "v"(g), "s"(lds_base) : "memory"); }
#define MFMA32(a, b, c) __builtin_amdgcn_mfma_f32_32x32x16_bf16(a, b, c, 0, 0, 0)
#define A3_SBAR() __builtin_amdgcn_sched_barrier(0)
#define A3_PIN(x) asm volatile("" : "+v"(x))
#define A3_WAIT_BAR(N) asm volatile("s_waitcnt vmcnt(" #N ") lgkmcnt(0)\n\ts_barrier" ::: "memory")
#define A3_MX3(a, b, c) __builtin_fmaxf(__builtin_fmaxf((a), (b)), (c))
__device__ __forceinline__ void a3_swap32(float& a, float& b) { asm volatile("s_nop 1\n\tv_permlane32_swap_b32 %0, %1\n\ts_nop 1" : "+v"(a), "+v"(b)); }
__device__ __forceinline__ float a3_rowmax(const f32x16& p0, const f32x16& p1) {
    float a = A3_MX3(p0[0], p0[1], p1[0]), b = A3_MX3(p0[2], p0[3], p1[1]); a = A3_MX3(a, p1[2], p1[3]);
#pragma unroll
    for (int r = 4; r < 16; r += 4) { a = A3_MX3(a, p0[r], p0[r + 1]); b = A3_MX3(b, p0[r + 2], p0[r + 3]); a = A3_MX3(a, p1[r], p1[r + 1]); b = A3_MX3(b, p1[r + 2], p1[r + 3]); }
    float m = __builtin_fmaxf(a, b), m2 = m; a3_swap32(m, m2);
    return __builtin_fmaxf(m, m2); }
__device__ __forceinline__ void a3_kload2(bf16x8* kf, const LAS unsigned char* kp, int d0) { kf[2 * d0] = *(const LAS bf16x8*)(kp + d0 * 2048); kf[2 * d0 + 1] = *(const LAS bf16x8*)(kp + d0 * 2048 + 512); }
__device__ __forceinline__ void chunk_attention_head3(const bf16_t* PQp, const bf16_t* PRp, bf16_t* Oout, int opitch, const float* relb, int b, int h, LAS unsigned char* lds, int tid) {
    const int lane = tid & 63, r32 = lane & 31, hi = lane >> 5; const int wid = __builtin_amdgcn_readfirstlane(tid >> 6);
    LAS float* tbx = (LAS float*)(lds + A3_TB);
    LAS float* wsf = (LAS float*)(lds + A3_WS) + wid * 64;
    __syncthreads();
    for (int i = tid; i < 1040; i += 512) { const int s = i / 260, m = i - 260 * s, n = m - s; float v = 0.f;
        if (n >= 0 && n <= 254) { int D = 191 - n; D = D > 128 ? 128 : D; v = (relb[h * 192 + D + 63] - relb[h * 192 + 191]) * LOG2E; }
        tbx[i] = v; }
    const float farv = relb[h * 192 + 191] * LOG2E;
    const size_t rowbase = (size_t)b * SEQ;
    const bf16_t* Kh = PRp + rowbase * NPR + C_KA + h * 64; const bf16_t* Vh = PRp + rowbase * NPR + C_VA + h * 64;
    const unsigned lds0 = (unsigned)(size_t)lds;
    const unsigned kdst = lds0 + A3_K + wid * 1024, vdst = lds0 + A3_V + wid * 1024;
    const LAS unsigned char* vp0 = lds + A3_V + ((lane >> 4) & 1) * 32 + (lane & 3) * 8 + (4 * hi + ((lane & 15) >> 2)) * 64;
    const LAS unsigned char* kp0 = lds + A3_K + hi * 1024 + r32 * 16;
    const int sgn = (r32 + 1) & 3;
    const LAS float* tbase = tbx + 260 * sgn + (191 - (32 * (wid & 1) + r32) + 4 * hi + sgn);
    __syncthreads();
    const bf16_t* Kl = Kh + (size_t)lane * NPR + wid * 8;
    const bf16_t* Vl = Vh + (size_t)(16 * (wid & 3) + (lane >> 2)) * NPR + (wid >> 2) * 32 + (lane & 3) * 8;
    int sl_prev = 2 * A3_SLOT, sl_cur = 0, sl_next = A3_SLOT;
    bf16x8 qr[4];
#pragma unroll 1
    for (int qb = 0; qb < 8; ++qb) {
        const int c0 = qb * 4, kstart = c0 > 8 ? c0 - 8 : 0, NT = c0 + 4 - kstart, dc0 = c0 + (wid >> 1) - kstart;
        const int knext = qb < 7 ? (c0 > 4 ? c0 - 4 : 0) : kstart + NT - 1;
        const bf16_t* Qw = PQp + (rowbase + qb * 256 + wid * 32) * NPQ + C_Q + h * 64;
        bf16_t* Ow = Oout + (rowbase + qb * 256 + wid * 32) * opitch + h * 64;
#define A3_KC(t) int t_ = (t); const int kc_ = t_ < NT ? kstart + t_ : (qb < 7 ? knext + (t_ - NT) : knext);
#define DMA_K(t, slot) do { A3_KC(t) glds16(Kl + (size_t)kc_ * 64 * NPR, (unsigned)__builtin_amdgcn_readfirstlane(kdst + (slot))); } while (0)
#define DMA_V(t, slot) do { A3_KC(t) glds16(Vl + (size_t)kc_ * 64 * NPR, (unsigned)__builtin_amdgcn_readfirstlane(vdst + (slot))); } while (0)
#define NEARADD(X0, X1, dc) do { const LAS float* tp_ = tbase - 64 * (dc); _Pragma("unroll") for (int g = 0; g < 4; ++g) { const f32x4 a_ = *(const LAS f32x4*)(tp_ + 8 * g), b_ = *(const LAS f32x4*)(tp_ + 32 + 8 * g); \
            X0[4 * g] += a_[0]; X0[4 * g + 1] += a_[1]; X0[4 * g + 2] += a_[2]; X0[4 * g + 3] += a_[3]; X1[4 * g] += b_[0]; X1[4 * g + 1] += b_[1]; X1[4 * g + 2] += b_[2]; X1[4 * g + 3] += b_[3]; } } while (0)
        if (qb == 0) { DMA_K(0, sl_cur); DMA_V(0, sl_cur); DMA_K(1, sl_next);
#pragma unroll
            for (int d0 = 0; d0 < 4; ++d0) qr[d0] = *(const bf16x8*)&Qw[(size_t)r32 * NPQ + d0 * 16 + hi * 8]; }
        float mhat = 0.f, l_reg = 0.f; f32x16 o[2];
#pragma unroll
        for (int r = 0; r < 16; ++r) { o[0][r] = 0.f; o[1][r] = 0.f; }
        f32x16 ci16;
#pragma unroll
        for (int r = 0; r < 16; ++r) ci16[r] = farv;
        A3_PIN(ci16);
        bool resc = false, first = true;
        f32x16 pA0, pA1, pB0, pB1; bf16x8 kf[8]; s16x4 vlo[8], vhi[8]; u32x4 pw0, pw1, pw2, pw3;
#define ROT() do { sl_prev = sl_cur; sl_cur = sl_next; sl_next = (sl_next == 2 * A3_SLOT) ? 0 : sl_next + A3_SLOT; } while (0)
#define EX(v) __builtin_amdgcn_exp2f(v)
#define RESC() do { if (resc) { _Pragma("unroll") for (int d_ = 0; d_ < 2; ++d_) _Pragma("unroll") for (int r = 0; r < 16; ++r) o[d_][r] *= wsf[crow(r, hi)]; } } while (0)
#define DECIDE(C0, C1, t) resc = false; \
        { const int dc_ = dc0 - (t); \
          if (dc_ >= 0 && dc_ <= 8) { if (dc_ <= 2) NEARADD(C0, C1, dc_); \
              const float rm = a3_rowmax(C0, C1); float dl = 0.f; bool mv_ = false; \
              if (first) { dl = rm; first = false; mv_ = true; } \
              else if (__builtin_expect(__any(rm > 8.0f), 0)) { dl = __builtin_fmaxf(rm, 0.f); const float f = __builtin_amdgcn_exp2f(-dl); l_reg *= f; if (hi == 0) wsf[r32] = f; resc = true; mv_ = true; } \
              if (mv_) { mhat += dl; const float cv_ = farv - mhat; \
                  _Pragma("unroll") for (int r = 0; r < 16; ++r) { C0[r] -= dl; C1[r] -= dl; ci16[r] = cv_; } A3_PIN(ci16); } } \
          else { _Pragma("unroll") for (int r = 0; r < 16; ++r) { C0[r] = -30000.f; C1[r] = -30000.f; } } }
        if (qb == 0) { DMA_K(2, sl_prev); A3_WAIT_BAR(3); }
#pragma unroll
        for (int d0 = 0; d0 < 4; ++d0) a3_kload2(kf, kp0 + sl_cur, d0);
        pA0 = MFMA32(kf[0], qr[0], ci16); pA1 = MFMA32(kf[1], qr[0], ci16); pA0 = MFMA32(kf[2], qr[1], pA0); pA1 = MFMA32(kf[3], qr[1], pA1);
        pA0 = MFMA32(kf[4], qr[2], pA0); pA1 = MFMA32(kf[5], qr[2], pA1); pA0 = MFMA32(kf[6], qr[3], pA0); pA1 = MFMA32(kf[7], qr[3], pA1);
        { DECIDE(pA0, pA1, 0)
#pragma unroll
          for (int r = 0; r < 16; ++r) { pA0[r] = EX(pA0[r]); pA1[r] = EX(pA1[r]); } }
        A3_WAIT_BAR(0);
        DMA_K(3, sl_cur); DMA_V(1, sl_next); ROT();
#pragma unroll
        for (int d0 = 0; d0 < 4; ++d0) a3_kload2(kf, kp0 + sl_cur, d0);
        A3_WAIT_BAR(2);
#define PKW(P, i) cvtpk(P[i], P[i + 1])
#define PAF(k) __builtin_bit_cast(bf16x8, pw##k)
#define VFR(i) (bf16x8){vlo[i][0], vlo[i][1], vlo[i][2], vlo[i][3], vhi[i][0], vhi[i][1], vhi[i][2], vhi[i][3]}
#define VRD(i) do { vlo[i] = vtr(vp_ + (((i) >> 2) * 4096 + ((i) & 3) * 1024)); vhi[i] = vtr(vp_ + (((i) >> 2) * 4096 + ((i) & 3) * 1024 + 512)); } while (0)
#define KRD(G, d0) do { if (G) { a3_kload2(kf, kp0 + sl_next, d0); A3_SBAR(); } } while (0)
#define GAPA(MF, a0, a1, a2, a3, W0, W1, PW) do { MF; sacc += a0; sacc += a1; sacc += a2; sacc += a3; W0; W1; A3_PIN(PW); A3_PIN(sacc); A3_SBAR(); } while (0)
#define GAPB(MF, X, i) do { MF; X[i] = EX(X[i]); X[i + 1] = EX(X[i + 1]); X[i + 2] = EX(X[i + 2]); X[i + 3] = EX(X[i + 3]); A3_PIN(X); A3_SBAR(); } while (0)
#define STEP(C0, C1, P0, P1, t, GD, GL) do { A3_SBAR(); \
        const LAS unsigned char* vp_ = vp0 + sl_prev; \
        VRD(0); A3_SBAR(); float sacc = P0[0] + P0[1]; \
                           GAPA(C0 = MFMA32(kf[0], qr[0], ci16),   P0[2], P0[3], P0[4], P0[5],     pw0[0] = PKW(P0, 0),  pw0[1] = PKW(P0, 2),  pw0); \
        VRD(4); A3_SBAR(); GAPA(C1 = MFMA32(kf[1], qr[0], ci16),   P0[6], P0[7], P0[8], P0[9],     pw0[2] = PKW(P0, 4),  pw0[3] = PKW(P0, 6),  pw0); \
        VRD(1); A3_SBAR(); GAPA(C0 = MFMA32(kf[2], qr[1], C0),    P0[10], P0[11], P0[12], P0[13], pw1[0] = PKW(P0, 8),  pw1[1] = PKW(P0, 10), pw1); \
        VRD(5); A3_SBAR(); GAPA(C1 = MFMA32(kf[3], qr[1], C1),    P0[14], P0[15], P1[0], P1[1],   pw1[2] = PKW(P0, 12), pw1[3] = PKW(P0, 14), pw1); \
        VRD(2); A3_SBAR(); GAPA(C0 = MFMA32(kf[4], qr[2], C0),    P1[2], P1[3], P1[4], P1[5],     pw2[0] = PKW(P1, 0),  pw2[1] = PKW(P1, 2),  pw2); \
        VRD(6); A3_SBAR(); GAPA(C1 = MFMA32(kf[5], qr[2], C1),    P1[6], P1[7], P1[8], P1[9],     pw2[2] = PKW(P1, 4),  pw2[3] = PKW(P1, 6),  pw2); \
        VRD(3); A3_SBAR(); GAPA(C0 = MFMA32(kf[6], qr[3], C0),    P1[10], P1[11], P1[12], P1[13], pw3[0] = PKW(P1, 8),  pw3[1] = PKW(P1, 10), pw3); \
        VRD(7); A3_SBAR(); GAPA(C1 = MFMA32(kf[7], qr[3], C1),    P1[14], P1[15], 0.f, 0.f,       pw3[2] = PKW(P1, 12), pw3[3] = PKW(P1, 14), pw3); \
        l_reg += sacc; \
        if (GD) { DMA_K((t) + 3, sl_cur); DMA_V((t) + 1, sl_next); } \
        DECIDE(C0, C1, t) \
        A3_SBAR(); \
        GAPB(o[0] = MFMA32(PAF(0), VFR(0), o[0]), C0, 0);              GAPB(o[1] = MFMA32(PAF(0), VFR(4), o[1]), C0, 4); \
        KRD(GL, 0); GAPB(o[0] = MFMA32(PAF(1), VFR(1), o[0]), C0, 8);  KRD(GL, 1); GAPB(o[1] = MFMA32(PAF(1), VFR(5), o[1]), C0, 12); \
        KRD(GL, 2); GAPB(o[0] = MFMA32(PAF(2), VFR(2), o[0]), C1, 0);  KRD(GL, 3); GAPB(o[1] = MFMA32(PAF(2), VFR(6), o[1]), C1, 4); \
        GAPB(o[0] = MFMA32(PAF(3), VFR(3), o[0]), C1, 8);              GAPB(o[1] = MFMA32(PAF(3), VFR(7), o[1]), C1, 12); \
        } while (0)
        int t = 1;
#pragma unroll 1
        for (; t + 1 < NT; t += 2) {
            STEP(pB0, pB1, pA0, pA1, t, true, true);     A3_WAIT_BAR(2); RESC(); ROT();
            STEP(pA0, pA1, pB0, pB1, t + 1, true, true); A3_WAIT_BAR(2); RESC(); ROT();
        }
        STEP(pB0, pB1, pA0, pA1, NT - 1, true, false);
        A3_WAIT_BAR(2); RESC();
        if (qb < 7) { const bf16_t* Qn = Qw + (size_t)256 * NPQ;
#pragma unroll
            for (int d0 = 0; d0 < 4; ++d0) qr[d0] = *(const bf16x8*)&Qn[(size_t)r32 * NPQ + d0 * 16 + hi * 8]; }
        { float sacc = pB0[0] + pB0[1];
#pragma unroll
          for (int r = 2; r < 16; ++r) sacc += pB0[r];
#pragma unroll
          for (int r = 0; r < 16; ++r) sacc += pB1[r];
          l_reg += sacc;
          pw0 = (u32x4){PKW(pB0, 0), PKW(pB0, 2), PKW(pB0, 4), PKW(pB0, 6)}; pw1 = (u32x4){PKW(pB0, 8), PKW(pB0, 10), PKW(pB0, 12), PKW(pB0, 14)};
          pw2 = (u32x4){PKW(pB1, 0), PKW(pB1, 2), PKW(pB1, 4), PKW(pB1, 6)}; pw3 = (u32x4){PKW(pB1, 8), PKW(pB1, 10), PKW(pB1, 12), PKW(pB1, 14)};
          const LAS unsigned char* vp_ = vp0 + sl_cur;
#pragma unroll
          for (int i = 0; i < 8; ++i) VRD(i);
          o[0] = MFMA32(PAF(0), VFR(0), o[0]); o[1] = MFMA32(PAF(0), VFR(4), o[1]); o[0] = MFMA32(PAF(1), VFR(1), o[0]); o[1] = MFMA32(PAF(1), VFR(5), o[1]);
          o[0] = MFMA32(PAF(2), VFR(2), o[0]); o[1] = MFMA32(PAF(2), VFR(6), o[1]); o[0] = MFMA32(PAF(3), VFR(3), o[0]); o[1] = MFMA32(PAF(3), VFR(7), o[1]); }
        { float l2 = l_reg; a3_swap32(l_reg, l2); l_reg += l2; }
        if (hi == 0) wsf[32 + r32] = l_reg;
        LDS_WAIT(); asm volatile("" ::: "memory");
        LAS unsigned short* stg = (LAS unsigned short*)(lds + A3_OST) + wid * 2048;
#pragma unroll
        for (int r = 0; r < 16; ++r) { const int orow = crow(r, hi); const float rl = __builtin_amdgcn_rcpf(wsf[32 + orow]);
#pragma unroll
            for (int d0 = 0; d0 < 2; ++d0) stg[orow * 64 + d0 * 32 + r32] = (unsigned short)f2bf(o[d0][r] * rl); }
        LDS_WAIT(); asm volatile("" ::: "memory");
#pragma unroll
        for (int i = 0; i < 4; ++i) { const int row = i * 8 + (lane >> 3), ch = lane & 7; const u32x4 v = *(const LAS u32x4*)(stg + row * 64 + ch * 8); *(u32x4*)(Ow + (size_t)row * opitch + ch * 8) = v; }
        ROT();
        asm volatile("s_waitcnt lgkmcnt(0)\n\ts_barrier" ::: "memory");
#undef A3_KC
#undef DMA_K
#undef DMA_V
#undef NEARADD
#undef ROT
#undef EX
#undef RESC
#undef DECIDE
#undef PKW
#undef PAF
#undef VFR
#undef VRD
#undef KRD
#undef GAPA
#undef GAPB
#undef STEP
    }
    asm volatile("s_waitcnt vmcnt(0)" ::: "memory");
}

constexpr int CA_K = 0, CA_V = 65536, CA_WS = 132096, CA_OST = CA_WS + 8 * 256;
static_assert(CA_WS >= MISC_OFF + 128 && CA_OST + 8 * 2048 <= LDS_BYTES, "CA LDS");
struct NoBias { __device__ __forceinline__ bool uniform() const { return true; } __device__ __forceinline__ float uval() const { return 0.f; } __device__ __forceinline__ float operator()(int) const { return 0.f; } };
__device__ __forceinline__ void cross_attention(const bf16_t* Q2, const bf16_t* KVM, bf16_t* O2, LAS unsigned char* lds, int vcu, int G, int tid) {
    const int lane = tid & 63, r32 = lane & 31, hi = lane >> 5; const int wid = __builtin_amdgcn_readfirstlane(tid >> 6);
    LAS float* wsf = (LAS float*)(lds + CA_WS) + wid * 64;
    for (int u = vcu; u < 256; u += G) {
        const int pair = u >> 2, b = pair >> 2, hh = pair & 3;
        const bf16_t* Kg = KVM + (size_t)b * MEMT * DM + hh * 128; const bf16_t* Vg = Kg + 512;
        __syncthreads();
#pragma unroll
        for (int i = 0; i < 8; ++i) {
            const int piece = tid + 512 * i, key = piece & 255, ch = piece >> 8;
            const u32x4 v = *(const u32x4*)(Kg + (size_t)key * DM + ch * 8);
            *(LAS u32x4*)(lds + CA_K + (key >> 6) * 16384 + ch * 1024 + (key & 63) * 16) = v;
        }
#pragma unroll
        for (int i = 0; i < 8; ++i) {
            const int piece = tid + 512 * i, pc = piece & 15, key = piece >> 4;
            const u32x4 v = *(const u32x4*)(Vg + (size_t)key * DM + pc * 8);
            *(LAS u32x4*)(lds + CA_V + (key >> 6) * 16384 + (pc >> 2) * 4096 + (key & 63) * 64 + (pc & 3) * 16) = v;
        }
        __syncthreads();
        for (int qq = 0; qq < 2; ++qq) {
            const int qblk = 2 * (u & 3) + qq;
            const size_t row0 = (size_t)b * SEQ + qblk * 256 + wid * 32;
            const bf16_t* Qw = Q2 + row0 * 512 + hh * 128;
            bf16x8 qr[8];
#pragma unroll
            for (int d0 = 0; d0 < 8; ++d0) qr[d0] = *(const bf16x8*)&Qw[(size_t)r32 * 512 + d0 * 16 + hi * 8];
            float m_run = 0.f, l_run = 0.f; f32x16 o[4];
#pragma unroll
            for (int d = 0; d < 4; ++d)
#pragma unroll
                for (int r = 0; r < 16; ++r) o[d][r] = 0.f;
            attn_tile<128>(lds + CA_K, lds + CA_V, qr, m_run, l_run, o, wsf, r32, hi, NoBias{}, true);
#pragma unroll 1
            for (int t = 1; t < 4; ++t) attn_tile<128>(lds + CA_K + t * 16384, lds + CA_V + t * 16384, qr, m_run, l_run, o, wsf, r32, hi, NoBias{}, false);
            attn_finish<4>(l_run, o, wsf, r32, hi);
            bf16_t* Ow = O2 + row0 * 512 + hh * 128;
            LAS unsigned short* stg = (LAS unsigned short*)(lds + CA_OST) + wid * 1024;
#pragma unroll
            for (int d0 = 0; d0 < 4; ++d0) {
#pragma unroll
                for (int r = 0; r < 16; ++r) stg[crow(r, hi) * 32 + r32] = (unsigned short)f2bf(o[d0][r]);
                LDS_WAIT(); asm volatile("" ::: "memory");
#pragma unroll
                for (int i = 0; i < 2; ++i) { const int row = i * 16 + (lane >> 2), ch = lane & 3; const u32x4 v = *(const LAS u32x4*)(stg + row * 32 + ch * 8); *(u32x4*)(Ow + (size_t)row * 512 + d0 * 32 + ch * 8) = v; }
                LDS_WAIT(); asm volatile("" ::: "memory");
            }
        }
    }
    __syncthreads();
}

constexpr int TC = 32;
constexpr int SC_ZR = 0, SC_ZK = 8192, SC_ZV = 16384, SC_WD = 24576, SC_AA = 32768, SC_GG = 40960, SC_KK = 49152, SC_YY = 57344;
constexpr int SC_AW = 65536;
constexpr int SC_AZ = SC_AW + 32 * 144;
constexpr int SC_AG = SC_AZ + 32 * 144;
constexpr int SC_BD = SC_AG + 32 * 336;
constexpr int SC_CARRY = SC_BD + 128;
constexpr int SC_END = SC_CARRY + 2 * 64 * 16;
static_assert(SC_END <= RING_BYTES, "scan LDS");

template <int CTRL> __device__ __forceinline__ float dpp_f(float x) { return __builtin_bit_cast(float, __builtin_amdgcn_update_dpp(__builtin_bit_cast(int, x), __builtin_bit_cast(int, x), CTRL, 0xF, 0xF, false)); }
__device__ __forceinline__ float red8(float x) { x += dpp_f<0xB1>(x); x += dpp_f<0x4E>(x); x += dpp_f<0x141>(x); return x; }
__device__ __forceinline__ float red16(float x) { x = red8(x); x += dpp_f<0x140>(x); return x; }

template <int NK>
__device__ __forceinline__ f32x16 lora_mma(const LAS unsigned char* Abase, int astride, const bf16x8* bfr, int r32, int hi) {
    f32x16 acc;
#pragma unroll
    for (int r = 0; r < 16; ++r) acc[r] = 0.f;
#pragma unroll
    for (int s = 0; s < NK; ++s) {
        const bf16x8 af = *(const LAS bf16x8*)(Abase + r32 * astride + (16 * s + 8 * hi) * 2);
        acc = __builtin_amdgcn_mfma_f32_32x32x16_bf16(af, bfr[s], acc, 0, 0, 0);
    }
    return acc;
}

__device__ __forceinline__ void lora_prep(const Args& a, const bf16_t* P, int vcu, int G, int tid) {
    bf16_t* LORA = (bf16_t*)(a.ws + WS_LORA); const float* mixp = a.in[I_SHIFT] + 3072;
    for (int gp = vcu * 512 + tid; gp < M * 36; gp += G * 512) {
        const int m = gp / 36, pc = gp - m * 36;
        const bf16_t* src = P + (size_t)m * NPR + C_L + pc * 8;
        const u32x4 cur = *(const u32x4*)src;
        u32x4 prv = (u32x4){0u, 0u, 0u, 0u};
        if ((m & (SEQ - 1)) != 0) prv = *(const u32x4*)(src - NPR);
        const f32x4 m0 = *(const f32x4*)(mixp + pc * 8), m1 = *(const f32x4*)(mixp + pc * 8 + 4);
        float z[8];
        { const unsigned cw_[4] = {cur.x, cur.y, cur.z, cur.w}, pw_[4] = {prv.x, prv.y, prv.z, prv.w}; const float mm[8] = {m0.x, m0.y, m0.z, m0.w, m1.x, m1.y, m1.z, m1.w};
#pragma unroll
          for (int e = 0; e < 4; ++e) { const float c0_ = bflo(cw_[e]), c1_ = bfhi(cw_[e]), p0_ = bflo(pw_[e]), p1_ = bfhi(pw_[e]);
              z[2 * e] = c0_ + (p0_ - c0_) * mm[2 * e]; z[2 * e + 1] = c1_ + (p1_ - c1_) * mm[2 * e + 1]; } }
        if (pc < 8) {
#pragma unroll
            for (int e = 0; e < 8; ++e) { const float ex = fast_exp2(2.f * LOG2E * z[e]); z[e] = 1.f - 2.f * __builtin_amdgcn_rcpf(ex + 1.f); }
        } else if (pc >= 16) {
#pragma unroll
            for (int e = 0; e < 8; ++e) z[e] = sigmoidf_(z[e]);
        }
        *(u32x4*)(LORA + (size_t)m * 288 + pc * 8) = (u32x4){cvtpk(z[0], z[1]), cvtpk(z[2], z[3]), cvtpk(z[4], z[5]), cvtpk(z[6], z[7])};
    }
}

constexpr int CK_RAW = 0;
constexpr int CK_CARRY = 12288;
constexpr int CK_CL = 13312, CK_AA = CK_CL + 8192, CK_GG = CK_AA + 8192, CK_YY = CK_GG + 8192;
constexpr int CK_BD = CK_YY + 8192;
constexpr int CK_GC = CK_BD + 128;
constexpr int CK_AW = CK_GC + 256, CK_AZ = CK_AW + 32 * 144, CK_AG = CK_AZ + 32 * 144;
constexpr int CK_RKK = CK_AW, CK_RBH = CK_RKK + 4608, CK_RKH = CK_RBH + 4608, CK_RRH = CK_RKH + 4608;
constexpr int CK_VKK = CK_AG + 32 * 336;
constexpr int CK_VVM = CK_VKK + 4096;
constexpr int CK_VBT = CK_VVM + 4096;
constexpr int CK_VKT = CK_VBT + 4096;
constexpr int CK_IP = CK_VKT + 4096;
constexpr int CK_IT = CK_IP + 2048, CK_ILK = CK_IT + 2048, CK_IMB = CK_ILK + 2048, CK_IMK = CK_IMB + 2048;
constexpr int CK_IG = CK_IMK + 2048;
constexpr int CK_WD = CK_IG + 4096;
constexpr int CK_WG = CK_WD + 64 * 144;
constexpr int CK_END = CK_WG + 64 * 336;
constexpr int CK_WI = 132096;
static_assert(CK_WI + 64 * 144 <= LDS_BYTES, "lora weights LDS");
static_assert(CK_RRH + 4608 <= CK_VKK && CK_END <= RING_BYTES && (CK_AW % 16) == 0 && (CK_VKK % 16) == 0, "chunked scan LDS");

__device__ __forceinline__ bf16x8 a_perm(const LAS unsigned char* img, int stride, int row, int col0, int hi) {
    const LAS unsigned char* p = img + row * stride + (col0 + 4 * hi) * 2;
    const s16x4 lo = *(const LAS s16x4*)p, hh = *(const LAS s16x4*)(p + 16);
    return (bf16x8){lo[0], lo[1], lo[2], lo[3], hh[0], hh[1], hh[2], hh[3]};
}
__device__ __forceinline__ bf16x8 b_tr(const LAS unsigned char* blk, int ks, int r32, int hi) {
    const LAS unsigned char* vp = blk + ((r32 >> 4) & 1) * 32 + (r32 & 3) * 8 + (4 * hi + ((r32 & 15) >> 2)) * 64 + ks * 1024;
    const s16x4 lo = vtr(vp), hh = vtr(vp + 512);
    return (bf16x8){lo[0], lo[1], lo[2], lo[3], hh[0], hh[1], hh[2], hh[3]};
}
__device__ __forceinline__ bf16x8 acc_frag(const f32x16& x, int s) {
    const u32x4 w = (u32x4){cvtpk(x[8 * s + 0], x[8 * s + 1]), cvtpk(x[8 * s + 2], x[8 * s + 3]), cvtpk(x[8 * s + 4], x[8 * s + 5]), cvtpk(x[8 * s + 6], x[8 * s + 7])};
    return __builtin_bit_cast(bf16x8, w);
}
__device__ __forceinline__ void img_store_t(LAS unsigned char* img, int col, int hi, const f32x16& x, float sgn) {
#pragma unroll
    for (int q = 0; q < 4; ++q) *(LAS u32x2*)(img + col * 64 + (8 * q + 4 * hi) * 2) = (u32x2){cvtpk(x[4 * q] * sgn, x[4 * q + 1] * sgn), cvtpk(x[4 * q + 2] * sgn, x[4 * q + 3] * sgn)};
}
#define MFMA32(a, b, c) __builtin_amdgcn_mfma_f32_32x32x16_bf16(a, b, c, 0, 0, 0)

constexpr int PK_HB = 39296;
constexpr int HB_RKK = 0, HB_RBH = 4608, HB_RKH = 9216, HB_RRH = 13824, HB_VKK = 18432, HB_VVM = 22528, HB_VBT = 26624, HB_VKT = 30720, HB_GC = 34816, HB_BD = 35072, HB_GG = 35200;
constexpr int PK_RAW = 2 * PK_HB, PK_CARRY = PK_RAW + 12288, PK_CL = PK_CARRY + 1024, PK_AA = PK_CL + 8192, PK_AW = PK_AA + 8192, PK_AZ = PK_AW + 4608, PK_AG = PK_AZ + 4608;
static_assert(PK_AG + 32 * 336 <= RING_BYTES, "pipelined scan LDS (ring part)");
constexpr int PK_CONST = PK_AG + 32 * 336;
static_assert(PK_CONST + 2048 <= RING_BYTES, "pipelined scan LDS (constants)");
constexpr int PK_YY = 132096;
static_assert(PK_YY + 2 * 8192 <= LDS_BYTES, "pipelined scan LDS (upper part)");
constexpr int NCH = SEQ / TC;

__device__ __forceinline__ f32x16 gram_tile(const bf16x8 (&af)[4], const bf16x8 (&bf)[4]) {
    f32x16 acc;
#pragma unroll
    for (int r = 0; r < 16; ++r) acc[r] = 0.f;
#pragma unroll
    for (int s = 0; s < 4; ++s) acc = MFMA32(af[s], bf[s], acc);
    return acc;
}
template <int MODE> __device__ __forceinline__ void tri_mask(f32x16& x, int r32, int hi, float sgn) {
#pragma unroll
    for (int r = 0; r < 16; ++r) { const int row = crow(r, hi); const bool keep = (MODE == 0) ? (r32 < row) : ((MODE == 1) ? (r32 > row) : (r32 >= row)); x[r] = keep ? x[r] * sgn : 0.f; }
}

__device__ __forceinline__ void rwkv_head_pipe(const Args& a, const bf16_t* PQp, const bf16_t* PRp, bf16_t* Yout, int ypitch, int b, int h, LAS unsigned char* lds, int tid) {
    const int lane = tid & 63, r32 = lane & 31, hi = lane >> 5; const int wid = __builtin_amdgcn_readfirstlane(tid >> 6);
    const size_t rowbase = (size_t)b * SEQ;
    if (wid < 6) {
        LAS float* CL = (LAS float*)(lds + PK_CL); LAS float* AA = (LAS float*)(lds + PK_AA);
        const int lnb = wid & 1, lch = h * 64 + 32 * lnb + r32;
        const float lbase = (wid < 2) ? a.in[I_DBASE][lch] : ((wid < 4) ? a.in[I_IBASE][lch] : 0.f);
        const int oc = tid & 7, tk = (tid >> 3) & 31, ch0 = h * 64 + 8 * oc;
        if (tid < 128) { const int v8 = tid >> 4, q = tid & 15; const float* srcv;
            switch (v8) { case 0: srcv = a.in[I_KNS]; break; case 1: srcv = a.in[I_KIS]; break; case 2: srcv = a.in[I_BONUS]; break; case 3: srcv = a.in[I_LNW]; break; case 4: srcv = a.in[I_LNB]; break;
                          case 5: srcv = a.in[I_SHIFT]; break; case 6: srcv = a.in[I_SHIFT] + 1024; break; default: srcv = a.in[I_SHIFT] + 2048; break; }
            *(LAS f32x4*)(lds + PK_CONST + v8 * 256 + q * 16) = *(const f32x4*)(srcv + h * 64 + 4 * q); }
        (void)ch0;
        f32x4 cvr[6];
        { const int cb = h * 64 + 8 * oc;
#pragma unroll
          for (int j = 0; j < 3; ++j) { cvr[2 * j] = *(const f32x4*)(a.in[I_SHIFT] + j * 1024 + cb); cvr[2 * j + 1] = *(const f32x4*)(a.in[I_SHIFT] + j * 1024 + cb + 4); } }
#define CV(v8, q) (*(const LAS f32x4*)(lds + PK_CONST + (v8) * 256 + oc * 32 + (q) * 16))
        bf16x8 bfr[10];
        { const bf16_t* up = (wid < 2) ? (const bf16_t*)(a.ws + WS_DUPT) + (size_t)lch * 64 : ((wid < 4) ? (const bf16_t*)(a.ws + WS_IUPT) + (size_t)lch * 64 : (const bf16_t*)(a.ws + WS_GUPT) + (size_t)lch * 160);
          if (wid < 4) {
#pragma unroll
              for (int s = 0; s < 4; ++s) bfr[s] = *(const bf16x8*)(up + 16 * s + 8 * hi);
#pragma unroll
              for (int s = 4; s < 10; ++s) bfr[s] = bfr[0];
          } else {
#pragma unroll
              for (int s = 0; s < 10; ++s) bfr[s] = *(const bf16x8*)(up + 16 * s + 8 * hi);
          } }
        const unsigned char* psrc[5]; unsigned pstride[5]; u32x4 pre[5];
        const bf16_t* LORA = (const bf16_t*)(a.ws + WS_LORA);
#pragma unroll
        for (int i = 0; i < 5; ++i) {
            const int p = tid + 384 * i; const int tl = p / 60, pc = p - tl * 60;
            if (pc < 8) { psrc[i] = (const unsigned char*)(PQp + (rowbase + tl) * NPQ + C_R + h * 64 + pc * 8); pstride[i] = NPQ * 2; }
            else if (pc < 24) { psrc[i] = (const unsigned char*)(PRp + (rowbase + tl) * NPR + (pc < 16 ? C_K : C_V) + h * 64 + (pc & 7) * 8); pstride[i] = NPR * 2; }
            else { psrc[i] = (const unsigned char*)(LORA + (rowbase + tl) * 288 + (pc - 24) * 8); pstride[i] = 288 * 2; }
            pre[i] = __builtin_nontemporal_load((const u32x4*)psrc[i]);
        }
        u32x4 po_g[2], po_v[2]; float po_bd[2];
#pragma unroll
        for (int i2 = 0; i2 < 2; ++i2) { po_g[i2] = (u32x4){0u, 0u, 0u, 0u}; po_v[i2] = po_g[i2]; po_bd[i2] = 0.f; }
#pragma unroll 1
        for (int it = 0; it < NCH + 2; ++it) {
            if (it >= 2 && wid >= 4) {
                const LAS unsigned char* hb = lds + (it & 1) * PK_HB;
#pragma unroll
                for (int i2 = 0; i2 < 2; ++i2) { const int tk2 = ((tid - 256) >> 3) + 16 * i2;
                    po_g[i2] = *(const LAS u32x4*)(hb + HB_GG + tk2 * 128 + oc * 16); po_v[i2] = *(const LAS u32x4*)(hb + HB_VVM + (oc >> 2) * 2048 + tk2 * 64 + (oc & 3) * 16);
                    po_bd[i2] = *(const LAS float*)(hb + HB_BD + tk2 * 4); }
            }
#ifdef X_DUPCOPY
            for (int rep_ = 0; rep_ < 2; ++rep_)
#endif
            if (it < NCH) {
#pragma unroll
                for (int i = 0; i < 5; ++i) {
                    const int p = tid + 384 * i; const int tl = p / 60, pc = p - tl * 60;
                    LAS unsigned char* dst;
                    if (pc < 24) dst = lds + PK_RAW + (tl * 24 + pc) * 16;
                    else if (pc < 32) dst = lds + PK_AW + tl * 144 + (pc - 24) * 16;
                    else if (pc < 40) dst = lds + PK_AZ + tl * 144 + (pc - 32) * 16;
                    else dst = lds + PK_AG + tl * 336 + (pc - 40) * 16;
                    *(LAS u32x4*)dst = pre[i];
                }
                if (it + 1 < NCH) {
#pragma unroll
                    for (int i = 0; i < 5; ++i) pre[i] = __builtin_nontemporal_load((const u32x4*)(psrc[i] + (size_t)((it + 1) * TC) * pstride[i]));
                }
            }
            __syncthreads();
#ifdef X_DUPJ2
            for (int rep_ = 0; rep_ < 2; ++rep_)
#endif
            if (it < NCH) {
                LAS unsigned char* hb = lds + (it & 1) * PK_HB;
                f32x16 acc;
                if (wid < 4) acc = lora_mma<4>(lds + (wid < 2 ? PK_AW : PK_AZ), 144, bfr, r32, hi);
                else acc = lora_mma<10>(lds + PK_AG, 336, bfr, r32, hi);
                if (wid < 2) {
                    float ew[16];
#pragma unroll
                    for (int r = 0; r < 16; ++r) ew[r] = (-0.6065306597126334f * LOG2E) * sigmoidf_(lbase + acc[r]);
                    float pf[16], tot[4], oth[4];
#pragma unroll
                    for (int m = 0; m < 4; ++m) { pf[4 * m] = ew[4 * m]; pf[4 * m + 1] = pf[4 * m] + ew[4 * m + 1]; pf[4 * m + 2] = pf[4 * m + 1] + ew[4 * m + 2]; pf[4 * m + 3] = pf[4 * m + 2] + ew[4 * m + 3]; tot[m] = pf[4 * m + 3]; }
#pragma unroll
                    for (int m = 0; m < 4; ++m) oth[m] = __shfl_xor(tot[m], 32);
                    float off = 0.f;
#pragma unroll
                    for (int m = 0; m < 4; ++m) { const float o_m = off + (hi ? oth[m] : 0.f);
#pragma unroll
                        for (int q = 0; q < 4; ++q) { const int r = 4 * m + q; CL[crow(r, hi) * 64 + 32 * lnb + r32] = fast_exp2(o_m + pf[r]); }
                        off += tot[m] + oth[m]; }
                } else if (wid < 4) {
#pragma unroll
                    for (int r = 0; r < 16; ++r) AA[crow(r, hi) * 64 + 32 * lnb + r32] = sigmoidf_(lbase + acc[r]);
                } else {
#pragma unroll
                    for (int r = 0; r < 16; ++r) *(LAS unsigned short*)(hb + HB_GG + crow(r, hi) * 128 + (32 * lnb + r32) * 2) = (unsigned short)f2bf(acc[r]);
                }
            }
            __syncthreads();
            if (it < NCH && wid < 4) {
                LAS unsigned char* hb = lds + (it & 1) * PK_HB;
                const LAS unsigned char* rc = lds + PK_RAW + (tk * 24 + oc) * 16;
                const u32x4 cr = *(const LAS u32x4*)rc, ck = *(const LAS u32x4*)(rc + 128), cv = *(const LAS u32x4*)(rc + 256);
                u32x4 pr, pk, pv;
                if (tk > 0) { pr = *(const LAS u32x4*)(rc - 384); pk = *(const LAS u32x4*)(rc - 256); pv = *(const LAS u32x4*)(rc - 128); }
                else if (it > 0) { const LAS unsigned char* cc = lds + PK_CARRY + ((it - 1) & 1) * 384 + oc * 16; pr = *(const LAS u32x4*)cc; pk = *(const LAS u32x4*)(cc + 128); pv = *(const LAS u32x4*)(cc + 256); }
                else { pr = (u32x4){0u, 0u, 0u, 0u}; pk = pr; pv = pr; }
                if (tk == TC - 1) { LAS unsigned char* cc = lds + PK_CARRY + (it & 1) * 384 + oc * 16; *(LAS u32x4*)cc = cr; *(LAS u32x4*)(cc + 128) = ck; *(LAS u32x4*)(cc + 256) = cv; }
                f32x4 rv[2], zk[2], vv[2];
#define LERP8(dst, c, p, mx) do { const f32x4 c0_ = (f32x4){bflo(c.x), bfhi(c.x), bflo(c.y), bfhi(c.y)}, c1_ = (f32x4){bflo(c.z), bfhi(c.z), bflo(c.w), bfhi(c.w)}; \
                    const f32x4 p0_ = (f32x4){bflo(p.x), bfhi(p.x), bflo(p.y), bfhi(p.y)}, p1_ = (f32x4){bflo(p.z), bfhi(p.z), bflo(p.w), bfhi(p.w)}; \
                    dst[0] = c0_ + (p0_ - c0_) * mx[0]; dst[1] = c1_ + (p1_ - c1_) * mx[1]; } while (0)
                { const f32x4 mr_[2] = {cvr[0], cvr[1]}, mk_[2] = {cvr[2], cvr[3]}, mv_[2] = {cvr[4], cvr[5]}; LERP8(rv, cr, pr, mr_); LERP8(zk, ck, pk, mk_); LERP8(vv, cv, pv, mv_); }
#undef LERP8
                f32x4 kkv[2], kp[2], bb[2]; float ss = 0.f, bd = 0.f;
                f32x4 e1[2], e0[2], em[2], ec[2];
#pragma unroll
                for (int q = 0; q < 2; ++q) {
                    const f32x4 av = *(LAS f32x4*)(AA + tk * 64 + 8 * oc + 4 * q);
                    const f32x4 cl = *(LAS f32x4*)(CL + tk * 64 + 8 * oc + 4 * q), clc = *(LAS f32x4*)(CL + 31 * 64 + 8 * oc + 4 * q);
                    f32x4 clp = (f32x4){1.f, 1.f, 1.f, 1.f}; if (tk > 0) clp = *(LAS f32x4*)(CL + (tk - 1) * 64 + 8 * oc + 4 * q);
                    kkv[q] = zk[q] * CV(0, q);
                    ss += (kkv[q].x * kkv[q].x + kkv[q].y * kkv[q].y) + (kkv[q].z * kkv[q].z + kkv[q].w * kkv[q].w);
                    kp[q] = zk[q] * (1.0f + (av - 1.0f) * CV(1, q));
                    bb[q] = av;
                    const f32x4 t3 = rv[q] * kp[q] * CV(2, q); bd += (t3.x + t3.y) + (t3.z + t3.w);
#pragma unroll
                    for (int e = 0; e < 4; ++e) { e1[q][e] = cl[e]; e0[q][e] = clp[e]; em[q][e] = __builtin_amdgcn_rcpf(cl[e]); ec[q][e] = clc[e] * em[q][e]; }
                }
                ss = red8(ss); bd = red8(bd);
                const float inv = __builtin_amdgcn_rsqf(fmaxf(ss, 1e-24f));
                if (oc == 0) *(LAS float*)(hb + HB_BD + tk * 4) = bd;
                if (tk == 31) { *(LAS f32x4*)(hb + HB_GC + 32 * oc) = e1[0]; *(LAS f32x4*)(hb + HB_GC + 32 * oc + 16) = e1[1]; }
                u32x4 wkk, wbh, wkh, wrh, wbt, wkt, wvv;
                {
                    const f32x4 k0 = kkv[0] * inv, k1 = kkv[1] * inv, b0 = k0 * bb[0], b1 = k1 * bb[1];
                    const f32x4 kkh0 = k0 * e0[0], kkh1 = k1 * e0[1], bh0 = b0 * em[0], bh1 = b1 * em[1], kh0 = kp[0] * em[0], kh1 = kp[1] * em[1];
                    const f32x4 rh0 = rv[0] * e1[0], rh1 = rv[1] * e1[1], bt0 = b0 * ec[0], bt1 = b1 * ec[1], kt0 = kp[0] * ec[0], kt1 = kp[1] * ec[1];
                    wkk = (u32x4){cvtpk(kkh0.x, kkh0.y), cvtpk(kkh0.z, kkh0.w), cvtpk(kkh1.x, kkh1.y), cvtpk(kkh1.z, kkh1.w)};
                    wbh = (u32x4){cvtpk(bh0.x, bh0.y), cvtpk(bh0.z, bh0.w), cvtpk(bh1.x, bh1.y), cvtpk(bh1.z, bh1.w)};
                    wkh = (u32x4){cvtpk(kh0.x, kh0.y), cvtpk(kh0.z, kh0.w), cvtpk(kh1.x, kh1.y), cvtpk(kh1.z, kh1.w)};
                    wrh = (u32x4){cvtpk(rh0.x, rh0.y), cvtpk(rh0.z, rh0.w), cvtpk(rh1.x, rh1.y), cvtpk(rh1.z, rh1.w)};
                    wbt = (u32x4){cvtpk(-bt0.x, -bt0.y), cvtpk(-bt0.z, -bt0.w), cvtpk(-bt1.x, -bt1.y), cvtpk(-bt1.z, -bt1.w)};
                    wkt = (u32x4){cvtpk(kt0.x, kt0.y), cvtpk(kt0.z, kt0.w), cvtpk(kt1.x, kt1.y), cvtpk(kt1.z, kt1.w)};
                    wvv = (u32x4){cvtpk(vv[0].x, vv[0].y), cvtpk(vv[0].z, vv[0].w), cvtpk(vv[1].x, vv[1].y), cvtpk(vv[1].z, vv[1].w)};
                }
                const int ro = tk * 144 + 16 * oc, vo = (oc >> 2) * 2048 + tk * 64 + (oc & 3) * 16;
                *(LAS u32x4*)(hb + HB_RKK + ro) = wkk; *(LAS u32x4*)(hb + HB_RBH + ro) = wbh; *(LAS u32x4*)(hb + HB_RKH + ro) = wkh; *(LAS u32x4*)(hb + HB_RRH + ro) = wrh;
                *(LAS u32x4*)(hb + HB_VKK + vo) = wkk; *(LAS u32x4*)(hb + HB_VVM + vo) = wvv; *(LAS u32x4*)(hb + HB_VBT + vo) = wbt; *(LAS u32x4*)(hb + HB_VKT + vo) = wkt;
            }
            if (it >= 2 && wid >= 4) {
                const LAS float* YY = (const LAS float*)(lds + PK_YY + (it & 1) * 8192); const int t0p = (it - 2) * TC;
#pragma unroll
                for (int i2 = 0; i2 < 2; ++i2) { const int tk2 = ((tid - 256) >> 3) + 16 * i2;
                    const f32x4 y0 = *(const LAS f32x4*)(YY + tk2 * 64 + 8 * oc), y1 = *(const LAS f32x4*)(YY + tk2 * 64 + 8 * oc + 4);
                    const u32x4 gw = po_g[i2], vw = po_v[i2];
                    const f32x4 g0 = (f32x4){bflo(gw.x), bfhi(gw.x), bflo(gw.y), bfhi(gw.y)}, g1 = (f32x4){bflo(gw.z), bfhi(gw.z), bflo(gw.w), bfhi(gw.w)};
                    const f32x4 v0 = (f32x4){bflo(vw.x), bfhi(vw.x), bflo(vw.y), bfhi(vw.y)}, v1 = (f32x4){bflo(vw.z), bfhi(vw.z), bflo(vw.w), bfhi(vw.w)};
                    float s1 = ((y0.x + y0.y) + (y0.z + y0.w)) + ((y1.x + y1.y) + (y1.z + y1.w)); s1 = red8(s1);
                    const float mu = s1 * (1.f / 64.f);
                    const f32x4 d0 = y0 - mu, d1 = y1 - mu;
                    float s2 = ((d0.x * d0.x + d0.y * d0.y) + (d0.z * d0.z + d0.w * d0.w)) + ((d1.x * d1.x + d1.y * d1.y) + (d1.z * d1.z + d1.w * d1.w)); s2 = red8(s2);
                    const float rstd = __builtin_amdgcn_rsqf(s2 * (1.f / 64.f) + GN_EPS);
                    const float bd = po_bd[i2];
                    const f32x4 o0 = ((d0 * rstd) * CV(3, 0) + CV(4, 0) + v0 * bd) * g0, o1 = ((d1 * rstd) * CV(3, 1) + CV(4, 1) + v1 * bd) * g1;
                    *(u32x4*)(Yout + (rowbase + t0p + tk2) * ypitch + h * 64 + 8 * oc) = (u32x4){cvtpk(o0.x, o0.y), cvtpk(o0.z, o0.w), cvtpk(o1.x, o1.y), cvtpk(o1.z, o1.w)}; }
            }
            __syncthreads();
        }
    } else {
        const int vb = wid - 6;
        __builtin_amdgcn_s_setprio(2);
        f32x16 St0, St1;
#pragma unroll
        for (int r = 0; r < 16; ++r) { St0[r] = 0.f; St1[r] = 0.f; }
#pragma unroll 1
        for (int it = 0; it < NCH + 2; ++it) {
            const bool act = (it >= 1) && (it <= NCH);
            const LAS unsigned char* hb = lds + ((it - 1) & 1) * PK_HB;
            f32x16 Pw, Qw, R, Rt, LkT, MbT, MkT, X;
#ifdef X_DUPGRAM
            for (int rep_ = 0; rep_ < 2; ++rep_)
#endif
            if (act) {
                bf16x8 fkk[4], fbh[4], fkh[4], frh[4];
#pragma unroll
                for (int s = 0; s < 4; ++s) { const int o = r32 * 144 + (16 * s + 8 * hi) * 2;
                    fkk[s] = *(const LAS bf16x8*)(hb + HB_RKK + o); fbh[s] = *(const LAS bf16x8*)(hb + HB_RBH + o); fkh[s] = *(const LAS bf16x8*)(hb + HB_RKH + o); frh[s] = *(const LAS bf16x8*)(hb + HB_RRH + o); }
                Pw = gram_tile(fkk, fbh);  tri_mask<0>(Pw, r32, hi, 1.f);
                Qw = gram_tile(fbh, fkk);  tri_mask<1>(Qw, r32, hi, 1.f);
                LkT = gram_tile(fkh, fkk);
                MbT = gram_tile(fbh, frh);
                MkT = gram_tile(fkh, frh);
            }
            __syncthreads();
            if (act) {
#pragma unroll
                for (int r = 0; r < 16; ++r) { const float id = (crow(r, hi) == r32) ? 1.f : 0.f; R[r] = id - Pw[r]; Rt[r] = id - Qw[r]; }
                tri_mask<1>(LkT, r32, hi, 1.f); tri_mask<2>(MbT, r32, hi, -1.f); tri_mask<2>(MkT, r32, hi, 1.f);
#pragma unroll
                for (int k = 0; k < 4; ++k) {
                    const bf16x8 p0 = acc_frag(Pw, 0), p1 = acc_frag(Pw, 1), q0 = acc_frag(Qw, 0), q1 = acc_frag(Qw, 1);
                    f32x16 Pn, Qn;
#pragma unroll
                    for (int r = 0; r < 16; ++r) { Pn[r] = 0.f; Qn[r] = 0.f; }
                    Pn = MFMA32(q0, p0, Pn); Pn = MFMA32(q1, p1, Pn);
                    Qn = MFMA32(p0, q0, Qn); Qn = MFMA32(p1, q1, Qn);
                    const bf16x8 r0 = acc_frag(R, 0), r1 = acc_frag(R, 1);
                    const bf16x8 n0 = acc_frag(Qn, 0), n1 = acc_frag(Qn, 1);
                    f32x16 Rn = R, Rtn = Rt;
                    Rn = MFMA32(n0, r0, Rn);  Rn = MFMA32(n1, r1, Rn);
                    Rtn = MFMA32(r0, n0, Rtn); Rtn = MFMA32(r1, n1, Rtn);
                    R = Rn; Rt = Rtn; Pw = Pn; Qw = Qn;
                }
                { const bf16x8 v0f = b_tr(hb + HB_VVM + vb * 2048, 0, r32, hi), v1f = b_tr(hb + HB_VVM + vb * 2048, 1, r32, hi);
#pragma unroll
                  for (int r = 0; r < 16; ++r) X[r] = 0.f;
                  X = MFMA32(acc_frag(LkT, 0), v0f, X); X = MFMA32(acc_frag(LkT, 1), v1f, X); }
            }
            __syncthreads();
            if (act) {
                const bf16x8 t0f = acc_frag(Rt, 0), t1f = acc_frag(Rt, 1);
                const bf16x8 v0f = b_tr(hb + HB_VVM + vb * 2048, 0, r32, hi), v1f = b_tr(hb + HB_VVM + vb * 2048, 1, r32, hi);
                f32x16 E;
#pragma unroll
                for (int r = 0; r < 16; ++r) E[r] = 0.f;
                E = MFMA32(t0f, acc_frag(X, 0), E); E = MFMA32(t1f, acc_frag(X, 1), E);
                f32x16 G0, G1;
#pragma unroll
                for (int r = 0; r < 16; ++r) { G0[r] = 0.f; G1[r] = 0.f; }
                G0 = MFMA32(b_tr(hb + HB_VKK, 0, r32, hi), t0f, G0);        G0 = MFMA32(b_tr(hb + HB_VKK, 1, r32, hi), t1f, G0);
                G1 = MFMA32(b_tr(hb + HB_VKK + 2048, 0, r32, hi), t0f, G1); G1 = MFMA32(b_tr(hb + HB_VKK + 2048, 1, r32, hi), t1f, G1);
                const bf16x8 s00 = acc_frag(St0, 0), s01 = acc_frag(St0, 1), s10 = acc_frag(St1, 0), s11 = acc_frag(St1, 1);
                E = MFMA32(acc_frag(G0, 0), s00, E); E = MFMA32(acc_frag(G0, 1), s01, E);
                E = MFMA32(acc_frag(G1, 0), s10, E); E = MFMA32(acc_frag(G1, 1), s11, E);
                const bf16x8 e0f = acc_frag(E, 0), e1f = acc_frag(E, 1);
                f32x16 Y;
#pragma unroll
                for (int r = 0; r < 16; ++r) Y[r] = 0.f;
                Y = MFMA32(a_perm(hb + HB_RRH, 144, r32, 0, hi), s00, Y);  Y = MFMA32(a_perm(hb + HB_RRH, 144, r32, 16, hi), s01, Y);
                Y = MFMA32(a_perm(hb + HB_RRH, 144, r32, 32, hi), s10, Y); Y = MFMA32(a_perm(hb + HB_RRH, 144, r32, 48, hi), s11, Y);
                Y = MFMA32(acc_frag(MbT, 0), e0f, Y); Y = MFMA32(acc_frag(MbT, 1), e1f, Y);
                Y = MFMA32(acc_frag(MkT, 0), v0f, Y); Y = MFMA32(acc_frag(MkT, 1), v1f, Y);
                LAS float* YY = (LAS float*)(lds + PK_YY + ((it - 1) & 1) * 8192);
#pragma unroll
                for (int r = 0; r < 16; ++r) YY[crow(r, hi) * 64 + 32 * vb + r32] = Y[r];
                const LAS float* GC = (const LAS float*)(hb + HB_GC);
#pragma unroll
                for (int q = 0; q < 4; ++q) { const f32x4 g0 = *(const LAS f32x4*)(GC + 8 * q + 4 * hi), g1 = *(const LAS f32x4*)(GC + 32 + 8 * q + 4 * hi);
#pragma unroll
                    for (int e = 0; e < 4; ++e) { St0[4 * q + e] *= g0[e]; St1[4 * q + e] *= g1[e]; } }
                St0 = MFMA32(b_tr(hb + HB_VBT, 0, r32, hi), e0f, St0);        St0 = MFMA32(b_tr(hb + HB_VBT, 1, r32, hi), e1f, St0);
                St0 = MFMA32(b_tr(hb + HB_VKT, 0, r32, hi), v0f, St0);        St0 = MFMA32(b_tr(hb + HB_VKT, 1, r32, hi), v1f, St0);
                St1 = MFMA32(b_tr(hb + HB_VBT + 2048, 0, r32, hi), e0f, St1); St1 = MFMA32(b_tr(hb + HB_VBT + 2048, 1, r32, hi), e1f, St1);
                St1 = MFMA32(b_tr(hb + HB_VKT + 2048, 0, r32, hi), v0f, St1); St1 = MFMA32(b_tr(hb + HB_VKT + 2048, 1, r32, hi), v1f, St1);
            }
            __syncthreads();
        }
        __builtin_amdgcn_s_setprio(0);
    }
#undef CV
    __syncthreads();
}

__global__ void __launch_bounds__(NWAVES * 64, 2) hyb_fwd(Args args) {
    extern __shared__ __attribute__((aligned(16))) unsigned char lds_raw[];
    LAS unsigned char* lds = (LAS unsigned char*)lds_raw;
    volatile LAS unsigned* MISC = (volatile LAS unsigned*)(lds + MISC_OFF);
    const int G = gridDim.x; const int bx = blockIdx.x; const int vcu = (G % 8 == 0) ? (bx % 8) * (G / 8) + bx / 8 : bx;
    unsigned char* ws = args.ws;
    for (int u = threadIdx.x; u < (LDS_BYTES - LDSCTL_OFF) / 4; u += NWAVES * 64) ((LAS unsigned*)(lds + LDSCTL_OFF))[u] = 0u;
    __syncthreads();
    XcdBarrier bar = xcd_barrier_post((unsigned*)(ws + WS_CTL) + CW_BAR, MISC + 8);
#define GRID_BAR() xcd_barrier(bar)
    bf16_t* PQ = (bf16_t*)(ws + WS_PQ); bf16_t* PR = (bf16_t*)(ws + WS_PR);
    bf16_t* XN = (bf16_t*)args.out; bf16_t* MIXED = (bf16_t*)((unsigned char*)args.out + 64 * MiB);
    bf16_t* O1 = (bf16_t*)(ws + WS_O1); bf16_t* XN2 = (bf16_t*)(ws + WS_XN2); bf16_t* Q2 = (bf16_t*)(ws + WS_Q2); bf16_t* O2 = (bf16_t*)(ws + WS_O2);
    bf16_t* ACT = (bf16_t*)(ws + WS_ACT); bf16_t* MN = (bf16_t*)(ws + WS_MN); bf16_t* KVM = (bf16_t*)(ws + WS_KVM);
    bf16_t* XB1 = (bf16_t*)(ws + WS_ACT); bf16_t* XB2 = (bf16_t*)(ws + WS_Q2);

#define FRESH_TID() int tid = threadIdx.x; asm volatile("" : "+v"(tid)); const int lane = tid & 63, wave = __builtin_amdgcn_readfirstlane(tid >> 6); (void)lane; (void)wave
#define GEMM(Aptr, Bptr, lda_, K_, Mrows, Ncols, pair_, ...) do { pg8::Gemm g{Aptr, (const bf16_t*)(Bptr), lda_, K_}; pg8::Order S; S.init(Mrows, Ncols, G, bx, pair_); \
        const pg8::Epi E{__VA_ARGS__}; pg8::gemm_phase(lds, g, S, E); } while (0)
    { FRESH_TID(); p0_prologue(args, lds, vcu, G, wave, lane); }
    GRID_BAR();
    GEMM(XN, ws + WS_W1T, DM, DM, M, NP, 0, pg8::EPI_STORE, PQ, NPQ, 0, C_Q / 256, C_Q / 256 + 4, QS_ATT, nullptr, 1, PR, NPR, NPQ / 256, 0);
    GRID_BAR();
    GEMM(MN, ws + WS_WKVT, DM, DM, MROWS, DM, 0, pg8::EPI_STORE, KVM, DM, 0, 0, 0, 1.f, nullptr, 0, nullptr, 0, 0, 0);
    if (G > 64) { if (bx >= 64) { FRESH_TID(); lora_prep(args, PR, bx - 64, G - 64, tid); } }
    else { FRESH_TID(); lora_prep(args, PR, bx, G, tid); }
    GRID_BAR();
    for (int u = vcu; u < NB * 16; u += G) { const int b = u >> 4, h = u & 15;
        { FRESH_TID(); rwkv_head_pipe(args, PQ, PR, PQ + C_R, NPQ, b, h, lds, tid); }
#if defined(ATT_2GROUP)
        { FRESH_TID(); chunk_attention_head(PQ, PR, PQ + C_Q, NPQ, args.in[I_RELB], b, h, lds, tid); }
#elif defined(ATT_8W2T)
        { FRESH_TID(); chunk_attention_head2(PQ, PR, PQ + C_Q, NPQ, args.in[I_RELB], b, h, lds, tid); }
#else
        { FRESH_TID(); chunk_attention_head3(PQ, PR, PQ + C_Q, NPQ, args.in[I_RELB], b, h, lds, tid); }
#endif
    }
    GRID_BAR();
    GEMM(XN, ws + WS_WGT, DM, DM, M, 2048, 0, pg8::EPI_SIGMOID, PR, NPR, C_GA, 0, 0, 1.f, nullptr, 0, nullptr, 0, 0, 0);
    GRID_BAR();
    GEMM(PQ, ws + WS_WABT, NPQ, DM, M, DM, 1, pg8::EPI_MIX, MIXED, DM, 0, 0, 0, 1.f, PR, 0, nullptr, 0, 0, NPR);
    GRID_BAR();
    GEMM(MIXED, ws + WS_WOUTT, DM, DM, M, DM, 0, pg8::EPI_STORE, O1, DM, 0, 0, 0, 1.f, nullptr, 0, nullptr, 0, 0, 0);
    GRID_BAR();
    { FRESH_TID(); norm_pass<false, true>(O1, args.in[I_X], XB1, args.in[I_GPOSTMIX], args.in[I_GPRECROSS], XN2, vcu, G, wave, lane); }
    GRID_BAR();
    GEMM(XN2, ws + WS_WQT, DM, DM, M, 512, 0, pg8::EPI_STORE, Q2, 512, 0, 0, 2, QS_MEM, nullptr, 0, nullptr, 0, 0, 0);
    GRID_BAR();
    { FRESH_TID(); cross_attention(Q2, KVM, O2, lds, vcu, G, tid); }
    GRID_BAR();
    GEMM(O2, ws + WS_WOT, 512, 512, M, DM, 0, pg8::EPI_STORE, O1, DM, 0, 0, 0, 1.f, nullptr, 0, nullptr, 0, 0, 0);
    GRID_BAR();
    { FRESH_TID(); norm_pass<true, true>(O1, XB1, XB2, args.in[I_GPOSTCROSS], args.in[I_GPREFFN], XN2, vcu, G, wave, lane); }
    GRID_BAR();
    GEMM(XN2, ws + WS_WF1T, DM, DM, M, 2 * FFH, 0, pg8::EPI_SWIGLU, ACT, FFH, 0, 0, 0, 1.f, nullptr, 0, nullptr, 0, 0, 0);
    GRID_BAR();
    GEMM(ACT, ws + WS_WF2T, FFH, FFH, M, DM, 0, pg8::EPI_STORE, O1, DM, 0, 0, 0, 1.f, nullptr, 0, nullptr, 0, 0, 0);
    GRID_BAR();
    { FRESH_TID(); norm_pass<true, false>(O1, XB2, args.out, args.in[I_GPOSTFFN], nullptr, nullptr, vcu, G, wave, lane); }
}

extern "C" void kernel_launch(void* const* d_in, const int* in_sizes, int n_in, void* d_out, int out_size, void* d_ws, size_t ws_size, hipStream_t stream) {
    static int grid = 0;
    if (grid == 0) {
        if (n_in != N_IN || in_sizes[0] != M * DM || out_size != M * DM || ws_size < WS_END) {
            fprintf(stderr, "kernel_launch: unexpected shapes (n_in %d, in0 %d, out %d, ws %zu); nothing launched\n", n_in, n_in > 0 ? in_sizes[0] : -1, out_size, ws_size); grid = -1; return; }
        int dev = 0, cus = 0;
        if (hipGetDevice(&dev) != hipSuccess || hipDeviceGetAttribute(&cus, hipDeviceAttributeMultiprocessorCount, dev) != hipSuccess) { grid = -1; return; }
        if (hipFuncSetAttribute((const void*)hyb_fwd, hipFuncAttributeMaxDynamicSharedMemorySize, LDS_BYTES) != hipSuccess) { fprintf(stderr, "kernel_launch: hipFuncSetAttribute failed\n"); grid = -1; return; }
        (void)hipGetLastError();
        grid = cus;
    }
    if (grid < 0) return;
    if (hipMemsetAsync((char*)d_ws + WS_CTL, 0, CTL_ZERO_BYTES, stream) != hipSuccess) return;
    Args a{};
    for (int i = 0; i < N_IN; ++i) a.in[i] = (const float*)d_in[i];
    a.out = (float*)d_out; a.ws = (unsigned char*)d_ws;
    hipLaunchKernelGGL(hyb_fwd, dim3(grid), dim3(NWAVES * 64), LDS_BYTES, stream, a);
}
```
